# Optimizing an MI355X kernel written in HIP

```python
import math
import jax
import jax.numpy as jnp
from jax import lax
import numpy as np

D_MODEL = 1024
BATCH = 8
SEQ = 4096
DEPTH = 2

CTX_LEN = 256
GRID_W = 64
N_MOD = 6
N_BRANCH = 4
BRANCH_W = 256

MLA_HEADS = 4
MLA_NOPE = 64
MLA_ROPE = 32
MLA_V = 64
MLA_Q_RANK = 192
MLA_KV_RANK = 128
ROPE_THETA = 10000.0

NA_HEADS = 4
NA_HEAD_DIM = 64
NA_WIN_R = 8
NA_WIN_C = 16

HY_WIDTH = 256
HY_ORDER = 2
HY_SHORT = 3
HY_BANDS = 16
HY_EMB = 2 * HY_BANDS + 1
HY_FFN = 64
HY_DECAY_MIN = 3.0
HY_DECAY_MAX = 15.0

LRU_WIDTH = 256
LRU_BLOCKS = 4
LRU_BLOCK_W = LRU_WIDTH // LRU_BLOCKS
LRU_CONV = 4
LRU_C = 8.0

N_EXPERTS = 64
TOP_K = 6
EXPERT_HIDDEN = 256
SHARED_HIDDEN = 256
ROUTED_SCALE = 2.5
MOE_BLOCK = 256

Q_BLOCK = 128
NORM_EPS = 1e-6

IN_SIZES = (MLA_Q_RANK, MLA_KV_RANK, MLA_ROPE, 3 * NA_HEADS * NA_HEAD_DIM, 3 * HY_WIDTH,
            LRU_WIDTH, LRU_WIDTH, N_BRANCH * D_MODEL)
IN_COLS = (MLA_Q_RANK + MLA_KV_RANK + MLA_ROPE + 3 * NA_HEADS * NA_HEAD_DIM + 3 * HY_WIDTH
           + 2 * LRU_WIDTH + N_BRANCH * D_MODEL)

kernel_name = 'hybrid_mla_na_hyena_rglru_moe_dit'


def rmsnorm(x, g):
    xf = x.astype(jnp.float32)
    y = xf * lax.rsqrt(jnp.mean(xf * xf, axis=-1, keepdims=True) + NORM_EPS)
    return (y * g.astype(jnp.float32)).astype(x.dtype)


def split_cols(z):
    parts = []
    start = 0
    for n in IN_SIZES:
        parts.append(z[..., start:start + n])
        start += n
    return parts


def depthwise_conv(x, w, b, left):
    n_taps = w.shape[0]
    length = x.shape[1]
    xp = jnp.pad(x, ((0, 0), (left, n_taps - 1 - left), (0, 0)))
    y = b
    for k in range(n_taps):
        y = y + xp[:, k:k + length] * w[k]
    return y


def axial_rope_tables(n_tok, rot_dim):
    t = jnp.arange(n_tok, dtype=jnp.int32)
    row = (t // GRID_W).astype(jnp.float32)
    col = (t % GRID_W).astype(jnp.float32)
    n_axis = rot_dim // 4
    inv_freq = ROPE_THETA ** (-jnp.arange(n_axis, dtype=jnp.float32) / n_axis)
    ang = jnp.concatenate([row[:, None] * inv_freq, col[:, None] * inv_freq], axis=-1)
    return jnp.cos(ang), jnp.sin(ang)


def apply_rope(x, cos, sin):
    half = x.shape[-1] // 2
    x1 = x[..., :half].astype(jnp.float32)
    x2 = x[..., half:].astype(jnp.float32)
    cb = cos[None, :, None, :]
    sb = sin[None, :, None, :]
    return jnp.concatenate([x1 * cb - x2 * sb, x1 * sb + x2 * cb], axis=-1).astype(x.dtype)


def blocked_attention(q, k, v, scale):
    b, n_q, h, dq = q.shape
    n_blk = n_q // Q_BLOCK
    qb = q.reshape(b, n_blk, Q_BLOCK, h, dq).transpose(1, 0, 2, 3, 4)

    def one_block(q_blk):
        s = jnp.einsum('bqhd,bkhd->bhqk', q_blk, k).astype(jnp.float32) * scale
        p = jax.nn.softmax(s, axis=-1).astype(v.dtype)
        return jnp.einsum('bhqk,bkhd->bqhd', p, v)

    o = lax.map(one_block, qb)
    return o.transpose(1, 0, 2, 3, 4).reshape(b, n_q, h * v.shape[-1])


def mla_queries(q_lat, lp, rope):
    b, n, _ = q_lat.shape
    q = (rmsnorm(q_lat, lp['mla_g_q']) @ lp['mla_w_uq']).reshape(b, n, MLA_HEADS, MLA_NOPE + MLA_ROPE)
    q_nope, q_rope = q[..., :MLA_NOPE], q[..., MLA_NOPE:]
    if rope is not None:
        q_rope = apply_rope(q_rope, rope[0], rope[1])
    return jnp.concatenate([q_nope, q_rope], axis=-1)


def mla_keys_values(kv_lat, k_rope, lp, rope):
    b, n, _ = kv_lat.shape
    kv = (rmsnorm(kv_lat, lp['mla_g_kv']) @ lp['mla_w_ukv']).reshape(b, n, MLA_HEADS, MLA_NOPE + MLA_V)
    k_nope, v = kv[..., :MLA_NOPE], kv[..., MLA_NOPE:]
    k_rope = k_rope[:, :, None, :]
    if rope is not None:
        k_rope = apply_rope(k_rope, rope[0], rope[1])
    k_rope = jnp.broadcast_to(k_rope, (b, n, MLA_HEADS, MLA_ROPE))
    return jnp.concatenate([k_nope, k_rope], axis=-1), v


def na_heads(z):
    b, n, _ = z.shape
    z5 = z.reshape(b, n, 3, NA_HEADS, NA_HEAD_DIM)
    return z5[:, :, 0], z5[:, :, 1], z5[:, :, 2]


def na_mixer(z_lat, z_ctx, rpb, with_ctx_out):
    q, k, v = na_heads(z_lat)
    q_c, k_c, v_c = na_heads(z_ctx)
    b, s = q.shape[0], q.shape[1]
    rows = s // GRID_W
    wr = min(NA_WIN_R, rows)
    n_loc = wr * GRID_W
    scale = NA_HEAD_DIM ** -0.5
    grid = (b, rows, GRID_W, NA_HEADS, NA_HEAD_DIM)
    q_g, k_g, v_g = q.reshape(grid), k.reshape(grid), v.reshape(grid)
    col = jnp.arange(GRID_W, dtype=jnp.int32)
    c0 = jnp.clip(col - NA_WIN_C // 2, 0, GRID_W - NA_WIN_C)
    in_win = (col[None, :] >= c0[:, None]) & (col[None, :] < c0[:, None] + NA_WIN_C)
    dc_idx = jnp.clip(col[None, :] - col[:, None], 1 - NA_WIN_C, NA_WIN_C - 1) + NA_WIN_C - 1
    rpb_f = rpb.astype(jnp.float32)

    def one_row(r):
        r0 = jnp.clip(r - wr // 2, 0, rows - wr)
        k_r = lax.dynamic_slice_in_dim(k_g, r0, wr, axis=1).reshape(b, n_loc, NA_HEADS, NA_HEAD_DIM)
        v_r = lax.dynamic_slice_in_dim(v_g, r0, wr, axis=1).reshape(b, n_loc, NA_HEADS, NA_HEAD_DIM)
        q_r = lax.dynamic_index_in_dim(q_g, r, axis=1, keepdims=False)
        dr_idx = r0 + jnp.arange(wr, dtype=jnp.int32) - r + NA_WIN_R - 1
        bias = rpb_f[:, dr_idx][:, :, dc_idx]
        bias = jnp.where(in_win[None, None], bias, -jnp.inf)
        bias = bias.transpose(0, 2, 1, 3).reshape(NA_HEADS, GRID_W, n_loc)
        s_loc = jnp.einsum('bqhd,bkhd->bhqk', q_r, k_r).astype(jnp.float32) * scale + bias
        s_ctx = jnp.einsum('bqhd,bchd->bhqc', q_r, k_c).astype(jnp.float32) * scale
        p = jax.nn.softmax(jnp.concatenate([s_loc, s_ctx], axis=-1), axis=-1).astype(v.dtype)
        return (jnp.einsum('bhqk,bkhd->bqhd', p[..., :n_loc], v_r)
                + jnp.einsum('bhqc,bchd->bqhd', p[..., n_loc:], v_c))

    o = lax.map(one_row, jnp.arange(rows, dtype=jnp.int32))
    y_lat = o.transpose(1, 0, 2, 3, 4).reshape(b, s, NA_HEADS * NA_HEAD_DIM)
    y_ctx = blocked_attention(q_c, k_c, v_c, scale) if with_ctx_out else None
    return y_lat, y_ctx


def hyena_pos_features(length):
    t = jnp.linspace(0.0, 1.0, length, dtype=jnp.float32)[:, None]
    w = 2.0 * math.pi * jnp.arange(length, dtype=jnp.float32)[:, None] / length
    f = jnp.linspace(1e-4, HY_BANDS - 1, HY_BANDS, dtype=jnp.float32)[None, :]
    z = w * f
    return jnp.concatenate([t, jnp.cos(z), -jnp.sin(z)], axis=-1)


def hyena_filter_spectra(length, lp):
    f32 = jnp.float32
    feats = hyena_pos_features(length)
    h = jnp.sin(feats @ lp['hy_w1'].astype(f32) + lp['hy_b1'].astype(f32))
    h = jnp.sin(h @ lp['hy_w2'].astype(f32) + lp['hy_b2'].astype(f32))
    h = (h @ lp['hy_w3'].astype(f32)).reshape(length, HY_ORDER, 2, HY_WIDTH)
    lag = jnp.linspace(0.0, 1.0, length, dtype=f32)[:, None, None, None]
    h = h * jnp.exp(-lag * jnp.abs(lp['hy_decay'].astype(f32))[None])
    h = h.transpose(1, 2, 0, 3)
    taps = jnp.concatenate([h[:, 0], jnp.zeros((HY_ORDER, 1, HY_WIDTH), f32), h[:, 1, :0:-1]], axis=1)
    return jnp.fft.rfft(taps, axis=1)


def fft_long_conv(u, taps_f):
    length = u.shape[1]
    u_f = jnp.fft.rfft(u, n=2 * length, axis=1)
    return jnp.fft.irfft(u_f * taps_f[None], n=2 * length, axis=1)[:, :length]


def hyena_seq(z, lp):
    zc = depthwise_conv(z, lp['hy_short_w'], lp['hy_short_b'], HY_SHORT // 2).astype(jnp.float32)
    v, x1, x2 = jnp.split(zc, 3, axis=-1)
    taps_f = hyena_filter_spectra(z.shape[1], lp)
    bias = lp['hy_bias'].astype(jnp.float32)
    y = v
    for n, gate in enumerate((x1, x2)):
        y = gate * (fft_long_conv(y, taps_f[n]) + y * bias[n])
    return y.astype(z.dtype)


def linear_scan(a, b, h0, reverse):
    def combine(left, right):
        return left[0] * right[0], right[0] * left[1] + right[1]
    a_cum, b_cum = lax.associative_scan(combine, (a, b), axis=1, reverse=reverse)
    return a_cum * h0[:, None, :] + b_cum


def rglru_dir(u, h0, conv_w, conv_b, wa, ba, wx, bx, lam, reverse):
    f32 = jnp.float32
    x = depthwise_conv(u, conv_w, conv_b, 0 if reverse else LRU_CONV - 1)
    b, length, w = x.shape
    xf = x.astype(f32)
    xb = xf.reshape(b, length, LRU_BLOCKS, LRU_BLOCK_W)
    r = jax.nn.sigmoid(jnp.einsum('blnc,ncd->blnd', xb, wa.astype(f32)).reshape(b, length, w) + ba.astype(f32))
    i = jax.nn.sigmoid(jnp.einsum('blnc,ncd->blnd', xb, wx.astype(f32)).reshape(b, length, w) + bx.astype(f32))
    log_a = -LRU_C * r * jax.nn.softplus(-lam.astype(f32))
    a = jnp.exp(log_a)
    bt = jnp.sqrt(-jnp.expm1(2.0 * log_a)) * (i * xf)
    h = linear_scan(a, bt, h0, reverse)
    final = h[:, 0] if reverse else h[:, -1]
    return h, final


def lru_mixer(u_lat, g_lat, u_ctx, g_ctx, lp, with_ctx_out):
    b = u_lat.shape[0]
    y_lat = 0.0
    y_ctx = 0.0
    for d, rev in enumerate((False, True)):
        prm = (lp['lru_conv_w'][d], lp['lru_conv_b'][d], lp['lru_wa'][d], lp['lru_ba'][d],
               lp['lru_wx'][d], lp['lru_bx'][d], lp['lru_lambda'][d])
        h_ctx, ctx_final = rglru_dir(u_ctx, jnp.zeros((b, LRU_WIDTH), jnp.float32), *prm, rev)
        h_lat, _ = rglru_dir(u_lat, ctx_final, *prm, rev)
        y_lat = y_lat + h_lat
        y_ctx = y_ctx + h_ctx
    out_lat = (y_lat * jax.nn.gelu(g_lat.astype(jnp.float32))).astype(u_lat.dtype)
    out_ctx = (y_ctx * jax.nn.gelu(g_ctx.astype(jnp.float32))).astype(u_ctx.dtype) if with_ctx_out else None
    return out_lat, out_ctx


def merge_branches(branches, gate_cols, w_branch, w_out):
    b, n, _ = gate_cols.shape
    gates = jax.nn.sigmoid(gate_cols.astype(jnp.float32)).reshape(b, n, N_BRANCH, D_MODEL)
    acc = 0.0
    for k, br in enumerate(branches):
        acc = acc + gates[:, :, k] * (br @ w_branch[k]).astype(jnp.float32)
    return acc.astype(gate_cols.dtype) @ w_out


def swiglu(h, w_gate, w_up, w_down):
    return (jax.nn.silu(h @ w_gate) * (h @ w_up)) @ w_down


def routed_experts(h, idx, wts, w_gate, w_up, w_down):
    f32 = jnp.float32
    t, d = h.shape
    e_count = w_gate.shape[0]
    m = t * TOP_K
    flat_e = idx.reshape(m).astype(jnp.int32)
    flat_tok = jnp.repeat(jnp.arange(t, dtype=jnp.int32), TOP_K)
    flat_w = wts.reshape(m)
    order = jnp.argsort(flat_e)
    e_sorted = flat_e[order]
    counts = jnp.bincount(flat_e, length=e_count)
    starts = jnp.cumsum(counts) - counts
    padded = (counts + MOE_BLOCK - 1) // MOE_BLOCK * MOE_BLOCK
    p_ends = jnp.cumsum(padded)
    p_starts = p_ends - padded
    dest = p_starts[e_sorted] + jnp.arange(m, dtype=jnp.int32) - starts[e_sorted]
    n_blocks = (m + e_count * (MOE_BLOCK - 1) + MOE_BLOCK - 1) // MOE_BLOCK
    n_rows = n_blocks * MOE_BLOCK
    row_tok = jnp.full((n_rows,), t, jnp.int32).at[dest].set(flat_tok[order])
    row_w = jnp.zeros((n_rows,), f32).at[dest].set(flat_w[order].astype(f32))
    block_e = jnp.minimum(jnp.searchsorted(p_ends, jnp.arange(n_blocks, dtype=jnp.int32) * MOE_BLOCK,
                                           side='right'), e_count - 1).astype(jnp.int32)
    h_pad = jnp.concatenate([h, jnp.zeros((1, d), h.dtype)], axis=0)

    def step(acc, blk):
        e, rows, w = blk
        xb = h_pad[rows]
        hid = jax.nn.silu(xb @ w_gate[e]) * (xb @ w_up[e])
        y = (hid @ w_down[e]).astype(f32) * w[:, None]
        return acc.at[rows].add(y), None

    acc, _ = lax.scan(step, jnp.zeros((t + 1, d), f32),
                      (block_e, row_tok.reshape(n_blocks, MOE_BLOCK), row_w.reshape(n_blocks, MOE_BLOCK)))
    return acc[:t].astype(h.dtype)


def moe_ffn(h, lp):
    scores = jax.nn.sigmoid((h @ lp['router_w']).astype(jnp.float32))
    _, idx = lax.top_k(scores + lp['router_bias'].astype(jnp.float32), TOP_K)
    sel = jnp.take_along_axis(scores, idx, axis=-1)
    wts = sel / jnp.sum(sel, axis=-1, keepdims=True) * ROUTED_SCALE
    routed = routed_experts(h, idx, wts, lp['exp_w_gate'], lp['exp_w_up'], lp['exp_w_down'])
    shared = swiglu(h, lp['sh_w_gate'], lp['sh_w_up'], lp['sh_w_down'])
    return routed + shared


def mixer(h, hc, lp, rope, with_ctx_out):
    b, s, _ = h.shape
    n_ctx = hc.shape[1]
    q_l, kv_l, kr_l, na_l, hy_l, lu_l, lg_l, gt_l = split_cols(h @ lp['w_in'])
    q_c, kv_c, kr_c, na_c, hy_c, lu_c, lg_c, gt_c = split_cols(hc @ lp['w_in'])
    mla_scale = (MLA_NOPE + MLA_ROPE) ** -0.5
    k_lat, v_lat = mla_keys_values(kv_l, kr_l, lp, rope)
    k_ctx, v_ctx = mla_keys_values(kv_c, kr_c, lp, None)
    a_l = blocked_attention(mla_queries(q_l, lp, rope), jnp.concatenate([k_lat, k_ctx], axis=1),
                            jnp.concatenate([v_lat, v_ctx], axis=1), mla_scale)
    b_l, b_c = na_mixer(na_l, na_c, lp['na_rpb'], with_ctx_out)
    c_l = hyena_seq(hy_l, lp)
    d_l, d_c = lru_mixer(lu_l, lg_l, lu_c, lg_c, lp, with_ctx_out)
    y = merge_branches((a_l, b_l, c_l, d_l), gt_l, lp['w_branch'], lp['w_out'])
    y_c = None
    if with_ctx_out:
        a_c = blocked_attention(mla_queries(q_c, lp, None), k_ctx, v_ctx, mla_scale)
        c_c = hyena_seq(hy_c, lp)
        y_c = merge_branches((a_c, b_c, c_c, d_c), gt_c, lp['w_branch'], lp['w_out'])
    return y, y_c


def layer(x, xc, c, c_ctx, lp, rope, with_ctx_out):
    b, s, d = x.shape
    n_ctx = xc.shape[1]
    mod = (jax.nn.silu(c) @ lp['w_mod'] + lp['b_mod'])[:, None, :]
    mod_c = jax.nn.silu(c_ctx) @ lp['w_mod'] + lp['b_mod']
    sh1, sc1, g1, sh2, sc2, g2 = jnp.split(mod, N_MOD, axis=-1)
    csh1, csc1, cg1, csh2, csc2, cg2 = jnp.split(mod_c, N_MOD, axis=-1)
    h = rmsnorm(x, lp['g_norm1']) * (1.0 + sc1) + sh1
    hc = rmsnorm(xc, lp['g_norm1']) * (1.0 + csc1) + csh1
    y, y_c = mixer(h, hc, lp, rope, with_ctx_out)
    x = x + g1 * y
    h2 = (rmsnorm(x, lp['g_norm2']) * (1.0 + sc2) + sh2).reshape(b * s, d)
    if with_ctx_out:
        xc = xc + cg1 * y_c
        hc2 = (rmsnorm(xc, lp['g_norm2']) * (1.0 + csc2) + csh2).reshape(b * n_ctx, d)
        f = moe_ffn(jnp.concatenate([h2, hc2], axis=0), lp)
        x = x + g2 * f[:b * s].reshape(b, s, d)
        xc = xc + cg2 * f[b * s:].reshape(b, n_ctx, d)
    else:
        x = x + g2 * moe_ffn(h2, lp).reshape(b, s, d)
    return x, xc


def setup_inputs(seed: int = 0) -> dict:
    key = jax.random.key(seed)
    keys = iter(jax.random.split(key, 64))
    f32 = jnp.float32
    L, D = DEPTH, D_MODEL

    def nrm(shape, scale):
        return jax.random.normal(next(keys), shape, f32) * scale

    def gain(shape):
        return 1.0 + nrm(shape, 0.05)

    u = jax.random.uniform(next(keys), (L, 2, LRU_WIDTH), f32, 0.9, 0.999)
    a0 = u ** (1.0 / LRU_C)
    lru_lambda = jnp.log(a0) - jnp.log1p(-a0)
    hy_decay = jax.random.uniform(next(keys), (L, HY_ORDER, 2, HY_WIDTH), f32, HY_DECAY_MIN, HY_DECAY_MAX)
    return {
        'x': nrm((BATCH, SEQ, D), 1.0),
        'c': nrm((BATCH, D), 1.0),
        'ctx': nrm((BATCH, CTX_LEN, D), 1.0),
        'c_ctx': nrm((D,), 1.0),
        'w_mod': nrm((L, D, N_MOD * D), 0.5 * D ** -0.5),
        'b_mod': nrm((L, N_MOD * D), 0.02),
        'g_norm1': gain((L, D)),
        'g_norm2': gain((L, D)),
        'w_in': nrm((L, D, IN_COLS), D ** -0.5),
        'mla_g_q': gain((L, MLA_Q_RANK)),
        'mla_w_uq': nrm((L, MLA_Q_RANK, MLA_HEADS * (MLA_NOPE + MLA_ROPE)), MLA_Q_RANK ** -0.5),
        'mla_g_kv': gain((L, MLA_KV_RANK)),
        'mla_w_ukv': nrm((L, MLA_KV_RANK, MLA_HEADS * (MLA_NOPE + MLA_V)), MLA_KV_RANK ** -0.5),
        'na_rpb': nrm((L, NA_HEADS, 2 * NA_WIN_R - 1, 2 * NA_WIN_C - 1), 0.1),
        'hy_short_w': nrm((L, HY_SHORT, 3 * HY_WIDTH), HY_SHORT ** -0.5),
        'hy_short_b': nrm((L, 3 * HY_WIDTH), 0.02),
        'hy_w1': nrm((L, HY_EMB, HY_FFN), HY_EMB ** -0.5),
        'hy_b1': nrm((L, HY_FFN), 0.5),
        'hy_w2': nrm((L, HY_FFN, HY_FFN), HY_FFN ** -0.5),
        'hy_b2': nrm((L, HY_FFN), 0.5),
        'hy_w3': nrm((L, HY_FFN, HY_ORDER * 2 * HY_WIDTH), 0.05 * HY_FFN ** -0.5),
        'hy_decay': hy_decay,
        'hy_bias': nrm((L, HY_ORDER, HY_WIDTH), 0.5),
        'lru_conv_w': nrm((L, 2, LRU_CONV, LRU_WIDTH), LRU_CONV ** -0.5),
        'lru_conv_b': nrm((L, 2, LRU_WIDTH), 0.02),
        'lru_wa': nrm((L, 2, LRU_BLOCKS, LRU_BLOCK_W, LRU_BLOCK_W), LRU_BLOCK_W ** -0.5),
        'lru_ba': nrm((L, 2, LRU_WIDTH), 0.1),
        'lru_wx': nrm((L, 2, LRU_BLOCKS, LRU_BLOCK_W, LRU_BLOCK_W), LRU_BLOCK_W ** -0.5),
        'lru_bx': nrm((L, 2, LRU_WIDTH), 0.1),
        'lru_lambda': lru_lambda,
        'w_branch': nrm((L, N_BRANCH, BRANCH_W, D), BRANCH_W ** -0.5),
        'w_out': nrm((L, D, D), D ** -0.5),
        'router_w': nrm((L, D, N_EXPERTS), D ** -0.5),
        'router_bias': nrm((L, N_EXPERTS), 0.01),
        'exp_w_gate': nrm((L, N_EXPERTS, D, EXPERT_HIDDEN), D ** -0.5),
        'exp_w_up': nrm((L, N_EXPERTS, D, EXPERT_HIDDEN), D ** -0.5),
        'exp_w_down': nrm((L, N_EXPERTS, EXPERT_HIDDEN, D), EXPERT_HIDDEN ** -0.5),
        'sh_w_gate': nrm((L, D, SHARED_HIDDEN), D ** -0.5),
        'sh_w_up': nrm((L, D, SHARED_HIDDEN), D ** -0.5),
        'sh_w_down': nrm((L, SHARED_HIDDEN, D), SHARED_HIDDEN ** -0.5),
        'g_final': gain((D,)),
    }


def reference(x, c, ctx, c_ctx, w_mod, b_mod, g_norm1, g_norm2, w_in, mla_g_q, mla_w_uq, mla_g_kv,
              mla_w_ukv, na_rpb, hy_short_w, hy_short_b, hy_w1, hy_b1, hy_w2, hy_b2, hy_w3, hy_decay,
              hy_bias, lru_conv_w, lru_conv_b, lru_wa, lru_ba, lru_wx, lru_bx, lru_lambda, w_branch, w_out,
              router_w, router_bias, exp_w_gate, exp_w_up, exp_w_down, sh_w_gate, sh_w_up, sh_w_down,
              g_final):
    rope = axial_rope_tables(x.shape[1], MLA_ROPE)
    xc = ctx
    for i in range(DEPTH):
        lp = {
            'w_mod': w_mod[i], 'b_mod': b_mod[i], 'g_norm1': g_norm1[i], 'g_norm2': g_norm2[i],
            'w_in': w_in[i], 'mla_g_q': mla_g_q[i], 'mla_w_uq': mla_w_uq[i], 'mla_g_kv': mla_g_kv[i],
            'mla_w_ukv': mla_w_ukv[i], 'na_rpb': na_rpb[i], 'hy_short_w': hy_short_w[i],
            'hy_short_b': hy_short_b[i], 'hy_w1': hy_w1[i], 'hy_b1': hy_b1[i], 'hy_w2': hy_w2[i],
            'hy_b2': hy_b2[i], 'hy_w3': hy_w3[i], 'hy_decay': hy_decay[i], 'hy_bias': hy_bias[i],
            'lru_conv_w': lru_conv_w[i], 'lru_conv_b': lru_conv_b[i], 'lru_wa': lru_wa[i],
            'lru_ba': lru_ba[i], 'lru_wx': lru_wx[i], 'lru_bx': lru_bx[i], 'lru_lambda': lru_lambda[i],
            'w_branch': w_branch[i], 'w_out': w_out[i], 'router_w': router_w[i],
            'router_bias': router_bias[i], 'exp_w_gate': exp_w_gate[i], 'exp_w_up': exp_w_up[i],
            'exp_w_down': exp_w_down[i], 'sh_w_gate': sh_w_gate[i], 'sh_w_up': sh_w_up[i],
            'sh_w_down': sh_w_down[i],
        }
        x, xc = layer(x, xc, c, c_ctx, lp, rope, i < DEPTH - 1)
    return rmsnorm(x, g_final)
```

```cpp
#include <hip/hip_runtime.h>
#include <stdint.h>
#include <stdio.h>

typedef unsigned short bf16_t;
typedef short bf16x8 __attribute__((ext_vector_type(8)));
typedef float f32x16 __attribute__((ext_vector_type(16)));
typedef unsigned u32x4 __attribute__((ext_vector_type(4)));

#define DEVI __device__ __forceinline__

constexpr int DM = 1024, TL = 32768, TCX = 2048, TT = 34816, NKEY = 4352;
constexpr int ZLD = 1408;
constexpr int NIN = 2432;
constexpr int NMT = 136;
constexpr int ZC_QL = 0, ZC_KVL = 192, ZC_KR = 320, ZC_NAQ = 384, ZC_NAK = 640, ZC_LU = 896, ZC_LG = 1152;
constexpr int ZT_NAV = 0, ZT_HY = 256;

constexpr size_t AL(size_t x) { return (x + 255) & ~(size_t)255; }
constexpr size_t OFF_BAR = 0;
constexpr size_t OFF_GCNT = 16384;
constexpr size_t ZERO_BYTES = 32768;
constexpr size_t OFF_MOD = 32768;
constexpr size_t OFF_COS = OFF_MOD + AL(2 * 9 * 6144 * 4);
constexpr size_t OFF_SIN = OFF_COS + 4096 * 16 * 4;
constexpr size_t OFF_H2T = OFF_SIN + 4096 * 16 * 4;
constexpr size_t OFF_SEGA = OFF_H2T + 4352 * 64 * 4;
constexpr size_t OFF_SEGB = OFF_SEGA + 2 * 544 * 256 * 4;
constexpr size_t OFF_TOKS = OFF_SEGB + 2 * 544 * 256 * 4;
constexpr size_t OFF_WTS = OFF_TOKS + AL((size_t)TT * 6 * 4);
constexpr size_t OFF_XC = OFF_WTS + AL((size_t)TT * 6 * 4);
constexpr size_t OFF_LIST = OFF_XC + (size_t)TCX * DM * 4;
constexpr size_t OFF_WDT = OFF_LIST + (size_t)64 * TT * 4;
constexpr size_t OFF_ZBIG = OFF_WDT + (size_t)65 * 1024 * 256 * 2;
constexpr size_t OFF_Z = OFF_ZBIG;
constexpr size_t OFF_ZT = OFF_Z + (size_t)TT * ZLD * 2;
constexpr size_t ZBIG_BYTES = (size_t)TT * ZLD * 2 + (size_t)8 * 1024 * NKEY * 2;
constexpr size_t OFF_ACC = OFF_ZBIG;
constexpr size_t OFF_HID = OFF_ZBIG;
constexpr size_t HID_BYTES = (size_t)1016 * 256 * 256 * 2;
constexpr size_t OFF_Y = OFF_ZBIG + HID_BYTES;
constexpr size_t Y_BYTES = (size_t)TT * 6 * DM * 2;
constexpr size_t OFF_WGU = OFF_ZBIG + ZBIG_BYTES;
constexpr size_t OFF_WIN = OFF_WGU + (size_t)65 * 512 * 1024 * 2;
constexpr size_t OFF_WUQ = OFF_WIN + (size_t)6528 * 1024 * 2;
constexpr size_t OFF_WUKV = OFF_WUQ + 384 * 192 * 2;
constexpr size_t OFF_WBR = OFF_WUKV + 512 * 128 * 2;
constexpr size_t OFF_WOUT = OFF_WBR + 4 * 1024 * 256 * 2;
constexpr size_t OFF_RT = OFF_WOUT + 1024 * 1024 * 2;
constexpr size_t OFF_H = OFF_RT + 128 * 1024 * 2;
constexpr size_t OFF_BR = OFF_H + (size_t)TT * DM * 2;
constexpr size_t OFF_YT = OFF_BR + (size_t)TT * DM * 2;
constexpr size_t OFF_Q = OFF_YT + (size_t)8 * 256 * NKEY * 2;
constexpr size_t OFF_K = OFF_Q + (size_t)8 * 4 * NKEY * 96 * 2;
constexpr size_t OFF_VT = OFF_K + (size_t)8 * 4 * NKEY * 96 * 2;
constexpr size_t OFF_HS = OFF_VT + (size_t)8 * 4 * 64 * NKEY * 2;
constexpr size_t OFF_HSC = OFF_HS + (size_t)2 * 256 * 8192 * 8;
constexpr size_t OFF_HLOC = OFF_HSC + (size_t)2 * 256 * 512 * 8;
constexpr size_t OFF_CUMA = OFF_HLOC + (size_t)2 * TT * 256 * 2;
constexpr size_t WS_END = OFF_CUMA + (size_t)2 * TT * 256 * 2;
static_assert(OFF_Y + Y_BYTES <= WS_END, "Y must fit inside the workspace map");
static_assert(OFF_Y >= OFF_HID + HID_BYTES, "Y vs hid");
static_assert(WS_END < (size_t)670 * 1000 * 1000, "workspace too large");

constexpr int LDS_BYTES = 147456;
#ifndef PH_HI
#define PH_HI 1000
#define DIAG_FIRST 0
#define DIAG_MODE 0
#define DIAG_ARG 10
#define DIAG_DIV 1408
#define DIAG_MOD 50
#define DIAG_DIV2 (1408 * 400)
#define DIAG_MOD2 100
#endif

struct Params {
    const float* in[41];
    float* out;
    char* ws;
    int ph_lo, ph_hi;
};

enum { I_X = 0, I_C, I_CTX, I_CCTX, I_WMOD, I_BMOD, I_GN1, I_GN2, I_WIN, I_GQ, I_WUQ, I_GKV, I_WUKV, I_RPB, I_HSW, I_HSB, I_HW1, I_HB1, I_HW2,
       I_HB2, I_HW3, I_HDEC, I_HBIAS, I_LCW, I_LCB, I_LWA, I_LBA, I_LWX, I_LBX, I_LLAM, I_WBR, I_WOUT, I_RW, I_RB, I_EG, I_EU, I_ED, I_SG, I_SU,
       I_SD, I_GF };

#define XB_TMO      128
#define XB_XCNT(j)  (256  + 64 * (j))
#define XB_XSUB(j)  (1280 + 64 * (j))
#define XB_XGEN(j)  (2304 + 64 * (j))
#define XB_TOP      3328
#define XB_TOPGEN   3392
#define XCD_BAR_WORDS 3456
#define XB_SPIN_CAP (1u << 18)
#define LAS __attribute__((address_space(3)))

__device__ __forceinline__ unsigned xb_ld(unsigned* p)              { return __hip_atomic_load(p, __ATOMIC_RELAXED, __HIP_MEMORY_SCOPE_AGENT); }
__device__ __forceinline__ unsigned xb_add(unsigned* p, unsigned v) { return __hip_atomic_fetch_add(p, v, __ATOMIC_RELAXED, __HIP_MEMORY_SCOPE_AGENT); }
__device__ __forceinline__ unsigned xb_xcc_id() { return (unsigned)__builtin_amdgcn_s_getreg((3 << 11) | 20) & 0xFu; }
#define XB_SPIN(cond, bar) do { unsigned _sp = 0; while (cond) { __builtin_amdgcn_s_sleep(1); \
    if ((++_sp & 255u) == 0u) { if (xb_ld(&(bar)[XB_TMO])) break; if (_sp > XB_SPIN_CAP) { atomicAdd(&(bar)[XB_TMO], 1u); break; } } } } while (0)

struct XcdBarrier { unsigned* bar; unsigned x; volatile LAS unsigned* st; };

__device__ __forceinline__ XcdBarrier xcd_barrier_post(unsigned* bar, volatile LAS unsigned* st) {
    XcdBarrier b; b.bar = bar; b.x = xb_xcc_id(); b.st = st;
    if (threadIdx.x == 0) (void)xb_add(&bar[XB_XCNT(b.x)], 1u);
    return b;
}
__device__ __forceinline__ void xcd_barrier_complete(unsigned* bar, unsigned x, unsigned& nloc, unsigned& nx) {
    const unsigned G = gridDim.x * gridDim.y * gridDim.z;
    unsigned sum, cnt, mine, sp = 0u;
    for (;;) {
        sum = 0u; cnt = 0u; mine = 0u;
#pragma unroll
        for (unsigned j = 0; j < 16; ++j) { const unsigned c = xb_ld(&bar[XB_XCNT(j)]); sum += c; cnt += (c > 0u) ? 1u : 0u; mine = (j == x) ? c : mine; }
        if (sum == G) break;
        __builtin_amdgcn_s_sleep(1);
        if ((++sp & 255u) == 0u) { if (xb_ld(&bar[XB_TMO])) break; if (sp > XB_SPIN_CAP) { atomicAdd(&bar[XB_TMO], 1u); break; } }
    }
    nloc = mine > 0u ? mine : 1u; nx = cnt > 0u ? cnt : 1u;
}
__device__ __forceinline__ void xcd_barrier(const XcdBarrier& b) {
    asm volatile("s_waitcnt vmcnt(0)" ::: "memory");
    __syncthreads();
    if (threadIdx.x == 0) {
        unsigned* bar = b.bar;
        __builtin_amdgcn_s_waitcnt(0);
        unsigned nloc = b.st[0], nx = b.st[1];
        if (nloc == 0u) { xcd_barrier_complete(bar, b.x, nloc, nx); b.st[0] = nloc; b.st[1] = nx; }
        const unsigned old = xb_add(&bar[XB_XSUB(b.x)], 1u);
        const unsigned gen = old / nloc;
        if (old + 1u == (gen + 1u) * nloc) {
            __builtin_amdgcn_fence(__ATOMIC_RELEASE, "agent");
            asm volatile("s_waitcnt vmcnt(0)" ::: "memory");
            const unsigned og = xb_add(&bar[XB_TOP], 1u);
            const unsigned tg = og / nx;
            if (og + 1u == (tg + 1u) * nx) xb_add(&bar[XB_TOPGEN], 1u);
            else XB_SPIN(xb_ld(&bar[XB_TOPGEN]) == tg, bar);
            __builtin_amdgcn_fence(__ATOMIC_ACQUIRE, "agent");
            xb_add(&bar[XB_XGEN(b.x)], 1u);
            asm volatile("s_waitcnt vmcnt(0)" ::: "memory");
        } else {
            XB_SPIN(xb_ld(&bar[XB_XGEN(b.x)]) == gen, bar);
            __builtin_amdgcn_fence(__ATOMIC_ACQUIRE, "agent");
            asm volatile("s_waitcnt vmcnt(0)" ::: "memory");
        }
    }
    __syncthreads();
}

extern __shared__ __attribute__((aligned(16))) char smem[];
__device__ __forceinline__ const Params& kparams() { return *(const Params*)(const void*)__builtin_amdgcn_kernarg_segment_ptr(); }
#define NOINL __device__ __forceinline__
#define UNIT_LOOP(u, n, off) for (int u = (int)((blockIdx.x + gridDim.x - ((off) % gridDim.x)) % gridDim.x); u < (n); u += gridDim.x)
DEVI int tidx() { int t = threadIdx.x; asm volatile("" : "+v"(t)); return t; }
DEVI float bf2f(bf16_t v) { return __uint_as_float((unsigned)v << 16); }
typedef __bf16 bf16v2 __attribute__((ext_vector_type(2)));
DEVI unsigned pk2(float lo, float hi) { bf16v2 v; v[0] = (__bf16)lo; v[1] = (__bf16)hi; return __builtin_bit_cast(unsigned, v); }
DEVI bf16_t f2bf(float v) { return (bf16_t)(pk2(v, 0.f) & 0xffffu); }
DEVI float lo_bf(unsigned u) { return __uint_as_float(u << 16); }
DEVI float hi_bf(unsigned u) { return __uint_as_float(u & 0xffff0000u); }
DEVI float sigmoidf_(float x) { return 1.f / (1.f + __expf(-x)); }
DEVI float wave_sum(float v) {
#pragma unroll
    for (int m = 32; m >= 1; m >>= 1) v += __shfl_xor(v, m);
    return v;
}
DEVI int row_b(int r) { return r < TL ? (r >> 12) : ((r - TL) >> 8); }
DEVI int row_key(int r) { return r < TL ? (r & 4095) : (4096 + ((r - TL) & 255)); }
DEVI int row_mod(int r) { return r < TL ? (r >> 12) : 8; }
DEVI const float* xsrc(const Params& p, int l, int r) {
    if (l == 0) return r < TL ? p.in[I_X] + (size_t)r * DM : p.in[I_CTX] + (size_t)(r - TL) * DM;
    return r < TL ? p.out + (size_t)r * DM : (const float*)(p.ws + OFF_XC) + (size_t)(r - TL) * DM;
}
DEVI float* xdst(const Params& p, int r) { return r < TL ? p.out + (size_t)r * DM : (float*)(p.ws + OFF_XC) + (size_t)(r - TL) * DM; }
DEVI int mt_row0(int mt) { return mt < 128 ? mt * 256 : TL + (mt - 128) * 256; }

#define MFMA(a, b, c) __builtin_amdgcn_mfma_f32_32x32x16_bf16((a), (b), (c), 0, 0, 0)

constexpr int G_LD = 72;
constexpr int G_ASZ = 256 * G_LD * 2;
constexpr int G_BSZ = 128 * G_LD * 2;
constexpr int G_STAGE = G_ASZ + G_BSZ;
constexpr int G_LDS = 2 * G_STAGE;

struct RowLoader {
    const bf16_t* p0; const bf16_t* p1; const bf16_t* p2; const bf16_t* p3; int soff;
    u32x4 r0, r1, r2, r3;
    DEVI void issue(int k0) { r0 = *(const u32x4*)(p0 + k0); r1 = *(const u32x4*)(p1 + k0); r2 = *(const u32x4*)(p2 + k0); r3 = *(const u32x4*)(p3 + k0); }
    DEVI void commit(bf16_t* As) const {
        *(u32x4*)(As + soff) = r0; *(u32x4*)(As + soff + 64 * G_LD) = r1; *(u32x4*)(As + soff + 128 * G_LD) = r2; *(u32x4*)(As + soff + 192 * G_LD) = r3;
    }
};
struct TransLoader {
    const bf16_t* base; int ldk; int tid;
    u32x4 r0, r1, r2, r3;
    DEVI const bf16_t* src(int k0, int i) const { const int cidx = tid + 512 * i, ch = cidx & 63, kg = cidx >> 6; return base + (size_t)(k0 + ch) * ldk + 8 * kg; }
    DEVI void issue(int k0) { r0 = *(const u32x4*)src(k0, 0); r1 = *(const u32x4*)src(k0, 1); r2 = *(const u32x4*)src(k0, 2); r3 = *(const u32x4*)src(k0, 3); }
    DEVI void put(bf16_t* As, int i, const u32x4& r) const {
        const int cidx = tid + 512 * i, ch = cidx & 63, kg = cidx >> 6;
#pragma unroll
        for (int j = 0; j < 4; ++j) { As[(8 * kg + 2 * j) * G_LD + ch] = (bf16_t)(r[j] & 0xffffu); As[(8 * kg + 2 * j + 1) * G_LD + ch] = (bf16_t)(r[j] >> 16); }
    }
    DEVI void commit(bf16_t* As) const { put(As, 0, r0); put(As, 1, r1); put(As, 2, r2); put(As, 3, r3); }
};

template <bool SW, int NI, class AL_>
DEVI void gemm_mainloop(f32x16 (&acc)[2][NI], AL_ al, const bf16_t* __restrict__ Bt, int ldb, int K, char* lds) {
    const int tid = tidx(), lane = tid & 63, w = tid >> 6, wm = w >> 1, wn = w & 1, l31 = lane & 31, hh = lane >> 5;
    const int lr = tid >> 3, kc = (tid & 7) * 8;
    const bf16_t* bp0 = Bt + (size_t)lr * ldb + kc;
    const bf16_t* bp1 = Bt + (size_t)(lr + 64) * ldb + kc;
    u32x4 rb0, rb1;
#pragma unroll
    for (int mi = 0; mi < 2; ++mi)
#pragma unroll
        for (int ni = 0; ni < NI; ++ni)
#pragma unroll
            for (int e = 0; e < 16; ++e) acc[mi][ni][e] = 0.f;
    __syncthreads();
    al.issue(0); rb0 = *(const u32x4*)bp0; if (NI == 2) rb1 = *(const u32x4*)bp1;
    {
        bf16_t* As = (bf16_t*)lds; bf16_t* Bs = (bf16_t*)(lds + G_ASZ);
        al.commit(As);
        *(u32x4*)(Bs + lr * G_LD + kc) = rb0; if (NI == 2) *(u32x4*)(Bs + (lr + 64) * G_LD + kc) = rb1;
    }
    __syncthreads();
    const int nk = K >> 6;
    for (int kt = 0; kt < nk; ++kt) {
        const bf16_t* As = (const bf16_t*)(lds + (kt & 1) * G_STAGE);
        const bf16_t* Bs = (const bf16_t*)(lds + (kt & 1) * G_STAGE + G_ASZ);
        const bool more = kt + 1 < nk;
        if (more) { const int k0 = (kt + 1) << 6; al.issue(k0); rb0 = *(const u32x4*)(bp0 + k0); if (NI == 2) rb1 = *(const u32x4*)(bp1 + k0); }
#pragma unroll
        for (int ks = 0; ks < 4; ++ks) {
            bf16x8 af[2], bfr[NI];
#pragma unroll
            for (int mi = 0; mi < 2; ++mi) af[mi] = *(const bf16x8*)(As + (wm * 64 + mi * 32 + l31) * G_LD + ks * 16 + 8 * hh);
#pragma unroll
            for (int ni = 0; ni < NI; ++ni) bfr[ni] = *(const bf16x8*)(Bs + (wn * 32 * NI + ni * 32 + l31) * G_LD + ks * 16 + 8 * hh);
#pragma unroll
            for (int mi = 0; mi < 2; ++mi)
#pragma unroll
                for (int ni = 0; ni < NI; ++ni) {
                    if (SW) acc[mi][ni] = MFMA(bfr[ni], af[mi], acc[mi][ni]);
                    else    acc[mi][ni] = MFMA(af[mi], bfr[ni], acc[mi][ni]);
                }
        }
        if (more) {
            bf16_t* An = (bf16_t*)(lds + ((kt + 1) & 1) * G_STAGE); bf16_t* Bn = (bf16_t*)(lds + ((kt + 1) & 1) * G_STAGE + G_ASZ);
            al.commit(An);
            *(u32x4*)(Bn + lr * G_LD + kc) = rb0; if (NI == 2) *(u32x4*)(Bn + (lr + 64) * G_LD + kc) = rb1;
        }
        __syncthreads();
    }
}
DEVI RowLoader make_rows(const bf16_t* base, size_t ld, int row0) {
    RowLoader r; const int tid = tidx(), lr = tid >> 3, kc = (tid & 7) * 8;
    r.p0 = base + (size_t)(row0 + lr) * ld + kc; r.p1 = r.p0 + 64 * ld; r.p2 = r.p0 + 128 * ld; r.p3 = r.p0 + 192 * ld; r.soff = lr * G_LD + kc;
    return r;
}

DEVI void mod_unit(const Params& p, int u, char* lds) {
    const int tid = tidx(), l = u / 96, j0 = (u % 96) * 64;
    float* sc = (float*)lds; float* red = sc + 9 * 1024;
    __syncthreads();
    for (int i = tid; i < 9 * 1024; i += 512) { const int row = i >> 10, k = i & 1023; const float v = row < 8 ? p.in[I_C][row * 1024 + k] : p.in[I_CCTX][k]; sc[i] = v / (1.f + expf(-v)); }
    __syncthreads();
    const int col = tid & 63, kg = tid >> 6;
    float a[9];
#pragma unroll
    for (int r = 0; r < 9; ++r) a[r] = 0.f;
    const float* w = p.in[I_WMOD] + (size_t)l * 1024 * 6144 + j0 + col;
    for (int k = kg * 128; k < kg * 128 + 128; ++k) {
        const float wv = w[(size_t)k * 6144];
#pragma unroll
        for (int r = 0; r < 9; ++r) a[r] += sc[r * 1024 + k] * wv;
    }
#pragma unroll
    for (int r = 0; r < 9; ++r) red[(kg * 9 + r) * 64 + col] = a[r];
    __syncthreads();
    float* mod = (float*)(p.ws + OFF_MOD);
    for (int i = tid; i < 9 * 64; i += 512) {
        const int r = i >> 6, cc = i & 63; float s = 0.f;
#pragma unroll
        for (int g = 0; g < 8; ++g) s += red[(g * 9 + r) * 64 + cc];
        mod[(size_t)(l * 9 + r) * 6144 + j0 + cc] = s + p.in[I_BMOD][l * 6144 + j0 + cc];
    }
}
DEVI void rope_unit(const Params& p, int v) {
    const int idx = v * 512 + tidx(), pos = idx >> 4, i = idx & 15, fi = i & 7;
    const float inv = powf(10000.f, -(float)fi / 8.f);
    const float coord = (float)(i < 8 ? (pos >> 6) : (pos & 63));
    const float ang = coord * inv;
    ((float*)(p.ws + OFF_COS))[idx] = cosf(ang);
    ((float*)(p.ws + OFF_SIN))[idx] = sinf(ang);
}
DEVI void norm_rows(const Params& p, int l, int nu, int which  ) {
    const int lane = tidx() & 63, w = tidx() >> 6;
    const float* mod = (const float*)(p.ws + OFF_MOD);
    bf16_t* h = (bf16_t*)(p.ws + OFF_H);
    const float* gn = p.in[which ? I_GN2 : I_GN1] + l * 1024;
#pragma unroll 1
    for (int i = 0; i < 8; ++i) {
        const int r = nu * 64 + w * 8 + i;
        const float* src = which ? (const float*)xdst(p, r) : xsrc(p, l, r);
        const float* mr = mod + (size_t)(l * 9 + row_mod(r)) * 6144 + (which ? 3072 : 0);
        float4 xv[4]; float ss = 0.f;
#pragma unroll
        for (int q = 0; q < 4; ++q) { xv[q] = *(const float4*)(src + 4 * lane + 256 * q); ss += xv[q].x * xv[q].x + xv[q].y * xv[q].y + xv[q].z * xv[q].z + xv[q].w * xv[q].w; }
        ss = wave_sum(ss);
        const float rstd = rsqrtf(ss * (1.f / 1024.f) + 1e-6f);
#pragma unroll
        for (int q = 0; q < 4; ++q) {
            const int k = 4 * lane + 256 * q;
            const float4 g = *(const float4*)(gn + k), sh = *(const float4*)(mr + k), sc = *(const float4*)(mr + 1024 + k);
            const float o0 = xv[q].x * rstd * g.x * (1.f + sc.x) + sh.x, o1 = xv[q].y * rstd * g.y * (1.f + sc.y) + sh.y;
            const float o2 = xv[q].z * rstd * g.z * (1.f + sc.z) + sh.z, o3 = xv[q].w * rstd * g.w * (1.f + sc.w) + sh.w;
            uint2 pk; pk.x = pk2(o0, o1); pk.y = pk2(o2, o3);
            *(uint2*)(h + (size_t)r * DM + k) = pk;
        }
    }
}

constexpr int CJ_WIN = 0, CJ_WUQ = CJ_WIN + 16 * 102, CJ_WUKV = CJ_WUQ + 3 * 6, CJ_WBR = CJ_WUKV + 2 * 8, CJ_WOUT = CJ_WBR + 4 * 64, CJ_RT = CJ_WOUT + 256,
              CJ_EG = CJ_RT + 16, CJ_EU = CJ_EG + 65 * 64, CJ_ED = CJ_EU + 65 * 64, CJ_END = CJ_ED + 65 * 64;
DEVI int win_map(int n) {
    if (n < 352) return n;
    if (n < 1120) { const int j = n - 352; return j < 256 ? ZC_NAQ + j : (j < 512 ? ZC_NAK + (j - 256) : ZLD + ZT_NAV + (j - 512)); }
    if (n < 1888) return ZLD + ZT_HY + (n - 1120);
    if (n < 2144) return ZC_LU + (n - 1888);
    if (n < 2400) return ZC_LG + (n - 2144);
    return NIN + (n - 2400);
}
DEVI void conv_unit(const Params& p, int l, int cu, char* lds) {
    const int tid = tidx();
    const float* src; int K, N, kt, nt; bf16_t* dst; int mode = 0; const float* ksc = nullptr;
    if (cu < CJ_WUQ) { const int t = cu - CJ_WIN; kt = t / 102; nt = t % 102; src = p.in[I_WIN] + (size_t)l * 1024 * 6496; K = 1024; N = 6496; dst = (bf16_t*)(p.ws + OFF_WIN); mode = 1; }
    else if (cu < CJ_WUKV) { const int t = cu - CJ_WUQ; kt = t / 6; nt = t % 6; src = p.in[I_WUQ] + (size_t)l * 192 * 384; K = 192; N = 384; dst = (bf16_t*)(p.ws + OFF_WUQ); ksc = p.in[I_GQ] + l * 192; }
    else if (cu < CJ_WBR) { const int t = cu - CJ_WUKV; kt = t / 8; nt = t % 8; src = p.in[I_WUKV] + (size_t)l * 128 * 512; K = 128; N = 512; dst = (bf16_t*)(p.ws + OFF_WUKV); ksc = p.in[I_GKV] + l * 128; }
    else if (cu < CJ_WOUT) { const int t = cu - CJ_WBR, k = t >> 6, tt = t & 63; kt = tt >> 4; nt = tt & 15; src = p.in[I_WBR] + (size_t)(l * 4 + k) * 256 * 1024; K = 256; N = 1024; dst = (bf16_t*)(p.ws + OFF_WBR) + (size_t)k * 1024 * 256; }
    else if (cu < CJ_RT) { const int t = cu - CJ_WOUT; kt = t >> 4; nt = t & 15; src = p.in[I_WOUT] + (size_t)l * 1024 * 1024; K = 1024; N = 1024; dst = (bf16_t*)(p.ws + OFF_WOUT); }
    else if (cu < CJ_EG) { kt = cu - CJ_RT; nt = 0; src = p.in[I_RW] + (size_t)l * 1024 * 64; K = 1024; N = 64; dst = (bf16_t*)(p.ws + OFF_RT); mode = 4; }
    else if (cu < CJ_EU) { const int t = cu - CJ_EG, e = t >> 6, tt = t & 63; kt = tt >> 2; nt = tt & 3; src = e < 64 ? p.in[I_EG] + (size_t)(l * 64 + e) * 1024 * 256 : p.in[I_SG] + (size_t)l * 1024 * 256; K = 1024; N = 256; dst = (bf16_t*)(p.ws + OFF_WGU) + (size_t)e * 512 * 1024; mode = 2; }
    else if (cu < CJ_ED) { const int t = cu - CJ_EU, e = t >> 6, tt = t & 63; kt = tt >> 2; nt = tt & 3; src = e < 64 ? p.in[I_EU] + (size_t)(l * 64 + e) * 1024 * 256 : p.in[I_SU] + (size_t)l * 1024 * 256; K = 1024; N = 256; dst = (bf16_t*)(p.ws + OFF_WGU) + (size_t)e * 512 * 1024; mode = 3; }
    else { const int t = cu - CJ_ED, e = t >> 6, tt = t & 63; kt = tt >> 4; nt = tt & 15; src = e < 64 ? p.in[I_ED] + (size_t)(l * 64 + e) * 256 * 1024 : p.in[I_SD] + (size_t)l * 256 * 1024; K = 256; N = 1024; dst = (bf16_t*)(p.ws + OFF_WDT) + (size_t)e * 1024 * 256; }
    float* tl = (float*)lds;
    __syncthreads();
    {
        const int kk = tid >> 4, n4 = (tid & 15) * 4;
#pragma unroll
        for (int ps = 0; ps < 2; ++ps) {
            const int k = kt * 64 + kk + 32 * ps, n = nt * 64 + n4;
            float4 v = make_float4(0.f, 0.f, 0.f, 0.f);
            if (n < N) v = *(const float4*)(src + (size_t)k * N + n);
            if (ksc) { const float s = ksc[k]; v.x *= s; v.y *= s; v.z *= s; v.w *= s; }
            float* t = tl + (kk + 32 * ps) * 65 + n4; t[0] = v.x; t[1] = v.y; t[2] = v.z; t[3] = v.w;
        }
    }
    __syncthreads();
    {
        const int nn = tid >> 3, kc = (tid & 7) * 8, n = nt * 64 + nn;
        if (n < N) {
            int dr = n;
            if (mode == 1) dr = win_map(n);
            else if (mode == 2) dr = (n >> 5) * 64 + (n & 31);
            else if (mode == 3) dr = (n >> 5) * 64 + 32 + (n & 31);
            uint4 o;
            o.x = pk2(tl[(kc + 0) * 65 + nn], tl[(kc + 1) * 65 + nn]); o.y = pk2(tl[(kc + 2) * 65 + nn], tl[(kc + 3) * 65 + nn]);
            o.z = pk2(tl[(kc + 4) * 65 + nn], tl[(kc + 5) * 65 + nn]); o.w = pk2(tl[(kc + 6) * 65 + nn], tl[(kc + 7) * 65 + nn]);
            *(uint4*)(dst + (size_t)dr * K + kt * 64 + kc) = o;
            if (mode == 4) *(uint4*)(dst + (size_t)(64 + n) * K + kt * 64 + kc) = make_uint4(0u, 0u, 0u, 0u);
        }
        if (mode == 1 && nt == 0 && nn < 32) *(uint4*)(dst + (size_t)(352 + nn) * K + kt * 64 + kc) = make_uint4(0u, 0u, 0u, 0u);
    }
}
DEVI void h2tab_unit(const Params& p, int l, int hu, char* lds) {
    const int tid = tidx();
    const int L = hu < 64 ? 4096 : 256, pos0 = hu < 64 ? hu * 64 : (hu - 64) * 64, rbase = hu < 64 ? 0 : 4096;
    float* feats = (float*)lds; float* h1 = feats + 64 * 33;
    const float* w1 = p.in[I_HW1] + l * 33 * 64; const float* b1 = p.in[I_HB1] + l * 64;
    const float* w2 = p.in[I_HW2] + l * 64 * 64; const float* b2 = p.in[I_HB2] + l * 64;
    __syncthreads();
    for (int i = tid; i < 64 * 33; i += 512) {
        const int pl = i / 33, f = i % 33, pos = pos0 + pl; float v;
        if (f == 0) v = (float)pos / (float)(L - 1);
        else { const int j = (f - 1) & 15; const float wv = 6.283185307179586f * (float)pos / (float)L; const float fj = 1e-4f + (float)j * ((15.f - 1e-4f) / 15.f); const float zz = wv * fj; v = f <= 16 ? cosf(zz) : -sinf(zz); }
        feats[i] = v;
    }
    __syncthreads();
    const int pl = tid >> 3, og = tid & 7;
    float o[8];
#pragma unroll
    for (int j = 0; j < 8; ++j) o[j] = b1[og * 8 + j];
#pragma unroll 1
    for (int i = 0; i < 33; ++i) { const float f = feats[pl * 33 + i];
#pragma unroll
        for (int j = 0; j < 8; ++j) o[j] += f * w1[i * 64 + og * 8 + j]; }
#pragma unroll
    for (int j = 0; j < 8; ++j) h1[pl * 64 + og * 8 + j] = sinf(o[j]);
    __syncthreads();
#pragma unroll
    for (int j = 0; j < 8; ++j) o[j] = b2[og * 8 + j];
#pragma unroll 2
    for (int i = 0; i < 64; ++i) { const float f = h1[pl * 64 + i];
#pragma unroll
        for (int j = 0; j < 8; ++j) o[j] += f * w2[i * 64 + og * 8 + j]; }
    float* tab = (float*)(p.ws + OFF_H2T) + (size_t)(rbase + pos0 + pl) * 64 + og * 8;
#pragma unroll
    for (int j = 0; j < 8; ++j) tab[j] = sinf(o[j]);
}
DEVI void fft_twiddles(float2* tw) {
    for (int i = tidx(); i < 4096; i += 512) { float s, c; sincospif((float)i * (1.f / 4096.f), &s, &c); tw[i] = make_float2(c, -s); }
}
DEVI void fft_dif(float2* X, const float2* tw, int logn) {
    const int nb = (1 << logn) >> 1;
    for (int s = logn - 1; s >= 0; --s) {
        const int half = 1 << s;
        for (int q = tidx(); q < nb; q += 512) {
            const int j = q & (half - 1), i0 = ((q - j) << 1) + j, i1 = i0 + half;
            const float2 a = X[i0], b = X[i1], w = tw[j << (12 - s)];
            X[i0] = make_float2(a.x + b.x, a.y + b.y);
            const float dx = a.x - b.x, dy = a.y - b.y;
            X[i1] = make_float2(dx * w.x - dy * w.y, dx * w.y + dy * w.x);
        }
        __syncthreads();
    }
}
DEVI void fft_dit_inv(float2* X, const float2* tw, int logn) {
    const int nb = (1 << logn) >> 1;
    for (int s = 0; s < logn; ++s) {
        const int half = 1 << s;
        for (int q = tidx(); q < nb; q += 512) {
            const int j = q & (half - 1), i0 = ((q - j) << 1) + j, i1 = i0 + half;
            const float2 a = X[i0], b = X[i1], w = tw[j << (12 - s)];
            const float bx = b.x * w.x + b.y * w.y, by = b.y * w.x - b.x * w.y;
            X[i0] = make_float2(a.x + bx, a.y + by);
            X[i1] = make_float2(a.x - bx, a.y - by);
        }
        __syncthreads();
    }
}
DEVI void spectrum_unit(const Params& p, int l, int n, int c, int L, int logn, const float* h2tab, float2* Hout, char* lds) {
    const int tid = tidx(), N2 = 1 << logn;
    float2* X = (float2*)lds; float2* tw = X + 8192; float* w3c = (float*)(tw + 4096);
    __syncthreads();
    fft_twiddles(tw);
    if (tid < 128) { const int dir = tid >> 6, k = tid & 63; w3c[tid] = p.in[I_HW3][(size_t)(l * 64 + k) * 1024 + (n * 2 + dir) * 256 + c]; }
    const float dec0 = fabsf(p.in[I_HDEC][((l * 2 + n) * 2 + 0) * 256 + c]), dec1 = fabsf(p.in[I_HDEC][((l * 2 + n) * 2 + 1) * 256 + c]);
    __syncthreads();
    for (int j = tid; j < L; j += 512) {
        const float4* hr = (const float4*)(h2tab + (size_t)j * 64);
        float f = 0.f, b = 0.f;
#pragma unroll
        for (int k4 = 0; k4 < 16; ++k4) { const float4 hv = hr[k4];
            f += hv.x * w3c[4 * k4] + hv.y * w3c[4 * k4 + 1] + hv.z * w3c[4 * k4 + 2] + hv.w * w3c[4 * k4 + 3];
            b += hv.x * w3c[64 + 4 * k4] + hv.y * w3c[64 + 4 * k4 + 1] + hv.z * w3c[64 + 4 * k4 + 2] + hv.w * w3c[64 + 4 * k4 + 3]; }
        const float lag = (float)j / (float)(L - 1);
        f *= expf(-lag * dec0); b *= expf(-lag * dec1);
        X[j] = make_float2(f, 0.f);
        if (j >= 1) X[N2 - j] = make_float2(b, 0.f);
    }
    if (tid == 0) X[L] = make_float2(0.f, 0.f);
    __syncthreads();
    fft_dif(X, tw, logn);
    for (int i = tid; i < N2; i += 512) Hout[i] = X[i];
}

DEVI void inproj_unit(const Params& p, int gu, char* lds) {
    const int mt = gu / 19, nt = gu % 19;
    const int tid = tidx(), lane = tid & 63, w = tid >> 6, wm = w >> 1, wn = w & 1, l31 = lane & 31, hh = lane >> 5;
    const bf16_t* h = (const bf16_t*)(p.ws + OFF_H);
    const bf16_t* Bt = (const bf16_t*)(p.ws + OFF_WIN) + (size_t)nt * 128 * 1024;
    const int row0 = mt_row0(mt);
    const RowLoader al = make_rows(h, DM, row0);
    f32x16 acc[2][2];
    if (nt < 11) {
        gemm_mainloop<true, 2>(acc, al, Bt, 1024, 1024, lds);
        bf16_t* z = (bf16_t*)(p.ws + OFF_Z);
#pragma unroll
        for (int mi = 0; mi < 2; ++mi)
#pragma unroll
            for (int ni = 0; ni < 2; ++ni) {
                const int row = row0 + wm * 64 + mi * 32 + l31, col = nt * 128 + wn * 64 + ni * 32 + 4 * hh;
#pragma unroll
                for (int g = 0; g < 4; ++g) { uint2 v; v.x = pk2(acc[mi][ni][4 * g], acc[mi][ni][4 * g + 1]); v.y = pk2(acc[mi][ni][4 * g + 2], acc[mi][ni][4 * g + 3]);
                    *(uint2*)(z + (size_t)row * ZLD + col + 8 * g) = v; }
            }
    } else {
        gemm_mainloop<false, 2>(acc, al, Bt, 1024, 1024, lds);
        bf16_t* zT = (bf16_t*)(p.ws + OFF_ZT);
        const int b = mt < 128 ? (mt >> 4) : (mt - 128), key0 = mt < 128 ? (mt & 15) * 256 : 4096;
#pragma unroll
        for (int mi = 0; mi < 2; ++mi)
#pragma unroll
            for (int ni = 0; ni < 2; ++ni) {
                const int ch = (nt - 11) * 128 + wn * 64 + ni * 32 + l31, key = key0 + wm * 64 + mi * 32 + 4 * hh;
#pragma unroll
                for (int g = 0; g < 4; ++g) { uint2 v; v.x = pk2(acc[mi][ni][4 * g], acc[mi][ni][4 * g + 1]); v.y = pk2(acc[mi][ni][4 * g + 2], acc[mi][ni][4 * g + 3]);
                    *(uint2*)(zT + ((size_t)(b * 1024 + ch) * NKEY + key + 8 * g)) = v; }
            }
    }
}
DEVI float conv3(const bf16_t* r, int t, int L, float w0, float w1, float w2, float b) {
    float v = b + w1 * bf2f(r[t]);
    if (t > 0) v += w0 * bf2f(r[t - 1]);
    if (t < L - 1) v += w2 * bf2f(r[t + 1]);
    return v;
}
template <int NPT>
DEVI void hyena_job(const Params& p, int l, int c, int b0, int L, int logn, int koff, const float2* H0, const float2* H1, float2* X, const float2* tw) {
    const int tid = tidx(), N2 = 1 << logn;
    const bf16_t* zT = (const bf16_t*)(p.ws + OFF_ZT);
    bf16_t* yT = (bf16_t*)(p.ws + OFF_YT);
    const float* sw = p.in[I_HSW] + l * 3 * 768; const float* sb = p.in[I_HSB] + l * 768;
    const float bias0 = p.in[I_HBIAS][(l * 2 + 0) * 256 + c], bias1 = p.in[I_HBIAS][(l * 2 + 1) * 256 + c];
    const bf16_t* rv[2]; const bf16_t* r1[2]; const bf16_t* r2[2];
#pragma unroll
    for (int q = 0; q < 2; ++q) { const size_t base = (size_t)((b0 + q) * 1024 + ZT_HY + c) * NKEY + koff; rv[q] = zT + base; r1[q] = zT + base + (size_t)256 * NKEY; r2[q] = zT + base + (size_t)512 * NKEY; }
    float vr[NPT][2], yr[NPT][2];
    const float inv = 1.f / (float)N2;
    __syncthreads();
#pragma unroll
    for (int i = 0; i < NPT; ++i) { const int t = tid + 512 * i;
        if (t < L) {
            vr[i][0] = conv3(rv[0], t, L, sw[c], sw[768 + c], sw[1536 + c], sb[c]);
            vr[i][1] = conv3(rv[1], t, L, sw[c], sw[768 + c], sw[1536 + c], sb[c]);
            X[t] = make_float2(vr[i][0], vr[i][1]); X[t + L] = make_float2(0.f, 0.f);
        } }
    __syncthreads();
    fft_dif(X, tw, logn);
    for (int i = tid; i < N2; i += 512) { const float2 a = X[i], hv = H0[i]; X[i] = make_float2(a.x * hv.x - a.y * hv.y, a.x * hv.y + a.y * hv.x); }
    __syncthreads();
    fft_dit_inv(X, tw, logn);
#pragma unroll
    for (int i = 0; i < NPT; ++i) { const int t = tid + 512 * i;
        if (t < L) {
            const float2 cv = X[t];
            const float x10 = conv3(r1[0], t, L, sw[256 + c], sw[768 + 256 + c], sw[1536 + 256 + c], sb[256 + c]);
            const float x11 = conv3(r1[1], t, L, sw[256 + c], sw[768 + 256 + c], sw[1536 + 256 + c], sb[256 + c]);
            yr[i][0] = x10 * (cv.x * inv + vr[i][0] * bias0); yr[i][1] = x11 * (cv.y * inv + vr[i][1] * bias0);
        } }
    __syncthreads();
#pragma unroll
    for (int i = 0; i < NPT; ++i) { const int t = tid + 512 * i; if (t < L) { X[t] = make_float2(yr[i][0], yr[i][1]); X[t + L] = make_float2(0.f, 0.f); } }
    __syncthreads();
    fft_dif(X, tw, logn);
    for (int i = tid; i < N2; i += 512) { const float2 a = X[i], hv = H1[i]; X[i] = make_float2(a.x * hv.x - a.y * hv.y, a.x * hv.y + a.y * hv.x); }
    __syncthreads();
    fft_dit_inv(X, tw, logn);
#pragma unroll
    for (int i = 0; i < NPT; ++i) { const int t = tid + 512 * i;
        if (t < L) {
            const float2 cv = X[t];
            const float x20 = conv3(r2[0], t, L, sw[512 + c], sw[768 + 512 + c], sw[1536 + 512 + c], sb[512 + c]);
            const float x21 = conv3(r2[1], t, L, sw[512 + c], sw[768 + 512 + c], sw[1536 + 512 + c], sb[512 + c]);
            yT[(size_t)((b0 + 0) * 256 + c) * NKEY + koff + t] = f2bf(x20 * (cv.x * inv + yr[i][0] * bias1));
            yT[(size_t)((b0 + 1) * 256 + c) * NKEY + koff + t] = f2bf(x21 * (cv.y * inv + yr[i][1] * bias1));
        } }
}
DEVI void hyena_unit(const Params& p, int l, int hu, char* lds) {
    float2* X = (float2*)lds; float2* tw = X + 8192;
    __syncthreads();
    fft_twiddles(tw);
    __syncthreads();
    if (hu < 1024) {
        const int c = hu & 255, bp = hu >> 8;
        const float2* H = (const float2*)(p.ws + OFF_HS);
        hyena_job<8>(p, l, c, 2 * bp, 4096, 13, 0, H + (size_t)c * 8192, H + (size_t)(256 + c) * 8192, X, tw);
    } else {
        const int c = hu - 1024;
        const float2* H = (const float2*)(p.ws + OFF_HSC);
        for (int bp = 0; bp < 4; ++bp) hyena_job<1>(p, l, c, 2 * bp, 256, 9, 4096, H + (size_t)c * 512, H + (size_t)(256 + c) * 512, X, tw);
    }
}

struct KVTile { const bf16_t* k; const bf16_t* vt; };
template <int DQ, bool NA, class TF>
DEVI void attn_core(const bf16x8 (&qf)[DQ / 16], int ntiles, const TF& tilefn, int kstride, int vstride,
                    int r_q, int qc, int kr_lo, int nloc, const float* rpb_s, f32x16 (&o)[2], float& lsum, char* lds) {
    constexpr int KLD = DQ + 8, KCH = DQ / 8, KSZ = 64 * KLD * 2, VSZ = 64 * 72 * 2, ST = KSZ + VSZ;
    constexpr int NKC = (64 * KCH + 511) / 512;
    const int tid = tidx(), lane = tid & 63, l31 = lane & 31, hh = lane >> 5;
    float m = -1e30f; lsum = 0.f;
#pragma unroll
    for (int e = 0; e < 16; ++e) { o[0][e] = 0.f; o[1][e] = 0.f; }
    const int r0 = min(max(r_q - 4, 0), 56), c0 = min(max(qc - 8, 0), 48);
    u32x4 rk0, rk1, rv;
    auto issue = [&](int j) __attribute__((always_inline)) {
        const KVTile t = tilefn(j);
        { const int c = tid; const int key = c / KCH, ch = c % KCH; rk0 = *(const u32x4*)(t.k + (size_t)key * kstride + ch * 8); }
        if (NKC == 2) { const int c = tid + 512; if (c < 64 * KCH) { const int key = c / KCH, ch = c % KCH; rk1 = *(const u32x4*)(t.k + (size_t)key * kstride + ch * 8); } }
        rv = *(const u32x4*)(t.vt + (size_t)(tid >> 3) * vstride + (tid & 7) * 8);
    };
    auto commit = [&](int buf) __attribute__((always_inline)) {
        bf16_t* Ks = (bf16_t*)(lds + buf * ST); bf16_t* Vs = (bf16_t*)(lds + buf * ST + KSZ);
        { const int c = tid; const int key = c / KCH, ch = c % KCH; *(u32x4*)(Ks + key * KLD + ch * 8) = rk0; }
        if (NKC == 2) { const int c = tid + 512; if (c < 64 * KCH) { const int key = c / KCH, ch = c % KCH; *(u32x4*)(Ks + key * KLD + ch * 8) = rk1; } }
        *(u32x4*)(Vs + (tid >> 3) * 72 + (tid & 7) * 8) = rv;
    };
    __syncthreads();
    issue(0); commit(0);
    __syncthreads();
    for (int j = 0; j < ntiles; ++j) {
        const bool more = j + 1 < ntiles;
        if (more) issue(j + 1);
        const int kr = kr_lo + j;
        const bool active = !NA || j >= nloc || (kr >= r0 && kr < r0 + 8);
        if (active) {
            const bf16_t* Ks = (const bf16_t*)(lds + (j & 1) * ST); const bf16_t* Vs = (const bf16_t*)(lds + (j & 1) * ST + KSZ);
            f32x16 s0, s1;
#pragma unroll
            for (int e = 0; e < 16; ++e) { s0[e] = 0.f; s1[e] = 0.f; }
#pragma unroll
            for (int ks = 0; ks < DQ / 16; ++ks) {
                const bf16x8 k0 = *(const bf16x8*)(Ks + l31 * KLD + ks * 16 + 8 * hh);
                const bf16x8 k1 = *(const bf16x8*)(Ks + (32 + l31) * KLD + ks * 16 + 8 * hh);
                s0 = MFMA(k0, qf[ks], s0); s1 = MFMA(k1, qf[ks], s1);
            }
            if (NA && j < nloc) {
                const float* rb = rpb_s + (kr - r_q + 7) * 31 + 15 - qc;
#pragma unroll
                for (int e = 0; e < 16; ++e) {
                    const int kc = (e & 3) + 8 * (e >> 2) + 4 * hh;
                    const bool v0 = kc >= c0 && kc < c0 + 16, v1 = (kc + 32) >= c0 && (kc + 32) < c0 + 16;
                    s0[e] = v0 ? s0[e] + rb[kc] : -1e30f;
                    s1[e] = v1 ? s1[e] + rb[kc + 32] : -1e30f;
                }
            }
            float mx = s0[0];
#pragma unroll
            for (int e = 1; e < 16; ++e) mx = fmaxf(mx, s0[e]);
#pragma unroll
            for (int e = 0; e < 16; ++e) mx = fmaxf(mx, s1[e]);
            mx = fmaxf(mx, __shfl_xor(mx, 32));
            const float mn = fmaxf(m, mx), alpha = __builtin_amdgcn_exp2f(m - mn);
            m = mn;
            float ps = 0.f;
#pragma unroll
            for (int e = 0; e < 16; ++e) { s0[e] = __builtin_amdgcn_exp2f(s0[e] - mn); s1[e] = __builtin_amdgcn_exp2f(s1[e] - mn); ps += s0[e] + s1[e]; }
            lsum = lsum * alpha + ps;
#pragma unroll
            for (int e = 0; e < 16; ++e) { o[0][e] *= alpha; o[1][e] *= alpha; }
#pragma unroll
            for (int s4 = 0; s4 < 4; ++s4) {
                const int bs = 8 * (s4 & 1);
                u32x4 pu;
                if (s4 < 2) { pu[0] = pk2(s0[bs], s0[bs + 1]); pu[1] = pk2(s0[bs + 2], s0[bs + 3]); pu[2] = pk2(s0[bs + 4], s0[bs + 5]); pu[3] = pk2(s0[bs + 6], s0[bs + 7]); }
                else        { pu[0] = pk2(s1[bs], s1[bs + 1]); pu[1] = pk2(s1[bs + 2], s1[bs + 3]); pu[2] = pk2(s1[bs + 4], s1[bs + 5]); pu[3] = pk2(s1[bs + 6], s1[bs + 7]); }
                const bf16x8 pfv = __builtin_bit_cast(bf16x8, pu);
#pragma unroll
                for (int dvt = 0; dvt < 2; ++dvt) {
                    const uint2 v0 = *(const uint2*)(Vs + (dvt * 32 + l31) * 72 + s4 * 16 + 4 * hh);
                    const uint2 v1 = *(const uint2*)(Vs + (dvt * 32 + l31) * 72 + s4 * 16 + 8 + 4 * hh);
                    u32x4 vu; vu[0] = v0.x; vu[1] = v0.y; vu[2] = v1.x; vu[3] = v1.y;
                    o[dvt] = MFMA(__builtin_bit_cast(bf16x8, vu), pfv, o[dvt]);
                }
            }
        }
        if (more) commit((j + 1) & 1);
        __syncthreads();
    }
    lsum += __shfl_xor(lsum, 32);
}
DEVI void attn_store(const f32x16 (&o)[2], float lsum, bf16_t* dst  ) {
    const int lane = tidx() & 63, hh = lane >> 5;
    const float il = 1.f / lsum;
#pragma unroll
    for (int dvt = 0; dvt < 2; ++dvt)
#pragma unroll
        for (int g = 0; g < 4; ++g) { uint2 v; v.x = pk2(o[dvt][4 * g] * il, o[dvt][4 * g + 1] * il); v.y = pk2(o[dvt][4 * g + 2] * il, o[dvt][4 * g + 3] * il);
            *(uint2*)(dst + dvt * 32 + 8 * g + 4 * hh) = v; }
}
DEVI void na_unit(const Params& p, int l, int au, char* lds) {
    const int tid = tidx(), lane = tid & 63, w = tid >> 6, l31 = lane & 31, hh = lane >> 5;
    const bf16_t* z = (const bf16_t*)(p.ws + OFF_Z); const bf16_t* zT = (const bf16_t*)(p.ws + OFF_ZT);
    bf16_t* br = (bf16_t*)(p.ws + OFF_BR);
    const bool isctx = au >= 512;
    int b, h, R;
    if (!isctx) { b = au >> 6; h = (au >> 4) & 3; R = au & 15; } else { b = (au - 512) >> 2; h = (au - 512) & 3; R = 0; }
    float* rpb_s = (float*)(lds + 2 * (64 * 72 * 2 + 64 * 72 * 2));
    __syncthreads();
    for (int i = tid; i < 465; i += 512) rpb_s[i] = p.in[I_RPB][(size_t)(l * 4 + h) * 465 + i] * 1.4426950408889634f;
    const int r_q = 4 * R + (w >> 1), qc = (w & 1) * 32 + l31;
    const int qrow = isctx ? TL + b * 256 + w * 32 + l31 : b * 4096 + r_q * 64 + qc;
    bf16x8 qf[4];
    {
        const bf16_t* qs = z + (size_t)qrow * ZLD + ZC_NAQ + h * 64 + 8 * hh;
        const float sc = 0.125f * 1.4426950408889634f;
#pragma unroll
        for (int ks = 0; ks < 4; ++ks) { const uint4 v = *(const uint4*)(qs + ks * 16); u32x4 t;
            t[0] = pk2(lo_bf(v.x) * sc, hi_bf(v.x) * sc); t[1] = pk2(lo_bf(v.y) * sc, hi_bf(v.y) * sc); t[2] = pk2(lo_bf(v.z) * sc, hi_bf(v.z) * sc); t[3] = pk2(lo_bf(v.w) * sc, hi_bf(v.w) * sc);
            qf[ks] = __builtin_bit_cast(bf16x8, t); }
    }
    int kr_lo = 0, nloc = 0;
    if (!isctx) { kr_lo = min(max(4 * R - 4, 0), 56); const int kr_hi = min(max(4 * R - 1, 0), 56) + 7; nloc = kr_hi - kr_lo + 1; }
    const bf16_t* kb = z + ZC_NAK + h * 64; const bf16_t* vb = zT + (size_t)(b * 1024 + ZT_NAV + h * 64) * NKEY;
    auto tf = [&](int j) { KVTile t;
        if (j < nloc) { const int kr = kr_lo + j; t.k = kb + (size_t)(b * 4096 + kr * 64) * ZLD; t.vt = vb + kr * 64; }
        else { const int i = j - nloc; t.k = kb + (size_t)(TL + b * 256 + 64 * i) * ZLD; t.vt = vb + 4096 + 64 * i; }
        return t; };
    f32x16 o[2]; float ls;
    attn_core<64, true>(qf, nloc + 4, tf, ZLD, NKEY, r_q, qc, kr_lo, nloc, rpb_s, o, ls, lds);
    attn_store(o, ls, br + (size_t)qrow * DM + 256 + h * 64);
}
DEVI void lru1_unit(const Params& p, int l, int lu, char* lds) {
    const int tid = tidx(), c = tid & 255, half = tid >> 8, n = c >> 6, jc = c & 63;
    const int tt = lu >> 1, d = lu & 1;
    const int row0 = tt * 128;
    const int s0 = row0 < TL ? (row0 & 4095) : ((row0 - TL) & 255);
    const int L = row0 < TL ? 4096 : 256;
    const bf16_t* z = (const bf16_t*)(p.ws + OFF_Z);
    float* xs = (float*)lds;
    const float* cw = p.in[I_LCW] + (size_t)(l * 2 + d) * 4 * 256; const float cb = p.in[I_LCB][(l * 2 + d) * 256 + c];
    const float w0 = cw[c], w1 = cw[256 + c], w2 = cw[512 + c], w3 = cw[768 + c];
    __syncthreads();
    {
        const bf16_t* zu = z + (size_t)(row0 - s0) * ZLD + ZC_LU + c;
        auto U = [&](int s) -> float { return (s >= 0 && s < L) ? bf2f(zu[(size_t)s * ZLD]) : 0.f; };
        const int sb = s0 + 64 * half;
        if (d == 0) { float a = U(sb - 3), b = U(sb - 2), cc = U(sb - 1);
            for (int i = 0; i < 64; ++i) { const float e = U(sb + i); xs[(64 * half + i) * 256 + c] = cb + w0 * a + w1 * b + w2 * cc + w3 * e; a = b; b = cc; cc = e; } }
        else { float a = U(sb), b = U(sb + 1), cc = U(sb + 2);
            for (int i = 0; i < 64; ++i) { const float e = U(sb + i + 3); xs[(64 * half + i) * 256 + c] = cb + w0 * a + w1 * b + w2 * cc + w3 * e; a = b; b = cc; cc = e; } }
    }
    __syncthreads();
    float wa[64], wx[64];
    {
        const float* pa = p.in[I_LWA] + ((size_t)((l * 2 + d) * 4 + n) * 64) * 64 + jc; const float* px = p.in[I_LWX] + ((size_t)((l * 2 + d) * 4 + n) * 64) * 64 + jc;
#pragma unroll
        for (int k = 0; k < 64; ++k) { wa[k] = pa[k * 64]; wx[k] = px[k * 64]; }
    }
    const float ba = p.in[I_LBA][(l * 2 + d) * 256 + c], bx = p.in[I_LBX][(l * 2 + d) * 256 + c];
    const float lam = p.in[I_LLAM][(l * 2 + d) * 256 + c];
    const float sp = log1pf(expf(-lam));
    bf16_t* hloc = (bf16_t*)(p.ws + OFF_HLOC) + (size_t)d * TT * 256; bf16_t* cuma = (bf16_t*)(p.ws + OFF_CUMA) + (size_t)d * TT * 256;
    float hst = 0.f, cum = 1.f;
    for (int i = 0; i < 64; ++i) {
        const int tl = 64 * half + (d == 0 ? i : 63 - i);
        const float4* xr = (const float4*)(xs + tl * 256 + 64 * n);
        float ra = ba, ri = bx;
#pragma unroll
        for (int k4 = 0; k4 < 16; ++k4) { const float4 xv = xr[k4];
            ra += xv.x * wa[4 * k4] + xv.y * wa[4 * k4 + 1] + xv.z * wa[4 * k4 + 2] + xv.w * wa[4 * k4 + 3];
            ri += xv.x * wx[4 * k4] + xv.y * wx[4 * k4 + 1] + xv.z * wx[4 * k4 + 2] + xv.w * wx[4 * k4 + 3]; }
        const float r = sigmoidf_(ra), ig = sigmoidf_(ri);
        const float la = -8.f * r * sp, a = expf(la), mult = sqrtf(-expm1f(2.f * la));
        const float bt = mult * ig * xs[tl * 256 + c];
        hst = a * hst + bt; cum *= a;
        hloc[(size_t)(row0 + tl) * 256 + c] = f2bf(hst); cuma[(size_t)(row0 + tl) * 256 + c] = f2bf(cum);
    }
    const int seg = tt * 2 + half;
    ((float*)(p.ws + OFF_SEGA))[(size_t)(d * 544 + seg) * 256 + c] = cum;
    ((float*)(p.ws + OFF_SEGB))[(size_t)(d * 544 + seg) * 256 + c] = hst;
}
DEVI void qproj_unit(const Params& p, int qu, char* lds) {
    const int mt = qu / 3, nt = qu % 3;
    const int tid = tidx(), lane = tid & 63, w = tid >> 6, wm = w >> 1, wn = w & 1, l31 = lane & 31, hh = lane >> 5;
    const bf16_t* z = (const bf16_t*)(p.ws + OFF_Z);
    const int row0 = mt_row0(mt);
    float* rs = (float*)(lds + G_LDS);
    __syncthreads();
    if (tid < 256) { const bf16_t* zr = z + (size_t)(row0 + tid) * ZLD + ZC_QL; float ss = 0.f;
#pragma unroll
        for (int i = 0; i < 24; ++i) { const uint4 v = *(const uint4*)(zr + 8 * i); const unsigned u[4] = {v.x, v.y, v.z, v.w};
#pragma unroll
            for (int j = 0; j < 4; ++j) { const float a = lo_bf(u[j]), b = hi_bf(u[j]); ss += a * a + b * b; } }
        rs[tid] = rsqrtf(ss * (1.f / 192.f) + 1e-6f); }
    const RowLoader al = make_rows(z + ZC_QL, ZLD, row0);
    f32x16 acc[2][2];
    gemm_mainloop<true, 2>(acc, al, (const bf16_t*)(p.ws + OFF_WUQ) + (size_t)nt * 128 * 192, 192, 192, lds);
    bf16_t* Q = (bf16_t*)(p.ws + OFF_Q);
    const float* cosT = (const float*)(p.ws + OFF_COS); const float* sinT = (const float*)(p.ws + OFF_SIN);
    const float QS = 0.10206207261596575f * 1.4426950408889634f;
    const bool lat = mt < 128;
#pragma unroll
    for (int mi = 0; mi < 2; ++mi) {
        const int rl = wm * 64 + mi * 32 + l31, row = row0 + rl, b = row_b(row), key = row_key(row);
        const float rstd = rs[rl] * QS;
#pragma unroll
        for (int ni = 0; ni < 2; ++ni) {
            const int ct = nt * 4 + wn * 2 + ni, hd = ct / 3, part = ct % 3;
            float v[16];
#pragma unroll
            for (int e = 0; e < 16; ++e) v[e] = acc[mi][ni][e] * rstd;
            if (part == 2 && lat) {
#pragma unroll
                for (int g = 0; g < 2; ++g)
#pragma unroll
                    for (int j = 0; j < 4; ++j) { const int i = 8 * g + 4 * hh + j; const float cs = cosT[key * 16 + i], sn = sinT[key * 16 + i];
                        const float x1 = v[4 * g + j], x2 = v[4 * (g + 2) + j]; v[4 * g + j] = x1 * cs - x2 * sn; v[4 * (g + 2) + j] = x1 * sn + x2 * cs; }
            }
            bf16_t* dst = Q + ((size_t)((b * 4 + hd) * NKEY + key)) * 96 + part * 32 + 4 * hh;
#pragma unroll
            for (int g = 0; g < 4; ++g) { uint2 o; o.x = pk2(v[4 * g], v[4 * g + 1]); o.y = pk2(v[4 * g + 2], v[4 * g + 3]); *(uint2*)(dst + 8 * g) = o; }
        }
    }
}
DEVI void kvproj_unit(const Params& p, int ku, char* lds) {
    const int mt = ku >> 2, nt = ku & 3;
    const int tid = tidx(), lane = tid & 63, w = tid >> 6, wm = w >> 1, wn = w & 1, l31 = lane & 31, hh = lane >> 5;
    const bf16_t* z = (const bf16_t*)(p.ws + OFF_Z);
    const int row0 = mt_row0(mt);
    float* rs = (float*)(lds + G_LDS);
    bf16_t* Kb = (bf16_t*)(p.ws + OFF_K); bf16_t* Vt = (bf16_t*)(p.ws + OFF_VT);
    const float* cosT = (const float*)(p.ws + OFF_COS); const float* sinT = (const float*)(p.ws + OFF_SIN);
    const bool lat = mt < 128;
    __syncthreads();
    if (tid < 256) { const bf16_t* zr = z + (size_t)(row0 + tid) * ZLD + ZC_KVL; float ss = 0.f;
#pragma unroll
        for (int i = 0; i < 16; ++i) { const uint4 v = *(const uint4*)(zr + 8 * i); const unsigned u[4] = {v.x, v.y, v.z, v.w};
#pragma unroll
            for (int j = 0; j < 4; ++j) { const float a = lo_bf(u[j]), b = hi_bf(u[j]); ss += a * a + b * b; } }
        rs[tid] = rsqrtf(ss * (1.f / 128.f) + 1e-6f); }
    if (nt == 0) {
        const int rl = tid >> 1, part = tid & 1, row = row0 + rl, b = row_b(row), key = row_key(row);
        const bf16_t* zr = z + (size_t)row * ZLD + ZC_KR;
#pragma unroll
        for (int ii = 0; ii < 8; ++ii) { const int i = 8 * part + ii; float x1 = bf2f(zr[i]), x2 = bf2f(zr[16 + i]);
            if (lat) { const float cs = cosT[key * 16 + i], sn = sinT[key * 16 + i]; const float a = x1 * cs - x2 * sn, c2 = x1 * sn + x2 * cs; x1 = a; x2 = c2; }
            const bf16_t o1 = f2bf(x1), o2 = f2bf(x2);
#pragma unroll
            for (int hd = 0; hd < 4; ++hd) { bf16_t* kd = Kb + ((size_t)((b * 4 + hd) * NKEY + key)) * 96 + 64; kd[i] = o1; kd[16 + i] = o2; } }
    }
    const RowLoader al = make_rows(z + ZC_KVL, ZLD, row0);
    f32x16 acc[2][2];
    gemm_mainloop<true, 2>(acc, al, (const bf16_t*)(p.ws + OFF_WUKV) + (size_t)nt * 128 * 128, 128, 128, lds);
    const int hd = nt;
#pragma unroll
    for (int mi = 0; mi < 2; ++mi) {
        const int rl = wm * 64 + mi * 32 + l31, row = row0 + rl, b = row_b(row), key = row_key(row);
        const float rstd = rs[rl];
#pragma unroll
        for (int ni = 0; ni < 2; ++ni) {
            if (wn == 0) {
                bf16_t* dst = Kb + ((size_t)((b * 4 + hd) * NKEY + key)) * 96 + ni * 32 + 4 * hh;
#pragma unroll
                for (int g = 0; g < 4; ++g) { uint2 o; o.x = pk2(acc[mi][ni][4 * g] * rstd, acc[mi][ni][4 * g + 1] * rstd); o.y = pk2(acc[mi][ni][4 * g + 2] * rstd, acc[mi][ni][4 * g + 3] * rstd); *(uint2*)(dst + 8 * g) = o; }
            } else {
#pragma unroll
                for (int e = 0; e < 16; ++e) { const int dv = ni * 32 + (e & 3) + 8 * (e >> 2) + 4 * hh;
                    Vt[((size_t)((b * 4 + hd) * 64 + dv)) * NKEY + key] = f2bf(acc[mi][ni][e] * rstd); }
            }
        }
    }
}
DEVI void mla_unit(const Params& p, int au, char* lds) {
    const int tid = tidx(), lane = tid & 63, w = tid >> 6, l31 = lane & 31, hh = lane >> 5;
    const bool isctx = au >= 512;
    int b, h, qb;
    if (!isctx) { b = au >> 6; h = (au >> 4) & 3; qb = au & 15; } else { b = (au - 512) >> 2; h = (au - 512) & 3; qb = 16; }
    const int q0 = qb * 256 + w * 32 + l31;
    const bf16_t* Qp = (const bf16_t*)(p.ws + OFF_Q) + ((size_t)((b * 4 + h) * NKEY + q0)) * 96 + 8 * hh;
    bf16x8 qf[6];
#pragma unroll
    for (int ks = 0; ks < 6; ++ks) qf[ks] = *(const bf16x8*)(Qp + ks * 16);
    const bf16_t* kb = (const bf16_t*)(p.ws + OFF_K) + (size_t)((b * 4 + h) * NKEY) * 96;
    const bf16_t* vb = (const bf16_t*)(p.ws + OFF_VT) + (size_t)((b * 4 + h) * 64) * NKEY;
    const int jt0 = isctx ? 64 : 0, ntl = isctx ? 4 : 68;
    auto tf = [&](int j) { KVTile t; t.k = kb + (size_t)(jt0 + j) * 64 * 96; t.vt = vb + (jt0 + j) * 64; return t; };
    f32x16 o[2]; float ls;
    attn_core<96, false>(qf, ntl, tf, 96, NKEY, 0, 0, 0, 0, nullptr, o, ls, lds);
    const int row = isctx ? TL + b * 256 + w * 32 + l31 : b * 4096 + q0;
    attn_store(o, ls, (bf16_t*)(p.ws + OFF_BR) + (size_t)row * DM + h * 64);
}
DEVI float gelu_tanh(float x) { return 0.5f * x * (1.f + tanhf(0.7978845608028654f * (x + 0.044715f * x * x * x))); }
DEVI void lru2_unit(const Params& p, int tt) {
    const int tid = tidx(), c = tid & 255, half = tid >> 8;
    const int sg = tt * 2 + half;
    const bool lat = sg < 512;
    const int b = lat ? (sg >> 6) : ((sg - 512) >> 2), i = lat ? (sg & 63) : ((sg - 512) & 3);
    const float* SA = (const float*)(p.ws + OFF_SEGA); const float* SB = (const float*)(p.ws + OFF_SEGB);
    float hin[2];
    {
        float h = 0.f; const int nc = lat ? 4 : i;
        for (int s = 0; s < nc; ++s) { const size_t o = (size_t)(0 * 544 + 512 + 4 * b + s) * 256 + c; h = SA[o] * h + SB[o]; }
        if (lat) for (int s = 0; s < i; ++s) { const size_t o = (size_t)(0 * 544 + 64 * b + s) * 256 + c; h = SA[o] * h + SB[o]; }
        hin[0] = h;
    }
    {
        float h = 0.f; const int lo = lat ? 0 : i + 1;
        for (int s = 3; s >= lo; --s) { const size_t o = (size_t)(1 * 544 + 512 + 4 * b + s) * 256 + c; h = SA[o] * h + SB[o]; }
        if (lat) for (int s = 63; s > i; --s) { const size_t o = (size_t)(1 * 544 + 64 * b + s) * 256 + c; h = SA[o] * h + SB[o]; }
        hin[1] = h;
    }
    const bf16_t* hl = (const bf16_t*)(p.ws + OFF_HLOC); const bf16_t* ca = (const bf16_t*)(p.ws + OFF_CUMA);
    const bf16_t* z = (const bf16_t*)(p.ws + OFF_Z); bf16_t* br = (bf16_t*)(p.ws + OFF_BR);
    for (int t = 0; t < 64; ++t) {
        const size_t row = (size_t)sg * 64 + t;
        const float hf = bf2f(hl[row * 256 + c]) + bf2f(ca[row * 256 + c]) * hin[0];
        const float hr = bf2f(hl[((size_t)TT + row) * 256 + c]) + bf2f(ca[((size_t)TT + row) * 256 + c]) * hin[1];
        const float g = bf2f(z[row * ZLD + ZC_LG + c]);
        br[row * DM + 768 + c] = f2bf((hf + hr) * gelu_tanh(g));
    }
}
DEVI void merge_unit(const Params& p, int mu, char* lds) {
    const int mt = mu >> 4, nt = mu & 15;
    const int tid = tidx(), lane = tid & 63, w = tid >> 6, wm = w >> 1, wn = w & 1, l31 = lane & 31, hh = lane >> 5;
    const int row0 = mt_row0(mt);
    const bf16_t* h = (const bf16_t*)(p.ws + OFF_H); const bf16_t* br = (const bf16_t*)(p.ws + OFF_BR);
    const bf16_t* win = (const bf16_t*)(p.ws + OFF_WIN); const bf16_t* wbr = (const bf16_t*)(p.ws + OFF_WBR);
    f32x16 tot[2][1];
#pragma unroll
    for (int mi = 0; mi < 2; ++mi)
#pragma unroll
        for (int e = 0; e < 16; ++e) tot[mi][0][e] = 0.f;
#pragma unroll 1
    for (int k = 0; k < 4; ++k) {
        f32x16 G[2][1];
        {
            const RowLoader al = make_rows(h, DM, row0);
            gemm_mainloop<true, 1>(G, al, win + (size_t)(NIN + k * 1024 + nt * 64) * 1024, 1024, 1024, lds);
#pragma unroll
            for (int mi = 0; mi < 2; ++mi)
#pragma unroll
                for (int e = 0; e < 16; ++e) G[mi][0][e] = sigmoidf_(G[mi][0][e]);
        }
        f32x16 P[2][1];
        if (k != 2) { const RowLoader al = make_rows(br + k * 256, DM, row0); gemm_mainloop<true, 1>(P, al, wbr + (size_t)(k * 1024 + nt * 64) * 256, 256, 256, lds); }
        else {
            const int b = mt < 128 ? (mt >> 4) : (mt - 128), key0 = mt < 128 ? (mt & 15) * 256 : 4096;
            TransLoader tl; tl.base = (const bf16_t*)(p.ws + OFF_YT) + (size_t)(b * 256) * NKEY + key0; tl.ldk = NKEY; tl.tid = tidx();
            gemm_mainloop<true, 1>(P, tl, wbr + (size_t)(k * 1024 + nt * 64) * 256, 256, 256, lds);
        }
#pragma unroll
        for (int mi = 0; mi < 2; ++mi)
#pragma unroll
            for (int e = 0; e < 16; ++e) tot[mi][0][e] += G[mi][0][e] * P[mi][0][e];
    }
    bf16_t* accb = (bf16_t*)(p.ws + OFF_ACC);
#pragma unroll
    for (int mi = 0; mi < 2; ++mi) {
        const int row = row0 + wm * 64 + mi * 32 + l31, col = nt * 64 + wn * 32 + 4 * hh;
#pragma unroll
        for (int g = 0; g < 4; ++g) { uint2 v; v.x = pk2(tot[mi][0][4 * g], tot[mi][0][4 * g + 1]); v.y = pk2(tot[mi][0][4 * g + 2], tot[mi][0][4 * g + 3]);
            *(uint2*)(accb + (size_t)row * DM + col + 8 * g) = v; }
    }
}
DEVI void wout_unit(const Params& p, int l, int mu, char* lds) {
    const int mt = mu >> 3, nt = mu & 7;
    const int tid = tidx(), lane = tid & 63, w = tid >> 6, wm = w >> 1, wn = w & 1, l31 = lane & 31, hh = lane >> 5;
    const int row0 = mt_row0(mt);
    const RowLoader al = make_rows((const bf16_t*)(p.ws + OFF_ACC), DM, row0);
    f32x16 acc[2][2];
    gemm_mainloop<true, 2>(acc, al, (const bf16_t*)(p.ws + OFF_WOUT) + (size_t)nt * 128 * 1024, 1024, 1024, lds);
    const float* mod = (const float*)(p.ws + OFF_MOD);
#pragma unroll
    for (int mi = 0; mi < 2; ++mi) {
        const int row = row0 + wm * 64 + mi * 32 + l31;
        const float* xs = xsrc(p, l, row); float* xd = xdst(p, row);
        const float* g1 = mod + (size_t)(l * 9 + row_mod(row)) * 6144 + 2048;
#pragma unroll
        for (int ni = 0; ni < 2; ++ni) {
            const int col = nt * 128 + wn * 64 + ni * 32 + 4 * hh;
#pragma unroll
            for (int g = 0; g < 4; ++g) { const float4 xv = *(const float4*)(xs + col + 8 * g), gv = *(const float4*)(g1 + col + 8 * g);
                float4 o; o.x = xv.x + gv.x * acc[mi][ni][4 * g]; o.y = xv.y + gv.y * acc[mi][ni][4 * g + 1]; o.z = xv.z + gv.z * acc[mi][ni][4 * g + 2]; o.w = xv.w + gv.w * acc[mi][ni][4 * g + 3];
                *(float4*)(xd + col + 8 * g) = o; }
        }
    }
}
DEVI void router_unit(const Params& p, int l, int mt, char* lds) {
    const int tid = tidx(), lane = tid & 63, w = tid >> 6, wm = w >> 1, wn = w & 1, l31 = lane & 31, hh = lane >> 5;
    const int row0 = mt_row0(mt);
    for (int q = 0; q < 4; ++q) norm_rows(p, l, (row0 >> 6) + q, 1);
    asm volatile("s_waitcnt vmcnt(0)" ::: "memory");
    __syncthreads();
    const RowLoader al = make_rows((const bf16_t*)(p.ws + OFF_H), DM, row0);
    f32x16 acc[2][2];
    gemm_mainloop<true, 2>(acc, al, (const bf16_t*)(p.ws + OFF_RT), 1024, 1024, lds);
    float* lg = (float*)lds;
    int* cnt_l = (int*)(lds + 256 * 65 * 4);
    int* base_g = cnt_l + 64;
    if (wn == 0) {
#pragma unroll
        for (int mi = 0; mi < 2; ++mi)
#pragma unroll
            for (int ni = 0; ni < 2; ++ni)
#pragma unroll
                for (int e = 0; e < 16; ++e) lg[(wm * 64 + mi * 32 + l31) * 65 + ni * 32 + (e & 3) + 8 * (e >> 2) + 4 * hh] = acc[mi][ni][e];
    }
    if (tid < 64) cnt_l[tid] = 0;
    __syncthreads();
    int se[6], spos[6]; float swt[6];
    if (tid < 256) {
        const float* rb = p.in[I_RB] + l * 64;
        float* my = lg + tid * 65;
        float ssum = 0.f;
#pragma unroll
        for (int k = 0; k < 6; ++k) {
            float best = -1e30f; int bi = 0;
            for (int e = 0; e < 64; ++e) { const float v = my[e]; const float s = v > -1e29f ? sigmoidf_(v) + rb[e] : -1e30f; if (s > best) { best = s; bi = e; } }
            const float sc = sigmoidf_(my[bi]);
            se[k] = bi; swt[k] = sc; ssum += sc; my[bi] = -1e30f;
        }
        const float nrm = 2.5f / ssum;
#pragma unroll
        for (int k = 0; k < 6; ++k) { swt[k] *= nrm; spos[k] = atomicAdd(&cnt_l[se[k]], 1); }
    }
    __syncthreads();
    if (tid < 64) base_g[tid] = (int)__hip_atomic_fetch_add((unsigned*)(p.ws + OFF_GCNT) + l * 64 + tid, (unsigned)cnt_l[tid], __ATOMIC_RELAXED, __HIP_MEMORY_SCOPE_AGENT);
    __syncthreads();
    if (tid < 256) {
        const int r = row0 + tid;
        int* list = (int*)(p.ws + OFF_LIST); unsigned* toks = (unsigned*)(p.ws + OFF_TOKS); float* wts = (float*)(p.ws + OFF_WTS);
#pragma unroll
        for (int k = 0; k < 6; ++k) { const int pos = base_g[se[k]] + spos[k]; list[(size_t)se[k] * TT + pos] = r; toks[(size_t)r * 6 + k] = ((unsigned)se[k] << 16) | (unsigned)pos; wts[(size_t)r * 6 + k] = swt[k]; }
    }
}
struct MoeTab { int* cnt; int* blkbase; int* cbase; };
DEVI MoeTab moe_tables(const Params& p, int l, int nact, char* lds) {
    MoeTab t; t.cnt = (int*)(lds + LDS_BYTES - 4096); t.blkbase = t.cnt + 80; t.cbase = t.blkbase + 80;
    __syncthreads();
    if (tidx() == 0) {
        unsigned* g = (unsigned*)(p.ws + OFF_GCNT) + l * 64; int bb = 0, cb = 0;
        for (int e = 0; e < 64; ++e) { const int c = (int)__hip_atomic_load(g + e, __ATOMIC_RELAXED, __HIP_MEMORY_SCOPE_AGENT); t.cnt[e] = c; t.blkbase[e] = bb; t.cbase[e] = cb; bb += (c + 255) >> 8; cb += c; }
        t.cnt[64] = nact; t.blkbase[64] = bb; t.cbase[64] = cb; t.blkbase[65] = bb + (nact >> 8);
    }
    __syncthreads();
    return t;
}
DEVI int find_expert(const MoeTab& t, int rb) { int e = 0; while (e < 64 && rb >= t.blkbase[e + 1]) ++e; return e; }
DEVI void moe1_unit(const Params& p, const MoeTab& t, int u, char* lds) {
    const int rb = u >> 2, nt = u & 3;
    const int tid = tidx(), lane = tid & 63, w = tid >> 6, wm = w >> 1, wn = w & 1, l31 = lane & 31, hh = lane >> 5;
    const int e = find_expert(t, rb), i0 = (rb - t.blkbase[e]) * 256, cnt = t.cnt[e];
    const bf16_t* h2 = (const bf16_t*)(p.ws + OFF_H);
    const int* list = (const int*)(p.ws + OFF_LIST) + (size_t)e * TT;
    RowLoader al; { const int lr = tid >> 3, kc = (tid & 7) * 8; const bf16_t* pp[4];
#pragma unroll
        for (int i = 0; i < 4; ++i) { const int ii = i0 + lr + 64 * i; const int tok = e == 64 ? ii : (ii < cnt ? list[ii] : 0); pp[i] = h2 + (size_t)tok * DM + kc; }
        al.p0 = pp[0]; al.p1 = pp[1]; al.p2 = pp[2]; al.p3 = pp[3]; al.soff = lr * G_LD + kc; }
    f32x16 acc[2][2];
    gemm_mainloop<true, 2>(acc, al, (const bf16_t*)(p.ws + OFF_WGU) + ((size_t)e * 512 + nt * 128) * 1024, 1024, 1024, lds);
    bf16_t* hid = (bf16_t*)(p.ws + OFF_HID);
#pragma unroll
    for (int mi = 0; mi < 2; ++mi) {
        const size_t hrow = (size_t)rb * 256 + wm * 64 + mi * 32 + l31;
        bf16_t* dst = hid + hrow * 256 + (nt * 2 + wn) * 32 + 4 * hh;
#pragma unroll
        for (int g = 0; g < 4; ++g) { float v[4];
#pragma unroll
            for (int j = 0; j < 4; ++j) { const float gt = acc[mi][0][4 * g + j], up = acc[mi][1][4 * g + j]; v[j] = gt * sigmoidf_(gt) * up; }
            uint2 o; o.x = pk2(v[0], v[1]); o.y = pk2(v[2], v[3]); *(uint2*)(dst + 8 * g) = o; }
    }
}
DEVI void moe2_unit(const Params& p, int l, const MoeTab& t, int u, char* lds) {
    const int rb = u >> 3, nt = u & 7;
    const int tid = tidx(), lane = tid & 63, w = tid >> 6, wm = w >> 1, wn = w & 1, l31 = lane & 31, hh = lane >> 5;
    const int e = find_expert(t, rb), i0 = (rb - t.blkbase[e]) * 256, cnt = t.cnt[e];
    const RowLoader al = make_rows((const bf16_t*)(p.ws + OFF_HID), 256, rb * 256);
    f32x16 acc[2][2];
    gemm_mainloop<true, 2>(acc, al, (const bf16_t*)(p.ws + OFF_WDT) + ((size_t)e * 1024 + nt * 128) * 256, 256, 256, lds);
    if (e < 64) {
        bf16_t* Y = (bf16_t*)(p.ws + OFF_Y);
#pragma unroll
        for (int mi = 0; mi < 2; ++mi) {
            const int ii = i0 + wm * 64 + mi * 32 + l31;
            if (ii < cnt) {
                bf16_t* dst = Y + ((size_t)(t.cbase[e] + ii)) * DM + nt * 128 + wn * 64 + 4 * hh;
#pragma unroll
                for (int ni = 0; ni < 2; ++ni)
#pragma unroll
                    for (int g = 0; g < 4; ++g) { uint2 o; o.x = pk2(acc[mi][ni][4 * g], acc[mi][ni][4 * g + 1]); o.y = pk2(acc[mi][ni][4 * g + 2], acc[mi][ni][4 * g + 3]); *(uint2*)(dst + ni * 32 + 8 * g) = o; }
            }
        }
    } else {
        const float* mod = (const float*)(p.ws + OFF_MOD);
#pragma unroll
        for (int mi = 0; mi < 2; ++mi) {
            const int row = i0 + wm * 64 + mi * 32 + l31;
            float* xd = xdst(p, row);
            const float* g2 = mod + (size_t)(l * 9 + row_mod(row)) * 6144 + 5120;
#pragma unroll
            for (int ni = 0; ni < 2; ++ni) {
                const int col = nt * 128 + wn * 64 + ni * 32 + 4 * hh;
#pragma unroll
                for (int g = 0; g < 4; ++g) { float4 xv = *(float4*)(xd + col + 8 * g); const float4 gv = *(const float4*)(g2 + col + 8 * g);
                    xv.x += gv.x * acc[mi][ni][4 * g]; xv.y += gv.y * acc[mi][ni][4 * g + 1]; xv.z += gv.z * acc[mi][ni][4 * g + 2]; xv.w += gv.w * acc[mi][ni][4 * g + 3];
                    *(float4*)(xd + col + 8 * g) = xv; }
            }
        }
    }
}
DEVI void combine_unit(const Params& p, int l, const MoeTab& t, int cu) {
    const int lane = tidx() & 63, w = tidx() >> 6;
    const float* mod = (const float*)(p.ws + OFF_MOD);
    const bf16_t* Y = (const bf16_t*)(p.ws + OFF_Y);
    const unsigned* toks = (const unsigned*)(p.ws + OFF_TOKS); const float* wts = (const float*)(p.ws + OFF_WTS);
#pragma unroll 1
    for (int i = 0; i < 8; ++i) {
        const int r = cu * 64 + w * 8 + i;
        float* xd = xdst(p, r);
        const float* g2 = mod + (size_t)(l * 9 + row_mod(r)) * 6144 + 5120;
        const bf16_t* yr[6]; float wk[6];
#pragma unroll
        for (int k = 0; k < 6; ++k) { const unsigned v = toks[(size_t)r * 6 + k]; yr[k] = Y + (size_t)(t.cbase[v >> 16] + (int)(v & 0xffffu)) * DM; wk[k] = wts[(size_t)r * 6 + k]; }
        float4 xo[4]; float ss = 0.f;
#pragma unroll
        for (int q = 0; q < 4; ++q) {
            const int k0 = 4 * lane + 256 * q;
            float f0 = 0.f, f1 = 0.f, f2 = 0.f, f3 = 0.f;
#pragma unroll
            for (int k = 0; k < 6; ++k) { const uint2 yv = *(const uint2*)(yr[k] + k0); f0 += wk[k] * lo_bf(yv.x); f1 += wk[k] * hi_bf(yv.x); f2 += wk[k] * lo_bf(yv.y); f3 += wk[k] * hi_bf(yv.y); }
            float4 xv = *(const float4*)(xd + k0); const float4 gv = *(const float4*)(g2 + k0);
            xv.x += gv.x * f0; xv.y += gv.y * f1; xv.z += gv.z * f2; xv.w += gv.w * f3;
            xo[q] = xv; ss += xv.x * xv.x + xv.y * xv.y + xv.z * xv.z + xv.w * xv.w;
        }
        if (l == 1) {
            ss = wave_sum(ss);
            const float rstd = rsqrtf(ss * (1.f / 1024.f) + 1e-6f);
#pragma unroll
            for (int q = 0; q < 4; ++q) { const int k0 = 4 * lane + 256 * q; const float4 gf = *(const float4*)(p.in[I_GF] + k0);
                float4 o; o.x = xo[q].x * rstd * gf.x; o.y = xo[q].y * rstd * gf.y; o.z = xo[q].z * rstd * gf.z; o.w = xo[q].w * rstd * gf.w; *(float4*)(xd + k0) = o; }
        } else {
#pragma unroll
            for (int q = 0; q < 4; ++q) *(float4*)(xd + 4 * lane + 256 * q) = xo[q];
        }
    }
}

NOINL void f_p0() { const Params& p = kparams(); char* lds = smem + 256; UNIT_LOOP(u, 320, 0) { if (u < 192) mod_unit(p, u, lds); else rope_unit(p, u - 192); } }
NOINL void f_norm1(int l) { const Params& p = kparams(); UNIT_LOOP(u, 544, 0) norm_rows(p, l, u, 0); }
NOINL void f_conv(int l) { const Params& p = kparams(); char* lds = smem + 256; UNIT_LOOP(u, CJ_END, 544) conv_unit(p, l, u, lds); }
NOINL void f_h2tab(int l) { const Params& p = kparams(); char* lds = smem + 256; UNIT_LOOP(u, 68, 544 + CJ_END) h2tab_unit(p, l, u, lds); }
NOINL void f_spectrum(int l) {
    const Params& p = kparams(); char* lds = smem + 256;
    const int nspec = l == 0 ? 1024 : 512;
    UNIT_LOOP(u, nspec, 0) {
        if (u < 512) spectrum_unit(p, l, u >> 8, u & 255, 4096, 13, (const float*)(p.ws + OFF_H2T), (float2*)(p.ws + OFF_HS) + (size_t)u * 8192, lds);
        else { const int v = u - 512; spectrum_unit(p, l, v >> 8, v & 255, 256, 9, (const float*)(p.ws + OFF_H2T) + 4096 * 64, (float2*)(p.ws + OFF_HSC) + (size_t)v * 512, lds); }
    }
}
NOINL void f_inproj(int off) { const Params& p = kparams(); char* lds = smem + 256; UNIT_LOOP(u, NMT * 19, off) inproj_unit(p, u, lds); }
NOINL void f_hyena(int l) { const Params& p = kparams(); char* lds = smem + 256; const int n = l == 0 ? 1280 : 1024; UNIT_LOOP(u, n, 0) hyena_unit(p, l, u, lds); }
NOINL void f_na(int l, int off) { const Params& p = kparams(); char* lds = smem + 256; const int n = l == 0 ? 544 : 512; UNIT_LOOP(u, n, off) na_unit(p, l, u, lds); }
NOINL void f_lru1(int l, int off) { const Params& p = kparams(); char* lds = smem + 256; UNIT_LOOP(u, 544, off) lru1_unit(p, l, u, lds); }
NOINL void f_qproj(int off) { const Params& p = kparams(); char* lds = smem + 256; UNIT_LOOP(u, NMT * 3, off) qproj_unit(p, u, lds); }
NOINL void f_kvproj(int off) { const Params& p = kparams(); char* lds = smem + 256; UNIT_LOOP(u, NMT * 4, off) kvproj_unit(p, u, lds); }
NOINL void f_mla(int l) { const Params& p = kparams(); char* lds = smem + 256; const int n = l == 0 ? 544 : 512; UNIT_LOOP(u, n, 0) mla_unit(p, u, lds); }
NOINL void f_lru2(int off) { const Params& p = kparams(); UNIT_LOOP(u, 272, off) lru2_unit(p, u); }
NOINL void f_merge(int nmt) { const Params& p = kparams(); char* lds = smem + 256; UNIT_LOOP(u, nmt * 16, 0) merge_unit(p, u, lds); }
NOINL void f_wout(int l, int nmt) { const Params& p = kparams(); char* lds = smem + 256; UNIT_LOOP(u, nmt * 8, 0) wout_unit(p, l, u, lds); }
NOINL void f_router(int l, int nmt) { const Params& p = kparams(); char* lds = smem + 256; UNIT_LOOP(u, nmt, 0) router_unit(p, l, u, lds); }
NOINL void f_moe1(int l, int nmt) { const Params& p = kparams(); char* lds = smem + 256; const MoeTab t = moe_tables(p, l, nmt * 256, lds); const int nu = t.blkbase[65] * 4; UNIT_LOOP(u, nu, 0) moe1_unit(p, t, u, lds); }
NOINL void f_moe2(int l, int nmt) { const Params& p = kparams(); char* lds = smem + 256; const MoeTab t = moe_tables(p, l, nmt * 256, lds); const int nu = t.blkbase[65] * 8; UNIT_LOOP(u, nu, 0) moe2_unit(p, l, t, u, lds); }
NOINL void f_combine(int l, int nmt) { const Params& p = kparams(); char* lds = smem + 256; const MoeTab t = moe_tables(p, l, nmt * 256, lds); UNIT_LOOP(u, nmt * 4, 0) combine_unit(p, l, t, u); }


#ifdef DIAG
struct DiagBuf { size_t off; size_t n; int kind; };
DEVI void diag_phase(const Params& p, const XcdBarrier& bar) {
    const DiagBuf bufs[] = {
        {OFF_MOD, 2 * 9 * 6144, 1}, {OFF_COS, 2 * 4096 * 16, 1}, {OFF_H2T, 4352 * 64, 1}, {OFF_WIN, (size_t)6528 * 1024, 0}, {OFF_WGU, (size_t)65 * 512 * 1024, 0},
        {OFF_WDT, (size_t)65 * 1024 * 256, 0}, {OFF_WUQ, (OFF_H - OFF_WUQ) / 2, 0}, {OFF_H, (size_t)TT * DM, 0}, {OFF_HS, (size_t)2 * 256 * 8192 * 2, 1}, {OFF_HSC, (size_t)2 * 256 * 512 * 2, 1},
        {OFF_Z, (size_t)TT * ZLD, 0}, {OFF_ZT, (size_t)8 * 1024 * NKEY, 0}, {OFF_YT, (size_t)8 * 256 * NKEY, 0}, {OFF_Q, (size_t)8 * 4 * NKEY * 96, 0}, {OFF_K, (size_t)8 * 4 * NKEY * 96, 0},
        {OFF_VT, (size_t)8 * 4 * 64 * NKEY, 0}, {OFF_HLOC, (size_t)2 * TT * 256, 0}, {OFF_CUMA, (size_t)2 * TT * 256, 0}, {OFF_SEGA, (size_t)4 * 544 * 256, 1}, {OFF_BR, (size_t)TT * DM, 0},
        {OFF_XC, (size_t)TCX * DM, 1}, {OFF_WTS, (size_t)TT * 6, 1} };
    constexpr int NB = sizeof(bufs) / sizeof(bufs[0]);
    unsigned* flags = (unsigned*)(p.ws + OFF_GCNT) + 1024;
    xcd_barrier(bar);
    const size_t gtid = (size_t)blockIdx.x * 512 + threadIdx.x, gn = (size_t)gridDim.x * 512;
    for (int b = DIAG_FIRST; b < NB; ++b) {
        unsigned bad = 0, poi = 0;
        if (bufs[b].kind == 0) { const bf16_t* q = (const bf16_t*)(p.ws + bufs[b].off);
            for (size_t i = gtid; i < bufs[b].n; i += gn) { const unsigned v = q[i]; if ((v & 0x7F80u) == 0x7F80u || fabsf(bf2f((bf16_t)v)) > 1e5f) ++bad; if (v == 0xAAAAu) ++poi; } }
        else { const unsigned* q = (const unsigned*)(p.ws + bufs[b].off);
            for (size_t i = gtid; i < bufs[b].n; i += gn) { const unsigned v = q[i]; if ((v & 0x7F800000u) == 0x7F800000u || fabsf(__uint_as_float(v)) > 1e5f) ++bad; if (v == 0xAAAAAAAAu) ++poi; } }
        bad = (unsigned)wave_sum((float)bad); poi = (unsigned)wave_sum((float)poi);
        if ((threadIdx.x & 63) == 0) { if (bad) atomicAdd(&flags[2 * b], bad); if (poi) atomicAdd(&flags[2 * b + 1], poi); }
    }
    xcd_barrier(bar);
    float K = 1000.f, K2 = 0.f;
    for (int b = NB - 1; b >= DIAG_FIRST; --b) {
        const unsigned bad = __hip_atomic_load(&flags[2 * b], __ATOMIC_RELAXED, __HIP_MEMORY_SCOPE_AGENT), poi = __hip_atomic_load(&flags[2 * b + 1], __ATOMIC_RELAXED, __HIP_MEMORY_SCOPE_AGENT);
        if (bad) K = 1000.f * (float)(10 + b);
        else if ((size_t)poi * 2 > bufs[b].n) K = 1000.f * (float)(50 + b);
    }
#if DIAG_MODE == 1
    {
        float* acc = (float*)((unsigned*)(p.ws + OFF_GCNT) + 2048);
        float s = 0.f; const int b = DIAG_ARG;
        if (bufs[b].kind == 0) { const bf16_t* q = (const bf16_t*)(p.ws + bufs[b].off); for (size_t i = gtid; i < bufs[b].n; i += gn) { const float v = bf2f(q[i]); s += v * v; } }
        else { const float* q = (const float*)(p.ws + bufs[b].off); for (size_t i = gtid; i < bufs[b].n; i += gn) { const float v = q[i]; s += v * v; } }
        s = wave_sum(s); if ((threadIdx.x & 63) == 0) atomicAdd(acc, s);
        xcd_barrier(bar);
        K = 1000.f * sqrtf(__hip_atomic_load(acc, __ATOMIC_RELAXED, __HIP_MEMORY_SCOPE_AGENT) / (float)bufs[b].n);
    }
#elif DIAG_MODE == 2
    K = (float)__hip_atomic_load(&flags[2 * DIAG_ARG], __ATOMIC_RELAXED, __HIP_MEMORY_SCOPE_AGENT);
#elif DIAG_MODE == 3
    {
        unsigned* mn = (unsigned*)(p.ws + OFF_GCNT) + 2048;
        if (blockIdx.x == 0 && threadIdx.x == 0) __hip_atomic_store(mn, 0xFFFFFFFFu, __ATOMIC_RELAXED, __HIP_MEMORY_SCOPE_AGENT);
        xcd_barrier(bar);
        const int b = DIAG_ARG; unsigned best = 0xFFFFFFFFu;
        if (bufs[b].kind == 0) { const bf16_t* q = (const bf16_t*)(p.ws + bufs[b].off);
            for (size_t i = gtid; i < bufs[b].n; i += gn) { const unsigned v = q[i]; if (((v & 0x7F80u) == 0x7F80u || fabsf(bf2f((bf16_t)v)) > 1e5f) && (unsigned)i < best) best = (unsigned)i; } }
        if (best != 0xFFFFFFFFu) atomicMin(mn, best);
        xcd_barrier(bar);
        const unsigned r = __hip_atomic_load(mn, __ATOMIC_RELAXED, __HIP_MEMORY_SCOPE_AGENT);
        K = (float)((r / DIAG_DIV) % DIAG_MOD);
        K2 = 1000.f * (float)((r / DIAG_DIV2) % DIAG_MOD2);
#ifdef DIAG_ROW0
        { const bf16_t* q = (const bf16_t*)(p.ws + bufs[b].off); int cnt = 0, cnt2 = 0;
          for (int c2 = 0; c2 < ZLD; ++c2) { const unsigned v = q[(size_t)DIAG_ROW0 * ZLD + c2]; if ((v & 0x7F80u) == 0x7F80u) ++cnt; }
          for (int r2 = 0; r2 < 99; ++r2) { const unsigned v = q[(size_t)r2 * ZLD + DIAG_COL0]; if ((v & 0x7F80u) == 0x7F80u) ++cnt2; }
          K = (float)cnt; K2 = 1000.f * (float)cnt2; }
#endif
#ifdef DIAG_VAL
        { const unsigned v = ((const bf16_t*)(p.ws + bufs[b].off))[r]; const float f = fabsf(bf2f((bf16_t)v)); K = ((v & 0x7F80u) == 0x7F80u) ? ((v & 0x7Fu) ? 49.f : 48.f) : fminf(47.f, log2f(f) * 0.25f); }
#endif
    }
#endif
    for (size_t i = gtid; i < (size_t)TL * DM; i += gn) p.out[i] = (i == 12345 && K2 != 0.f) ? K2 : K;
}
#endif

__global__ void __launch_bounds__(512, 2) mega_fwd(Params p) {
    if (threadIdx.x == 0) *(uint4*)smem = make_uint4(0u, 0u, 0u, 0u);
    __syncthreads();
    XcdBarrier bar = xcd_barrier_post((unsigned*)(p.ws + OFF_BAR), (volatile LAS unsigned*)smem);
    int ph = 0;
#define PHASE(...) do { if (ph >= p.ph_lo && ph < p.ph_hi) { __VA_ARGS__; if (ph + 1 < p.ph_hi) xcd_barrier(bar); } ++ph; } while (0)
    PHASE(f_p0());
    for (int l = 0; l < 2; ++l) {
        const int nmt = l == 0 ? NMT : 128;
        PHASE({ f_norm1(l); f_conv(l); f_h2tab(l); });
        PHASE({ f_spectrum(l); f_inproj(l == 0 ? 1024 : 512); });
        PHASE({ const int nh = l == 0 ? 1280 : 1024, nn = l == 0 ? 544 : 512; f_hyena(l); f_na(l, nh); f_lru1(l, nh + nn); f_qproj(nh + nn + 544); f_kvproj(nh + nn + 544 + NMT * 3); });
        PHASE({ f_mla(l); f_lru2(l == 0 ? 544 : 512); });
        PHASE(f_merge(nmt));
        PHASE(f_wout(l, nmt));
        PHASE(f_router(l, nmt));
        PHASE(f_moe1(l, nmt));
        PHASE(f_moe2(l, nmt));
        PHASE(f_combine(l, nmt));
    }
#ifdef DIAG
    diag_phase(p, bar);
#endif
}

extern "C" void kernel_launch(void* const* d_in, const int* in_sizes, int n_in, void* d_out, int out_size, void* d_ws, size_t ws_size, hipStream_t stream) {
    static int grid = 0;
    if (!grid) {
        int dev = 0, cus = 0, per_cu = 0;
        hipGetDevice(&dev);
        hipDeviceGetAttribute(&cus, hipDeviceAttributeMultiprocessorCount, dev);
        if (hipFuncSetAttribute((const void*)mega_fwd, hipFuncAttributeMaxDynamicSharedMemorySize, LDS_BYTES + 256) != hipSuccess) fprintf(stderr, "hipFuncSetAttribute failed\n");
        if (hipOccupancyMaxActiveBlocksPerMultiprocessor(&per_cu, (const void*)mega_fwd, 512, LDS_BYTES + 256) != hipSuccess || per_cu < 1) { fprintf(stderr, "occupancy query failed\n"); per_cu = 1; }
        grid = cus * 1;
        if (ws_size < WS_END) fprintf(stderr, "workspace too small: %zu < %zu\n", ws_size, (size_t)WS_END);
    }
    hipMemsetAsync(d_ws, 0, ZERO_BYTES, stream);
    Params p{};
    for (int i = 0; i < 41; ++i) p.in[i] = (const float*)d_in[i];
    p.out = (float*)d_out; p.ws = (char*)d_ws; p.ph_lo = 0; p.ph_hi = PH_HI;
    hipLaunchKernelGGL(mega_fwd, dim3(grid), dim3(512), LDS_BYTES + 256, stream, p);
}
```

```cpp
#include <hip/hip_runtime.h>
#include <stdint.h>
#include <stdio.h>

typedef unsigned short bf16_t;
typedef short bf16x8 __attribute__((ext_vector_type(8)));
typedef float f32x16 __attribute__((ext_vector_type(16)));
typedef unsigned u32x4 __attribute__((ext_vector_type(4)));

#define DEVI __device__ __forceinline__

constexpr int DM = 1024, TL = 32768, TCX = 2048, TT = 34816, NKEY = 4352;
constexpr int ZLD = 1408;
constexpr int NIN = 2432;
constexpr int WIN_G0 = 2560;
constexpr int NMT = 136;
constexpr int ZC_QL = 0, ZC_KVL = 192, ZC_KR = 320, ZC_NAQ = 384, ZC_NAK = 640, ZC_LU = 896, ZC_LG = 1152;
constexpr int ZT_NAV = 0, ZT_HY = 256;

constexpr size_t AL(size_t x) { return (x + 255) & ~(size_t)255; }
constexpr size_t OFF_BAR = 0;
constexpr size_t OFF_GCNT = 16384;
constexpr size_t ZERO_BYTES = 32768;
constexpr size_t OFF_MOD = 32768;
constexpr size_t OFF_COS = OFF_MOD + AL(2 * 9 * 6144 * 4);
constexpr size_t OFF_SIN = OFF_COS + 4096 * 16 * 4;
constexpr size_t OFF_H2T = OFF_SIN + 4096 * 16 * 4;
constexpr size_t OFF_SEGA = OFF_H2T + 4352 * 64 * 4;
constexpr size_t OFF_SEGB = OFF_SEGA + 2 * 1088 * 256 * 4;
constexpr size_t OFF_LWT = OFF_SEGB + 2 * 1088 * 256 * 4;
constexpr size_t OFF_HIN = OFF_LWT + 16 * 64 * 64 * 2;
constexpr size_t OFF_TOKS = OFF_HIN + 2 * 1088 * 256 * 4;
constexpr size_t OFF_WTS = OFF_TOKS + AL((size_t)TT * 6 * 4);
constexpr size_t OFF_XC = OFF_WTS + AL((size_t)TT * 6 * 4);
constexpr size_t OFF_LIST = OFF_XC + (size_t)TCX * DM * 4;
constexpr size_t OFF_WDT = OFF_LIST + (size_t)64 * TT * 4;
constexpr size_t OFF_ZBIG = OFF_WDT + (size_t)65 * 1024 * 256 * 2;
constexpr size_t OFF_Z = OFF_ZBIG;
constexpr size_t OFF_ZT = OFF_Z + (size_t)TT * ZLD * 2;
constexpr size_t ZBIG_BYTES = (size_t)TT * ZLD * 2 + (size_t)8 * 1024 * NKEY * 2;
constexpr size_t OFF_PHI = OFF_ZBIG;
constexpr size_t OFF_HID = OFF_ZBIG;
constexpr size_t HID_BYTES = (size_t)1016 * 256 * 256 * 2;
constexpr size_t OFF_Y = OFF_ZBIG + HID_BYTES;
constexpr size_t Y_BYTES = (size_t)TT * 6 * DM * 2;
constexpr size_t OFF_WGU = OFF_ZBIG + ZBIG_BYTES;
constexpr size_t OFF_WIN = OFF_WGU + (size_t)65 * 512 * 1024 * 2;
constexpr size_t OFF_WUQ = OFF_WIN + (size_t)(WIN_G0 + 4096) * 1024 * 2;
constexpr size_t OFF_WUKV = OFF_WUQ + 384 * 192 * 2;
constexpr size_t OFF_WBR = OFF_WUKV + 512 * 128 * 2;
constexpr size_t OFF_WOUT = OFF_WBR + 4 * 1024 * 256 * 2;
constexpr size_t OFF_RT = OFF_WOUT + 1024 * 1024 * 2;
constexpr size_t OFF_H = OFF_RT + 128 * 1024 * 2;
constexpr size_t OFF_BR = OFF_H + (size_t)TT * DM * 2;
constexpr size_t OFF_ACC = OFF_BR;
constexpr size_t OFF_YT = OFF_BR + (size_t)TT * DM * 2;
constexpr size_t OFF_PLO = OFF_YT;
constexpr size_t OFF_Q = OFF_YT + (size_t)8 * 256 * NKEY * 2;
constexpr size_t OFF_K = OFF_Q + (size_t)8 * 4 * NKEY * 96 * 2;
constexpr size_t OFF_VT = OFF_K + (size_t)8 * 4 * NKEY * 96 * 2;
constexpr size_t OFF_HS = OFF_VT + (size_t)8 * 4 * 64 * NKEY * 2;
constexpr size_t OFF_HSC = OFF_HS + (size_t)2 * 256 * 8192 * 8;
constexpr size_t OFF_HLOC = OFF_HSC + (size_t)2 * 256 * 512 * 8;
constexpr size_t OFF_CUMA = OFF_HLOC + (size_t)2 * TT * 256 * 2;
constexpr size_t WS_END = OFF_CUMA + (size_t)2 * TT * 256 * 2;
constexpr size_t OFF_WG8 = OFF_WIN + (size_t)WIN_G0 * 1024 * 2;
constexpr size_t OFF_H8 = OFF_CUMA;
static_assert(OFF_PLO + (size_t)TT * 4096 <= OFF_CUMA, "P_lo must not reach h8");
constexpr size_t OFF_RS = OFF_SEGA;
constexpr float WG8_SCALE = 512.f;
static_assert(OFF_Y + Y_BYTES <= WS_END, "Y must fit inside the workspace map");
static_assert(OFF_PLO + (size_t)TT * 4096 <= WS_END && OFF_PHI + (size_t)TT * 4096 <= OFF_ZBIG + ZBIG_BYTES, "P halves must fit the dead regions");
static_assert(OFF_Y >= OFF_HID + HID_BYTES, "Y vs hid");
static_assert(WS_END < (size_t)670 * 1000 * 1000, "workspace too large");

constexpr int LDS_BYTES = 147456;
#ifndef PH_HI
#define PH_HI 1000
#define DIAGT_A 1
#define DIAGT_B 2
#define DIAG_FIRST 0
#define DIAG_MODE 0
#define DIAG_ARG 10
#define DIAG_DIV 1408
#define DIAG_MOD 50
#define DIAG_DIV2 (1408 * 400)
#define DIAG_MOD2 100
#endif

struct Params {
    const float* in[41];
    float* out;
    char* ws;
    int ph_lo, ph_hi;
};

enum { I_X = 0, I_C, I_CTX, I_CCTX, I_WMOD, I_BMOD, I_GN1, I_GN2, I_WIN, I_GQ, I_WUQ, I_GKV, I_WUKV, I_RPB, I_HSW, I_HSB, I_HW1, I_HB1, I_HW2,
       I_HB2, I_HW3, I_HDEC, I_HBIAS, I_LCW, I_LCB, I_LWA, I_LBA, I_LWX, I_LBX, I_LLAM, I_WBR, I_WOUT, I_RW, I_RB, I_EG, I_EU, I_ED, I_SG, I_SU,
       I_SD, I_GF };

#define XB_TMO      128
#define XB_XCNT(j)  (256  + 64 * (j))
#define XB_XSUB(j)  (1280 + 64 * (j))
#define XB_XGEN(j)  (2304 + 64 * (j))
#define XB_TOP      3328
#define XB_TOPGEN   3392
#define XCD_BAR_WORDS 3456
#define XB_SPIN_CAP (1u << 18)
#define LAS __attribute__((address_space(3)))

__device__ __forceinline__ unsigned xb_ld(unsigned* p)              { return __hip_atomic_load(p, __ATOMIC_RELAXED, __HIP_MEMORY_SCOPE_AGENT); }
__device__ __forceinline__ unsigned xb_add(unsigned* p, unsigned v) { return __hip_atomic_fetch_add(p, v, __ATOMIC_RELAXED, __HIP_MEMORY_SCOPE_AGENT); }
__device__ __forceinline__ unsigned xb_xcc_id() { return (unsigned)__builtin_amdgcn_s_getreg((3 << 11) | 20) & 0xFu; }
#define XB_SPIN(cond, bar) do { unsigned _sp = 0; while (cond) { __builtin_amdgcn_s_sleep(1); \
    if ((++_sp & 255u) == 0u) { if (xb_ld(&(bar)[XB_TMO])) break; if (_sp > XB_SPIN_CAP) { atomicAdd(&(bar)[XB_TMO], 1u); break; } } } } while (0)

struct XcdBarrier { unsigned* bar; unsigned x; volatile LAS unsigned* st; };

__device__ __forceinline__ XcdBarrier xcd_barrier_post(unsigned* bar, volatile LAS unsigned* st) {
    XcdBarrier b; b.bar = bar; b.x = xb_xcc_id(); b.st = st;
    if (threadIdx.x == 0) (void)xb_add(&bar[XB_XCNT(b.x)], 1u);
    return b;
}
__device__ __forceinline__ void xcd_barrier_complete(unsigned* bar, unsigned x, unsigned& nloc, unsigned& nx) {
    const unsigned G = gridDim.x * gridDim.y * gridDim.z;
    unsigned sum, cnt, mine, sp = 0u;
    for (;;) {
        sum = 0u; cnt = 0u; mine = 0u;
#pragma unroll
        for (unsigned j = 0; j < 16; ++j) { const unsigned c = xb_ld(&bar[XB_XCNT(j)]); sum += c; cnt += (c > 0u) ? 1u : 0u; mine = (j == x) ? c : mine; }
        if (sum == G) break;
        __builtin_amdgcn_s_sleep(1);
        if ((++sp & 255u) == 0u) { if (xb_ld(&bar[XB_TMO])) break; if (sp > XB_SPIN_CAP) { atomicAdd(&bar[XB_TMO], 1u); break; } }
    }
    nloc = mine > 0u ? mine : 1u; nx = cnt > 0u ? cnt : 1u;
}
__device__ __forceinline__ void xcd_barrier(const XcdBarrier& b) {
    asm volatile("s_waitcnt vmcnt(0)" ::: "memory");
    __syncthreads();
    if (threadIdx.x == 0) {
        unsigned* bar = b.bar;
        __builtin_amdgcn_s_waitcnt(0);
        unsigned nloc = b.st[0], nx = b.st[1];
        if (nloc == 0u) { xcd_barrier_complete(bar, b.x, nloc, nx); b.st[0] = nloc; b.st[1] = nx; }
        const unsigned old = xb_add(&bar[XB_XSUB(b.x)], 1u);
        const unsigned gen = old / nloc;
        if (old + 1u == (gen + 1u) * nloc) {
            __builtin_amdgcn_fence(__ATOMIC_RELEASE, "agent");
            asm volatile("s_waitcnt vmcnt(0)" ::: "memory");
            const unsigned og = xb_add(&bar[XB_TOP], 1u);
            const unsigned tg = og / nx;
            if (og + 1u == (tg + 1u) * nx) xb_add(&bar[XB_TOPGEN], 1u);
            else XB_SPIN(xb_ld(&bar[XB_TOPGEN]) == tg, bar);
            __builtin_amdgcn_fence(__ATOMIC_ACQUIRE, "agent");
            xb_add(&bar[XB_XGEN(b.x)], 1u);
            asm volatile("s_waitcnt vmcnt(0)" ::: "memory");
        } else {
            XB_SPIN(xb_ld(&bar[XB_XGEN(b.x)]) == gen, bar);
            __builtin_amdgcn_fence(__ATOMIC_ACQUIRE, "agent");
            asm volatile("s_waitcnt vmcnt(0)" ::: "memory");
        }
    }
    __syncthreads();
}

extern __shared__ __attribute__((aligned(16))) char smem[];
typedef __attribute__((address_space(4))) const Params CParams;
__device__ __forceinline__ const Params& kparams() { CParams* q = (CParams*)__builtin_amdgcn_kernarg_segment_ptr(); asm volatile("" : "+s"(q)); return *(const Params*)q; }
__device__ __forceinline__ char* lds_at(unsigned off) { return (char*)(LAS char*)(uintptr_t)off; }
#define NOINL __device__ __forceinline__
#define UNIT_LOOP(u, n, off) for (int u = (int)((blockIdx.x + gridDim.x - ((off) % gridDim.x)) % gridDim.x); u < (n); u += gridDim.x)
DEVI int tidx() { int t = threadIdx.x; asm volatile("" : "+v"(t)); return t; }
DEVI float bf2f(bf16_t v) { return __uint_as_float((unsigned)v << 16); }
typedef __bf16 bf16v2 __attribute__((ext_vector_type(2)));
DEVI unsigned pk2(float lo, float hi) { bf16v2 v; v[0] = (__bf16)lo; v[1] = (__bf16)hi; return __builtin_bit_cast(unsigned, v); }
DEVI bf16_t f2bf(float v) { return (bf16_t)(pk2(v, 0.f) & 0xffffu); }
DEVI float lo_bf(unsigned u) { return __uint_as_float(u << 16); }
DEVI float hi_bf(unsigned u) { return __uint_as_float(u & 0xffff0000u); }
DEVI float sigmoidf_(float x) { return __builtin_amdgcn_rcpf(1.f + __expf(-x)); }
DEVI float wave_sum(float v) {
#pragma unroll
    for (int m = 32; m >= 1; m >>= 1) v += __shfl_xor(v, m);
    return v;
}
DEVI float wave_max(float v) {
#pragma unroll
    for (int m = 32; m >= 1; m >>= 1) v = fmaxf(v, __shfl_xor(v, m));
    return v;
}
DEVI unsigned f2e4m3(float x) {
    const unsigned s = (__float_as_uint(x) >> 24) & 0x80u;
    const float a = fminf(fabsf(x), 448.f);
    const unsigned au = __float_as_uint(a);
    const unsigned nrm = ((au + 0x7FFFFu + ((au >> 20) & 1u)) >> 20) - (120u << 3);
    const unsigned sub = (unsigned)__float2int_rn(a * 512.f);
    const unsigned mag = a < 0.015625f ? sub : nrm;
    return mag ? (s | mag) : 0u;
}
DEVI unsigned pk4_fp8(float a, float b, float c, float d) { return f2e4m3(a) | (f2e4m3(b) << 8) | (f2e4m3(c) << 16) | (f2e4m3(d) << 24); }
DEVI int row_b(int r) { return r < TL ? (r >> 12) : ((r - TL) >> 8); }
DEVI int row_key(int r) { return r < TL ? (r & 4095) : (4096 + ((r - TL) & 255)); }
DEVI int row_mod(int r) { return r < TL ? (r >> 12) : 8; }
DEVI const float* xsrc(const Params& p, int l, int r) {
    if (l == 0) return r < TL ? p.in[I_X] + (size_t)r * DM : p.in[I_CTX] + (size_t)(r - TL) * DM;
    return r < TL ? p.out + (size_t)r * DM : (const float*)(p.ws + OFF_XC) + (size_t)(r - TL) * DM;
}
DEVI float* xdst(const Params& p, int r) { return r < TL ? p.out + (size_t)r * DM : (float*)(p.ws + OFF_XC) + (size_t)(r - TL) * DM; }
DEVI int mt_row0(int mt) { return mt < 128 ? mt * 256 : TL + (mt - 128) * 256; }

#define MFMA(a, b, c) __builtin_amdgcn_mfma_f32_32x32x16_bf16((a), (b), (c), 0, 0, 0)

constexpr int G_LD = 72;
constexpr int G_ASZ = 256 * G_LD * 2;
constexpr int G_BSZ = 128 * G_LD * 2;
constexpr int G_STAGE = G_ASZ + G_BSZ;
constexpr int G_LDS = 2 * G_STAGE;

struct RowLoader {
    const bf16_t* p0; const bf16_t* p1; const bf16_t* p2; const bf16_t* p3; int soff;
    u32x4 r0, r1, r2, r3;
    DEVI void issue(int k0) { r0 = *(const u32x4*)(p0 + k0); r1 = *(const u32x4*)(p1 + k0); r2 = *(const u32x4*)(p2 + k0); r3 = *(const u32x4*)(p3 + k0); }
    DEVI void commit(bf16_t* As) const {
        *(u32x4*)(As + soff) = r0; *(u32x4*)(As + soff + 64 * G_LD) = r1; *(u32x4*)(As + soff + 128 * G_LD) = r2; *(u32x4*)(As + soff + 192 * G_LD) = r3;
    }
};

template <bool SW, int NI, class AL_>
DEVI void gemm_mainloop(f32x16 (&acc)[2][NI], AL_ al0, const bf16_t* __restrict__ Bt, int ldb, int K, char* lds) {
    const int tid = tidx(), lane = tid & 63, w = tid >> 6, wm = w >> 1, wn = w & 1, l31 = lane & 31, hh = lane >> 5;
    const int lr = tid >> 3, kc = (tid & 7) * 8;
    const bf16_t* bp0 = Bt + (size_t)lr * ldb + kc;
    const bf16_t* bp1 = Bt + (size_t)(lr + 64) * ldb + kc;
    AL_ al1 = al0;
    u32x4 b00, b01, b10, b11;
#pragma unroll
    for (int mi = 0; mi < 2; ++mi)
#pragma unroll
        for (int ni = 0; ni < NI; ++ni)
#pragma unroll
            for (int e = 0; e < 16; ++e) acc[mi][ni][e] = 0.f;
    const int nk = K >> 6;
    const int aoff = (wm * 64 + l31) * G_LD + 8 * hh, boff = (wn * 32 * NI + l31) * G_LD + 8 * hh, bst = lr * G_LD + kc;
    auto compute = [&](const char* st) __attribute__((always_inline)) {
        const bf16_t* As = (const bf16_t*)st; const bf16_t* Bs = (const bf16_t*)(st + G_ASZ);
#pragma unroll
        for (int ks = 0; ks < 4; ++ks) {
            bf16x8 af[2], bfr[NI];
#pragma unroll
            for (int mi = 0; mi < 2; ++mi) af[mi] = *(const bf16x8*)(As + aoff + mi * 32 * G_LD + ks * 16);
#pragma unroll
            for (int ni = 0; ni < NI; ++ni) bfr[ni] = *(const bf16x8*)(Bs + boff + ni * 32 * G_LD + ks * 16);
#pragma unroll
            for (int mi = 0; mi < 2; ++mi)
#pragma unroll
                for (int ni = 0; ni < NI; ++ni) {
                    if (SW) acc[mi][ni] = MFMA(bfr[ni], af[mi], acc[mi][ni]);
                    else    acc[mi][ni] = MFMA(af[mi], bfr[ni], acc[mi][ni]);
                }
            if (ks == 1) __builtin_amdgcn_sched_barrier(0);
        }
    };
    __syncthreads();
    al0.issue(0); b00 = *(const u32x4*)bp0; if (NI == 2) b01 = *(const u32x4*)bp1;
    { const int k0 = min(1, nk - 1) << 6; al1.issue(k0); b10 = *(const u32x4*)(bp0 + k0); if (NI == 2) b11 = *(const u32x4*)(bp1 + k0); }
    {
        bf16_t* As = (bf16_t*)lds; bf16_t* Bs = (bf16_t*)(lds + G_ASZ);
        al0.commit(As);
        *(u32x4*)(Bs + bst) = b00; if (NI == 2) *(u32x4*)(Bs + bst + 64 * G_LD) = b01;
    }
    __syncthreads();
    for (int kt = 0; kt < nk; kt += 2) {
        { const int k0 = min(kt + 2, nk - 1) << 6; al0.issue(k0); b00 = *(const u32x4*)(bp0 + k0); if (NI == 2) b01 = *(const u32x4*)(bp1 + k0); }
        compute(lds);
        if (kt + 1 < nk) {
            bf16_t* As = (bf16_t*)(lds + G_STAGE); bf16_t* Bs = (bf16_t*)(lds + G_STAGE + G_ASZ);
            al1.commit(As);
            *(u32x4*)(Bs + bst) = b10; if (NI == 2) *(u32x4*)(Bs + bst + 64 * G_LD) = b11;
        }
        __syncthreads();
        if (kt + 1 >= nk) break;
        { const int k0 = min(kt + 3, nk - 1) << 6; al1.issue(k0); b10 = *(const u32x4*)(bp0 + k0); if (NI == 2) b11 = *(const u32x4*)(bp1 + k0); }
        compute(lds + G_STAGE);
        if (kt + 2 < nk) {
            bf16_t* As = (bf16_t*)lds; bf16_t* Bs = (bf16_t*)(lds + G_ASZ);
            al0.commit(As);
            *(u32x4*)(Bs + bst) = b00; if (NI == 2) *(u32x4*)(Bs + bst + 64 * G_LD) = b01;
        }
        __syncthreads();
    }
}
template <bool SW, int NI, class AL_>
DEVI void gemm_mainloop1(f32x16 (&acc)[2][NI], AL_ al, const bf16_t* __restrict__ Bt, int ldb, int K, char* lds, int bhalf = -1) {
    const int tid = tidx(), lane = tid & 63, w = tid >> 6, wm = w >> 1, wn = w & 1, l31 = lane & 31, hh = lane >> 5;
    const int lr = tid >> 3, kc = (tid & 7) * 8;
    const bf16_t* bp0 = Bt + (size_t)(bhalf < 0 ? lr : ((lr >> 5) * 64 + bhalf * 32 + (lr & 31))) * ldb + kc;
    const bf16_t* bp1 = Bt + (size_t)(lr + 64) * ldb + kc;
    u32x4 rb0, rb1;
#pragma unroll
    for (int mi = 0; mi < 2; ++mi)
#pragma unroll
        for (int ni = 0; ni < NI; ++ni)
#pragma unroll
            for (int e = 0; e < 16; ++e) acc[mi][ni][e] = 0.f;
    __syncthreads();
    al.issue(0); rb0 = *(const u32x4*)bp0; if (NI == 2) rb1 = *(const u32x4*)bp1;
    {
        bf16_t* As = (bf16_t*)lds; bf16_t* Bs = (bf16_t*)(lds + G_ASZ);
        al.commit(As);
        *(u32x4*)(Bs + lr * G_LD + kc) = rb0; if (NI == 2) *(u32x4*)(Bs + (lr + 64) * G_LD + kc) = rb1;
    }
    __syncthreads();
    const int nk = K >> 6;
#pragma unroll 1
    for (int kt = 0; kt < nk; ++kt) {
        const bf16_t* As = (const bf16_t*)(lds + (kt & 1) * G_STAGE);
        const bf16_t* Bs = (const bf16_t*)(lds + (kt & 1) * G_STAGE + G_ASZ);
        const bool more = kt + 1 < nk;
        if (more) { const int k0 = (kt + 1) << 6; al.issue(k0); rb0 = *(const u32x4*)(bp0 + k0); if (NI == 2) rb1 = *(const u32x4*)(bp1 + k0); }
#pragma unroll
        for (int ks = 0; ks < 4; ++ks) {
            bf16x8 af[2], bfr[NI];
#pragma unroll
            for (int mi = 0; mi < 2; ++mi) af[mi] = *(const bf16x8*)(As + (wm * 64 + mi * 32 + l31) * G_LD + ks * 16 + 8 * hh);
#pragma unroll
            for (int ni = 0; ni < NI; ++ni) bfr[ni] = *(const bf16x8*)(Bs + (wn * 32 * NI + ni * 32 + l31) * G_LD + ks * 16 + 8 * hh);
#pragma unroll
            for (int mi = 0; mi < 2; ++mi)
#pragma unroll
                for (int ni = 0; ni < NI; ++ni) {
                    if (SW) acc[mi][ni] = MFMA(bfr[ni], af[mi], acc[mi][ni]);
                    else    acc[mi][ni] = MFMA(af[mi], bfr[ni], acc[mi][ni]);
                }
        }
        if (more) {
            bf16_t* An = (bf16_t*)(lds + ((kt + 1) & 1) * G_STAGE); bf16_t* Bn = (bf16_t*)(lds + ((kt + 1) & 1) * G_STAGE + G_ASZ);
            al.commit(An);
            *(u32x4*)(Bn + lr * G_LD + kc) = rb0; if (NI == 2) *(u32x4*)(Bn + (lr + 64) * G_LD + kc) = rb1;
        }
        __syncthreads();
    }
}
DEVI RowLoader make_rows(const bf16_t* base, size_t ld, int row0) {
    RowLoader r; const int tid = tidx(), lr = tid >> 3, kc = (tid & 7) * 8;
    r.p0 = base + (size_t)(row0 + lr) * ld + kc; r.p1 = r.p0 + 64 * ld; r.p2 = r.p0 + 128 * ld; r.p3 = r.p0 + 192 * ld; r.soff = lr * G_LD + kc;
    return r;
}

constexpr int K2_LD = 264;
constexpr int K2_BUF = 64 * K2_LD * 2;
struct K256A { bf16x8 f[2][16]; };
DEVI void k256_load_a(K256A& a, const bf16_t* A, size_t lda, int row0, char* lds) {
    const int tid = tidx(), lane = tid & 63, w = tid >> 6, wm = w >> 1, l31 = lane & 31, hh = lane >> 5;
    bf16_t* As = (bf16_t*)lds;
#pragma unroll 1
    for (int half = 0; half < 2; ++half) {
        __syncthreads();
        u32x4 r[8];
#pragma unroll
        for (int i = 0; i < 8; ++i) { const int c = tid + 512 * i; r[i] = *(const u32x4*)(A + (size_t)(row0 + half * 128 + (c >> 5)) * lda + (c & 31) * 8); }
#pragma unroll
        for (int i = 0; i < 8; ++i) { const int c = tid + 512 * i; *(u32x4*)(As + (c >> 5) * K2_LD + (c & 31) * 8) = r[i]; }
        __syncthreads();
        if ((wm >> 1) == half) {
#pragma unroll
            for (int mi = 0; mi < 2; ++mi)
#pragma unroll
                for (int ks = 0; ks < 16; ++ks) a.f[mi][ks] = *(const bf16x8*)(As + ((wm & 1) * 64 + mi * 32 + l31) * K2_LD + ks * 16 + 8 * hh);
        }
    }
}
template <class EPI>
DEVI void k256_stream(const K256A& a, const bf16_t* Bt, int n_tiles, char* lds, const EPI& epi) {
    const int tid = tidx(), lane = tid & 63, w = tid >> 6, wn = w & 1, l31 = lane & 31, hh = lane >> 5;
    const int br = tid >> 3, bc = (tid & 7) * 8;
    const bf16_t* bp = Bt + (size_t)br * 256 + bc;
    const int sto = br * K2_LD + bc, fro = (wn * 32 + l31) * K2_LD + 8 * hh;
    u32x4 s0, s1, s2, s3, t0, t1, t2, t3;
#define K2_ISSUE(j_, A_, B_, C_, D_) do { const bf16_t* _q = bp + (size_t)(j_) * 64 * 256; A_ = *(const u32x4*)_q; B_ = *(const u32x4*)(_q + 64); C_ = *(const u32x4*)(_q + 128); D_ = *(const u32x4*)(_q + 192); } while (0)
#define K2_COMMIT(buf_, A_, B_, C_, D_) do { bf16_t* _b = (bf16_t*)(lds + (buf_) * K2_BUF) + sto; *(u32x4*)_b = A_; *(u32x4*)(_b + 64) = B_; *(u32x4*)(_b + 128) = C_; *(u32x4*)(_b + 192) = D_; } while (0)
#define K2_TILE(j_, buf_) do { const bf16_t* Bs = (const bf16_t*)(lds + (buf_) * K2_BUF) + fro; f32x16 acc[2]; \
        _Pragma("unroll") for (int e = 0; e < 16; ++e) { acc[0][e] = 0.f; acc[1][e] = 0.f; } \
        _Pragma("unroll") for (int ks = 0; ks < 16; ++ks) { const bf16x8 bf = *(const bf16x8*)(Bs + ks * 16); acc[0] = MFMA(bf, a.f[0][ks], acc[0]); acc[1] = MFMA(bf, a.f[1][ks], acc[1]); } \
        epi((j_), acc); } while (0)
    __syncthreads();
    K2_ISSUE(0, s0, s1, s2, s3);
    K2_ISSUE(min(1, n_tiles - 1), t0, t1, t2, t3);
    K2_COMMIT(0, s0, s1, s2, s3);
    __syncthreads();
#pragma unroll 1
    for (int j = 0; j < n_tiles; j += 2) {
        K2_ISSUE(min(j + 2, n_tiles - 1), s0, s1, s2, s3);
        K2_TILE(j, 0);
        if (j + 1 < n_tiles) K2_COMMIT(1, t0, t1, t2, t3);
        __syncthreads();
        if (j + 1 >= n_tiles) break;
        K2_ISSUE(min(j + 3, n_tiles - 1), t0, t1, t2, t3);
        K2_TILE(j + 1, 1);
        if (j + 2 < n_tiles) K2_COMMIT(0, s0, s1, s2, s3);
        __syncthreads();
    }
#undef K2_ISSUE
#undef K2_COMMIT
#undef K2_TILE
}

template <int KS> struct KFragA { bf16x8 f[2][KS]; };
template <int KS>
DEVI void kx_load_a(KFragA<KS>& a, const bf16_t* A, size_t lda, int row0, char* lds, float* rs, float eps) {
    constexpr int K = 16 * KS, LD = K + 8, CPR = K / 8, NCH = 256 * CPR / 512;
    const int tid = tidx(), lane = tid & 63, w = tid >> 6, wm = w >> 1, l31 = lane & 31, hh = lane >> 5;
    bf16_t* As = (bf16_t*)lds;
    __syncthreads();
    {
        u32x4 r[NCH];
#pragma unroll
        for (int i = 0; i < NCH; ++i) { const int c = tid + 512 * i; r[i] = *(const u32x4*)(A + (size_t)(row0 + c / CPR) * lda + (c % CPR) * 8); }
#pragma unroll
        for (int i = 0; i < NCH; ++i) { const int c = tid + 512 * i; *(u32x4*)(As + (c / CPR) * LD + (c % CPR) * 8) = r[i]; }
    }
    __syncthreads();
#pragma unroll
    for (int mi = 0; mi < 2; ++mi)
#pragma unroll
        for (int ks = 0; ks < KS; ++ks) a.f[mi][ks] = *(const bf16x8*)(As + (wm * 64 + mi * 32 + l31) * LD + ks * 16 + 8 * hh);
    if (tid < 256) { float ss = 0.f;
#pragma unroll
        for (int i = 0; i < CPR; ++i) { const u32x4 v = *(const u32x4*)(As + tid * LD + 8 * i);
#pragma unroll
            for (int j = 0; j < 4; ++j) { const float x = lo_bf(v[j]), y = hi_bf(v[j]); ss += x * x + y * y; } }
        rs[tid] = rsqrtf(ss * (1.f / (float)K) + eps); }
    __syncthreads();
}
template <int KS, class EPI>
DEVI void kx_stream(const KFragA<KS>& a, const bf16_t* Bt, int n_tiles, char* lds, const EPI& epi) {
    constexpr int K = 16 * KS, LD = K + 8, CPR = K / 8, NCH = 64 * CPR / 512, BUF = 64 * LD * 2;
    const int tid = tidx(), lane = tid & 63, w = tid >> 6, wn = w & 1, l31 = lane & 31, hh = lane >> 5;
    u32x4 s[NCH];
    auto issue = [&](int j) __attribute__((always_inline)) {
#pragma unroll
        for (int i = 0; i < NCH; ++i) { const int c = tid + 512 * i; s[i] = *(const u32x4*)(Bt + (size_t)(j * 64 + c / CPR) * K + (c % CPR) * 8); } };
    auto commit = [&](int buf) __attribute__((always_inline)) {
#pragma unroll
        for (int i = 0; i < NCH; ++i) { const int c = tid + 512 * i; *(u32x4*)((bf16_t*)(lds + buf * BUF) + (c / CPR) * LD + (c % CPR) * 8) = s[i]; } };
    __syncthreads();
    issue(0); commit(0);
    __syncthreads();
#pragma unroll 1
    for (int j = 0; j < n_tiles; ++j) {
        const bool more = j + 1 < n_tiles;
        issue(more ? j + 1 : j);
        const bf16_t* Bs = (const bf16_t*)(lds + (j & 1) * BUF) + (wn * 32 + l31) * LD + 8 * hh;
        f32x16 acc[2];
#pragma unroll
        for (int e = 0; e < 16; ++e) { acc[0][e] = 0.f; acc[1][e] = 0.f; }
#pragma unroll
        for (int ks = 0; ks < KS; ++ks) { const bf16x8 bf = *(const bf16x8*)(Bs + ks * 16); acc[0] = MFMA(bf, a.f[0][ks], acc[0]); acc[1] = MFMA(bf, a.f[1][ks], acc[1]); }
        epi(j, acc);
        if (more) commit((j + 1) & 1);
        __syncthreads();
    }
}
DEVI void mod_unit(const Params& p, int u, char* lds) {
    const int tid = tidx(), l = u / 96, j0 = (u % 96) * 64;
    float* sc = (float*)lds; float* red = sc + 9 * 1024;
    __syncthreads();
    for (int i = tid; i < 9 * 1024; i += 512) { const int row = i >> 10, k = i & 1023; const float v = row < 8 ? p.in[I_C][row * 1024 + k] : p.in[I_CCTX][k]; sc[i] = v / (1.f + expf(-v)); }
    __syncthreads();
    const int col = tid & 63, kg = tid >> 6;
    float a[9];
#pragma unroll
    for (int r = 0; r < 9; ++r) a[r] = 0.f;
    const float* w = p.in[I_WMOD] + (size_t)l * 1024 * 6144 + j0 + col;
    for (int k = kg * 128; k < kg * 128 + 128; ++k) {
        const float wv = w[(size_t)k * 6144];
#pragma unroll
        for (int r = 0; r < 9; ++r) a[r] += sc[r * 1024 + k] * wv;
    }
#pragma unroll
    for (int r = 0; r < 9; ++r) red[(kg * 9 + r) * 64 + col] = a[r];
    __syncthreads();
    float* mod = (float*)(p.ws + OFF_MOD);
    for (int i = tid; i < 9 * 64; i += 512) {
        const int r = i >> 6, cc = i & 63; float s = 0.f;
#pragma unroll
        for (int g = 0; g < 8; ++g) s += red[(g * 9 + r) * 64 + cc];
        mod[(size_t)(l * 9 + r) * 6144 + j0 + cc] = s + p.in[I_BMOD][l * 6144 + j0 + cc];
    }
}
DEVI void rope_unit(const Params& p, int v) {
    const int idx = v * 512 + tidx(), pos = idx >> 4, i = idx & 15, fi = i & 7;
    const float inv = powf(10000.f, -(float)fi / 8.f);
    const float coord = (float)(i < 8 ? (pos >> 6) : (pos & 63));
    const float ang = coord * inv;
    ((float*)(p.ws + OFF_COS))[idx] = cosf(ang);
    ((float*)(p.ws + OFF_SIN))[idx] = sinf(ang);
}
DEVI void norm_rows(const Params& p, int l, int r0, int r1, int which  ) {
    const int lane = tidx() & 63, w = tidx() >> 6;
    const float* mod = (const float*)(p.ws + OFF_MOD);
    bf16_t* h = (bf16_t*)(p.ws + OFF_H);
    const float* gn = p.in[which ? I_GN2 : I_GN1] + l * 1024;
#pragma unroll 1
    for (int r = r0 + w; r < r1; r += 16) {
        float4 xv[2][4], gq[4], shq[2][4], scq[2][4]; float ss[2] = {0.f, 0.f};
#pragma unroll
        for (int u = 0; u < 2; ++u) {
            const int rr = min(r + 8 * u, r1 - 1);
            const float* src = which ? (const float*)xdst(p, rr) : xsrc(p, l, rr);
            const float* mr = mod + (size_t)(l * 9 + row_mod(rr)) * 6144 + (which ? 3072 : 0);
#pragma unroll
            for (int q = 0; q < 4; ++q) { const int k = 4 * lane + 256 * q; xv[u][q] = *(const float4*)(src + k); shq[u][q] = *(const float4*)(mr + k); scq[u][q] = *(const float4*)(mr + 1024 + k); }
        }
#pragma unroll
        for (int q = 0; q < 4; ++q) gq[q] = *(const float4*)(gn + 4 * lane + 256 * q);
        __builtin_amdgcn_sched_barrier(0);
#pragma unroll
        for (int u = 0; u < 2; ++u) {
#pragma unroll
            for (int q = 0; q < 4; ++q) ss[u] += xv[u][q].x * xv[u][q].x + xv[u][q].y * xv[u][q].y + xv[u][q].z * xv[u][q].z + xv[u][q].w * xv[u][q].w;
            ss[u] = wave_sum(ss[u]);
        }
#pragma unroll
        for (int u = 0; u < 2; ++u) {
            const int rr = r + 8 * u;
            if (rr < r1) {
                const float rstd = rsqrtf(ss[u] * (1.f / 1024.f) + 1e-6f);
#pragma unroll
                for (int q = 0; q < 4; ++q) {
                    const int k = 4 * lane + 256 * q;
                    const float4 g = gq[q], sh = shq[u][q], sc = scq[u][q];
                    const float o0 = xv[u][q].x * rstd * g.x * (1.f + sc.x) + sh.x, o1 = xv[u][q].y * rstd * g.y * (1.f + sc.y) + sh.y;
                    const float o2 = xv[u][q].z * rstd * g.z * (1.f + sc.z) + sh.z, o3 = xv[u][q].w * rstd * g.w * (1.f + sc.w) + sh.w;
                    uint2 pk; pk.x = pk2(o0, o1); pk.y = pk2(o2, o3);
                    *(uint2*)(h + (size_t)rr * DM + k) = pk;
                }
            }
        }
    }
}

DEVI void quant_rows(const Params& p, int r0, int r1) {
    const int lane = tidx() & 63, w = tidx() >> 6;
    const bf16_t* h = (const bf16_t*)(p.ws + OFF_H);
    float* rs = (float*)(p.ws + OFF_RS);
#pragma unroll 1
    for (int rb = r0 + w; rb < r1; rb += 32) {
        uint4 a0[4], a1[4];
#pragma unroll
        for (int u = 0; u < 4; ++u) { const int r = min(rb + 8 * u, r1 - 1); a0[u] = *(const uint4*)(h + (size_t)r * DM + 8 * lane); a1[u] = *(const uint4*)(h + (size_t)r * DM + 512 + 8 * lane); }
        __builtin_amdgcn_sched_barrier(0);
#pragma unroll
        for (int u = 0; u < 4; ++u) {
            const int r = rb + 8 * u;
            if (r < r1) {
                const uint4 v0 = a0[u], v1 = a1[u];
                float m = fmaxf(fmaxf(fmaxf(fabsf(lo_bf(v0.x)), fabsf(hi_bf(v0.x))), fmaxf(fabsf(lo_bf(v0.y)), fabsf(hi_bf(v0.y)))), fmaxf(fmaxf(fabsf(lo_bf(v0.z)), fabsf(hi_bf(v0.z))), fmaxf(fabsf(lo_bf(v0.w)), fabsf(hi_bf(v0.w)))));
                m = fmaxf(m, fmaxf(fmaxf(fmaxf(fabsf(lo_bf(v1.x)), fabsf(hi_bf(v1.x))), fmaxf(fabsf(lo_bf(v1.y)), fabsf(hi_bf(v1.y)))), fmaxf(fmaxf(fabsf(lo_bf(v1.z)), fabsf(hi_bf(v1.z))), fmaxf(fabsf(lo_bf(v1.w)), fabsf(hi_bf(v1.w))))));
                m = fmaxf(wave_max(m), 1e-20f);
                const float s = 256.f / m;
                uint2 o0, o1;
                o0.x = pk4_fp8(lo_bf(v0.x) * s, hi_bf(v0.x) * s, lo_bf(v0.y) * s, hi_bf(v0.y) * s); o0.y = pk4_fp8(lo_bf(v0.z) * s, hi_bf(v0.z) * s, lo_bf(v0.w) * s, hi_bf(v0.w) * s);
                o1.x = pk4_fp8(lo_bf(v1.x) * s, hi_bf(v1.x) * s, lo_bf(v1.y) * s, hi_bf(v1.y) * s); o1.y = pk4_fp8(lo_bf(v1.z) * s, hi_bf(v1.z) * s, lo_bf(v1.w) * s, hi_bf(v1.w) * s);
                *(uint2*)(p.ws + OFF_H8 + (size_t)r * 1024 + 8 * lane) = o0;
                *(uint2*)(p.ws + OFF_H8 + (size_t)r * 1024 + 512 + 8 * lane) = o1;
                if (lane == 0) rs[r] = m * (1.f / (256.f * WG8_SCALE));
            }
        }
    }
}

constexpr int CJ_WIN = 0, CJ_WUQ = CJ_WIN + 8 * 102, CJ_WUKV = CJ_WUQ + 3 * 6, CJ_WBR = CJ_WUKV + 1 * 8, CJ_WOUT = CJ_WBR + 4 * 32, CJ_RT = CJ_WOUT + 128,
              CJ_EG = CJ_RT + 8, CJ_EU = CJ_EG + 65 * 32, CJ_ED = CJ_EU + 65 * 32, CJ_LW = CJ_ED + 65 * 32, CJ_END = CJ_LW + 16;
DEVI int win_map(int n) {
    if (n < 352) return n;
    if (n < 1120) { const int j = n - 352; return j < 256 ? ZC_NAQ + j : (j < 512 ? ZC_NAK + (j - 256) : ZLD + ZT_NAV + (j - 512)); }
    if (n < 1888) return ZLD + ZT_HY + (n - 1120);
    if (n < 2144) return ZC_LU + (n - 1888);
    if (n < 2400) return ZC_LG + (n - 2144);
    { const int np = n - 2400, g = np >> 10, col = np & 1023, pn = col >> 6, c64 = col & 63;
      return WIN_G0 + pn * 256 + 128 * (g >> 1) + 32 * (c64 >> 4) + 16 * (g & 1) + 4 * ((c64 >> 2) & 3) + (c64 & 3); }
}
template <int STAGE>
DEVI void conv_unit(const Params& p, int l, int cu, char* lds, float4 (&v)[4]) {
    const int tid = tidx();
    const float* src; int K, N, kt, nt, KH = 128; bf16_t* dst; int mode = 0; const float* ksc = nullptr;
    if (cu < CJ_WUQ) { const int t = cu - CJ_WIN; kt = t / 102; nt = t % 102; src = p.in[I_WIN] + (size_t)l * 1024 * 6496; K = 1024; N = 6496; dst = (bf16_t*)(p.ws + OFF_WIN); mode = 1; }
    else if (cu < CJ_WUKV) { const int t = cu - CJ_WUQ; kt = t / 6; nt = t % 6; src = p.in[I_WUQ] + (size_t)l * 192 * 384; K = 192; N = 384; dst = (bf16_t*)(p.ws + OFF_WUQ); ksc = p.in[I_GQ] + l * 192; KH = 64; }
    else if (cu < CJ_WBR) { const int t = cu - CJ_WUKV; kt = 0; nt = t; src = p.in[I_WUKV] + (size_t)l * 128 * 512; K = 128; N = 512; dst = (bf16_t*)(p.ws + OFF_WUKV); ksc = p.in[I_GKV] + l * 128; }
    else if (cu < CJ_WOUT) { const int t = cu - CJ_WBR, k = t >> 5, tt = t & 31; kt = tt >> 4; nt = tt & 15; src = p.in[I_WBR] + (size_t)(l * 4 + k) * 256 * 1024; K = 256; N = 1024; dst = (bf16_t*)(p.ws + OFF_WBR) + (size_t)k * 1024 * 256; }
    else if (cu < CJ_RT) { const int t = cu - CJ_WOUT; kt = t >> 4; nt = t & 15; src = p.in[I_WOUT] + (size_t)l * 1024 * 1024; K = 1024; N = 1024; dst = (bf16_t*)(p.ws + OFF_WOUT); }
    else if (cu < CJ_EG) { kt = cu - CJ_RT; nt = 0; src = p.in[I_RW] + (size_t)l * 1024 * 64; K = 1024; N = 64; dst = (bf16_t*)(p.ws + OFF_RT); mode = 4; }
    else if (cu < CJ_EU) { const int t = cu - CJ_EG, e = t >> 5, tt = t & 31; kt = tt >> 2; nt = tt & 3; src = e < 64 ? p.in[I_EG] + (size_t)(l * 64 + e) * 1024 * 256 : p.in[I_SG] + (size_t)l * 1024 * 256; K = 1024; N = 256; dst = (bf16_t*)(p.ws + OFF_WGU) + (size_t)e * 512 * 1024; mode = 2; }
    else if (cu < CJ_ED) { const int t = cu - CJ_EU, e = t >> 5, tt = t & 31; kt = tt >> 2; nt = tt & 3; src = e < 64 ? p.in[I_EU] + (size_t)(l * 64 + e) * 1024 * 256 : p.in[I_SU] + (size_t)l * 1024 * 256; K = 1024; N = 256; dst = (bf16_t*)(p.ws + OFF_WGU) + (size_t)e * 512 * 1024; mode = 3; }
    else if (cu >= CJ_LW) { const int t = cu - CJ_LW, d = t >> 3, g = (t >> 2) & 1, n = t & 3; kt = 0; nt = 0; src = p.in[g ? I_LWX : I_LWA] + (size_t)((l * 2 + d) * 4 + n) * 4096; K = 64; N = 64; dst = (bf16_t*)(p.ws + OFF_LWT) + (size_t)((d * 2 + g) * 4 + n) * 4096; KH = 64; }
    else { const int t = cu - CJ_ED, e = t >> 5, tt = t & 31; kt = tt >> 4; nt = tt & 15; src = e < 64 ? p.in[I_ED] + (size_t)(l * 64 + e) * 256 * 1024 : p.in[I_SD] + (size_t)l * 256 * 1024; K = 256; N = 1024; dst = (bf16_t*)(p.ws + OFF_WDT) + (size_t)e * 1024 * 256; }
    float* tl = (float*)lds;
    if constexpr (STAGE == 0) {
        const int kk = tid >> 4, n4 = (tid & 15) * 4, n = nt * 64 + n4, nc = min(n, N - 4);
#pragma unroll
        for (int ps = 0; ps < 4; ++ps) { const int pr = ps * 32 < KH ? ps : 0; v[ps] = *(const float4*)(src + (size_t)(kt * KH + kk + 32 * pr) * N + nc); }
        return;
    }
    __syncthreads();
    {
        const int kk = tid >> 4, n4 = (tid & 15) * 4, n = nt * 64 + n4;
        if (n >= N) {
#pragma unroll
            for (int ps = 0; ps < 4; ++ps) v[ps] = make_float4(0.f, 0.f, 0.f, 0.f);
        }
#pragma unroll
        for (int ps = 0; ps < 4; ++ps) if (ps * 32 < KH) {
            float4 x = v[ps];
            if (ksc) { const float s = ksc[kt * KH + kk + 32 * ps]; x.x *= s; x.y *= s; x.z *= s; x.w *= s; }
            float* t = tl + (kk + 32 * ps) * 65 + n4; t[0] = x.x; t[1] = x.y; t[2] = x.z; t[3] = x.w; }
    }
    __syncthreads();
    {
        const int nn = tid >> 3, n = nt * 64 + nn;
#pragma unroll
        for (int q = 0; q < 2; ++q) if (q * 64 < KH) {
            const int kc = (tid & 7) * 8 + 64 * q;
            if (n < N) {
                int dr = n;
                if (mode == 1) dr = win_map(n);
                else if (mode == 2 || mode == 3) { const int r = n & 127; dr = (n >> 7) * 256 + 128 * (r >> 6) + 32 * ((r >> 4) & 3) + 16 * (mode - 2) + 4 * ((r >> 2) & 3) + (r & 3); }
                if (mode == 1 && n >= 2400) {
                    uint2 o8;
                    o8.x = pk4_fp8(tl[(kc + 0) * 65 + nn] * WG8_SCALE, tl[(kc + 1) * 65 + nn] * WG8_SCALE, tl[(kc + 2) * 65 + nn] * WG8_SCALE, tl[(kc + 3) * 65 + nn] * WG8_SCALE);
                    o8.y = pk4_fp8(tl[(kc + 4) * 65 + nn] * WG8_SCALE, tl[(kc + 5) * 65 + nn] * WG8_SCALE, tl[(kc + 6) * 65 + nn] * WG8_SCALE, tl[(kc + 7) * 65 + nn] * WG8_SCALE);
                    *(uint2*)(p.ws + OFF_WG8 + (size_t)(dr - WIN_G0) * 1024 + kt * KH + kc) = o8;
                } else {
                uint4 o;
                o.x = pk2(tl[(kc + 0) * 65 + nn], tl[(kc + 1) * 65 + nn]); o.y = pk2(tl[(kc + 2) * 65 + nn], tl[(kc + 3) * 65 + nn]);
                o.z = pk2(tl[(kc + 4) * 65 + nn], tl[(kc + 5) * 65 + nn]); o.w = pk2(tl[(kc + 6) * 65 + nn], tl[(kc + 7) * 65 + nn]);
                *(uint4*)(dst + (size_t)dr * K + kt * KH + kc) = o;
                }
                if (mode == 4) *(uint4*)(dst + (size_t)(64 + n) * K + kt * KH + kc) = make_uint4(0u, 0u, 0u, 0u);
            }
            if (mode == 1 && nt == 0 && nn < 32) *(uint4*)(dst + (size_t)(352 + nn) * K + kt * KH + kc) = make_uint4(0u, 0u, 0u, 0u);
            if (mode == 1 && nt >= 1 && nt <= 2) *(uint4*)(dst + (size_t)(NIN + (nt - 1) * 64 + nn) * K + kt * KH + kc) = make_uint4(0u, 0u, 0u, 0u);
        }
    }
}
DEVI void h2tab_unit(const Params& p, int l, int hu, char* lds) {
    const int tid = tidx();
    const int L = hu < 64 ? 4096 : 256, pos0 = hu < 64 ? hu * 64 : (hu - 64) * 64, rbase = hu < 64 ? 0 : 4096;
    float* feats = (float*)lds; float* h1 = feats + 64 * 33;
    const float* w1 = p.in[I_HW1] + l * 33 * 64; const float* b1 = p.in[I_HB1] + l * 64;
    const float* w2 = p.in[I_HW2] + l * 64 * 64; const float* b2 = p.in[I_HB2] + l * 64;
    __syncthreads();
    for (int i = tid; i < 64 * 33; i += 512) {
        const int pl = i / 33, f = i % 33, pos = pos0 + pl; float v;
        if (f == 0) v = (float)pos / (float)(L - 1);
        else { const int j = (f - 1) & 15; const float wv = 6.283185307179586f * (float)pos / (float)L; const float fj = 1e-4f + (float)j * ((15.f - 1e-4f) / 15.f); const float zz = wv * fj; v = f <= 16 ? cosf(zz) : -sinf(zz); }
        feats[i] = v;
    }
    __syncthreads();
    const int pl = tid >> 3, og = tid & 7;
    float o[8];
#pragma unroll
    for (int j = 0; j < 8; ++j) o[j] = b1[og * 8 + j];
#pragma unroll 1
    for (int i = 0; i < 33; ++i) { const float f = feats[pl * 33 + i];
#pragma unroll
        for (int j = 0; j < 8; ++j) o[j] += f * w1[i * 64 + og * 8 + j]; }
#pragma unroll
    for (int j = 0; j < 8; ++j) h1[pl * 64 + og * 8 + j] = sinf(o[j]);
    __syncthreads();
#pragma unroll
    for (int j = 0; j < 8; ++j) o[j] = b2[og * 8 + j];
#pragma unroll 2
    for (int i = 0; i < 64; ++i) { const float f = h1[pl * 64 + i];
#pragma unroll
        for (int j = 0; j < 8; ++j) o[j] += f * w2[i * 64 + og * 8 + j]; }
    float* tab = (float*)(p.ws + OFF_H2T) + (size_t)(rbase + pos0 + pl) * 64 + og * 8;
#pragma unroll
    for (int j = 0; j < 8; ++j) tab[j] = sinf(o[j]);
}
DEVI void fft_twiddles(float2* tw) {
    for (int i = tidx(); i < 4096; i += 512) { float s, c; sincospif((float)i * (1.f / 4096.f), &s, &c); tw[i] = make_float2(c, -s); }
}

DEVI int PI(int i) { return i + (i >> 5); }
DEVI float2 cmul(float2 a, float2 b) { return make_float2(a.x * b.x - a.y * b.y, a.x * b.y + a.y * b.x); }
DEVI float2 cmulc(float2 a, float2 b) { return make_float2(a.x * b.x + a.y * b.y, a.y * b.x - a.x * b.y); }
template <int E> DEVI float2 mulw16(float2 d) {
    constexpr float C[8] = {1.f, 0.9238795325112867f, 0.7071067811865476f, 0.3826834323650898f, 0.f, -0.3826834323650898f, -0.7071067811865476f, -0.9238795325112867f};
    constexpr float S[8] = {0.f, 0.3826834323650898f, 0.7071067811865476f, 0.9238795325112867f, 1.f, 0.9238795325112867f, 0.7071067811865476f, 0.3826834323650898f};
    if (E == 0) return d;
    if (E == 4) return make_float2(d.y, -d.x);
    return make_float2(d.x * C[E] + d.y * S[E], d.y * C[E] - d.x * S[E]);
}
template <int I, int H> DEVI void bfly16(float2 (&v)[16]) { const float2 a = v[I], b = v[I + H]; v[I] = make_float2(a.x + b.x, a.y + b.y); v[I + H] = mulw16<(I & (H - 1)) * (8 / H)>(make_float2(a.x - b.x, a.y - b.y)); }
template <bool ZHI> DEVI void dft16(float2 (&v)[16]) {
    if (ZHI) { v[8] = v[0]; v[9] = mulw16<1>(v[1]); v[10] = mulw16<2>(v[2]); v[11] = mulw16<3>(v[3]); v[12] = mulw16<4>(v[4]); v[13] = mulw16<5>(v[5]); v[14] = mulw16<6>(v[6]); v[15] = mulw16<7>(v[7]); }
    else { bfly16<0, 8>(v); bfly16<1, 8>(v); bfly16<2, 8>(v); bfly16<3, 8>(v); bfly16<4, 8>(v); bfly16<5, 8>(v); bfly16<6, 8>(v); bfly16<7, 8>(v); }
    bfly16<0, 4>(v); bfly16<1, 4>(v); bfly16<2, 4>(v); bfly16<3, 4>(v); bfly16<8, 4>(v); bfly16<9, 4>(v); bfly16<10, 4>(v); bfly16<11, 4>(v);
    bfly16<0, 2>(v); bfly16<1, 2>(v); bfly16<4, 2>(v); bfly16<5, 2>(v); bfly16<8, 2>(v); bfly16<9, 2>(v); bfly16<12, 2>(v); bfly16<13, 2>(v);
    bfly16<0, 1>(v); bfly16<2, 1>(v); bfly16<4, 1>(v); bfly16<6, 1>(v); bfly16<8, 1>(v); bfly16<10, 1>(v); bfly16<12, 1>(v); bfly16<14, 1>(v);
}
#define BR4(k) ((((k) & 1) << 3) | (((k) & 2) << 1) | (((k) & 4) >> 1) | (((k) & 8) >> 3))
DEVI void fwd_store16(float2 (&v)[16], float2 w1, float2* X, int base, int S) {
    float2 w = w1;
    X[PI(base)] = v[0];
#pragma unroll
    for (int k = 1; k < 16; ++k) { X[PI(base + k * S)] = cmul(v[BR4(k)], w); if (k < 15) w = cmul(w, w1); }
}
DEVI void inv_load16(float2 (&v)[16], float2 w1, const float2* X, int base, int S) {
    float2 w = w1;
    { const float2 a = X[PI(base)]; v[0] = make_float2(a.x, -a.y); }
#pragma unroll
    for (int k = 1; k < 16; ++k) { const float2 a = cmulc(X[PI(base + k * S)], w); v[k] = make_float2(a.x, -a.y); if (k < 15) w = cmul(w, w1); }
}
DEVI float2 tw8192(const float2* tw, int idx) { const float2 t = tw[idx & 4095]; return (idx & 4096) ? make_float2(-t.x, -t.y) : t; }
DEVI void fft_fwd_C(float2* X, const float2* tw, int tid) {
    float2 v[16];
    const int n_lo = tid & 1, base = (tid >> 1) * 32 + n_lo;
#pragma unroll
    for (int r = 0; r < 16; ++r) v[r] = X[PI(base + 2 * r)];
    dft16<false>(v); fwd_store16(v, tw[256 * n_lo], X, base, 2);
    __syncthreads();
}
DEVI void fft_fwd_BC(float2* X, const float2* tw, int tid) {
    float2 v[16];
    { const int n_lo = tid & 31, base = (tid >> 5) * 512 + n_lo;
#pragma unroll
      for (int r = 0; r < 16; ++r) v[r] = X[PI(base + 32 * r)];
      dft16<false>(v); fwd_store16(v, tw[16 * n_lo], X, base, 32); }
    __syncthreads();
    fft_fwd_C(X, tw, tid);
}
DEVI void fft_inv_C(float2* X, const float2* tw, int tid) {
    float2 v[16];
    const int n_lo = tid & 1, base = (tid >> 1) * 32 + n_lo;
    inv_load16(v, tw[256 * n_lo], X, base, 2); dft16<false>(v);
#pragma unroll
    for (int n = 0; n < 16; ++n) X[PI(base + 2 * n)] = make_float2(v[BR4(n)].x, -v[BR4(n)].y);
    __syncthreads();
}
DEVI void fft_inv_CB(float2* X, const float2* tw, int tid) {
    fft_inv_C(X, tw, tid);
    float2 v[16];
    { const int n_lo = tid & 31, base = (tid >> 5) * 512 + n_lo;
      inv_load16(v, tw[16 * n_lo], X, base, 32); dft16<false>(v);
#pragma unroll
      for (int n = 0; n < 16; ++n) X[PI(base + 32 * n)] = make_float2(v[BR4(n)].x, -v[BR4(n)].y); }
    __syncthreads();
}
template <class HF>
DEVI void fft512x16_conv(float2 (&io)[8], const HF& Hq, float2* X, const float2* tw, int tid) {
    const int n_lo = tid & 31, baseB = (tid >> 5) * 512 + n_lo;
    {
        float2 v[16];
#pragma unroll
        for (int r = 0; r < 8; ++r) v[r] = io[r];
        dft16<true>(v);
        fwd_store16(v, tw[16 * n_lo], X, baseB, 32);
    }
    __syncthreads();
    fft_fwd_C(X, tw, tid);
#pragma unroll
    for (int i = 0; i < 8; ++i) {
        const int q = tid + 512 * i;
        const float4 hv = *(const float4*)(Hq(q >> 8) + 2 * (q & 255));
        const float2 a = X[PI(2 * q)], b = X[PI(2 * q + 1)];
        const float2 g0 = cmul(make_float2(a.x + b.x, a.y + b.y), make_float2(hv.x, hv.y)), g1 = cmul(make_float2(a.x - b.x, a.y - b.y), make_float2(hv.z, hv.w));
        X[PI(2 * q)] = make_float2(g0.x + g1.x, g0.y + g1.y); X[PI(2 * q + 1)] = make_float2(g0.x - g1.x, g0.y - g1.y);
    }
    __syncthreads();
    fft_inv_C(X, tw, tid);
    {
        float2 v[16];
        inv_load16(v, tw[16 * n_lo], X, baseB, 32); dft16<false>(v);
#pragma unroll
        for (int n = 0; n < 8; ++n) io[n] = make_float2(v[BR4(n)].x, -v[BR4(n)].y);
    }
    __syncthreads();
}
DEVI void fft_conv8192(float2 (&io)[8], const float2* __restrict__ H, float2* X, const float2* tw, int tid) {
    float4 hq[8];
#pragma unroll
    for (int i = 0; i < 8; ++i) hq[i] = *(const float4*)(H + 2 * (tid + 512 * i));
    {
        float2 v[16];
#pragma unroll
        for (int r = 0; r < 8; ++r) v[r] = io[r];
        dft16<true>(v);
        fwd_store16(v, tw[tid], X, tid, 512);
    }
    __syncthreads();
    fft_fwd_BC(X, tw, tid);
#pragma unroll
    for (int i = 0; i < 8; ++i) {
        const int q = tid + 512 * i;
        const float4 hv = hq[i];
        const float2 a = X[PI(2 * q)], b = X[PI(2 * q + 1)];
        const float2 g0 = cmul(make_float2(a.x + b.x, a.y + b.y), make_float2(hv.x, hv.y)), g1 = cmul(make_float2(a.x - b.x, a.y - b.y), make_float2(hv.z, hv.w));
        X[PI(2 * q)] = make_float2(g0.x + g1.x, g0.y + g1.y); X[PI(2 * q + 1)] = make_float2(g0.x - g1.x, g0.y - g1.y);
    }
    __syncthreads();
    fft_inv_CB(X, tw, tid);
    {
        float2 v[16];
        inv_load16(v, tw[tid], X, tid, 512); dft16<false>(v);
#pragma unroll
        for (int n = 0; n < 8; ++n) io[n] = make_float2(v[BR4(n)].x, -v[BR4(n)].y);
    }
    __syncthreads();
}
DEVI void fft_spectrum8192(float2 (&in)[16], float2* __restrict__ Hout, float2* X, const float2* tw, int tid) {
    dft16<false>(in);
    fwd_store16(in, tw[tid], X, tid, 512);
    __syncthreads();
    fft_fwd_BC(X, tw, tid);
#pragma unroll
    for (int i = 0; i < 8; ++i) {
        const int q = tid + 512 * i;
        const float2 a = X[PI(2 * q)], b = X[PI(2 * q + 1)];
        *(float4*)(Hout + 2 * q) = make_float4(a.x + b.x, a.y + b.y, a.x - b.x, a.y - b.y);
    }
    __syncthreads();
}


DEVI void spectrum8192_unit(const Params& p, int l, int n, int c, char* lds) {
    const int tid = tidx();
    float2* X = (float2*)lds; float2* tw = X + 8448; float* w3c = (float*)(tw + 4096);
    const float* h2tab = (const float*)(p.ws + OFF_H2T);
    __syncthreads();
    fft_twiddles(tw);
    if (tid < 128) { const int dir = tid >> 6, k = tid & 63; w3c[tid] = p.in[I_HW3][(size_t)(l * 64 + k) * 1024 + (n * 2 + dir) * 256 + c]; }
    const float dec0 = fabsf(p.in[I_HDEC][((l * 2 + n) * 2 + 0) * 256 + c]), dec1 = fabsf(p.in[I_HDEC][((l * 2 + n) * 2 + 1) * 256 + c]);
    __syncthreads();
    float* F = (float*)X;
    {
        const int part = tid & 7, rsub = tid >> 3;
        float w0[8], w1[8];
#pragma unroll
        for (int i = 0; i < 8; ++i) { w0[i] = w3c[part * 8 + i]; w1[i] = w3c[64 + part * 8 + i]; }
#pragma unroll 8
        for (int ch = 0; ch < 64; ++ch) {
            const int j = ch * 64 + rsub;
            const float4 a = *(const float4*)(h2tab + (size_t)j * 64 + part * 8), b = *(const float4*)(h2tab + (size_t)j * 64 + part * 8 + 4);
            float d0 = a.x * w0[0] + a.y * w0[1] + a.z * w0[2] + a.w * w0[3] + b.x * w0[4] + b.y * w0[5] + b.z * w0[6] + b.w * w0[7];
            float d1 = a.x * w1[0] + a.y * w1[1] + a.z * w1[2] + a.w * w1[3] + b.x * w1[4] + b.y * w1[5] + b.z * w1[6] + b.w * w1[7];
            d0 += __shfl_xor(d0, 1); d1 += __shfl_xor(d1, 1); d0 += __shfl_xor(d0, 2); d1 += __shfl_xor(d1, 2); d0 += __shfl_xor(d0, 4); d1 += __shfl_xor(d1, 4);
            F[j] = d0; F[4096 + j] = d1;
        }
    }
    __syncthreads();
    float2 v[16];
#pragma unroll
    for (int r = 0; r < 16; ++r) {
        const int t = tid + 512 * r;
        const int j = t < 4096 ? t : 8192 - t, dir = t < 4096 ? 0 : 1;
        const float f = F[dir * 4096 + (j & 4095)] * expf(-((float)j / 4095.f) * (dir ? dec1 : dec0));
        v[r] = make_float2(t != 4096 ? f : 0.f, 0.f);
    }
    __syncthreads();
    fft_spectrum8192(v, (float2*)(p.ws + OFF_HS) + (size_t)(n * 256 + c) * 8192, X, tw, tid);
}
DEVI float conv3(const bf16_t* r, int t, int L, float w0, float w1, float w2, float b) {
    const float c = bf2f(r[t]), lf = bf2f(r[max(t - 1, 0)]), rg = bf2f(r[min(t + 1, L - 1)]);
    return b + w1 * c + (t > 0 ? w0 : 0.f) * lf + (t < L - 1 ? w2 : 0.f) * rg;
}

DEVI void hyena8192_unit(const Params& p, int l, int c, int b0, char* lds) {
    const int tid = tidx();
    float2* X = (float2*)lds; float2* tw = X + 8448;
    const bf16_t* zT = (const bf16_t*)(p.ws + OFF_ZT);
    bf16_t* yT = (bf16_t*)(p.ws + OFF_YT);
    const float2* H0 = (const float2*)(p.ws + OFF_HS) + (size_t)c * 8192; const float2* H1 = H0 + (size_t)256 * 8192;
    const float* sw = p.in[I_HSW] + l * 3 * 768; const float* sb = p.in[I_HSB] + l * 768;
    const float bias0 = p.in[I_HBIAS][(l * 2 + 0) * 256 + c], bias1 = p.in[I_HBIAS][(l * 2 + 1) * 256 + c];
    const size_t base0 = (size_t)(b0 * 1024 + ZT_HY + c) * NKEY, base1 = base0 + (size_t)1024 * NKEY;
    const float inv = 1.f / 8192.f;
    float2 io[8], vr[8], x1[8], x2[8];
#pragma unroll
    for (int r = 0; r < 8; ++r) { const int t = tid + 512 * r;
        vr[r] = make_float2(conv3(zT + base0, t, 4096, sw[c], sw[768 + c], sw[1536 + c], sb[c]), conv3(zT + base1, t, 4096, sw[c], sw[768 + c], sw[1536 + c], sb[c]));
        x1[r] = make_float2(conv3(zT + base0 + (size_t)256 * NKEY, t, 4096, sw[256 + c], sw[768 + 256 + c], sw[1536 + 256 + c], sb[256 + c]),
                            conv3(zT + base1 + (size_t)256 * NKEY, t, 4096, sw[256 + c], sw[768 + 256 + c], sw[1536 + 256 + c], sb[256 + c]));
        x2[r] = make_float2(conv3(zT + base0 + (size_t)512 * NKEY, t, 4096, sw[512 + c], sw[768 + 512 + c], sw[1536 + 512 + c], sb[512 + c]),
                            conv3(zT + base1 + (size_t)512 * NKEY, t, 4096, sw[512 + c], sw[768 + 512 + c], sw[1536 + 512 + c], sb[512 + c]));
        io[r] = vr[r]; }
    fft_conv8192(io, H0, X, tw, tid);
#pragma unroll
    for (int r = 0; r < 8; ++r) {
        vr[r] = make_float2(x1[r].x * (io[r].x * inv + vr[r].x * bias0), x1[r].y * (io[r].y * inv + vr[r].y * bias0));
        io[r] = vr[r]; }
    fft_conv8192(io, H1, X, tw, tid);
#pragma unroll
    for (int r = 0; r < 8; ++r) {
        vr[r] = make_float2(x2[r].x * (io[r].x * inv + vr[r].x * bias1), x2[r].y * (io[r].y * inv + vr[r].y * bias1)); }
    __builtin_amdgcn_sched_barrier(0);
#pragma unroll
    for (int r = 0; r < 8; ++r) { const int t = tid + 512 * r;
        yT[(size_t)((b0 + 0) * 256 + c) * NKEY + t] = f2bf(vr[r].x);
        yT[(size_t)((b0 + 1) * 256 + c) * NKEY + t] = f2bf(vr[r].y); }
}

DEVI void spectrum512_unit(const Params& p, int l, int su, char* lds) {
    const int tid = tidx(), n_lo = tid & 31, blk = tid >> 5, f = su * 16 + blk, n = f >> 8, c = f & 255;
    float2* X = (float2*)lds; float2* tw = X + 8448;
    const float* h2tab = (const float*)(p.ws + OFF_H2T) + 4096 * 64;
    __syncthreads();
    fft_twiddles(tw);
    const float dec0 = fabsf(p.in[I_HDEC][((l * 2 + n) * 2 + 0) * 256 + c]), dec1 = fabsf(p.in[I_HDEC][((l * 2 + n) * 2 + 1) * 256 + c]);
    float* w3s = (float*)(tw + 4096);
    for (int i = tid; i < 16 * 128; i += 512) { const int fb = i >> 7, dir = (i >> 6) & 1, k = i & 63, ff = su * 16 + fb;
        w3s[i] = p.in[I_HW3][(size_t)(l * 64 + k) * 1024 + ((ff >> 8) * 2 + dir) * 256 + (ff & 255)]; }
    __syncthreads();
    float* T = (float*)X;
#pragma unroll
    for (int i = 0; i < 8; ++i) { const int idx = tid + 512 * i, row = idx >> 4, c4 = (idx & 15) * 4; const float4 hv = *(const float4*)(h2tab + (size_t)row * 64 + c4);
        float* d = T + row * 65 + c4; d[0] = hv.x; d[1] = hv.y; d[2] = hv.z; d[3] = hv.w; }
    __syncthreads();
    float2 v[16];
#pragma unroll
    for (int dir = 0; dir < 2; ++dir) {
        float fa[8]; int jr[8];
#pragma unroll
        for (int r = 0; r < 8; ++r) { const int t = n_lo + 32 * (r + 8 * dir); jr[r] = (dir ? 512 - t : t) & 255; fa[r] = 0.f; }
        const float* wc = w3s + blk * 128 + dir * 64;
#pragma unroll 4
        for (int k = 0; k < 64; ++k) { const float wk = wc[k];
#pragma unroll
            for (int r = 0; r < 8; ++r) fa[r] += T[jr[r] * 65 + k] * wk; }
#pragma unroll
        for (int r = 0; r < 8; ++r) { const int t = n_lo + 32 * (r + 8 * dir); const int jj = dir ? 512 - t : t;
            const float fv = fa[r] * expf(-((float)jj / 255.f) * (dir ? dec1 : dec0));
            v[r + 8 * dir] = make_float2(t != 256 ? fv : 0.f, 0.f); }
    }
    __syncthreads();
    dft16<false>(v);
    fwd_store16(v, tw[16 * n_lo], X, blk * 512 + n_lo, 32);
    __syncthreads();
    fft_fwd_C(X, tw, tid);
    float2* Hout = (float2*)(p.ws + OFF_HSC) + (size_t)su * 16 * 512;
#pragma unroll
    for (int i = 0; i < 8; ++i) { const int q = tid + 512 * i; const float2 a = X[PI(2 * q)], b = X[PI(2 * q + 1)];
        *(float4*)(Hout + 2 * q) = make_float4(a.x + b.x, a.y + b.y, a.x - b.x, a.y - b.y); }
    __syncthreads();
}
DEVI void hyena512_unit(const Params& p, int l, int hu, char* lds) {
    const int tid = tidx(), n_lo = tid & 31, blk = tid >> 5, c0 = hu * 4, c = c0 + (blk >> 2), b0 = 2 * (blk & 3);
    float2* X = (float2*)lds; float2* tw = X + 8448;
    const bf16_t* zT = (const bf16_t*)(p.ws + OFF_ZT);
    bf16_t* yT = (bf16_t*)(p.ws + OFF_YT);
    const float2* HC = (const float2*)(p.ws + OFF_HSC);
    const float* sw = p.in[I_HSW] + l * 3 * 768; const float* sb = p.in[I_HSB] + l * 768;
    const float bias0 = p.in[I_HBIAS][(l * 2 + 0) * 256 + c], bias1 = p.in[I_HBIAS][(l * 2 + 1) * 256 + c];
    const size_t base0 = (size_t)(b0 * 1024 + ZT_HY + c) * NKEY + 4096, base1 = base0 + (size_t)1024 * NKEY;
    const float inv = 1.f / 512.f;
    auto H0 = [&](int j) __attribute__((always_inline)) -> const float2* { return HC + (size_t)(c0 + (j >> 2)) * 512; };
    auto H1 = [&](int j) __attribute__((always_inline)) -> const float2* { return HC + (size_t)(256 + c0 + (j >> 2)) * 512; };
    float2 io[8], vr[8];
#pragma unroll
    for (int r = 0; r < 8; ++r) { const int t = n_lo + 32 * r;
        vr[r] = make_float2(conv3(zT + base0, t, 256, sw[c], sw[768 + c], sw[1536 + c], sb[c]), conv3(zT + base1, t, 256, sw[c], sw[768 + c], sw[1536 + c], sb[c]));
        io[r] = vr[r]; }
    fft512x16_conv(io, H0, X, tw, tid);
#pragma unroll
    for (int r = 0; r < 8; ++r) { const int t = n_lo + 32 * r;
        const float x10 = conv3(zT + base0 + (size_t)256 * NKEY, t, 256, sw[256 + c], sw[768 + 256 + c], sw[1536 + 256 + c], sb[256 + c]);
        const float x11 = conv3(zT + base1 + (size_t)256 * NKEY, t, 256, sw[256 + c], sw[768 + 256 + c], sw[1536 + 256 + c], sb[256 + c]);
        vr[r] = make_float2(x10 * (io[r].x * inv + vr[r].x * bias0), x11 * (io[r].y * inv + vr[r].y * bias0));
        io[r] = vr[r]; }
    fft512x16_conv(io, H1, X, tw, tid);
#pragma unroll
    for (int r = 0; r < 8; ++r) { const int t = n_lo + 32 * r;
        const float x20 = conv3(zT + base0 + (size_t)512 * NKEY, t, 256, sw[512 + c], sw[768 + 512 + c], sw[1536 + 512 + c], sb[512 + c]);
        const float x21 = conv3(zT + base1 + (size_t)512 * NKEY, t, 256, sw[512 + c], sw[768 + 512 + c], sw[1536 + 512 + c], sb[512 + c]);
        vr[r] = make_float2(x20 * (io[r].x * inv + vr[r].x * bias1), x21 * (io[r].y * inv + vr[r].y * bias1)); }
    __builtin_amdgcn_sched_barrier(0);
#pragma unroll
    for (int r = 0; r < 8; ++r) { const int t = n_lo + 32 * r;
        yT[(size_t)((b0 + 0) * 256 + c) * NKEY + 4096 + t] = f2bf(vr[r].x);
        yT[(size_t)((b0 + 1) * 256 + c) * NKEY + 4096 + t] = f2bf(vr[r].y); }
}
DEVI void hyena_unit(const Params& p, int l, int hu, char* lds) {
    float2* X = (float2*)lds; float2* tw = X + 8448;
    __syncthreads();
    fft_twiddles(tw);
    __syncthreads();
    if (hu < 1024) hyena8192_unit(p, l, hu & 255, 2 * (hu >> 8), lds);
    else hyena512_unit(p, l, hu - 1024, lds);
}

struct KVTile { const bf16_t* k; const bf16_t* vt; };
template <int DQ, bool NA, class TF>
DEVI void attn_core(const bf16x8 (&qf)[DQ / 16], int ntiles, const TF& tilefn, int kstride, int vstride,
                    int r_q, int qc, int kr_lo, int nloc, const float* rpb_s, f32x16 (&o)[2], float& lsum, char* lds) {
    constexpr int KLD = DQ + 8, KCH = DQ / 8, KSZ = 64 * KLD * 2, VSZ = 64 * 72 * 2, ST = KSZ + VSZ;
    constexpr int NKC = (64 * KCH + 511) / 512;
    const int tid = tidx(), lane = tid & 63, l31 = lane & 31, hh = lane >> 5;
    float m = -1e30f; lsum = 0.f;
#pragma unroll
    for (int e = 0; e < 16; ++e) { o[0][e] = 0.f; o[1][e] = 0.f; }
    const int r0 = min(max(r_q - 4, 0), 56), c0 = min(max(qc - 8, 0), 48);
    u32x4 rk0, rk1, rv, sk0, sk1, sv;
#define AT_ISSUE(j_, K0, K1, V_) do { const KVTile t = tilefn(j_); \
        { const int c = tid; const int key = c / KCH, ch = c % KCH; K0 = *(const u32x4*)(t.k + (size_t)key * kstride + ch * 8); } \
        if (NKC == 2) { const int c = min(tid + 512, 64 * KCH - 1); const int key = c / KCH, ch = c % KCH; K1 = *(const u32x4*)(t.k + (size_t)key * kstride + ch * 8); } \
        V_ = *(const u32x4*)(t.vt + (size_t)(tid >> 3) * vstride + (tid & 7) * 8); } while (0)
#define AT_COMMIT(buf_, K0, K1, V_) do { bf16_t* Ks_ = (bf16_t*)(lds + (buf_) * ST); bf16_t* Vs_ = (bf16_t*)(lds + (buf_) * ST + KSZ); \
        { const int c = tid; const int key = c / KCH, ch = c % KCH; *(u32x4*)(Ks_ + key * KLD + ch * 8) = K0; } \
        if (NKC == 2) { const int c = tid + 512; if (c < 64 * KCH) { const int key = c / KCH, ch = c % KCH; *(u32x4*)(Ks_ + key * KLD + ch * 8) = K1; } } \
        *(u32x4*)(Vs_ + (tid >> 3) * 72 + (tid & 7) * 8) = V_; } while (0)
    auto tile = [&](int j) __attribute__((always_inline)) {
        const int kr = kr_lo + j;
        const bool active = !NA || j >= nloc || (kr >= r0 && kr < r0 + 8);
        if (active) {
            const bf16_t* Ks = (const bf16_t*)(lds + (j & 1) * ST); const bf16_t* Vs = (const bf16_t*)(lds + (j & 1) * ST + KSZ);
            f32x16 s0, s1;
#pragma unroll
            for (int e = 0; e < 16; ++e) { s0[e] = 0.f; s1[e] = 0.f; }
#pragma unroll
            for (int ks = 0; ks < DQ / 16; ++ks) {
                const bf16x8 k0 = *(const bf16x8*)(Ks + l31 * KLD + ks * 16 + 8 * hh);
                const bf16x8 k1 = *(const bf16x8*)(Ks + (32 + l31) * KLD + ks * 16 + 8 * hh);
                s0 = MFMA(k0, qf[ks], s0); s1 = MFMA(k1, qf[ks], s1);
            }
            if (NA && j < nloc) {
                const float* rb = rpb_s + (kr - r_q + 7) * 31 + 15 - qc;
#pragma unroll
                for (int e = 0; e < 16; ++e) {
                    const int kc = (e & 3) + 8 * (e >> 2) + 4 * hh;
                    const bool v0 = kc >= c0 && kc < c0 + 16, v1 = (kc + 32) >= c0 && (kc + 32) < c0 + 16;
                    s0[e] = v0 ? s0[e] + rb[kc] : -1e30f;
                    s1[e] = v1 ? s1[e] + rb[kc + 32] : -1e30f;
                }
            }
            float mx = s0[0];
#pragma unroll
            for (int e = 1; e < 16; ++e) mx = fmaxf(mx, s0[e]);
#pragma unroll
            for (int e = 0; e < 16; ++e) mx = fmaxf(mx, s1[e]);
            mx = fmaxf(mx, __shfl_xor(mx, 32));
            const float mn = fmaxf(m, mx), alpha = __builtin_amdgcn_exp2f(m - mn);
            m = mn;
            float ps = 0.f;
#pragma unroll
            for (int e = 0; e < 16; ++e) { s0[e] = __builtin_amdgcn_exp2f(s0[e] - mn); s1[e] = __builtin_amdgcn_exp2f(s1[e] - mn); ps += s0[e] + s1[e]; }
            lsum = lsum * alpha + ps;
#pragma unroll
            for (int e = 0; e < 16; ++e) { o[0][e] *= alpha; o[1][e] *= alpha; }
#pragma unroll
            for (int s4 = 0; s4 < 4; ++s4) {
                const int bs = 8 * (s4 & 1);
                u32x4 pu;
                if (s4 < 2) { pu[0] = pk2(s0[bs], s0[bs + 1]); pu[1] = pk2(s0[bs + 2], s0[bs + 3]); pu[2] = pk2(s0[bs + 4], s0[bs + 5]); pu[3] = pk2(s0[bs + 6], s0[bs + 7]); }
                else        { pu[0] = pk2(s1[bs], s1[bs + 1]); pu[1] = pk2(s1[bs + 2], s1[bs + 3]); pu[2] = pk2(s1[bs + 4], s1[bs + 5]); pu[3] = pk2(s1[bs + 6], s1[bs + 7]); }
                const bf16x8 pfv = __builtin_bit_cast(bf16x8, pu);
#pragma unroll
                for (int dvt = 0; dvt < 2; ++dvt) {
                    const uint2 v0 = *(const uint2*)(Vs + (dvt * 32 + l31) * 72 + s4 * 16 + 4 * hh);
                    const uint2 v1 = *(const uint2*)(Vs + (dvt * 32 + l31) * 72 + s4 * 16 + 8 + 4 * hh);
                    u32x4 vu; vu[0] = v0.x; vu[1] = v0.y; vu[2] = v1.x; vu[3] = v1.y;
                    o[dvt] = MFMA(__builtin_bit_cast(bf16x8, vu), pfv, o[dvt]);
                }
            }
        }
    };
    __syncthreads();
    AT_ISSUE(0, rk0, rk1, rv); AT_COMMIT(0, rk0, rk1, rv);
    AT_ISSUE(min(1, ntiles - 1), sk0, sk1, sv);
    __syncthreads();
#pragma unroll 1
    for (int j = 0; j < ntiles; j += 2) {
        AT_ISSUE(min(j + 2, ntiles - 1), rk0, rk1, rv);
        tile(j);
        AT_COMMIT(1, sk0, sk1, sv);
        __syncthreads();
        if (j + 1 >= ntiles) break;
        AT_ISSUE(min(j + 3, ntiles - 1), sk0, sk1, sv);
        tile(j + 1);
        AT_COMMIT(0, rk0, rk1, rv);
        __syncthreads();
    }
#undef AT_ISSUE
#undef AT_COMMIT
    lsum += __shfl_xor(lsum, 32);
}
DEVI void attn_store(const f32x16 (&o)[2], float lsum, bf16_t* dst  ) {
    const int lane = tidx() & 63, hh = lane >> 5;
    const float il = 1.f / lsum;
#pragma unroll
    for (int dvt = 0; dvt < 2; ++dvt)
#pragma unroll
        for (int g = 0; g < 4; ++g) { uint2 v; v.x = pk2(o[dvt][4 * g] * il, o[dvt][4 * g + 1] * il); v.y = pk2(o[dvt][4 * g + 2] * il, o[dvt][4 * g + 3] * il);
            *(uint2*)(dst + dvt * 32 + 8 * g + 4 * hh) = v; }
}
DEVI void na_unit(const Params& p, int l, int au, char* lds) {
    const int tid = tidx(), lane = tid & 63, w = tid >> 6, l31 = lane & 31, hh = lane >> 5;
    const bf16_t* z = (const bf16_t*)(p.ws + OFF_Z); const bf16_t* zT = (const bf16_t*)(p.ws + OFF_ZT);
    bf16_t* br = (bf16_t*)(p.ws + OFF_BR);
    const bool isctx = au >= 512;
    int b, h, R;
    if (!isctx) { b = au >> 6; h = (au >> 4) & 3; R = au & 15; } else { b = (au - 512) >> 2; h = (au - 512) & 3; R = 0; }
    float* rpb_s = (float*)(lds + 2 * (64 * 72 * 2 + 64 * 72 * 2));
    __syncthreads();
    for (int i = tid; i < 465; i += 512) rpb_s[i] = p.in[I_RPB][(size_t)(l * 4 + h) * 465 + i] * 1.4426950408889634f;
    const int r_q = 4 * R + (w >> 1), qc = (w & 1) * 32 + l31;
    const int qrow = isctx ? TL + b * 256 + w * 32 + l31 : b * 4096 + r_q * 64 + qc;
    bf16x8 qf[4];
    {
        const bf16_t* qs = z + (size_t)qrow * ZLD + ZC_NAQ + h * 64 + 8 * hh;
        const float sc = 0.125f * 1.4426950408889634f;
#pragma unroll
        for (int ks = 0; ks < 4; ++ks) { const uint4 v = *(const uint4*)(qs + ks * 16); u32x4 t;
            t[0] = pk2(lo_bf(v.x) * sc, hi_bf(v.x) * sc); t[1] = pk2(lo_bf(v.y) * sc, hi_bf(v.y) * sc); t[2] = pk2(lo_bf(v.z) * sc, hi_bf(v.z) * sc); t[3] = pk2(lo_bf(v.w) * sc, hi_bf(v.w) * sc);
            qf[ks] = __builtin_bit_cast(bf16x8, t); }
    }
    int kr_lo = 0, nloc = 0;
    if (!isctx) { kr_lo = min(max(4 * R - 4, 0), 56); const int kr_hi = min(max(4 * R - 1, 0), 56) + 7; nloc = kr_hi - kr_lo + 1; }
    const bf16_t* kb = z + ZC_NAK + h * 64; const bf16_t* vb = zT + (size_t)(b * 1024 + ZT_NAV + h * 64) * NKEY;
    auto tf = [&](int j) { KVTile t;
        if (j < nloc) { const int kr = kr_lo + j; t.k = kb + (size_t)(b * 4096 + kr * 64) * ZLD; t.vt = vb + kr * 64; }
        else { const int i = j - nloc; t.k = kb + (size_t)(TL + b * 256 + 64 * i) * ZLD; t.vt = vb + 4096 + 64 * i; }
        return t; };
    f32x16 o[2]; float ls;
    attn_core<64, true>(qf, nloc + 4, tf, ZLD, NKEY, r_q, qc, kr_lo, nloc, rpb_s, o, ls, lds);
    attn_store(o, ls, br + (size_t)qrow * DM + 256 + h * 64);
}
DEVI void lru1_unit(const Params& p, int l, int lu, char* lds) {
    const int tid = tidx(), c = tid & 255, half = tid >> 8, lane = tid & 63, w = tid >> 6, l31 = lane & 31, hh = lane >> 5;
    const int tt = lu >> 1, d = lu & 1;
    const int row0 = tt * 64;
    const int s0 = row0 < TL ? (row0 & 4095) : ((row0 - TL) & 255);
    const int L = row0 < TL ? 4096 : 256;
    const bf16_t* z = (const bf16_t*)(p.ws + OFF_Z);
    constexpr int XLD = 264;
    bf16_t* xs = (bf16_t*)lds;
    float* As = (float*)(lds + 34816);
    bf16_t* Bs = (bf16_t*)(lds + 34816 + 65536);
    const int n = w & 3, th = w >> 2;
    bf16x8 wf[2][2][4];
    {
        const bf16_t* wt = (const bf16_t*)(p.ws + OFF_LWT);
#pragma unroll
        for (int g = 0; g < 2; ++g)
#pragma unroll
            for (int ct = 0; ct < 2; ++ct)
#pragma unroll
                for (int ks = 0; ks < 4; ++ks) wf[g][ct][ks] = *(const bf16x8*)(wt + (size_t)((d * 2 + g) * 4 + n) * 4096 + (ct * 32 + l31) * 64 + ks * 16 + 8 * hh);
    }
    float cba[2], cbx[2], csp[2];
#pragma unroll
    for (int ct = 0; ct < 2; ++ct) { const int ch = 64 * n + ct * 32 + l31; cba[ct] = p.in[I_LBA][(l * 2 + d) * 256 + ch]; cbx[ct] = p.in[I_LBX][(l * 2 + d) * 256 + ch]; csp[ct] = p.in[I_LLAM][(l * 2 + d) * 256 + ch]; }
    __syncthreads();
    {
        const float* cw = p.in[I_LCW] + (size_t)(l * 2 + d) * 4 * 256; const float cb = p.in[I_LCB][(l * 2 + d) * 256 + c];
        const float w0 = cw[c], w1 = cw[256 + c], w2 = cw[512 + c], w3 = cw[768 + c];
        const bf16_t* zu = z + (size_t)(row0 - s0) * ZLD + ZC_LU + c;
        auto U = [&](int s) -> float { const float v = bf2f(zu[(size_t)min(max(s, 0), L - 1) * ZLD]); return (s >= 0 && s < L) ? v : 0.f; };
        const int sb = s0 + 32 * half - (d == 0 ? 3 : 0);
        float uv[35];
#pragma unroll
        for (int i = 0; i < 35; ++i) uv[i] = U(sb + i);
#pragma unroll
        for (int i = 0; i < 32; ++i) xs[(32 * half + i) * XLD + c] = f2bf(cb + w0 * uv[i] + w1 * uv[i + 1] + w2 * uv[i + 2] + w3 * uv[i + 3]);
    }
    __syncthreads();
    {
        f32x16 acc[2][2];
#pragma unroll
        for (int g = 0; g < 2; ++g)
#pragma unroll
            for (int ct = 0; ct < 2; ++ct)
#pragma unroll
                for (int e = 0; e < 16; ++e) acc[g][ct][e] = 0.f;
#pragma unroll
        for (int ks = 0; ks < 4; ++ks) {
            const bf16x8 af = *(const bf16x8*)(xs + (th * 32 + l31) * XLD + 64 * n + ks * 16 + 8 * hh);
#pragma unroll
            for (int g = 0; g < 2; ++g)
#pragma unroll
                for (int ct = 0; ct < 2; ++ct) acc[g][ct] = MFMA(af, wf[g][ct][ks], acc[g][ct]);
        }
#pragma unroll
        for (int ct = 0; ct < 2; ++ct) {
            const int ch = 64 * n + ct * 32 + l31;
            const float ba = cba[ct], bx = cbx[ct];
            const float sp = log1pf(expf(-csp[ct]));
#pragma unroll
            for (int e = 0; e < 16; ++e) {
                const int tl = th * 32 + (e & 3) + 8 * (e >> 2) + 4 * hh;
                const float r = sigmoidf_(acc[0][ct][e] + ba), ig = sigmoidf_(acc[1][ct][e] + bx);
                const float la = -8.f * r * sp, a = __expf(la), mult = __builtin_amdgcn_sqrtf(fmaxf(1.f - a * a, 0.f));
                As[tl * 256 + ch] = a;
                Bs[tl * 256 + ch] = f2bf(mult * ig * bf2f(xs[tl * XLD + ch]));
            }
        }
    }
    __syncthreads();
    bf16_t* hloc = (bf16_t*)(p.ws + OFF_HLOC) + (size_t)d * TT * 256; bf16_t* cuma = (bf16_t*)(p.ws + OFF_CUMA) + (size_t)d * TT * 256;
    float hst = 0.f, cum = 1.f;
    for (int i = 0; i < 32; ++i) {
        const int tl = 32 * half + (d == 0 ? i : 31 - i);
        const float a = As[tl * 256 + c], bt = bf2f(Bs[tl * 256 + c]);
        hst = a * hst + bt; cum *= a;
        hloc[(size_t)(row0 + tl) * 256 + c] = f2bf(hst); cuma[(size_t)(row0 + tl) * 256 + c] = f2bf(cum);
    }
    const int seg = tt * 2 + half;
    ((float*)(p.ws + OFF_SEGA))[(size_t)(d * 1088 + seg) * 256 + c] = cum;
    ((float*)(p.ws + OFF_SEGB))[(size_t)(d * 1088 + seg) * 256 + c] = hst;
}
DEVI void qproj_unit(const Params& p, int qu, char* lds) {
    const int mt = qu >> 1, nh = qu & 1;
    const int tid = tidx(), lane = tid & 63, w = tid >> 6, wm = w >> 1, wn = w & 1, l31 = lane & 31, hh = lane >> 5;
    const bf16_t* z = (const bf16_t*)(p.ws + OFF_Z);
    const int row0 = mt_row0(mt);
    float* rs = (float*)(lds + 120 * 1024);
    KFragA<12> a;
    kx_load_a<12>(a, z + ZC_QL, ZLD, row0, lds, rs, 1e-6f);
    bf16_t* Q = (bf16_t*)(p.ws + OFF_Q);
    const float* cosT = (const float*)(p.ws + OFF_COS); const float* sinT = (const float*)(p.ws + OFF_SIN);
    const float QS = 0.10206207261596575f * 1.4426950408889634f;
    const bool lat = mt < 128;
    kx_stream<12>(a, (const bf16_t*)(p.ws + OFF_WUQ) + (size_t)nh * 192 * 192, 3, lds, [&](int j, const f32x16 (&acc)[2]) __attribute__((always_inline)) {
        const int ct = nh * 6 + j * 2 + wn, hd = ct / 3, part = ct % 3;
#pragma unroll
        for (int mi = 0; mi < 2; ++mi) {
            const int rl = wm * 64 + mi * 32 + l31, row = row0 + rl, b = row_b(row), key = row_key(row);
            const float rstd = rs[rl] * QS;
            float v[16];
#pragma unroll
            for (int e = 0; e < 16; ++e) v[e] = acc[mi][e] * rstd;
            if (part == 2 && lat) {
#pragma unroll
                for (int g = 0; g < 2; ++g)
#pragma unroll
                    for (int jj = 0; jj < 4; ++jj) { const int i = 8 * g + 4 * hh + jj; const float cs = cosT[key * 16 + i], sn = sinT[key * 16 + i];
                        const float x1 = v[4 * g + jj], x2 = v[4 * (g + 2) + jj]; v[4 * g + jj] = x1 * cs - x2 * sn; v[4 * (g + 2) + jj] = x1 * sn + x2 * cs; }
            }
            bf16_t* dst = Q + ((size_t)((b * 4 + hd) * NKEY + key)) * 96 + part * 32 + 4 * hh;
#pragma unroll
            for (int g = 0; g < 4; ++g) { uint2 o; o.x = pk2(v[4 * g], v[4 * g + 1]); o.y = pk2(v[4 * g + 2], v[4 * g + 3]); *(uint2*)(dst + 8 * g) = o; }
        }
    });
}
DEVI void kvproj_unit(const Params& p, int ku, char* lds) {
    const int mt = ku >> 1, nh = ku & 1;
    const int tid = tidx(), lane = tid & 63, w = tid >> 6, wm = w >> 1, wn = w & 1, l31 = lane & 31, hh = lane >> 5;
    const bf16_t* z = (const bf16_t*)(p.ws + OFF_Z);
    const int row0 = mt_row0(mt);
    float* rs = (float*)(lds + 120 * 1024);
    bf16_t* Kb = (bf16_t*)(p.ws + OFF_K); bf16_t* Vt = (bf16_t*)(p.ws + OFF_VT);
    const float* cosT = (const float*)(p.ws + OFF_COS); const float* sinT = (const float*)(p.ws + OFF_SIN);
    const bool lat = mt < 128;
    if (nh == 0) {
        const int rl = tid >> 1, part = tid & 1, row = row0 + rl, b = row_b(row), key = row_key(row);
        const bf16_t* zr = z + (size_t)row * ZLD + ZC_KR;
        const u32x4 q1 = *(const u32x4*)(zr + 8 * part), q2 = *(const u32x4*)(zr + 16 + 8 * part);
        const int kk = lat ? key : 0;
        const float4 ca = *(const float4*)(cosT + kk * 16 + 8 * part), cb = *(const float4*)(cosT + kk * 16 + 8 * part + 4);
        const float4 sa = *(const float4*)(sinT + kk * 16 + 8 * part), sb2 = *(const float4*)(sinT + kk * 16 + 8 * part + 4);
        const float csv[8] = {ca.x, ca.y, ca.z, ca.w, cb.x, cb.y, cb.z, cb.w}, snv[8] = {sa.x, sa.y, sa.z, sa.w, sb2.x, sb2.y, sb2.z, sb2.w};
        float y1[8], y2[8];
#pragma unroll
        for (int ii = 0; ii < 8; ++ii) { const float x1 = (ii & 1) ? hi_bf(q1[ii >> 1]) : lo_bf(q1[ii >> 1]), x2 = (ii & 1) ? hi_bf(q2[ii >> 1]) : lo_bf(q2[ii >> 1]);
            const float cs = lat ? csv[ii] : 1.f, sn = lat ? snv[ii] : 0.f; y1[ii] = x1 * cs - x2 * sn; y2[ii] = x1 * sn + x2 * cs; }
        u32x4 o1, o2;
#pragma unroll
        for (int j = 0; j < 4; ++j) { o1[j] = pk2(y1[2 * j], y1[2 * j + 1]); o2[j] = pk2(y2[2 * j], y2[2 * j + 1]); }
#pragma unroll
        for (int hd = 0; hd < 4; ++hd) { bf16_t* kd = Kb + ((size_t)((b * 4 + hd) * NKEY + key)) * 96 + 64 + 8 * part; *(u32x4*)kd = o1; *(u32x4*)(kd + 16) = o2; }
    }
    KFragA<8> a;
    kx_load_a<8>(a, z + ZC_KVL, ZLD, row0, lds, rs, 1e-6f);
    kx_stream<8>(a, (const bf16_t*)(p.ws + OFF_WUKV) + (size_t)nh * 256 * 128, 4, lds, [&](int j, const f32x16 (&acc)[2]) __attribute__((always_inline)) {
        const int hd = nh * 2 + (j >> 1), isv = j & 1;
#pragma unroll
        for (int mi = 0; mi < 2; ++mi) {
            const int rl = wm * 64 + mi * 32 + l31, row = row0 + rl, b = row_b(row), key = row_key(row);
            const float rstd = rs[rl];
            if (!isv) {
                bf16_t* dst = Kb + ((size_t)((b * 4 + hd) * NKEY + key)) * 96 + wn * 32 + 4 * hh;
#pragma unroll
                for (int g = 0; g < 4; ++g) { uint2 o; o.x = pk2(acc[mi][4 * g] * rstd, acc[mi][4 * g + 1] * rstd); o.y = pk2(acc[mi][4 * g + 2] * rstd, acc[mi][4 * g + 3] * rstd); *(uint2*)(dst + 8 * g) = o; }
            } else {
#pragma unroll
                for (int e = 0; e < 16; ++e) { const int dv = wn * 32 + (e & 3) + 8 * (e >> 2) + 4 * hh;
                    Vt[((size_t)((b * 4 + hd) * 64 + dv)) * NKEY + key] = f2bf(acc[mi][e] * rstd); }
            }
        }
    });
}
DEVI void mla_unit(const Params& p, int au, char* lds) {
    const int tid = tidx(), lane = tid & 63, w = tid >> 6, l31 = lane & 31, hh = lane >> 5;
    const bool isctx = au >= 512;
    int b, h, qb;
    if (!isctx) { b = au >> 6; h = (au >> 4) & 3; qb = au & 15; } else { b = (au - 512) >> 2; h = (au - 512) & 3; qb = 16; }
    const int q0 = qb * 256 + w * 32 + l31;
    const bf16_t* Qp = (const bf16_t*)(p.ws + OFF_Q) + ((size_t)((b * 4 + h) * NKEY + q0)) * 96 + 8 * hh;
    bf16x8 qf[6];
#pragma unroll
    for (int ks = 0; ks < 6; ++ks) qf[ks] = *(const bf16x8*)(Qp + ks * 16);
    const bf16_t* kb = (const bf16_t*)(p.ws + OFF_K) + (size_t)((b * 4 + h) * NKEY) * 96;
    const bf16_t* vb = (const bf16_t*)(p.ws + OFF_VT) + (size_t)((b * 4 + h) * 64) * NKEY;
    const int jt0 = isctx ? 64 : 0, ntl = isctx ? 4 : 68;
    auto tf = [&](int j) { KVTile t; t.k = kb + (size_t)(jt0 + j) * 64 * 96; t.vt = vb + (jt0 + j) * 64; return t; };
    f32x16 o[2]; float ls;
    attn_core<96, false>(qf, ntl, tf, 96, NKEY, 0, 0, 0, 0, nullptr, o, ls, lds);
    const int row = isctx ? TL + b * 256 + w * 32 + l31 : b * 4096 + q0;
    attn_store(o, ls, (bf16_t*)(p.ws + OFF_BR) + (size_t)row * DM + h * 64);
}

DEVI void ytrans_unit(const Params& p, int tu, char* lds) {
    const int tid = tidx();
    const int b = tu / 68, kt = tu % 68, key0 = kt * 64;
    const int row0 = kt < 64 ? b * 4096 + key0 : TL + b * 256 + (key0 - 4096);
    const bf16_t* yT = (const bf16_t*)(p.ws + OFF_YT) + (size_t)(b * 256) * NKEY + key0;
    bf16_t* br = (bf16_t*)(p.ws + OFF_BR);
    bf16_t* tl = (bf16_t*)lds;
    __syncthreads();
#pragma unroll
    for (int i = 0; i < 4; ++i) { const int cidx = tid + 512 * i, ch = cidx >> 3, kc = (cidx & 7) * 8; *(u32x4*)(tl + ch * 72 + kc) = *(const u32x4*)(yT + (size_t)ch * NKEY + kc); }
    __syncthreads();
#pragma unroll
    for (int i = 0; i < 4; ++i) { const int cidx = tid + 512 * i, t = cidx >> 5, c8 = (cidx & 31) * 8;
        u32x4 o;
#pragma unroll
        for (int j = 0; j < 4; ++j) o[j] = (unsigned)tl[(c8 + 2 * j) * 72 + t] | ((unsigned)tl[(c8 + 2 * j + 1) * 72 + t] << 16);
        *(u32x4*)(br + (size_t)(row0 + t) * DM + 512 + c8) = o; }
}
DEVI float gelu_tanh(float x) { const float u = 0.7978845608028654f * (x + 0.044715f * x * x * x); return x * __builtin_amdgcn_rcpf(1.f + __expf(-2.f * u)); }
DEVI void lru_carry_unit(const Params& p, int l, int b) {
    const int tid = tidx(), c = tid & 255, d = tid >> 8;
    const float* SA = (const float*)(p.ws + OFF_SEGA) + (size_t)d * 1088 * 256; const float* SB = (const float*)(p.ws + OFF_SEGB) + (size_t)d * 1088 * 256;
    float* HIN = (float*)(p.ws + OFF_HIN) + (size_t)d * 1088 * 256;
    const int cbase = 1024 + 8 * b, lbase = 128 * b;
    float h = 0.f;
#pragma unroll 1
    for (int k0 = 0; k0 < 136; k0 += 17) {
        float sa[17], sbv[17];
#pragma unroll
        for (int i = 0; i < 17; ++i) { const int k = k0 + i; const int seg = d == 0 ? (k < 8 ? cbase + k : lbase + (k - 8)) : (k < 8 ? cbase + 7 - k : lbase + 135 - k);
            const size_t o = (size_t)seg * 256 + c; sa[i] = SA[o]; sbv[i] = SB[o]; }
        __builtin_amdgcn_sched_barrier(0);
#pragma unroll
        for (int i = 0; i < 17; ++i) { const int k = k0 + i; const int seg = d == 0 ? (k < 8 ? cbase + k : lbase + (k - 8)) : (k < 8 ? cbase + 7 - k : lbase + 135 - k);
            const size_t o = (size_t)seg * 256 + c;
            __hip_atomic_store(HIN + o, h, __ATOMIC_RELAXED, __HIP_MEMORY_SCOPE_AGENT);
            h = sa[i] * h + sbv[i]; }
        __builtin_amdgcn_sched_barrier(0);
    }
    asm volatile("s_waitcnt vmcnt(0)" ::: "memory");
    __syncthreads();
    if (tid == 0) __hip_atomic_store((unsigned*)(p.ws + OFF_GCNT) + 768 + l * 8 + b, 1u, __ATOMIC_RELAXED, __HIP_MEMORY_SCOPE_AGENT);
}
DEVI void lru2_unit(const Params& p, int l, int tt) {
    const int tid = tidx(), c = tid & 255, half = tid >> 8;
    const int s0 = tt * 4 + half * 2;
    const bool lat = s0 < 1024;
    const int b = lat ? (s0 >> 7) : ((s0 - 1024) >> 3);
    if (tid == 0) {
        unsigned* flag = (unsigned*)(p.ws + OFF_GCNT) + 768 + l * 8 + b; unsigned sp = 0;
        while (__hip_atomic_load(flag, __ATOMIC_RELAXED, __HIP_MEMORY_SCOPE_AGENT) == 0u && ++sp < (1u << 22)) __builtin_amdgcn_s_sleep(2);
    }
    __syncthreads();
    const float* HIN = (const float*)(p.ws + OFF_HIN);
    float hin[2][2];
#pragma unroll
    for (int d = 0; d < 2; ++d)
#pragma unroll
        for (int sgi = 0; sgi < 2; ++sgi) hin[d][sgi] = __hip_atomic_load(HIN + ((size_t)d * 1088 + s0 + sgi) * 256 + c, __ATOMIC_RELAXED, __HIP_MEMORY_SCOPE_AGENT);
    const bf16_t* hl = (const bf16_t*)(p.ws + OFF_HLOC); const bf16_t* ca = (const bf16_t*)(p.ws + OFF_CUMA);
    const bf16_t* z = (const bf16_t*)(p.ws + OFF_Z); bf16_t* br = (bf16_t*)(p.ws + OFF_BR);
#pragma unroll 1
    for (int t8 = 0; t8 < 8; ++t8) {
        const int sgi = t8 >> 2; const size_t row0 = (size_t)(s0 + sgi) * 32 + (t8 & 3) * 8;
        bf16_t a0[8], a1[8], a2[8], a3[8], a4[8];
#pragma unroll
        for (int i = 0; i < 8; ++i) { const size_t row = row0 + i;
            a0[i] = hl[row * 256 + c]; a1[i] = ca[row * 256 + c]; a2[i] = hl[((size_t)TT + row) * 256 + c]; a3[i] = ca[((size_t)TT + row) * 256 + c]; a4[i] = z[row * ZLD + ZC_LG + c]; }
        __builtin_amdgcn_sched_barrier(0);
        const float h0 = sgi ? hin[0][1] : hin[0][0], h1 = sgi ? hin[1][1] : hin[1][0];
#pragma unroll
        for (int i = 0; i < 8; ++i) { const size_t row = row0 + i;
            const float hf = bf2f(a0[i]) + bf2f(a1[i]) * h0, hr = bf2f(a2[i]) + bf2f(a3[i]) * h1;
            br[row * DM + 768 + c] = f2bf((hf + hr) * gelu_tanh(bf2f(a4[i]))); }
        __builtin_amdgcn_sched_barrier(0);
    }
}
DEVI void pbranch_unit(const Params& p, int u, char* lds) {
    const int mt = u >> 3, g = (u >> 1) & 3, nh = u & 1;
    const int tid = tidx(), lane = tid & 63, w = tid >> 6, wm = w >> 1, wn = w & 1, l31 = lane & 31, hh = lane >> 5;
    const int row0 = mt_row0(mt);
    K256A a;
    k256_load_a(a, (const bf16_t*)(p.ws + OFF_BR) + g * 256, DM, row0, lds);
    bf16_t* P = (bf16_t*)(p.ws + (g < 2 ? OFF_PLO : OFF_PHI)) + (size_t)(g & 1) * 1024 + nh * 512;
    bf16_t* slab = (bf16_t*)(lds + 2 * K2_BUF) + w * (64 * 40);
    k256_stream(a, (const bf16_t*)(p.ws + OFF_WBR) + (size_t)(g * 1024 + nh * 512) * 256, 8, lds, [&](int j, const f32x16 (&acc)[2]) __attribute__((always_inline)) {
#pragma unroll
        for (int mi = 0; mi < 2; ++mi)
#pragma unroll
            for (int q = 0; q < 4; ++q) { uint2 o; o.x = pk2(acc[mi][4 * q], acc[mi][4 * q + 1]); o.y = pk2(acc[mi][4 * q + 2], acc[mi][4 * q + 3]);
                *(uint2*)(slab + (mi * 32 + l31) * 40 + 8 * q + 4 * hh) = o; }
        asm volatile("s_waitcnt lgkmcnt(0)" ::: "memory");
#pragma unroll
        for (int it = 0; it < 4; ++it) {
            const int r64 = it * 16 + (lane >> 2);
            const u32x4 v = *(const u32x4*)(slab + r64 * 40 + (lane & 3) * 8);
            *(u32x4*)(P + (size_t)(row0 + wm * 64 + r64) * 2048 + j * 64 + wn * 32 + (lane & 3) * 8) = v;
        }
        asm volatile("s_waitcnt lgkmcnt(0)" ::: "memory");
    });
}
DEVI void router_unit(const Params& p, int l, int r0, int r1, char* lds) {
    const int tid = tidx(), lane = tid & 63, w = tid >> 6, wm = w >> 1, wn = w & 1, l31 = lane & 31, hh = lane >> 5;
    const int nrows = r1 - r0;
    norm_rows(p, l, r0, r1, 1);
    asm volatile("s_waitcnt vmcnt(0)" ::: "memory");
    __syncthreads();
    const RowLoader al = make_rows((const bf16_t*)(p.ws + OFF_H), DM, r0);
    f32x16 acc[2][1];
    gemm_mainloop<true, 1>(acc, al, (const bf16_t*)(p.ws + OFF_RT), 1024, 1024, lds);
    float* lg = (float*)lds;
    int* cnt_l = (int*)(lds + 256 * 65 * 4);
    int* base_g = cnt_l + 64;
#pragma unroll
    for (int mi = 0; mi < 2; ++mi)
#pragma unroll
        for (int e = 0; e < 16; ++e) lg[(wm * 64 + mi * 32 + l31) * 65 + wn * 32 + (e & 3) + 8 * (e >> 2) + 4 * hh] = sigmoidf_(acc[mi][0][e]);
    float* rbs = (float*)(base_g + 64);
    if (tid < 64) { cnt_l[tid] = 0; rbs[tid] = p.in[I_RB][l * 64 + tid]; }
    __syncthreads();
    int se[6], spos[6]; float swt[6];
    if (tid < nrows) {
        const float* rb = rbs;
        float* my = lg + tid * 65;
        float ssum = 0.f;
#pragma unroll
        for (int k = 0; k < 6; ++k) {
            float best = -1e30f; int bi = 0;
#pragma unroll 8
            for (int e = 0; e < 64; ++e) { const float s = my[e] + rb[e]; if (s > best) { best = s; bi = e; } }
            const float sc = my[bi];
            se[k] = bi; swt[k] = sc; ssum += sc; my[bi] = -1e30f;
        }
        const float nrm = 2.5f / ssum;
#pragma unroll
        for (int k = 0; k < 6; ++k) { swt[k] *= nrm; spos[k] = atomicAdd(&cnt_l[se[k]], 1); }
    }
    __syncthreads();
    if (tid < 64) base_g[tid] = (int)__hip_atomic_fetch_add((unsigned*)(p.ws + OFF_GCNT) + l * 64 + tid, (unsigned)cnt_l[tid], __ATOMIC_RELAXED, __HIP_MEMORY_SCOPE_AGENT);
    __syncthreads();
    if (tid < nrows) {
        const int r = r0 + tid;
        int* list = (int*)(p.ws + OFF_LIST); unsigned* toks = (unsigned*)(p.ws + OFF_TOKS); float* wts = (float*)(p.ws + OFF_WTS);
#pragma unroll
        for (int k = 0; k < 6; ++k) { const int pos = base_g[se[k]] + spos[k]; list[(size_t)se[k] * TT + pos] = r; toks[(size_t)r * 6 + k] = ((unsigned)se[k] << 16) | (unsigned)pos; wts[(size_t)r * 6 + k] = swt[k]; }
    }
}
struct MoeTab { int* cnt; int* blkbase; int* cbase; };
DEVI MoeTab moe_tables(const Params& p, int l, int nact, char* lds) {
    MoeTab t; t.cnt = (int*)(lds + LDS_BYTES - 4096); t.blkbase = t.cnt + 80; t.cbase = t.blkbase + 80;
    __syncthreads();
    if (tidx() < 64) t.cnt[tidx()] = (int)__hip_atomic_load((unsigned*)(p.ws + OFF_GCNT) + l * 64 + tidx(), __ATOMIC_RELAXED, __HIP_MEMORY_SCOPE_AGENT);
    __syncthreads();
    if (tidx() == 0) {
        int bb = 0, cb = 0;
        for (int e = 0; e < 64; ++e) { const int c = t.cnt[e]; t.blkbase[e] = bb; t.cbase[e] = cb; bb += (c + 255) >> 8; cb += c; }
        t.cnt[64] = nact; t.blkbase[64] = bb; t.cbase[64] = cb; t.blkbase[65] = bb + (nact >> 8);
    }
    __syncthreads();
    {
        unsigned char* eb = (unsigned char*)(t.cbase + 80);
        const int nrb = t.blkbase[65];
        for (int rb = tidx(); rb < nrb; rb += 512) { int e = 0; while (e < 64 && rb >= t.blkbase[e + 1]) ++e; eb[rb] = (unsigned char)e; }
    }
    __syncthreads();
    return t;
}
DEVI int find_expert(const MoeTab& t, int rb) { return (int)((const unsigned char*)(t.cbase + 80))[rb]; }
DEVI void moe2_unit(const Params& p, int l, const MoeTab& t, int rb, char* lds) {
    const int tid = tidx(), lane = tid & 63, w = tid >> 6, wm = w >> 1, wn = w & 1, l31 = lane & 31, hh = lane >> 5;
    const int e = find_expert(t, rb), i0 = (rb - t.blkbase[e]) * 256, cnt = t.cnt[e], cbe = t.cbase[e];
    K256A a;
    k256_load_a(a, (const bf16_t*)(p.ws + OFF_HID), 256, rb * 256, lds);
    const bf16_t* Bt = (const bf16_t*)(p.ws + OFF_WDT) + (size_t)e * 1024 * 256;
    if (e < 64) {
        bf16_t* Y = (bf16_t*)(p.ws + OFF_Y);
        bf16_t* slab = (bf16_t*)(lds + 2 * K2_BUF) + w * (64 * 40);
        bf16_t* trash = (bf16_t*)(p.ws + OFF_SEGA + (size_t)blockIdx.x * 8192 + (size_t)tid * 16);
        k256_stream(a, Bt, 16, lds, [&](int j, const f32x16 (&acc)[2]) __attribute__((always_inline)) {
#pragma unroll
            for (int mi = 0; mi < 2; ++mi)
#pragma unroll
                for (int g = 0; g < 4; ++g) { uint2 o; o.x = pk2(acc[mi][4 * g], acc[mi][4 * g + 1]); o.y = pk2(acc[mi][4 * g + 2], acc[mi][4 * g + 3]);
                    *(uint2*)(slab + (mi * 32 + l31) * 40 + 8 * g + 4 * hh) = o; }
            asm volatile("s_waitcnt lgkmcnt(0)" ::: "memory");
#pragma unroll
            for (int it = 0; it < 4; ++it) {
                const int r64 = it * 16 + (lane >> 2), ii = i0 + wm * 64 + r64;
                const u32x4 v = *(const u32x4*)(slab + r64 * 40 + (lane & 3) * 8);
                *(u32x4*)(ii < cnt ? Y + (size_t)(cbe + ii) * DM + j * 64 + wn * 32 + (lane & 3) * 8 : trash) = v;
            }
            asm volatile("s_waitcnt lgkmcnt(0)" ::: "memory");
        });
    } else {
        const float* g2b = (const float*)(p.ws + OFF_MOD) + (size_t)l * 9 * 6144 + 5120 + (size_t)row_mod(i0) * 6144;
        bf16_t* slab = (bf16_t*)(lds + 2 * K2_BUF) + w * (64 * 40);
        k256_stream(a, Bt, 16, lds, [&](int j, const f32x16 (&acc)[2]) __attribute__((always_inline)) {
#pragma unroll
            for (int mi = 0; mi < 2; ++mi)
#pragma unroll
                for (int g = 0; g < 4; ++g) { uint2 o; o.x = pk2(acc[mi][4 * g], acc[mi][4 * g + 1]); o.y = pk2(acc[mi][4 * g + 2], acc[mi][4 * g + 3]);
                    *(uint2*)(slab + (mi * 32 + l31) * 40 + 8 * g + 4 * hh) = o; }
            const int c0 = j * 64 + wn * 32 + (lane & 3) * 8;
            const float4 ga = *(const float4*)(g2b + c0), gb = *(const float4*)(g2b + c0 + 4);
            asm volatile("s_waitcnt lgkmcnt(0)" ::: "memory");
#pragma unroll
            for (int h2 = 0; h2 < 2; ++h2) {
                float4 xa[2], xb[2];
#pragma unroll
                for (int i2 = 0; i2 < 2; ++i2) { const int r64 = (h2 * 2 + i2) * 16 + (lane >> 2); const float* xr = xdst(p, i0 + wm * 64 + r64) + c0; xa[i2] = *(const float4*)xr; xb[i2] = *(const float4*)(xr + 4); }
                __builtin_amdgcn_sched_barrier(0);
#pragma unroll
                for (int i2 = 0; i2 < 2; ++i2) { const int r64 = (h2 * 2 + i2) * 16 + (lane >> 2); float* xr = xdst(p, i0 + wm * 64 + r64) + c0;
                    const u32x4 v = *(const u32x4*)(slab + r64 * 40 + (lane & 3) * 8);
                    float4 oa = xa[i2], ob = xb[i2];
                    oa.x += ga.x * lo_bf(v[0]); oa.y += ga.y * hi_bf(v[0]); oa.z += ga.z * lo_bf(v[1]); oa.w += ga.w * hi_bf(v[1]);
                    ob.x += gb.x * lo_bf(v[2]); ob.y += gb.y * hi_bf(v[2]); ob.z += gb.z * lo_bf(v[3]); ob.w += gb.w * hi_bf(v[3]);
                    *(float4*)xr = oa; *(float4*)(xr + 4) = ob; }
                __builtin_amdgcn_sched_barrier(0);
            }
            asm volatile("s_waitcnt lgkmcnt(0)" ::: "memory");
        });
    }
}
DEVI void combine_unit(const Params& p, int l, const MoeTab& t, int r0, int r1) {
    const int lane = tidx() & 63, w = tidx() >> 6;
    const float* mod = (const float*)(p.ws + OFF_MOD);
    const bf16_t* Y = (const bf16_t*)(p.ws + OFF_Y);
    const unsigned* toks = (const unsigned*)(p.ws + OFF_TOKS); const float* wts = (const float*)(p.ws + OFF_WTS);
#pragma unroll 2
    for (int r = r0 + w; r < r1; r += 8) {
        float* xd = xdst(p, r);
        const float* g2 = mod + (size_t)(l * 9 + row_mod(r)) * 6144 + 5120;
        const bf16_t* yr[6]; float wk[6];
#pragma unroll
        for (int k = 0; k < 6; ++k) { const unsigned v = toks[(size_t)r * 6 + k]; yr[k] = Y + (size_t)(t.cbase[v >> 16] + (int)(v & 0xffffu)) * DM; wk[k] = wts[(size_t)r * 6 + k]; }
        float4 xo[4]; float ss = 0.f;
#pragma unroll
        for (int q = 0; q < 4; ++q) {
            const int k0 = 4 * lane + 256 * q;
            float f0 = 0.f, f1 = 0.f, f2 = 0.f, f3 = 0.f;
#pragma unroll
            for (int k = 0; k < 6; ++k) { const uint2 yv = *(const uint2*)(yr[k] + k0); f0 += wk[k] * lo_bf(yv.x); f1 += wk[k] * hi_bf(yv.x); f2 += wk[k] * lo_bf(yv.y); f3 += wk[k] * hi_bf(yv.y); }
            float4 xv = *(const float4*)(xd + k0); const float4 gv = *(const float4*)(g2 + k0);
            xv.x += gv.x * f0; xv.y += gv.y * f1; xv.z += gv.z * f2; xv.w += gv.w * f3;
            xo[q] = xv; ss += xv.x * xv.x + xv.y * xv.y + xv.z * xv.z + xv.w * xv.w;
        }
        if (l == 1) {
            ss = wave_sum(ss);
            const float rstd = rsqrtf(ss * (1.f / 1024.f) + 1e-6f);
#pragma unroll
            for (int q = 0; q < 4; ++q) { const int k0 = 4 * lane + 256 * q; const float4 gf = *(const float4*)(p.in[I_GF] + k0);
                float4 o; o.x = xo[q].x * rstd * gf.x; o.y = xo[q].y * rstd * gf.y; o.z = xo[q].z * rstd * gf.z; o.w = xo[q].w * rstd * gf.w; *(float4*)(xd + k0) = o; }
        } else {
#pragma unroll
            for (int q = 0; q < 4; ++q) *(float4*)(xd + 4 * lane + 256 * q) = xo[q];
        }
    }
}


namespace pg8 {
#define PG8_LAS __attribute__((address_space(3)))
typedef unsigned short bf16_t;
typedef short bf16x8 __attribute__((ext_vector_type(8)));
typedef float f32x4 __attribute__((ext_vector_type(4)));
typedef unsigned u32x4 __attribute__((ext_vector_type(4)));
typedef int i32x4 __attribute__((ext_vector_type(4)));
typedef int i32x8 __attribute__((ext_vector_type(8)));
constexpr int BM = 256, BK = 64, HALF = 128, HTB = HALF * BK * 2  , STAGE_BYTES = 8 * HTB, NXCD = 8, WGM = 8;

__host__ __device__ __forceinline__ int lds_byte(int r, int c) { const int st = (r >> 4) * 2 + (c >> 5), rr = r & 15, cc = c & 31, ob = rr * 64 + cc * 2; return st * 1024 + (ob ^ (((ob >> 9) & 1) << 5)); }
__host__ __device__ __forceinline__ void stage_rc(int b, int& R, int& C) { const int st = b / 1024, sb = b % 1024, swz = sb ^ (((sb >> 9) & 1) << 5); R = (st >> 1) * 16 + swz / 64; C = (st & 1) * 32 + (swz % 64) / 2; }
__host__ __device__ __forceinline__ int perm32(int rho) { const int n = rho >> 4, i = rho & 15; return 8 * (i >> 2) + 4 * n + (i & 3); }

struct Unit { int pm, pn; };
struct Gemm { const bf16_t* A; const bf16_t* Bt; int M, N, K; };

struct StaticOrder {
    int nM, nN, nwg, G, c;
    __host__ __device__ void init(int M, int N, int G_, int c_) { nM = M / BM; nN = N / BM; nwg = nM * nN; G = G_; c = c_; }
    __host__ __device__ bool next(int i, Unit& u) const {
        const long L = (long)i * G + c; if (L >= nwg) return false;
        int wgid = (int)L; { const int q = nwg / NXCD, r = nwg % NXCD, xcd = wgid % NXCD, off = wgid / NXCD; wgid = (xcd < r ? xcd * (q + 1) : r * (q + 1) + (xcd - r) * q) + off; }
        const int nig = WGM * nN, gid = wgid / nig, fm = gid * WGM, gsz = (nM - fm) < WGM ? (nM - fm) : WGM;
        u.pm = fm + ((wgid % nig) % gsz); u.pn = (wgid % nig) / gsz; return true;
    }
    __device__ __forceinline__ void a_ready(const Unit&) const {}
    __device__ __forceinline__ void done(const Unit&) const {}
};
template <class Epi, class Sched, bool STAMP = false, bool F8 = false>
__device__ __forceinline__ void gemm_phase(PG8_LAS unsigned char* lds, const Gemm g, const Sched& S, const Epi& E, unsigned long long* stamps) {
    const int tid = threadIdx.x, wid = __builtin_amdgcn_readfirstlane(tid >> 6), lane = tid & 63, wr = wid >> 2, wc = wid & 3, fr = lane & 15, fq = lane >> 4;
    int K = g.K; if constexpr (F8) asm volatile("" : "+s"(K));
    const int nt = K / BK;
    int ts_lo = 0, ts_hi = 0, nts = 0; const unsigned long long rt_entry = STAMP ? (unsigned long long)wall_clock64() : 0ull;
#define PG8_STAMP() do { if (STAMP && wid == 0 && nts < 64) { const unsigned long long _c = (unsigned long long)clock64(); \
        ts_lo = (lane == nts) ? (int)(unsigned)_c : ts_lo; ts_hi = (lane == nts) ? (int)(unsigned)(_c >> 32) : ts_hi; ++nts; } } while (0)
    PG8_STAMP();
    unsigned voffA[2], voffB[2];
#pragma unroll
    for (int i = 0; i < 2; ++i) { int R, C; stage_rc(tid * 16 + i * 8192, R, C); const int Rb = Epi::PERM ? ((R & ~31) + perm32(R & 31)) : R;
        voffA[i] = (unsigned)(R * K + C) * 2u; voffB[i] = (unsigned)(Rb * K + C) * 2u; }
    const size_t kstep = (size_t)(BK * 2);
    const size_t hstep = (size_t)HALF * K * 2;
    const size_t tstep = 2 * hstep;
    const unsigned ldsw = (unsigned)wid * 1024u;
    const int aoff = lds_byte(wr * 64 + fr, fq * 8), boff = lds_byte(wc * 32 + fr, fq * 8);
#define PG8_SA(b, h) (((b) * 2 + (h)) * HTB)
#define PG8_SB(b, h) ((4 + (b) * 2 + (h)) * HTB)
#define PG8_STAGE(bufoff, gbase, voff) do { _Pragma("unroll") for (int _i = 0; _i < 2; ++_i) \
        __builtin_amdgcn_global_load_lds((const unsigned*)((const char*)(gbase) + (voff)[_i]), (PG8_LAS unsigned*)(lds + (bufoff) + ldsw + _i * 8192), 16, 0, 0); } while (0)
#define PG8_CAT(x, y) __builtin_shufflevector(x, y, 0, 1, 2, 3, 4, 5, 6, 7)
#define PG8_LDA(dst, b, h) do { _Pragma("unroll") for (int m = 0; m < 4; ++m) { \
        if constexpr (F8) dst##8[m] = PG8_CAT(*(const PG8_LAS i32x4*)(lds + PG8_SA(b, h) + aoff + m * 2048), *(const PG8_LAS i32x4*)(lds + PG8_SA(b, h) + aoff + m * 2048 + 1024)); \
        else { _Pragma("unroll") for (int k = 0; k < 2; ++k) dst[m][k] = *(const PG8_LAS bf16x8*)(lds + PG8_SA(b, h) + aoff + m * 2048 + k * 1024); } } } while (0)
#define PG8_LDB(dst, b, h) do { _Pragma("unroll") for (int n = 0; n < 2; ++n) { \
        if constexpr (F8) dst##8[n] = PG8_CAT(*(const PG8_LAS i32x4*)(lds + PG8_SB(b, h) + boff + n * 2048), *(const PG8_LAS i32x4*)(lds + PG8_SB(b, h) + boff + n * 2048 + 1024)); \
        else { _Pragma("unroll") for (int k = 0; k < 2; ++k) dst[n][k] = *(const PG8_LAS bf16x8*)(lds + PG8_SB(b, h) + boff + n * 2048 + k * 1024); } } } while (0)
#define PG8_MMA(ai, bj, At, Bt) do { __builtin_amdgcn_s_setprio(1); _Pragma("unroll") for (int m = 0; m < 4; ++m) _Pragma("unroll") for (int n = 0; n < 2; ++n) { \
        if constexpr (F8) asm volatile("v_mfma_scale_f32_16x16x128_f8f6f4 %0, %1, %2, %0, %3, %3 op_sel_hi:[0,0,0]" : "+v"(acc[ai][bj][m][n]) : "v"(Bt##8[n]), "v"(At##8[m]), "v"(sc8)); \
        else { _Pragma("unroll") for (int k = 0; k < 2; ++k) acc[ai][bj][m][n] = __builtin_amdgcn_mfma_f32_16x16x32_bf16(Bt[n][k], At[m][k], acc[ai][bj][m][n], 0, 0, 0); } } __builtin_amdgcn_s_setprio(0); } while (0)
#define PG8_WAIT_V(n) asm volatile("s_waitcnt vmcnt(" #n ")" ::: "memory")
#define PG8_WAIT_L(n) asm volatile("s_waitcnt lgkmcnt(" #n ")" ::: "memory")
#define PG8_BAR __builtin_amdgcn_s_barrier()
#define PG8_SCHED __builtin_amdgcn_sched_barrier(0)
    Unit cur, nxt; int ui = 0;
    if (!S.next(0, cur)) return;
    f32x4 acc[2][2][4][2];
#pragma unroll
    for (int a = 0; a < 2; ++a)
#pragma unroll
        for (int b = 0; b < 2; ++b)
#pragma unroll
            for (int m = 0; m < 4; ++m)
#pragma unroll
                for (int n = 0; n < 2; ++n) acc[a][b][m][n] = (f32x4){0.f, 0.f, 0.f, 0.f};
    bf16x8 At[4][2], B0[2][2], B1[2][2];
    i32x8 At8[4], B08[2], B18[2];
    int sc8 = 0x7F7F7F7F; asm volatile("" : "+v"(sc8));
    const char* cA = (const char*)g.A + (size_t)cur.pm * tstep; const char* cB = (const char*)g.Bt + (size_t)cur.pn * tstep;
    S.a_ready(cur);
    PG8_STAGE(PG8_SB(0, 0), cB, voffB); PG8_STAGE(PG8_SA(0, 0), cA, voffA); PG8_STAGE(PG8_SB(0, 1), cB + hstep, voffB); PG8_STAGE(PG8_SA(0, 1), cA + hstep, voffA);
    if (wr == 1) PG8_BAR;
    PG8_WAIT_V(4); PG8_BAR;
    PG8_STAGE(PG8_SB(1, 0), cB + kstep, voffB); PG8_STAGE(PG8_SA(1, 0), cA + kstep, voffA); PG8_STAGE(PG8_SB(1, 1), cB + hstep + kstep, voffB);
    PG8_WAIT_V(6); PG8_BAR;
    PG8_STAMP();
    for (;;) {
        const bool has_next = S.next(ui + 1, nxt);
        const char* nA = has_next ? (const char*)g.A + (size_t)nxt.pm * tstep : cA; const char* nB = has_next ? (const char*)g.Bt + (size_t)nxt.pn * tstep : cB;
        for (int t = 0; t < nt; t += 2) {
            const bool last = (t == nt - 2);
            const char* a1 = cA + (size_t)(t + 1) * kstep;
            const char* a2 = last ? nA : cA + (size_t)(t + 2) * kstep; const char* b2 = last ? nB : cB + (size_t)(t + 2) * kstep;
            const char* a3 = a2 + kstep; const char* b3 = b2 + kstep;
            if (last && has_next) S.a_ready(nxt);
            PG8_LDB(B0, 0, 0); PG8_SCHED; PG8_LDA(At, 0, 0); PG8_STAGE(PG8_SA(1, 1), a1 + hstep, voffA);
            PG8_WAIT_L(8); PG8_BAR; PG8_WAIT_L(0); PG8_MMA(0, 0, At, B0); PG8_BAR; PG8_SCHED;
            PG8_LDB(B1, 0, 1); PG8_STAGE(PG8_SB(0, 0), b2, voffB);
            PG8_BAR; PG8_WAIT_L(0); PG8_MMA(0, 1, At, B1); PG8_BAR;
            PG8_LDA(At, 0, 1); PG8_STAGE(PG8_SA(0, 0), a2, voffA);
            PG8_BAR; PG8_WAIT_L(0); PG8_MMA(1, 0, At, B0); PG8_BAR; PG8_SCHED;
            PG8_STAGE(PG8_SB(0, 1), b2 + hstep, voffB);
            PG8_WAIT_V(6); PG8_BAR; PG8_MMA(1, 1, At, B1); PG8_BAR;
            PG8_LDB(B0, 1, 0); PG8_SCHED; PG8_LDA(At, 1, 0); PG8_STAGE(PG8_SA(0, 1), a2 + hstep, voffA);
            PG8_WAIT_L(8); PG8_BAR; PG8_WAIT_L(0); PG8_MMA(0, 0, At, B0); PG8_BAR; PG8_SCHED;
            PG8_LDB(B1, 1, 1); PG8_STAGE(PG8_SB(1, 0), b3, voffB);
            PG8_BAR; PG8_WAIT_L(0); PG8_MMA(0, 1, At, B1); PG8_BAR;
            PG8_LDA(At, 1, 1); PG8_STAGE(PG8_SA(1, 0), a3, voffA);
            PG8_BAR; PG8_WAIT_L(0); PG8_MMA(1, 0, At, B0); PG8_BAR; PG8_SCHED;
            PG8_STAGE(PG8_SB(1, 1), b3 + hstep, voffB);
            PG8_WAIT_V(6); PG8_BAR; PG8_MMA(1, 1, At, B1); PG8_BAR;
        }
        if constexpr (F8) asm volatile("s_nop 15\n\ts_nop 15" ::: "memory");
        PG8_STAMP();
        if constexpr (!Epi::AFTER_DRAIN) { E(acc, cur, wr, wc, fr, fq); S.done(cur); }
        PG8_STAMP();
        if (!has_next) break;
#pragma unroll
        for (int a = 0; a < 2; ++a)
#pragma unroll
            for (int b = 0; b < 2; ++b)
#pragma unroll
                for (int m = 0; m < 4; ++m)
#pragma unroll
                    for (int n = 0; n < 2; ++n) acc[a][b][m][n] = (f32x4){0.f, 0.f, 0.f, 0.f};
        cur = nxt; cA = nA; cB = nB; ++ui;
    }
    PG8_WAIT_V(0);
    if (wr == 0) PG8_BAR;
    PG8_BAR;
    if constexpr (Epi::AFTER_DRAIN) { E.fused(acc, cur, wr, wc, fr, fq, lds, wid, lane); S.done(cur); }
    PG8_STAMP();
    if (STAMP && wid == 0) { stamps[lane] = lane < nts ? (((unsigned long long)(unsigned)ts_hi << 32) | (unsigned)ts_lo) : 0ull;
        if (lane == 62) stamps[62] = rt_entry; if (lane == 63) stamps[63] = (unsigned long long)wall_clock64(); }
#undef PG8_STAMP
#undef PG8_SA
#undef PG8_SB
#undef PG8_STAGE
#undef PG8_LDA
#undef PG8_LDB
#undef PG8_MMA
#undef PG8_CAT
#undef PG8_WAIT_V
#undef PG8_WAIT_L
#undef PG8_BAR
#undef PG8_SCHED
}
template <class Epi, class Sched, bool STAMP = false>
__device__ __forceinline__ void gemm_phase_gather(PG8_LAS unsigned char* lds, const Gemm g, const Sched& S, const Epi& E, unsigned long long* stamps) {
    const int tid = threadIdx.x, wid = __builtin_amdgcn_readfirstlane(tid >> 6), lane = tid & 63, wr = wid >> 2, wc = wid & 3, fr = lane & 15, fq = lane >> 4;
    const int K = g.K, nt = K / BK;
    int ts_lo = 0, ts_hi = 0, nts = 0; const unsigned long long rt_entry = STAMP ? (unsigned long long)wall_clock64() : 0ull;
#define PG8_STAMP() do { if (STAMP && wid == 0 && nts < 64) { const unsigned long long _c = (unsigned long long)clock64(); \
        ts_lo = (lane == nts) ? (int)(unsigned)_c : ts_lo; ts_hi = (lane == nts) ? (int)(unsigned)(_c >> 32) : ts_hi; ++nts; } } while (0)
    PG8_STAMP();
    unsigned voffA[2], voffB[2];
#pragma unroll
    for (int i = 0; i < 2; ++i) { int R, C; stage_rc(tid * 16 + i * 8192, R, C); const int Rb = Epi::PERM ? ((R & ~31) + perm32(R & 31)) : R;
        voffA[i] = (unsigned)(R * K + C) * 2u; voffB[i] = (unsigned)(Rb * K + C) * 2u; }
    unsigned vc[2][2], vn[2][2];
    const char* gA = (const char*)g.A;
    const size_t kstep = (size_t)(BK * 2);
    const size_t hstep = (size_t)HALF * K * 2;
    const size_t tstep = 2 * hstep;
    const unsigned ldsw = (unsigned)wid * 1024u;
    const int aoff = lds_byte(wr * 64 + fr, fq * 8), boff = lds_byte(wc * 32 + fr, fq * 8);
#define PG8_SA(b, h) (((b) * 2 + (h)) * HTB)
#define PG8_SB(b, h) ((4 + (b) * 2 + (h)) * HTB)
#define PG8_STAGE(bufoff, gbase, voff) do { _Pragma("unroll") for (int _i = 0; _i < 2; ++_i) \
        __builtin_amdgcn_global_load_lds((const unsigned*)((const char*)(gbase) + (voff)[_i]), (PG8_LAS unsigned*)(lds + (bufoff) + ldsw + _i * 8192), 16, 0, 0); } while (0)
#define PG8_LDA(dst, b, h) do { _Pragma("unroll") for (int m = 0; m < 4; ++m) _Pragma("unroll") for (int k = 0; k < 2; ++k) dst[m][k] = *(const PG8_LAS bf16x8*)(lds + PG8_SA(b, h) + aoff + m * 2048 + k * 1024); } while (0)
#define PG8_LDB(dst, b, h) do { _Pragma("unroll") for (int n = 0; n < 2; ++n) _Pragma("unroll") for (int k = 0; k < 2; ++k) dst[n][k] = *(const PG8_LAS bf16x8*)(lds + PG8_SB(b, h) + boff + n * 2048 + k * 1024); } while (0)
#define PG8_MMA(ai, bj, At, Bt) do { __builtin_amdgcn_s_setprio(1); _Pragma("unroll") for (int m = 0; m < 4; ++m) _Pragma("unroll") for (int n = 0; n < 2; ++n) _Pragma("unroll") for (int k = 0; k < 2; ++k) \
        acc[ai][bj][m][n] = __builtin_amdgcn_mfma_f32_16x16x32_bf16(Bt[n][k], At[m][k], acc[ai][bj][m][n], 0, 0, 0); __builtin_amdgcn_s_setprio(0); } while (0)
#define PG8_WAIT_V(n) asm volatile("s_waitcnt vmcnt(" #n ")" ::: "memory")
#define PG8_WAIT_L(n) asm volatile("s_waitcnt lgkmcnt(" #n ")" ::: "memory")
#define PG8_BAR __builtin_amdgcn_s_barrier()
#define PG8_SCHED __builtin_amdgcn_sched_barrier(0)
    Unit cur, nxt; int ui = 0;
    if (!S.next(0, cur)) return;
    f32x4 acc[2][2][4][2];
#pragma unroll
    for (int a = 0; a < 2; ++a)
#pragma unroll
        for (int b = 0; b < 2; ++b)
#pragma unroll
            for (int m = 0; m < 4; ++m)
#pragma unroll
                for (int n = 0; n < 2; ++n) acc[a][b][m][n] = (f32x4){0.f, 0.f, 0.f, 0.f};
    bf16x8 At[4][2], B0[2][2], B1[2][2];
    const char* cA = (const char*)g.A + (size_t)cur.pm * tstep; const char* cB = S.bbase(g, cur, tstep);
    S.arows(cur, K, vc);
#pragma unroll
    for (int h_ = 0; h_ < 2; ++h_) { vn[h_][0] = vc[h_][0]; vn[h_][1] = vc[h_][1]; }
    PG8_STAGE(PG8_SB(0, 0), cB, voffB); PG8_STAGE(PG8_SA(0, 0), gA, vc[0]); PG8_STAGE(PG8_SB(0, 1), cB + hstep, voffB); PG8_STAGE(PG8_SA(0, 1), gA, vc[1]);
    if (wr == 1) PG8_BAR;
    PG8_WAIT_V(4); PG8_BAR;
    PG8_STAGE(PG8_SB(1, 0), cB + kstep, voffB); PG8_STAGE(PG8_SA(1, 0), gA + kstep, vc[0]); PG8_STAGE(PG8_SB(1, 1), cB + hstep + kstep, voffB);
    PG8_WAIT_V(6); PG8_BAR;
    PG8_STAMP();
    for (;;) {
        const bool has_next = S.next(ui + 1, nxt);
        const char* nA = has_next ? (const char*)g.A + (size_t)nxt.pm * tstep : cA; const char* nB = has_next ? S.bbase(g, nxt, tstep) : cB;
        for (int t = 0; t < nt; t += 2) {
            const bool last = (t == nt - 2);
            const char* a1 = gA + (size_t)(t + 1) * kstep;
            const char* a2 = last ? gA : gA + (size_t)(t + 2) * kstep; const char* b2 = last ? nB : cB + (size_t)(t + 2) * kstep;
            const char* a3 = a2 + kstep; const char* b3 = b2 + kstep;
            if (last && has_next) S.arows(nxt, K, vn);
            unsigned sel[2][2];
#pragma unroll
            for (int h_ = 0; h_ < 2; ++h_) { sel[h_][0] = last ? vn[h_][0] : vc[h_][0]; sel[h_][1] = last ? vn[h_][1] : vc[h_][1]; }
            PG8_LDB(B0, 0, 0); PG8_SCHED; PG8_LDA(At, 0, 0); PG8_STAGE(PG8_SA(1, 1), a1, vc[1]);
            PG8_WAIT_L(8); PG8_BAR; PG8_WAIT_L(0); PG8_MMA(0, 0, At, B0); PG8_BAR; PG8_SCHED;
            PG8_LDB(B1, 0, 1); PG8_STAGE(PG8_SB(0, 0), b2, voffB);
            PG8_BAR; PG8_WAIT_L(0); PG8_MMA(0, 1, At, B1); PG8_BAR;
            PG8_LDA(At, 0, 1); PG8_STAGE(PG8_SA(0, 0), a2, sel[0]);
            PG8_BAR; PG8_WAIT_L(0); PG8_MMA(1, 0, At, B0); PG8_BAR; PG8_SCHED;
            PG8_STAGE(PG8_SB(0, 1), b2 + hstep, voffB);
            PG8_WAIT_V(6); PG8_BAR; PG8_MMA(1, 1, At, B1); PG8_BAR;
            PG8_LDB(B0, 1, 0); PG8_SCHED; PG8_LDA(At, 1, 0); PG8_STAGE(PG8_SA(0, 1), a2, sel[1]);
            PG8_WAIT_L(8); PG8_BAR; PG8_WAIT_L(0); PG8_MMA(0, 0, At, B0); PG8_BAR; PG8_SCHED;
            PG8_LDB(B1, 1, 1); PG8_STAGE(PG8_SB(1, 0), b3, voffB);
            PG8_BAR; PG8_WAIT_L(0); PG8_MMA(0, 1, At, B1); PG8_BAR;
            PG8_LDA(At, 1, 1); PG8_STAGE(PG8_SA(1, 0), a3, sel[0]);
            PG8_BAR; PG8_WAIT_L(0); PG8_MMA(1, 0, At, B0); PG8_BAR; PG8_SCHED;
            PG8_STAGE(PG8_SB(1, 1), b3 + hstep, voffB);
            PG8_WAIT_V(6); PG8_BAR; PG8_MMA(1, 1, At, B1); PG8_BAR;
        }
        PG8_STAMP();
        if constexpr (!Epi::AFTER_DRAIN) { E(acc, cur, wr, wc, fr, fq); S.done(cur); }
        PG8_STAMP();
        if (!has_next) break;
#pragma unroll
        for (int a = 0; a < 2; ++a)
#pragma unroll
            for (int b = 0; b < 2; ++b)
#pragma unroll
                for (int m = 0; m < 4; ++m)
#pragma unroll
                    for (int n = 0; n < 2; ++n) acc[a][b][m][n] = (f32x4){0.f, 0.f, 0.f, 0.f};
        cur = nxt; cA = nA; cB = nB; ++ui;
#pragma unroll
        for (int h_ = 0; h_ < 2; ++h_) { vc[h_][0] = vn[h_][0]; vc[h_][1] = vn[h_][1]; }
    }
    PG8_WAIT_V(0);
    if (wr == 0) PG8_BAR;
    PG8_BAR;
    if constexpr (Epi::AFTER_DRAIN) { E.fused(acc, cur, wr, wc, fr, fq, lds, wid, lane); S.done(cur); }
    PG8_STAMP();
    if (STAMP && wid == 0) { stamps[lane] = lane < nts ? (((unsigned long long)(unsigned)ts_hi << 32) | (unsigned)ts_lo) : 0ull;
        if (lane == 62) stamps[62] = rt_entry; if (lane == 63) stamps[63] = (unsigned long long)wall_clock64(); }
#undef PG8_STAMP
#undef PG8_SA
#undef PG8_SB
#undef PG8_STAGE
#undef PG8_LDA
#undef PG8_LDB
#undef PG8_MMA
#undef PG8_WAIT_V
#undef PG8_WAIT_L
#undef PG8_BAR
#undef PG8_SCHED
}
}

struct EpiInproj {
    static constexpr bool PERM = false, AFTER_DRAIN = false;
    bf16_t* z; bf16_t* zT;
    __device__ __forceinline__ void operator()(const pg8::f32x4 (&acc)[2][2][4][2], const pg8::Unit& u, int wr, int wc, int fr, int fq) const {
        const int pm = u.pm, b = pm < 128 ? (pm >> 4) : (pm - 128), key0 = pm < 128 ? (pm & 15) * 256 : 4096, row0 = mt_row0(pm);
#pragma unroll
        for (int bj = 0; bj < 2; ++bj) {
            const int cb = u.pn * 256 + bj * 128;
            if (cb < ZLD) {
#pragma unroll
                for (int ai = 0; ai < 2; ++ai)
#pragma unroll
                    for (int m = 0; m < 4; ++m) { const int rl = ai * 128 + wr * 64 + m * 16 + fr;
#pragma unroll
                        for (int n = 0; n < 2; ++n) { const pg8::f32x4 v = acc[ai][bj][m][n]; uint2 o; o.x = pk2(v[0], v[1]); o.y = pk2(v[2], v[3]);
                            *(uint2*)(z + (size_t)(row0 + rl) * ZLD + cb + wc * 32 + n * 16 + fq * 4) = o; } }
            } else if (cb < NIN) {
#pragma unroll
                for (int ai = 0; ai < 2; ++ai)
#pragma unroll
                    for (int m = 0; m < 4; ++m) { const int rl = ai * 128 + wr * 64 + m * 16 + fr;
#pragma unroll
                        for (int n = 0; n < 2; ++n) { const pg8::f32x4 v = acc[ai][bj][m][n]; const int ch = cb - ZLD + wc * 32 + n * 16 + fq * 4;
                            bf16_t* d = zT + (size_t)(b * 1024 + ch) * NKEY + key0 + rl;
                            d[0] = f2bf(v[0]); d[NKEY] = f2bf(v[1]); d[2 * NKEY] = f2bf(v[2]); d[3 * NKEY] = f2bf(v[3]); } }
            }
        }
    }
};
struct EpiWout {
    static constexpr bool PERM = false, AFTER_DRAIN = false;
    const float* xs_lat; const float* xs_ctx; float* xd_lat; float* xd_ctx; const float* g1base;
    __device__ __forceinline__ void operator()(const pg8::f32x4 (&acc)[2][2][4][2], const pg8::Unit& u, int wr, int wc, int fr, int fq) const {
        const int row0 = mt_row0(u.pm);
        const float* xs = (row0 < TL ? xs_lat + (size_t)row0 * DM : xs_ctx + (size_t)(row0 - TL) * DM) + (size_t)(wr * 64 + fr) * DM + u.pn * 256 + wc * 32 + fq * 4;
        float* xd = (row0 < TL ? xd_lat + (size_t)row0 * DM : xd_ctx + (size_t)(row0 - TL) * DM) + (size_t)(wr * 64 + fr) * DM + u.pn * 256 + wc * 32 + fq * 4;
        const float* g1 = g1base + (size_t)row_mod(row0) * 6144 + u.pn * 256 + wc * 32 + fq * 4;
        float4 gv[2][2];
#pragma unroll
        for (int bj = 0; bj < 2; ++bj)
#pragma unroll
            for (int n = 0; n < 2; ++n) gv[bj][n] = *(const float4*)(g1 + bj * 128 + n * 16);
#pragma unroll
        for (int ai = 0; ai < 2; ++ai) {
            float4 xv[4][2][2];
#pragma unroll
            for (int m = 0; m < 4; ++m)
#pragma unroll
                for (int bj = 0; bj < 2; ++bj)
#pragma unroll
                    for (int n = 0; n < 2; ++n) xv[m][bj][n] = *(const float4*)(xs + (size_t)(ai * 128 + m * 16) * DM + bj * 128 + n * 16);
            __builtin_amdgcn_sched_barrier(0);
#pragma unroll
            for (int m = 0; m < 4; ++m)
#pragma unroll
                for (int bj = 0; bj < 2; ++bj)
#pragma unroll
                    for (int n = 0; n < 2; ++n) {
                        const pg8::f32x4 v = acc[ai][bj][m][n]; const float4 x4 = xv[m][bj][n], g4 = gv[bj][n];
                        float4 o; o.x = x4.x + g4.x * v[0]; o.y = x4.y + g4.y * v[1]; o.z = x4.z + g4.z * v[2]; o.w = x4.w + g4.w * v[3];
                        *(float4*)(xd + (size_t)(ai * 128 + m * 16) * DM + bj * 128 + n * 16) = o;
                    }
            __builtin_amdgcn_sched_barrier(0);
        }
    }
};

struct Moe1Order : pg8::StaticOrder {
    const unsigned char* eb; const int* blkbase; const int* cnt; const int* list;
    __device__ __forceinline__ const char* bbase(const pg8::Gemm& g, const pg8::Unit& u, size_t tstep) const { return (const char*)g.Bt + ((size_t)eb[u.pm] * 2 + u.pn) * tstep; }
    __device__ __forceinline__ void arows(const pg8::Unit& u, int K, unsigned (&vo)[2][2]) const {
        const int e = eb[u.pm], i0 = (u.pm - blkbase[e]) * 256, n_e = cnt[e];
        int lt[2][2];
#pragma unroll
        for (int h = 0; h < 2; ++h)
#pragma unroll
            for (int i = 0; i < 2; ++i) { int R, C; pg8::stage_rc((int)threadIdx.x * 16 + i * 8192, R, C);
                const int ii = i0 + h * 128 + R; lt[h][i] = list[(size_t)min(e, 63) * TT + min(ii, max(n_e - 1, 0))]; }
#pragma unroll
        for (int h = 0; h < 2; ++h)
#pragma unroll
            for (int i = 0; i < 2; ++i) { int R, C; pg8::stage_rc((int)threadIdx.x * 16 + i * 8192, R, C);
                const int ii = i0 + h * 128 + R; const int tok = e == 64 ? ii : (ii < n_e ? lt[h][i] : 0);
                vo[h][i] = (unsigned)(tok * K + C) * 2u; }
    }
};
struct EpiMoe1 {
    static constexpr bool PERM = false, AFTER_DRAIN = false;
    bf16_t* hid;
    __device__ __forceinline__ void operator()(const pg8::f32x4 (&acc)[2][2][4][2], const pg8::Unit& u, int wr, int wc, int fr, int fq) const {
#pragma unroll
        for (int ai = 0; ai < 2; ++ai)
#pragma unroll
            for (int m = 0; m < 4; ++m) { bf16_t* d = hid + ((size_t)u.pm * 256 + ai * 128 + wr * 64 + m * 16 + fr) * 256 + u.pn * 128 + 16 * wc + 4 * fq;
#pragma unroll
                for (int bj = 0; bj < 2; ++bj) { const pg8::f32x4 gt = acc[ai][bj][m][0], up = acc[ai][bj][m][1];
                    uint2 o; o.x = pk2(gt[0] * sigmoidf_(gt[0]) * up[0], gt[1] * sigmoidf_(gt[1]) * up[1]); o.y = pk2(gt[2] * sigmoidf_(gt[2]) * up[2], gt[3] * sigmoidf_(gt[3]) * up[3]);
                    *(uint2*)(d + 64 * bj) = o; } }
    }
};

struct EpiMerge {
    static constexpr bool PERM = false, AFTER_DRAIN = false;
    const bf16_t* plo; const bf16_t* phi; bf16_t* out; const float* rs;
    __device__ __forceinline__ void operator()(const pg8::f32x4 (&acc)[2][2][4][2], const pg8::Unit& u, int wr, int wc, int fr, int fq) const {
        const int row0 = mt_row0(u.pm) + wr * 64 + fr;
        const int col = u.pn * 64 + wc * 16 + fq * 4;
        uint2 pp[8][4]; float scv[8];
#pragma unroll
        for (int q = 0; q < 8; ++q) {
            const int row = row0 + (q >> 2) * 128 + (q & 3) * 16;
            pp[q][0] = *(const uint2*)(plo + (size_t)row * 2048 + col); pp[q][1] = *(const uint2*)(plo + (size_t)row * 2048 + 1024 + col);
            pp[q][2] = *(const uint2*)(phi + (size_t)row * 2048 + col); pp[q][3] = *(const uint2*)(phi + (size_t)row * 2048 + 1024 + col);
            scv[q] = rs[row];
        }
        __builtin_amdgcn_sched_barrier(0);
#pragma unroll
        for (int q = 0; q < 8; ++q) {
            const int ai = q >> 2, m = q & 3, row = row0 + ai * 128 + m * 16;
            const float sc = scv[q];
            float o0, o1, o2, o3;
            { const pg8::f32x4 v = acc[ai][0][m][0]; const uint2 pv = pp[q][0]; o0 = sigmoidf_(v[0] * sc) * lo_bf(pv.x); o1 = sigmoidf_(v[1] * sc) * hi_bf(pv.x); o2 = sigmoidf_(v[2] * sc) * lo_bf(pv.y); o3 = sigmoidf_(v[3] * sc) * hi_bf(pv.y); }
            { const pg8::f32x4 v = acc[ai][0][m][1]; const uint2 pv = pp[q][1]; o0 += sigmoidf_(v[0] * sc) * lo_bf(pv.x); o1 += sigmoidf_(v[1] * sc) * hi_bf(pv.x); o2 += sigmoidf_(v[2] * sc) * lo_bf(pv.y); o3 += sigmoidf_(v[3] * sc) * hi_bf(pv.y); }
            { const pg8::f32x4 v = acc[ai][1][m][0]; const uint2 pv = pp[q][2]; o0 += sigmoidf_(v[0] * sc) * lo_bf(pv.x); o1 += sigmoidf_(v[1] * sc) * hi_bf(pv.x); o2 += sigmoidf_(v[2] * sc) * lo_bf(pv.y); o3 += sigmoidf_(v[3] * sc) * hi_bf(pv.y); }
            { const pg8::f32x4 v = acc[ai][1][m][1]; const uint2 pv = pp[q][3]; o0 += sigmoidf_(v[0] * sc) * lo_bf(pv.x); o1 += sigmoidf_(v[1] * sc) * hi_bf(pv.x); o2 += sigmoidf_(v[2] * sc) * lo_bf(pv.y); o3 += sigmoidf_(v[3] * sc) * hi_bf(pv.y); }
            uint2 wv; wv.x = pk2(o0, o1); wv.y = pk2(o2, o3);
            *(uint2*)(out + (size_t)row * DM + col) = wv;
        }
    }
};
#define GEMM_TILE_LOOP(NM_, NN_, mt, nt, BODY) do { \
    const int _SN = ((NN_) + 3) >> 2, _SM = ((NM_) + 7) >> 3, _nx = (int)gridDim.x >> 3, _xcd = (int)blockIdx.x & 7; \
    if (((int)gridDim.x & 7) == 0) { \
        for (int _s = _xcd; _s < _SM * _SN; _s += 8) \
            for (int _jj = (int)blockIdx.x >> 3; _jj < 32; _jj += _nx) { \
                const int mt = (_s / _SN) * 8 + (_jj & 7), nt = (_s % _SN) * 4 + (_jj >> 3); \
                if (mt < (NM_) && nt < (NN_)) { BODY; } } \
    } else { for (int _u = (int)blockIdx.x; _u < (NM_) * (NN_); _u += (int)gridDim.x) { const int mt = _u / (NN_), nt = _u % (NN_); BODY; } } \
} while (0)
NOINL void f_p0() { const Params& p = kparams(); char* lds = lds_at(256); UNIT_LOOP(u, 320, 0) { if (u < 192) mod_unit(p, u, lds); else rope_unit(p, u - 192); } }
NOINL void f_norm1(int l) { const Params& p = kparams(); const int rpb = (TT + (int)gridDim.x - 1) / (int)gridDim.x, r0 = (int)blockIdx.x * rpb; norm_rows(p, l, r0, min(TT, r0 + rpb), 0); }
NOINL void f_conv(int l) {
    const Params& p = kparams(); char* lds = lds_at(256);
    const int G = (int)gridDim.x; int u = (int)((blockIdx.x + G - (544 % G)) % G);
    float4 va[4], vb[4];
    if (u < CJ_END) conv_unit<0>(p, l, u, lds, va);
    for (;;) {
        if (u >= CJ_END) break;
        { const int un = u + G; conv_unit<0>(p, l, un < CJ_END ? un : u, lds, vb); conv_unit<1>(p, l, u, lds, va); u = un; }
        if (u >= CJ_END) break;
        { const int un = u + G; conv_unit<0>(p, l, un < CJ_END ? un : u, lds, va); conv_unit<1>(p, l, u, lds, vb); u = un; }
    }
}
NOINL void f_h2tab(int l) { const Params& p = kparams(); char* lds = lds_at(256); UNIT_LOOP(u, 68, 544 + CJ_END) h2tab_unit(p, l, u, lds); }
NOINL void f_spectrum(int l) {
    const Params& p = kparams(); char* lds = lds_at(256);
    UNIT_LOOP(u, 512, 0) spectrum8192_unit(p, l, u >> 8, u & 255, lds);
}
NOINL void f_spectrum_ctx(int l) {
    const Params& p = kparams(); char* lds = lds_at(256);
    const int b0 = (int)gridDim.x >= 232 ? 200 : 0;
    for (int u = (int)blockIdx.x - b0; u >= 0 && u < 32; u += (int)gridDim.x) spectrum512_unit(p, l, u, lds);
}
NOINL void f_inproj(int off) {
    const Params& p = kparams();
    pg8::Gemm g{(const bf16_t*)(p.ws + OFF_H), (const bf16_t*)(p.ws + OFF_WIN), TT, WIN_G0, 1024};
    pg8::StaticOrder S; S.init(TT, WIN_G0, (int)gridDim.x, (int)blockIdx.x);
    EpiInproj E{(bf16_t*)(p.ws + OFF_Z), (bf16_t*)(p.ws + OFF_ZT)};
    __syncthreads();
    pg8::gemm_phase<EpiInproj, pg8::StaticOrder, false>((PG8_LAS unsigned char*)(uintptr_t)256, g, S, E, nullptr);
    __syncthreads();
}
NOINL void f_hyena(int l) { const Params& p = kparams(); char* lds = lds_at(256); const int n = l == 0 ? 1088 : 1024; UNIT_LOOP(u, n, 0) hyena_unit(p, l, u, lds); }
NOINL void f_na(int l, int off) { const Params& p = kparams(); char* lds = lds_at(256); const int n = l == 0 ? 544 : 512; UNIT_LOOP(u, n, off) na_unit(p, l, u, lds); }
NOINL void f_lru1(int l, int off) { const Params& p = kparams(); char* lds = lds_at(256); UNIT_LOOP(u, 1088, off) lru1_unit(p, l, u, lds); }
NOINL void f_qproj(int off) { const Params& p = kparams(); char* lds = lds_at(256); UNIT_LOOP(u, NMT * 2, off) qproj_unit(p, u, lds); }
NOINL void f_kvproj(int off) { const Params& p = kparams(); char* lds = lds_at(256); UNIT_LOOP(u, NMT * 2, off) kvproj_unit(p, u, lds); }
NOINL void f_mla(int l) { const Params& p = kparams(); char* lds = lds_at(256); const int n = l == 0 ? 544 : 512; UNIT_LOOP(u, n, 0) mla_unit(p, u, lds); }
NOINL void f_ytrans(int off) { const Params& p = kparams(); char* lds = lds_at(256); UNIT_LOOP(u, 544, off) ytrans_unit(p, u, lds); }
NOINL void f_lrucarry(int l) { const Params& p = kparams(); UNIT_LOOP(u, 8, 0) lru_carry_unit(p, l, u); }
NOINL void f_lru2(int l, int off) { const Params& p = kparams(); UNIT_LOOP(u, 272, off) lru2_unit(p, l, u); }
NOINL void f_quant(int nmt) {
    const Params& p = kparams(); const int rows = nmt * 256;
    int nb = (int)gridDim.x, b = (int)blockIdx.x;
    const int extra = nmt * 8 - (nmt * 8 / nb) * nb;
    if (extra > 0 && extra * 2 <= nb) { if (b < extra) return; b -= extra; nb -= extra; }
    const int rpb = (rows + nb - 1) / nb, r0 = b * rpb;
    quant_rows(p, r0, min(rows, r0 + rpb));
}
NOINL void f_pbranch(int nmt) { const Params& p = kparams(); char* lds = lds_at(256); UNIT_LOOP(u, nmt * 8, 0) pbranch_unit(p, u, lds); }
NOINL void f_merge(int nmt) {
    const Params& p = kparams();
    pg8::Gemm g{(const bf16_t*)(p.ws + OFF_H8), (const bf16_t*)(p.ws + OFF_WG8), nmt * 256, 4096, 512};
    pg8::StaticOrder S; S.init(nmt * 256, 4096, (int)gridDim.x, (int)blockIdx.x);
    EpiMerge E{(const bf16_t*)(p.ws + OFF_PLO), (const bf16_t*)(p.ws + OFF_PHI), (bf16_t*)(p.ws + OFF_ACC), (const float*)(p.ws + OFF_RS)};
    __syncthreads();
    pg8::gemm_phase<EpiMerge, pg8::StaticOrder, false, true>((PG8_LAS unsigned char*)(uintptr_t)256, g, S, E, nullptr);
    __syncthreads();
}
NOINL void f_wout(int l, int nmt) {
    const Params& p = kparams();
    pg8::Gemm g{(const bf16_t*)(p.ws + OFF_ACC), (const bf16_t*)(p.ws + OFF_WOUT), nmt * 256, 1024, 1024};
    pg8::StaticOrder S; S.init(nmt * 256, 1024, (int)gridDim.x, (int)blockIdx.x);
    EpiWout E{l == 0 ? p.in[I_X] : p.out, l == 0 ? p.in[I_CTX] : (const float*)(p.ws + OFF_XC), p.out, (float*)(p.ws + OFF_XC), (const float*)(p.ws + OFF_MOD) + (size_t)l * 9 * 6144 + 2048};
    __syncthreads();
    pg8::gemm_phase<EpiWout, pg8::StaticOrder, false>((PG8_LAS unsigned char*)(uintptr_t)256, g, S, E, nullptr);
    __syncthreads();
}
NOINL void f_router(int l, int nmt) { const Params& p = kparams(); char* lds = lds_at(256); const int tot = nmt * 256, rpb = (tot + (int)gridDim.x - 1) / (int)gridDim.x, r0 = (int)blockIdx.x * rpb; if (r0 < tot) router_unit(p, l, r0, min(tot, r0 + rpb), lds); }
NOINL void f_moe1(int l, int nmt) {
    const Params& p = kparams(); char* lds = lds_at(256);
    const MoeTab t = moe_tables(p, l, nmt * 256, lds);
    const int nrb = t.blkbase[65];
    pg8::Gemm g{(const bf16_t*)(p.ws + OFF_H), (const bf16_t*)(p.ws + OFF_WGU), nrb * 256, 512, 1024};
    Moe1Order S; S.init(nrb * 256, 512, (int)gridDim.x, (int)blockIdx.x);
    S.eb = (const unsigned char*)(t.cbase + 80); S.blkbase = t.blkbase; S.cnt = t.cnt; S.list = (const int*)(p.ws + OFF_LIST);
    EpiMoe1 E{(bf16_t*)(p.ws + OFF_HID)};
    __syncthreads();
    pg8::gemm_phase_gather<EpiMoe1, Moe1Order, false>((PG8_LAS unsigned char*)(uintptr_t)256, g, S, E, nullptr);
    __syncthreads();
}
NOINL void f_moe2(int l, int nmt) { const Params& p = kparams(); char* lds = lds_at(256); const MoeTab t = moe_tables(p, l, nmt * 256, lds); const int nrb = t.blkbase[65], s0 = t.blkbase[64];
    UNIT_LOOP(u, nrb, 0) { int rb = u + s0; if (rb >= nrb) rb -= nrb; moe2_unit(p, l, t, rb, lds); } }
NOINL void f_combine(int l, int nmt) { const Params& p = kparams(); char* lds = lds_at(256); const MoeTab t = moe_tables(p, l, nmt * 256, lds); const int tot = nmt * 256, rpb = (tot + (int)gridDim.x - 1) / (int)gridDim.x, r0 = (int)blockIdx.x * rpb; combine_unit(p, l, t, r0, min(tot, r0 + rpb)); }


#ifdef DIAG
struct DiagBuf { size_t off; size_t n; int kind; };
DEVI void diag_phase(const Params& p, const XcdBarrier& bar) {
    const DiagBuf bufs[] = {
        {OFF_MOD, 2 * 9 * 6144, 1}, {OFF_COS, 2 * 4096 * 16, 1}, {OFF_H2T, 4352 * 64, 1}, {OFF_WIN, (size_t)(WIN_G0 + 4096) * 1024, 0}, {OFF_WGU, (size_t)65 * 512 * 1024, 0},
        {OFF_WDT, (size_t)65 * 1024 * 256, 0}, {OFF_WUQ, (OFF_H - OFF_WUQ) / 2, 0}, {OFF_H, (size_t)TT * DM, 0}, {OFF_HS, (size_t)2 * 256 * 8192 * 2, 1}, {OFF_HSC, (size_t)2 * 256 * 512 * 2, 1},
        {OFF_Z, (size_t)TT * ZLD, 0}, {OFF_ZT, (size_t)8 * 1024 * NKEY, 0}, {OFF_YT, (size_t)8 * 256 * NKEY, 0}, {OFF_Q, (size_t)8 * 4 * NKEY * 96, 0}, {OFF_K, (size_t)8 * 4 * NKEY * 96, 0},
        {OFF_VT, (size_t)8 * 4 * 64 * NKEY, 0}, {OFF_HLOC, (size_t)2 * TT * 256, 0}, {OFF_CUMA, (size_t)2 * TT * 256, 0}, {OFF_SEGA, (size_t)4 * 1088 * 256, 1}, {OFF_BR, (size_t)TT * DM, 0},
        {OFF_XC, (size_t)TCX * DM, 1}, {OFF_WTS, (size_t)TT * 6, 1} };
    constexpr int NB = sizeof(bufs) / sizeof(bufs[0]);
    unsigned* flags = (unsigned*)(p.ws + OFF_GCNT) + 1024;
    xcd_barrier(bar);
    const size_t gtid = (size_t)blockIdx.x * 512 + threadIdx.x, gn = (size_t)gridDim.x * 512;
    for (int b = DIAG_FIRST; b < NB; ++b) {
        unsigned bad = 0, poi = 0;
        if (bufs[b].kind == 0) { const bf16_t* q = (const bf16_t*)(p.ws + bufs[b].off);
            for (size_t i = gtid; i < bufs[b].n; i += gn) { const unsigned v = q[i]; if ((v & 0x7F80u) == 0x7F80u || fabsf(bf2f((bf16_t)v)) > 1e5f) ++bad; if (v == 0xAAAAu) ++poi; } }
        else { const unsigned* q = (const unsigned*)(p.ws + bufs[b].off);
            for (size_t i = gtid; i < bufs[b].n; i += gn) { const unsigned v = q[i]; if ((v & 0x7F800000u) == 0x7F800000u || fabsf(__uint_as_float(v)) > 1e5f) ++bad; if (v == 0xAAAAAAAAu) ++poi; } }
        bad = (unsigned)wave_sum((float)bad); poi = (unsigned)wave_sum((float)poi);
        if ((threadIdx.x & 63) == 0) { if (bad) atomicAdd(&flags[2 * b], bad); if (poi) atomicAdd(&flags[2 * b + 1], poi); }
    }
    xcd_barrier(bar);
    float K = 1000.f, K2 = 0.f;
    for (int b = NB - 1; b >= DIAG_FIRST; --b) {
        const unsigned bad = __hip_atomic_load(&flags[2 * b], __ATOMIC_RELAXED, __HIP_MEMORY_SCOPE_AGENT), poi = __hip_atomic_load(&flags[2 * b + 1], __ATOMIC_RELAXED, __HIP_MEMORY_SCOPE_AGENT);
        if (bad) K = 1000.f * (float)(10 + b);
        else if ((size_t)poi * 2 > bufs[b].n) K = 1000.f * (float)(50 + b);
    }
#if DIAG_MODE == 1
    {
        float* acc = (float*)((unsigned*)(p.ws + OFF_GCNT) + 2048);
        float s = 0.f; const int b = DIAG_ARG;
        if (bufs[b].kind == 0) { const bf16_t* q = (const bf16_t*)(p.ws + bufs[b].off); for (size_t i = gtid; i < bufs[b].n; i += gn) { const float v = bf2f(q[i]); s += v * v; } }
        else { const float* q = (const float*)(p.ws + bufs[b].off); for (size_t i = gtid; i < bufs[b].n; i += gn) { const float v = q[i]; s += v * v; } }
        s = wave_sum(s); if ((threadIdx.x & 63) == 0) atomicAdd(acc, s);
        xcd_barrier(bar);
        K = 1000.f * sqrtf(__hip_atomic_load(acc, __ATOMIC_RELAXED, __HIP_MEMORY_SCOPE_AGENT) / (float)bufs[b].n);
    }
#elif DIAG_MODE == 5
    {
        unsigned* cn = (unsigned*)(p.ws + OFF_GCNT) + 2048;
        unsigned nn = 0, nz = 0;
        const unsigned char* q = (const unsigned char*)(p.ws + OFF_H8);
        for (size_t i = gtid; i < (size_t)TT * 1024; i += gn) { const unsigned v = q[i]; if ((v & 0x7Fu) == 0x7Fu) ++nz; }
        q = (const unsigned char*)(p.ws + OFF_WG8);
        for (size_t i = gtid; i < (size_t)4096 * 1024; i += gn) { const unsigned v = q[i]; if ((v & 0x7Fu) == 0x7Fu) ++nn; }
        nn = (unsigned)wave_sum((float)nn); nz = (unsigned)wave_sum((float)nz);
        if ((threadIdx.x & 63) == 0) { if (nn) atomicAdd(&cn[0], nn); if (nz) atomicAdd(&cn[1], nz); }
        xcd_barrier(bar);
        K = (float)__hip_atomic_load(&cn[0], __ATOMIC_RELAXED, __HIP_MEMORY_SCOPE_AGENT);
        K2 = (float)__hip_atomic_load(&cn[1], __ATOMIC_RELAXED, __HIP_MEMORY_SCOPE_AGENT);
    }
#elif DIAG_MODE == 2
    K = (float)__hip_atomic_load(&flags[2 * DIAG_ARG], __ATOMIC_RELAXED, __HIP_MEMORY_SCOPE_AGENT);
#elif DIAG_MODE == 3
    {
        unsigned* mn = (unsigned*)(p.ws + OFF_GCNT) + 2048;
        if (blockIdx.x == 0 && threadIdx.x == 0) __hip_atomic_store(mn, 0xFFFFFFFFu, __ATOMIC_RELAXED, __HIP_MEMORY_SCOPE_AGENT);
        xcd_barrier(bar);
        const int b = DIAG_ARG; unsigned best = 0xFFFFFFFFu;
        if (bufs[b].kind == 0) { const bf16_t* q = (const bf16_t*)(p.ws + bufs[b].off);
            for (size_t i = gtid; i < bufs[b].n; i += gn) { const unsigned v = q[i]; if (((v & 0x7F80u) == 0x7F80u || fabsf(bf2f((bf16_t)v)) > 1e5f) && (unsigned)i < best) best = (unsigned)i; } }
        if (best != 0xFFFFFFFFu) atomicMin(mn, best);
        xcd_barrier(bar);
        const unsigned r = __hip_atomic_load(mn, __ATOMIC_RELAXED, __HIP_MEMORY_SCOPE_AGENT);
        K = (float)((r / DIAG_DIV) % DIAG_MOD);
        K2 = 1000.f * (float)((r / DIAG_DIV2) % DIAG_MOD2);
#ifdef DIAG_ROW0
        { const bf16_t* q = (const bf16_t*)(p.ws + bufs[b].off); int cnt = 0, cnt2 = 0;
          for (int c2 = 0; c2 < ZLD; ++c2) { const unsigned v = q[(size_t)DIAG_ROW0 * ZLD + c2]; if ((v & 0x7F80u) == 0x7F80u) ++cnt; }
          for (int r2 = 0; r2 < 99; ++r2) { const unsigned v = q[(size_t)r2 * ZLD + DIAG_COL0]; if ((v & 0x7F80u) == 0x7F80u) ++cnt2; }
          K = (float)cnt; K2 = 1000.f * (float)cnt2; }
#endif
#ifdef DIAG_VAL
        { const unsigned v = ((const bf16_t*)(p.ws + bufs[b].off))[r]; const float f = fabsf(bf2f((bf16_t)v)); K = ((v & 0x7F80u) == 0x7F80u) ? ((v & 0x7Fu) ? 49.f : 48.f) : fminf(47.f, log2f(f) * 0.25f); }
#endif
    }
#endif
    for (size_t i = gtid; i < (size_t)TL * DM; i += gn) p.out[i] = (i == 12345 && K2 != 0.f) ? K2 : K;
}
#endif

__global__ void __launch_bounds__(512, 2) mega_fwd(Params p) {
    if (threadIdx.x == 0) *(uint4*)smem = make_uint4(0u, 0u, 0u, 0u);
    __syncthreads();
    XcdBarrier bar = xcd_barrier_post((unsigned*)(p.ws + OFF_BAR), (volatile LAS unsigned*)smem);
    int ph = 0;
#ifdef DIAGT
#define STAMP(i) do { if (blockIdx.x == 0 && threadIdx.x == 0) ((unsigned long long*)(p.ws + OFF_GCNT + 8192))[i] = wall_clock64(); } while (0)
#else
#define STAMP(i) do {} while (0)
#endif
#ifndef REP_PHASE
#define REP_PHASE -1
#endif
#define PHASE(...) do { if (ph >= p.ph_lo && ph < p.ph_hi) { STAMP(ph); __VA_ARGS__; if (ph == REP_PHASE) { xcd_barrier(bar); __VA_ARGS__; } if (ph + 1 < p.ph_hi) xcd_barrier(bar); } ++ph; } while (0)
    PHASE({ f_p0(); f_conv(0); f_h2tab(0); });
#define LAYER(l) do { \
        const int nmt = l == 0 ? NMT : 128; \
        PHASE({ f_norm1(l); if (l > 0) { f_conv(l); f_h2tab(l); } }); \
        PHASE({ f_spectrum(l); f_inproj(0); if (l == 0) f_spectrum_ctx(l); }); \
        PHASE({ const int nh = l == 0 ? 1088 : 1024, nn = l == 0 ? 544 : 512; f_hyena(l); f_na(l, nh); f_lru1(l, nh + nn); f_qproj(nh + nn + 1088); f_kvproj(nh + nn + 1088 + NMT * 2); }); \
        PHASE({ f_lrucarry(l); f_mla(l); f_lru2(l, l == 0 ? 544 : 512); f_ytrans((l == 0 ? 544 : 512) + 272); }); \
        PHASE({ f_quant(nmt); f_pbranch(nmt); }); \
        PHASE(f_merge(nmt)); \
        PHASE(f_wout(l, nmt)); \
        PHASE(f_router(l, nmt)); \
        PHASE(f_moe1(l, nmt)); \
        PHASE(f_moe2(l, nmt)); \
        PHASE(f_combine(l, nmt)); \
    } while (0)
    LAYER(0);
    LAYER(1);
#ifdef DIAG
    diag_phase(p, bar);
#endif
#ifdef DIAGT
    {
        xcd_barrier(bar); STAMP(ph); xcd_barrier(bar);
        const unsigned long long* ts = (const unsigned long long*)(p.ws + OFF_GCNT + 8192);
        const float K = (float)(__hip_atomic_load(ts + DIAGT_A + 1, __ATOMIC_RELAXED, __HIP_MEMORY_SCOPE_AGENT) - __hip_atomic_load(ts + DIAGT_A, __ATOMIC_RELAXED, __HIP_MEMORY_SCOPE_AGENT)) * 0.01f;
        const float K2 = (float)(__hip_atomic_load(ts + DIAGT_B + 1, __ATOMIC_RELAXED, __HIP_MEMORY_SCOPE_AGENT) - __hip_atomic_load(ts + DIAGT_B, __ATOMIC_RELAXED, __HIP_MEMORY_SCOPE_AGENT)) * 1.0f;
        const size_t gtid = (size_t)blockIdx.x * 512 + threadIdx.x, gn = (size_t)gridDim.x * 512;
        for (size_t i = gtid; i < (size_t)TL * DM; i += gn) p.out[i] = (i == 12345) ? K2 : K;
    }
#endif
}

extern "C" void kernel_launch(void* const* d_in, const int* in_sizes, int n_in, void* d_out, int out_size, void* d_ws, size_t ws_size, hipStream_t stream) {
    static int grid = 0;
    if (!grid) {
        int dev = 0, cus = 0, per_cu = 0;
        hipGetDevice(&dev);
        hipDeviceGetAttribute(&cus, hipDeviceAttributeMultiprocessorCount, dev);
        if (hipFuncSetAttribute((const void*)mega_fwd, hipFuncAttributeMaxDynamicSharedMemorySize, LDS_BYTES + 256) != hipSuccess) fprintf(stderr, "hipFuncSetAttribute failed\n");
        if (hipOccupancyMaxActiveBlocksPerMultiprocessor(&per_cu, (const void*)mega_fwd, 512, LDS_BYTES + 256) != hipSuccess || per_cu < 1) { fprintf(stderr, "occupancy query failed\n"); per_cu = 1; }
        grid = cus * 1;
        if (ws_size < WS_END) fprintf(stderr, "workspace too small: %zu < %zu\n", ws_size, (size_t)WS_END);
    }
    hipMemsetAsync(d_ws, 0, ZERO_BYTES, stream);
    Params p{};
    for (int i = 0; i < 41; ++i) p.in[i] = (const float*)d_in[i];
    p.out = (float*)d_out; p.ws = (char*)d_ws; p.ph_lo = 0; p.ph_hi = PH_HI;
    hipLaunchKernelGGL(mega_fwd, dim3(grid), dim3(512), LDS_BYTES + 256, stream, p);
}
```

```cpp
#include <hip/hip_runtime.h>
#include <stdint.h>
#include <stdio.h>

typedef unsigned short bf16_t;
typedef short bf16x8 __attribute__((ext_vector_type(8)));
typedef float f32x16 __attribute__((ext_vector_type(16)));
typedef unsigned u32x4 __attribute__((ext_vector_type(4)));

#define DEVI __device__ __forceinline__

constexpr int DM = 1024, TL = 32768, TCX = 2048, TT = 34816, NKEY = 4352;
constexpr int ZLD = 1408;
constexpr int NIN = 2432;
constexpr int WIN_G0 = 2560;
constexpr int NMT = 136;
constexpr int ZC_QL = 0, ZC_KVL = 192, ZC_KR = 320, ZC_NAQ = 384, ZC_NAK = 640, ZC_LU = 896, ZC_LG = 1152;
constexpr int ZT_NAV = 0, ZT_HY = 256;

constexpr size_t AL(size_t x) { return (x + 255) & ~(size_t)255; }
constexpr size_t OFF_BAR = 0;
constexpr size_t OFF_GCNT = 16384;
constexpr size_t ZERO_BYTES = 32768;
constexpr size_t OFF_MOD = 32768;
constexpr size_t OFF_COS = OFF_MOD + AL(2 * 9 * 6144 * 4);
constexpr size_t OFF_SIN = OFF_COS + 4096 * 16 * 4;
constexpr size_t OFF_H2T = OFF_SIN + 4096 * 16 * 4;
constexpr size_t OFF_SEGA = OFF_H2T + 4352 * 64 * 4;
constexpr size_t OFF_SEGB = OFF_SEGA + 2 * 1088 * 256 * 4;
constexpr size_t OFF_LWT = OFF_SEGB + 2 * 1088 * 256 * 4;
constexpr size_t OFF_HIN = OFF_LWT + 16 * 64 * 64 * 2;
constexpr size_t OFF_TOKS = OFF_HIN + 2 * 1088 * 256 * 4;
constexpr size_t OFF_WTS = OFF_TOKS + AL((size_t)TT * 6 * 4);
constexpr size_t OFF_XC = OFF_WTS + AL((size_t)TT * 6 * 4);
constexpr size_t OFF_LIST = OFF_XC + (size_t)TCX * DM * 4;
constexpr size_t OFF_WDT = OFF_LIST + (size_t)64 * TT * 4;
constexpr size_t OFF_ZBIG = OFF_WDT + (size_t)65 * 1024 * 256 * 2;
constexpr size_t OFF_Z = OFF_ZBIG;
constexpr size_t OFF_ZT = OFF_Z + (size_t)TT * ZLD * 2;
constexpr size_t ZBIG_BYTES = (size_t)TT * ZLD * 2 + (size_t)8 * 1024 * NKEY * 2;
constexpr size_t OFF_PHI = OFF_ZBIG;
constexpr size_t OFF_HID = OFF_ZBIG;
constexpr size_t HID_BYTES = (size_t)1016 * 256 * 256 * 2;
constexpr size_t OFF_Y = OFF_ZBIG + HID_BYTES;
constexpr size_t Y_BYTES = (size_t)TT * 6 * DM * 2;
constexpr size_t OFF_WGU = OFF_ZBIG + ZBIG_BYTES;
constexpr size_t OFF_WIN = OFF_WGU + (size_t)65 * 512 * 1024 * 2;
constexpr size_t OFF_WUQ = OFF_WIN + (size_t)(WIN_G0 + 4096) * 1024 * 2;
constexpr size_t OFF_WUKV = OFF_WUQ + 384 * 192 * 2;
constexpr size_t OFF_WBR = OFF_WUKV + 512 * 128 * 2;
constexpr size_t OFF_WOUT = OFF_WBR + 4 * 1024 * 256 * 2;
constexpr size_t OFF_RT = OFF_WOUT + 1024 * 1024 * 2;
constexpr size_t OFF_H = OFF_RT + 128 * 1024 * 2;
constexpr size_t OFF_BR = OFF_H + (size_t)TT * DM * 2;
constexpr size_t OFF_ACC = OFF_BR;
constexpr size_t OFF_YT = OFF_BR + (size_t)TT * DM * 2;
constexpr size_t OFF_PLO = OFF_YT;
constexpr size_t OFF_Q = OFF_YT + (size_t)8 * 256 * NKEY * 2;
constexpr size_t OFF_K = OFF_Q + (size_t)8 * 4 * NKEY * 96 * 2;
constexpr size_t OFF_VT = OFF_K + (size_t)8 * 4 * NKEY * 96 * 2;
constexpr size_t OFF_HS = OFF_VT + (size_t)8 * 4 * 64 * NKEY * 2;
constexpr size_t OFF_HSC = OFF_HS + (size_t)2 * 256 * 8192 * 8;
constexpr size_t OFF_HLOC = OFF_HSC + (size_t)2 * 256 * 512 * 8;
constexpr size_t OFF_CUMA = OFF_HLOC + (size_t)2 * TT * 256 * 2;
constexpr size_t WS_END = OFF_CUMA + (size_t)2 * TT * 256 * 2;
constexpr size_t OFF_WG8 = OFF_WIN + (size_t)WIN_G0 * 1024 * 2;
constexpr size_t OFF_H8 = OFF_CUMA;
static_assert(OFF_PLO + (size_t)TT * 4096 <= OFF_CUMA, "P_lo must not reach h8");
constexpr size_t OFF_RS = OFF_SEGA;
constexpr float WG8_SCALE = 512.f;
static_assert(OFF_Y + Y_BYTES <= WS_END, "Y must fit inside the workspace map");
static_assert(OFF_PLO + (size_t)TT * 4096 <= WS_END && OFF_PHI + (size_t)TT * 4096 <= OFF_ZBIG + ZBIG_BYTES, "P halves must fit the dead regions");
static_assert(OFF_Y >= OFF_HID + HID_BYTES, "Y vs hid");
static_assert(WS_END < (size_t)670 * 1000 * 1000, "workspace too large");

constexpr int LDS_BYTES = 147456;
#ifndef PH_HI
#define PH_HI 1000
#define DIAGT_A 1
#define DIAGT_B 2
#define DIAG_FIRST 0
#define DIAG_MODE 0
#define DIAG_ARG 10
#define DIAG_DIV 1408
#define DIAG_MOD 50
#define DIAG_DIV2 (1408 * 400)
#define DIAG_MOD2 100
#endif

struct Params {
    const float* in[41];
    float* out;
    char* ws;
    int ph_lo, ph_hi;
};

enum { I_X = 0, I_C, I_CTX, I_CCTX, I_WMOD, I_BMOD, I_GN1, I_GN2, I_WIN, I_GQ, I_WUQ, I_GKV, I_WUKV, I_RPB, I_HSW, I_HSB, I_HW1, I_HB1, I_HW2,
       I_HB2, I_HW3, I_HDEC, I_HBIAS, I_LCW, I_LCB, I_LWA, I_LBA, I_LWX, I_LBX, I_LLAM, I_WBR, I_WOUT, I_RW, I_RB, I_EG, I_EU, I_ED, I_SG, I_SU,
       I_SD, I_GF };

#define XB_TMO      128
#define XB_XCNT(j)  (256  + 64 * (j))
#define XB_XSUB(j)  (1280 + 64 * (j))
#define XB_XGEN(j)  (2304 + 64 * (j))
#define XB_TOP      3328
#define XB_TOPGEN   3392
#define XCD_BAR_WORDS 3456
#define XB_SPIN_CAP (1u << 18)
#define LAS __attribute__((address_space(3)))

__device__ __forceinline__ unsigned xb_ld(unsigned* p)              { return __hip_atomic_load(p, __ATOMIC_RELAXED, __HIP_MEMORY_SCOPE_AGENT); }
__device__ __forceinline__ unsigned xb_add(unsigned* p, unsigned v) { return __hip_atomic_fetch_add(p, v, __ATOMIC_RELAXED, __HIP_MEMORY_SCOPE_AGENT); }
__device__ __forceinline__ unsigned xb_xcc_id() { return (unsigned)__builtin_amdgcn_s_getreg((3 << 11) | 20) & 0xFu; }
#define XB_SPIN(cond, bar) do { unsigned _sp = 0; while (cond) { __builtin_amdgcn_s_sleep(1); \
    if ((++_sp & 255u) == 0u) { if (xb_ld(&(bar)[XB_TMO])) break; if (_sp > XB_SPIN_CAP) { atomicAdd(&(bar)[XB_TMO], 1u); break; } } } } while (0)

struct XcdBarrier { unsigned* bar; unsigned x; volatile LAS unsigned* st; };

__device__ __forceinline__ XcdBarrier xcd_barrier_post(unsigned* bar, volatile LAS unsigned* st) {
    XcdBarrier b; b.bar = bar; b.x = xb_xcc_id(); b.st = st;
    if (threadIdx.x == 0) (void)xb_add(&bar[XB_XCNT(b.x)], 1u);
    return b;
}
__device__ __forceinline__ void xcd_barrier_complete(unsigned* bar, unsigned x, unsigned& nloc, unsigned& nx) {
    const unsigned G = gridDim.x * gridDim.y * gridDim.z;
    unsigned sum, cnt, mine, sp = 0u;
    for (;;) {
        sum = 0u; cnt = 0u; mine = 0u;
#pragma unroll
        for (unsigned j = 0; j < 16; ++j) { const unsigned c = xb_ld(&bar[XB_XCNT(j)]); sum += c; cnt += (c > 0u) ? 1u : 0u; mine = (j == x) ? c : mine; }
        if (sum == G) break;
        __builtin_amdgcn_s_sleep(1);
        if ((++sp & 255u) == 0u) { if (xb_ld(&bar[XB_TMO])) break; if (sp > XB_SPIN_CAP) { atomicAdd(&bar[XB_TMO], 1u); break; } }
    }
    nloc = mine > 0u ? mine : 1u; nx = cnt > 0u ? cnt : 1u;
}
__device__ __forceinline__ void xcd_barrier(const XcdBarrier& b) {
    asm volatile("s_waitcnt vmcnt(0)" ::: "memory");
    __syncthreads();
    if (threadIdx.x == 0) {
        unsigned* bar = b.bar;
        __builtin_amdgcn_s_waitcnt(0);
        unsigned nloc = b.st[0], nx = b.st[1];
        if (nloc == 0u) { xcd_barrier_complete(bar, b.x, nloc, nx); b.st[0] = nloc; b.st[1] = nx; }
        const unsigned old = xb_add(&bar[XB_XSUB(b.x)], 1u);
        const unsigned gen = old / nloc;
        if (old + 1u == (gen + 1u) * nloc) {
            __builtin_amdgcn_fence(__ATOMIC_RELEASE, "agent");
            asm volatile("s_waitcnt vmcnt(0)" ::: "memory");
            const unsigned og = xb_add(&bar[XB_TOP], 1u);
            const unsigned tg = og / nx;
            if (og + 1u == (tg + 1u) * nx) xb_add(&bar[XB_TOPGEN], 1u);
            else XB_SPIN(xb_ld(&bar[XB_TOPGEN]) == tg, bar);
            __builtin_amdgcn_fence(__ATOMIC_ACQUIRE, "agent");
            xb_add(&bar[XB_XGEN(b.x)], 1u);
            asm volatile("s_waitcnt vmcnt(0)" ::: "memory");
        } else {
            XB_SPIN(xb_ld(&bar[XB_XGEN(b.x)]) == gen, bar);
            __builtin_amdgcn_fence(__ATOMIC_ACQUIRE, "agent");
            asm volatile("s_waitcnt vmcnt(0)" ::: "memory");
        }
    }
    __syncthreads();
}

extern __shared__ __attribute__((aligned(16))) char smem[];
typedef __attribute__((address_space(4))) const Params CParams;
__device__ __forceinline__ const Params& kparams() { CParams* q = (CParams*)__builtin_amdgcn_kernarg_segment_ptr(); asm volatile("" : "+s"(q)); return *(const Params*)q; }
__device__ __forceinline__ char* lds_at(unsigned off) { return (char*)(LAS char*)(uintptr_t)off; }
#define NOINL __device__ __forceinline__
#define UNIT_LOOP(u, n, off) for (int u = (int)((blockIdx.x + gridDim.x - ((off) % gridDim.x)) % gridDim.x); u < (n); u += gridDim.x)
DEVI int tidx() { int t = threadIdx.x; asm volatile("" : "+v"(t)); return t; }
DEVI float bf2f(bf16_t v) { return __uint_as_float((unsigned)v << 16); }
typedef __bf16 bf16v2 __attribute__((ext_vector_type(2)));
DEVI unsigned pk2(float lo, float hi) { bf16v2 v; v[0] = (__bf16)lo; v[1] = (__bf16)hi; return __builtin_bit_cast(unsigned, v); }
DEVI bf16_t f2bf(float v) { return (bf16_t)(pk2(v, 0.f) & 0xffffu); }
DEVI float lo_bf(unsigned u) { return __uint_as_float(u << 16); }
DEVI float hi_bf(unsigned u) { return __uint_as_float(u & 0xffff0000u); }
DEVI float sigmoidf_(float x) { return __builtin_amdgcn_rcpf(1.f + __expf(-x)); }
DEVI float wave_sum(float v) {
#pragma unroll
    for (int m = 32; m >= 1; m >>= 1) v += __shfl_xor(v, m);
    return v;
}
DEVI float wave_max(float v) {
#pragma unroll
    for (int m = 32; m >= 1; m >>= 1) v = fmaxf(v, __shfl_xor(v, m));
    return v;
}
DEVI unsigned f2e4m3(float x) {
    const unsigned s = (__float_as_uint(x) >> 24) & 0x80u;
    const float a = fminf(fabsf(x), 448.f);
    const unsigned au = __float_as_uint(a);
    const unsigned nrm = ((au + 0x7FFFFu + ((au >> 20) & 1u)) >> 20) - (120u << 3);
    const unsigned sub = (unsigned)__float2int_rn(a * 512.f);
    const unsigned mag = a < 0.015625f ? sub : nrm;
    return mag ? (s | mag) : 0u;
}
DEVI unsigned pk4_fp8(float a, float b, float c, float d) { return f2e4m3(a) | (f2e4m3(b) << 8) | (f2e4m3(c) << 16) | (f2e4m3(d) << 24); }
DEVI int row_b(int r) { return r < TL ? (r >> 12) : ((r - TL) >> 8); }
DEVI int row_key(int r) { return r < TL ? (r & 4095) : (4096 + ((r - TL) & 255)); }
DEVI int row_mod(int r) { return r < TL ? (r >> 12) : 8; }
DEVI const float* xsrc(const Params& p, int l, int r) {
    if (l == 0) return r < TL ? p.in[I_X] + (size_t)r * DM : p.in[I_CTX] + (size_t)(r - TL) * DM;
    return r < TL ? p.out + (size_t)r * DM : (const float*)(p.ws + OFF_XC) + (size_t)(r - TL) * DM;
}
DEVI float* xdst(const Params& p, int r) { return r < TL ? p.out + (size_t)r * DM : (float*)(p.ws + OFF_XC) + (size_t)(r - TL) * DM; }
DEVI int mt_row0(int mt) { return mt < 128 ? mt * 256 : TL + (mt - 128) * 256; }

#define MFMA(a, b, c) __builtin_amdgcn_mfma_f32_32x32x16_bf16((a), (b), (c), 0, 0, 0)

constexpr int G_LD = 72;
constexpr int G_ASZ = 256 * G_LD * 2;
constexpr int G_BSZ = 128 * G_LD * 2;
constexpr int G_STAGE = G_ASZ + G_BSZ;
constexpr int G_LDS = 2 * G_STAGE;

struct RowLoader {
    const bf16_t* p0; const bf16_t* p1; const bf16_t* p2; const bf16_t* p3; int soff;
    u32x4 r0, r1, r2, r3;
    DEVI void issue(int k0) { r0 = *(const u32x4*)(p0 + k0); r1 = *(const u32x4*)(p1 + k0); r2 = *(const u32x4*)(p2 + k0); r3 = *(const u32x4*)(p3 + k0); }
    DEVI void commit(bf16_t* As) const {
        *(u32x4*)(As + soff) = r0; *(u32x4*)(As + soff + 64 * G_LD) = r1; *(u32x4*)(As + soff + 128 * G_LD) = r2; *(u32x4*)(As + soff + 192 * G_LD) = r3;
    }
};

template <bool SW, int NI, class AL_>
DEVI void gemm_mainloop(f32x16 (&acc)[2][NI], AL_ al0, const bf16_t* __restrict__ Bt, int ldb, int K, char* lds) {
    const int tid = tidx(), lane = tid & 63, w = tid >> 6, wm = w >> 1, wn = w & 1, l31 = lane & 31, hh = lane >> 5;
    const int lr = tid >> 3, kc = (tid & 7) * 8;
    const bf16_t* bp0 = Bt + (size_t)lr * ldb + kc;
    const bf16_t* bp1 = Bt + (size_t)(lr + 64) * ldb + kc;
    AL_ al1 = al0;
    u32x4 b00, b01, b10, b11;
#pragma unroll
    for (int mi = 0; mi < 2; ++mi)
#pragma unroll
        for (int ni = 0; ni < NI; ++ni)
#pragma unroll
            for (int e = 0; e < 16; ++e) acc[mi][ni][e] = 0.f;
    const int nk = K >> 6;
    const int aoff = (wm * 64 + l31) * G_LD + 8 * hh, boff = (wn * 32 * NI + l31) * G_LD + 8 * hh, bst = lr * G_LD + kc;
    auto compute = [&](const char* st) __attribute__((always_inline)) {
        const bf16_t* As = (const bf16_t*)st; const bf16_t* Bs = (const bf16_t*)(st + G_ASZ);
#pragma unroll
        for (int ks = 0; ks < 4; ++ks) {
            bf16x8 af[2], bfr[NI];
#pragma unroll
            for (int mi = 0; mi < 2; ++mi) af[mi] = *(const bf16x8*)(As + aoff + mi * 32 * G_LD + ks * 16);
#pragma unroll
            for (int ni = 0; ni < NI; ++ni) bfr[ni] = *(const bf16x8*)(Bs + boff + ni * 32 * G_LD + ks * 16);
#pragma unroll
            for (int mi = 0; mi < 2; ++mi)
#pragma unroll
                for (int ni = 0; ni < NI; ++ni) {
                    if (SW) acc[mi][ni] = MFMA(bfr[ni], af[mi], acc[mi][ni]);
                    else    acc[mi][ni] = MFMA(af[mi], bfr[ni], acc[mi][ni]);
                }
            if (ks == 1) __builtin_amdgcn_sched_barrier(0);
        }
    };
    __syncthreads();
    al0.issue(0); b00 = *(const u32x4*)bp0; if (NI == 2) b01 = *(const u32x4*)bp1;
    if (nk > 1) { al1.issue(64); b10 = *(const u32x4*)(bp0 + 64); if (NI == 2) b11 = *(const u32x4*)(bp1 + 64); }
    {
        bf16_t* As = (bf16_t*)lds; bf16_t* Bs = (bf16_t*)(lds + G_ASZ);
        al0.commit(As);
        *(u32x4*)(Bs + bst) = b00; if (NI == 2) *(u32x4*)(Bs + bst + 64 * G_LD) = b01;
    }
    __syncthreads();
    for (int kt = 0; kt < nk; kt += 2) {
        if (kt + 2 < nk) { const int k0 = (kt + 2) << 6; al0.issue(k0); b00 = *(const u32x4*)(bp0 + k0); if (NI == 2) b01 = *(const u32x4*)(bp1 + k0); }
        compute(lds);
        if (kt + 1 < nk) {
            bf16_t* As = (bf16_t*)(lds + G_STAGE); bf16_t* Bs = (bf16_t*)(lds + G_STAGE + G_ASZ);
            al1.commit(As);
            *(u32x4*)(Bs + bst) = b10; if (NI == 2) *(u32x4*)(Bs + bst + 64 * G_LD) = b11;
        }
        __syncthreads();
        if (kt + 1 >= nk) break;
        if (kt + 3 < nk) { const int k0 = (kt + 3) << 6; al1.issue(k0); b10 = *(const u32x4*)(bp0 + k0); if (NI == 2) b11 = *(const u32x4*)(bp1 + k0); }
        compute(lds + G_STAGE);
        if (kt + 2 < nk) {
            bf16_t* As = (bf16_t*)lds; bf16_t* Bs = (bf16_t*)(lds + G_ASZ);
            al0.commit(As);
            *(u32x4*)(Bs + bst) = b00; if (NI == 2) *(u32x4*)(Bs + bst + 64 * G_LD) = b01;
        }
        __syncthreads();
    }
}
template <bool SW, int NI, class AL_>
DEVI void gemm_mainloop1(f32x16 (&acc)[2][NI], AL_ al, const bf16_t* __restrict__ Bt, int ldb, int K, char* lds, int bhalf = -1) {
    const int tid = tidx(), lane = tid & 63, w = tid >> 6, wm = w >> 1, wn = w & 1, l31 = lane & 31, hh = lane >> 5;
    const int lr = tid >> 3, kc = (tid & 7) * 8;
    const bf16_t* bp0 = Bt + (size_t)(bhalf < 0 ? lr : ((lr >> 5) * 64 + bhalf * 32 + (lr & 31))) * ldb + kc;
    const bf16_t* bp1 = Bt + (size_t)(lr + 64) * ldb + kc;
    u32x4 rb0, rb1;
#pragma unroll
    for (int mi = 0; mi < 2; ++mi)
#pragma unroll
        for (int ni = 0; ni < NI; ++ni)
#pragma unroll
            for (int e = 0; e < 16; ++e) acc[mi][ni][e] = 0.f;
    __syncthreads();
    al.issue(0); rb0 = *(const u32x4*)bp0; if (NI == 2) rb1 = *(const u32x4*)bp1;
    {
        bf16_t* As = (bf16_t*)lds; bf16_t* Bs = (bf16_t*)(lds + G_ASZ);
        al.commit(As);
        *(u32x4*)(Bs + lr * G_LD + kc) = rb0; if (NI == 2) *(u32x4*)(Bs + (lr + 64) * G_LD + kc) = rb1;
    }
    __syncthreads();
    const int nk = K >> 6;
#pragma unroll 1
    for (int kt = 0; kt < nk; ++kt) {
        const bf16_t* As = (const bf16_t*)(lds + (kt & 1) * G_STAGE);
        const bf16_t* Bs = (const bf16_t*)(lds + (kt & 1) * G_STAGE + G_ASZ);
        const bool more = kt + 1 < nk;
        if (more) { const int k0 = (kt + 1) << 6; al.issue(k0); rb0 = *(const u32x4*)(bp0 + k0); if (NI == 2) rb1 = *(const u32x4*)(bp1 + k0); }
#pragma unroll
        for (int ks = 0; ks < 4; ++ks) {
            bf16x8 af[2], bfr[NI];
#pragma unroll
            for (int mi = 0; mi < 2; ++mi) af[mi] = *(const bf16x8*)(As + (wm * 64 + mi * 32 + l31) * G_LD + ks * 16 + 8 * hh);
#pragma unroll
            for (int ni = 0; ni < NI; ++ni) bfr[ni] = *(const bf16x8*)(Bs + (wn * 32 * NI + ni * 32 + l31) * G_LD + ks * 16 + 8 * hh);
#pragma unroll
            for (int mi = 0; mi < 2; ++mi)
#pragma unroll
                for (int ni = 0; ni < NI; ++ni) {
                    if (SW) acc[mi][ni] = MFMA(bfr[ni], af[mi], acc[mi][ni]);
                    else    acc[mi][ni] = MFMA(af[mi], bfr[ni], acc[mi][ni]);
                }
        }
        if (more) {
            bf16_t* An = (bf16_t*)(lds + ((kt + 1) & 1) * G_STAGE); bf16_t* Bn = (bf16_t*)(lds + ((kt + 1) & 1) * G_STAGE + G_ASZ);
            al.commit(An);
            *(u32x4*)(Bn + lr * G_LD + kc) = rb0; if (NI == 2) *(u32x4*)(Bn + (lr + 64) * G_LD + kc) = rb1;
        }
        __syncthreads();
    }
}
DEVI RowLoader make_rows(const bf16_t* base, size_t ld, int row0) {
    RowLoader r; const int tid = tidx(), lr = tid >> 3, kc = (tid & 7) * 8;
    r.p0 = base + (size_t)(row0 + lr) * ld + kc; r.p1 = r.p0 + 64 * ld; r.p2 = r.p0 + 128 * ld; r.p3 = r.p0 + 192 * ld; r.soff = lr * G_LD + kc;
    return r;
}

constexpr int K2_LD = 264;
constexpr int K2_BUF = 64 * K2_LD * 2;
struct K256A { bf16x8 f[2][16]; };
DEVI void k256_load_a(K256A& a, const bf16_t* A, size_t lda, int row0, char* lds) {
    const int tid = tidx(), lane = tid & 63, w = tid >> 6, wm = w >> 1, l31 = lane & 31, hh = lane >> 5;
    bf16_t* As = (bf16_t*)lds;
#pragma unroll 1
    for (int half = 0; half < 2; ++half) {
        __syncthreads();
        u32x4 r[8];
#pragma unroll
        for (int i = 0; i < 8; ++i) { const int c = tid + 512 * i; r[i] = *(const u32x4*)(A + (size_t)(row0 + half * 128 + (c >> 5)) * lda + (c & 31) * 8); }
#pragma unroll
        for (int i = 0; i < 8; ++i) { const int c = tid + 512 * i; *(u32x4*)(As + (c >> 5) * K2_LD + (c & 31) * 8) = r[i]; }
        __syncthreads();
        if ((wm >> 1) == half) {
#pragma unroll
            for (int mi = 0; mi < 2; ++mi)
#pragma unroll
                for (int ks = 0; ks < 16; ++ks) a.f[mi][ks] = *(const bf16x8*)(As + ((wm & 1) * 64 + mi * 32 + l31) * K2_LD + ks * 16 + 8 * hh);
        }
    }
}
template <class EPI>
DEVI void k256_stream(const K256A& a, const bf16_t* Bt, int n_tiles, char* lds, const EPI& epi) {
    const int tid = tidx(), lane = tid & 63, w = tid >> 6, wn = w & 1, l31 = lane & 31, hh = lane >> 5;
    const int br = tid >> 3, bc = (tid & 7) * 8;
    const bf16_t* bp = Bt + (size_t)br * 256 + bc;
    const int sto = br * K2_LD + bc, fro = (wn * 32 + l31) * K2_LD + 8 * hh;
    u32x4 s0, s1, s2, s3, t0, t1, t2, t3;
#define K2_ISSUE(j_, A_, B_, C_, D_) do { const bf16_t* _q = bp + (size_t)(j_) * 64 * 256; A_ = *(const u32x4*)_q; B_ = *(const u32x4*)(_q + 64); C_ = *(const u32x4*)(_q + 128); D_ = *(const u32x4*)(_q + 192); } while (0)
#define K2_COMMIT(buf_, A_, B_, C_, D_) do { bf16_t* _b = (bf16_t*)(lds + (buf_) * K2_BUF) + sto; *(u32x4*)_b = A_; *(u32x4*)(_b + 64) = B_; *(u32x4*)(_b + 128) = C_; *(u32x4*)(_b + 192) = D_; } while (0)
#define K2_TILE(j_, buf_) do { const bf16_t* Bs = (const bf16_t*)(lds + (buf_) * K2_BUF) + fro; f32x16 acc[2]; \
        _Pragma("unroll") for (int e = 0; e < 16; ++e) { acc[0][e] = 0.f; acc[1][e] = 0.f; } \
        _Pragma("unroll") for (int ks = 0; ks < 16; ++ks) { const bf16x8 bf = *(const bf16x8*)(Bs + ks * 16); acc[0] = MFMA(bf, a.f[0][ks], acc[0]); acc[1] = MFMA(bf, a.f[1][ks], acc[1]); } \
        epi((j_), acc); } while (0)
    __syncthreads();
    K2_ISSUE(0, s0, s1, s2, s3);
    K2_ISSUE(min(1, n_tiles - 1), t0, t1, t2, t3);
    K2_COMMIT(0, s0, s1, s2, s3);
    __syncthreads();
#pragma unroll 1
    for (int j = 0; j < n_tiles; j += 2) {
        K2_ISSUE(min(j + 2, n_tiles - 1), s0, s1, s2, s3);
        K2_TILE(j, 0);
        if (j + 1 < n_tiles) K2_COMMIT(1, t0, t1, t2, t3);
        __syncthreads();
        if (j + 1 >= n_tiles) break;
        K2_ISSUE(min(j + 3, n_tiles - 1), t0, t1, t2, t3);
        K2_TILE(j + 1, 1);
        if (j + 2 < n_tiles) K2_COMMIT(0, s0, s1, s2, s3);
        __syncthreads();
    }
#undef K2_ISSUE
#undef K2_COMMIT
#undef K2_TILE
}

template <int KS> struct KFragA { bf16x8 f[2][KS]; };
template <int KS>
DEVI void kx_load_a(KFragA<KS>& a, const bf16_t* A, size_t lda, int row0, char* lds, float* rs, float eps) {
    constexpr int K = 16 * KS, LD = K + 8, CPR = K / 8, NCH = 256 * CPR / 512;
    const int tid = tidx(), lane = tid & 63, w = tid >> 6, wm = w >> 1, l31 = lane & 31, hh = lane >> 5;
    bf16_t* As = (bf16_t*)lds;
    __syncthreads();
    {
        u32x4 r[NCH];
#pragma unroll
        for (int i = 0; i < NCH; ++i) { const int c = tid + 512 * i; r[i] = *(const u32x4*)(A + (size_t)(row0 + c / CPR) * lda + (c % CPR) * 8); }
#pragma unroll
        for (int i = 0; i < NCH; ++i) { const int c = tid + 512 * i; *(u32x4*)(As + (c / CPR) * LD + (c % CPR) * 8) = r[i]; }
    }
    __syncthreads();
#pragma unroll
    for (int mi = 0; mi < 2; ++mi)
#pragma unroll
        for (int ks = 0; ks < KS; ++ks) a.f[mi][ks] = *(const bf16x8*)(As + (wm * 64 + mi * 32 + l31) * LD + ks * 16 + 8 * hh);
    if (tid < 256) { float ss = 0.f;
#pragma unroll
        for (int i = 0; i < CPR; ++i) { const u32x4 v = *(const u32x4*)(As + tid * LD + 8 * i);
#pragma unroll
            for (int j = 0; j < 4; ++j) { const float x = lo_bf(v[j]), y = hi_bf(v[j]); ss += x * x + y * y; } }
        rs[tid] = rsqrtf(ss * (1.f / (float)K) + eps); }
    __syncthreads();
}
template <int KS, class EPI>
DEVI void kx_stream(const KFragA<KS>& a, const bf16_t* Bt, int n_tiles, char* lds, const EPI& epi) {
    constexpr int K = 16 * KS, LD = K + 8, CPR = K / 8, NCH = 64 * CPR / 512, BUF = 64 * LD * 2;
    const int tid = tidx(), lane = tid & 63, w = tid >> 6, wn = w & 1, l31 = lane & 31, hh = lane >> 5;
    u32x4 s[NCH];
    auto issue = [&](int j) __attribute__((always_inline)) {
#pragma unroll
        for (int i = 0; i < NCH; ++i) { const int c = tid + 512 * i; s[i] = *(const u32x4*)(Bt + (size_t)(j * 64 + c / CPR) * K + (c % CPR) * 8); } };
    auto commit = [&](int buf) __attribute__((always_inline)) {
#pragma unroll
        for (int i = 0; i < NCH; ++i) { const int c = tid + 512 * i; *(u32x4*)((bf16_t*)(lds + buf * BUF) + (c / CPR) * LD + (c % CPR) * 8) = s[i]; } };
    __syncthreads();
    issue(0); commit(0);
    __syncthreads();
#pragma unroll 1
    for (int j = 0; j < n_tiles; ++j) {
        const bool more = j + 1 < n_tiles;
        issue(more ? j + 1 : j);
        const bf16_t* Bs = (const bf16_t*)(lds + (j & 1) * BUF) + (wn * 32 + l31) * LD + 8 * hh;
        f32x16 acc[2];
#pragma unroll
        for (int e = 0; e < 16; ++e) { acc[0][e] = 0.f; acc[1][e] = 0.f; }
#pragma unroll
        for (int ks = 0; ks < KS; ++ks) { const bf16x8 bf = *(const bf16x8*)(Bs + ks * 16); acc[0] = MFMA(bf, a.f[0][ks], acc[0]); acc[1] = MFMA(bf, a.f[1][ks], acc[1]); }
        epi(j, acc);
        if (more) commit((j + 1) & 1);
        __syncthreads();
    }
}
DEVI void mod_unit(const Params& p, int u, char* lds) {
    const int tid = tidx(), l = u / 96, j0 = (u % 96) * 64;
    float* sc = (float*)lds; float* red = sc + 9 * 1024;
    __syncthreads();
    for (int i = tid; i < 9 * 1024; i += 512) { const int row = i >> 10, k = i & 1023; const float v = row < 8 ? p.in[I_C][row * 1024 + k] : p.in[I_CCTX][k]; sc[i] = v / (1.f + expf(-v)); }
    __syncthreads();
    const int col = tid & 63, kg = tid >> 6;
    float a[9];
#pragma unroll
    for (int r = 0; r < 9; ++r) a[r] = 0.f;
    const float* w = p.in[I_WMOD] + (size_t)l * 1024 * 6144 + j0 + col;
#pragma unroll 1
    for (int k0 = kg * 128; k0 < kg * 128 + 128; k0 += 32) {
        float wv[32];
#pragma unroll
        for (int i = 0; i < 32; ++i) wv[i] = w[(size_t)(k0 + i) * 6144];
#pragma unroll
        for (int i = 0; i < 32; ++i)
#pragma unroll
            for (int r = 0; r < 9; ++r) a[r] += sc[r * 1024 + k0 + i] * wv[i];
    }
#pragma unroll
    for (int r = 0; r < 9; ++r) red[(kg * 9 + r) * 64 + col] = a[r];
    __syncthreads();
    float* mod = (float*)(p.ws + OFF_MOD);
    for (int i = tid; i < 9 * 64; i += 512) {
        const int r = i >> 6, cc = i & 63; float s = 0.f;
#pragma unroll
        for (int g = 0; g < 8; ++g) s += red[(g * 9 + r) * 64 + cc];
        mod[(size_t)(l * 9 + r) * 6144 + j0 + cc] = s + p.in[I_BMOD][l * 6144 + j0 + cc];
    }
}
DEVI void rope_unit(const Params& p, int v) {
    const int idx = v * 512 + tidx(), pos = idx >> 4, i = idx & 15, fi = i & 7;
    const float inv = powf(10000.f, -(float)fi / 8.f);
    const float coord = (float)(i < 8 ? (pos >> 6) : (pos & 63));
    const float ang = coord * inv;
    ((float*)(p.ws + OFF_COS))[idx] = cosf(ang);
    ((float*)(p.ws + OFF_SIN))[idx] = sinf(ang);
}
DEVI void norm_rows(const Params& p, int l, int r0, int r1, int which  ) {
    const int lane = tidx() & 63, w = tidx() >> 6;
    const float* mod = (const float*)(p.ws + OFF_MOD);
    bf16_t* h = (bf16_t*)(p.ws + OFF_H);
    const float* gn = p.in[which ? I_GN2 : I_GN1] + l * 1024;
#pragma unroll 1
    for (int r = r0 + w; r < r1; r += 16) {
        float4 xv[2][4], gq[4], shq[2][4], scq[2][4]; float ss[2] = {0.f, 0.f};
#pragma unroll
        for (int u = 0; u < 2; ++u) {
            const int rr = min(r + 8 * u, r1 - 1);
            const float* src = which ? (const float*)xdst(p, rr) : xsrc(p, l, rr);
            const float* mr = mod + (size_t)(l * 9 + row_mod(rr)) * 6144 + (which ? 3072 : 0);
#pragma unroll
            for (int q = 0; q < 4; ++q) { const int k = 4 * lane + 256 * q; xv[u][q] = *(const float4*)(src + k); shq[u][q] = *(const float4*)(mr + k); scq[u][q] = *(const float4*)(mr + 1024 + k); }
        }
#pragma unroll
        for (int q = 0; q < 4; ++q) gq[q] = *(const float4*)(gn + 4 * lane + 256 * q);
        __builtin_amdgcn_sched_barrier(0);
#pragma unroll
        for (int u = 0; u < 2; ++u) {
#pragma unroll
            for (int q = 0; q < 4; ++q) ss[u] += xv[u][q].x * xv[u][q].x + xv[u][q].y * xv[u][q].y + xv[u][q].z * xv[u][q].z + xv[u][q].w * xv[u][q].w;
            ss[u] = wave_sum(ss[u]);
        }
#pragma unroll
        for (int u = 0; u < 2; ++u) {
            const int rr = r + 8 * u;
            if (rr < r1) {
                const float rstd = rsqrtf(ss[u] * (1.f / 1024.f) + 1e-6f);
#pragma unroll
                for (int q = 0; q < 4; ++q) {
                    const int k = 4 * lane + 256 * q;
                    const float4 g = gq[q], sh = shq[u][q], sc = scq[u][q];
                    const float o0 = xv[u][q].x * rstd * g.x * (1.f + sc.x) + sh.x, o1 = xv[u][q].y * rstd * g.y * (1.f + sc.y) + sh.y;
                    const float o2 = xv[u][q].z * rstd * g.z * (1.f + sc.z) + sh.z, o3 = xv[u][q].w * rstd * g.w * (1.f + sc.w) + sh.w;
                    uint2 pk; pk.x = pk2(o0, o1); pk.y = pk2(o2, o3);
                    *(uint2*)(h + (size_t)rr * DM + k) = pk;
                }
            }
        }
    }
}

DEVI void quant_rows(const Params& p, int r0, int r1) {
    const int lane = tidx() & 63, w = tidx() >> 6;
    const bf16_t* h = (const bf16_t*)(p.ws + OFF_H);
    float* rs = (float*)(p.ws + OFF_RS);
#pragma unroll 1
    for (int rb = r0 + w; rb < r1; rb += 32) {
        uint4 a0[4], a1[4];
#pragma unroll
        for (int u = 0; u < 4; ++u) { const int r = min(rb + 8 * u, r1 - 1); a0[u] = *(const uint4*)(h + (size_t)r * DM + 8 * lane); a1[u] = *(const uint4*)(h + (size_t)r * DM + 512 + 8 * lane); }
        __builtin_amdgcn_sched_barrier(0);
#pragma unroll
        for (int u = 0; u < 4; ++u) {
            const int r = rb + 8 * u;
            if (r < r1) {
                const uint4 v0 = a0[u], v1 = a1[u];
                float m = fmaxf(fmaxf(fmaxf(fabsf(lo_bf(v0.x)), fabsf(hi_bf(v0.x))), fmaxf(fabsf(lo_bf(v0.y)), fabsf(hi_bf(v0.y)))), fmaxf(fmaxf(fabsf(lo_bf(v0.z)), fabsf(hi_bf(v0.z))), fmaxf(fabsf(lo_bf(v0.w)), fabsf(hi_bf(v0.w)))));
                m = fmaxf(m, fmaxf(fmaxf(fmaxf(fabsf(lo_bf(v1.x)), fabsf(hi_bf(v1.x))), fmaxf(fabsf(lo_bf(v1.y)), fabsf(hi_bf(v1.y)))), fmaxf(fmaxf(fabsf(lo_bf(v1.z)), fabsf(hi_bf(v1.z))), fmaxf(fabsf(lo_bf(v1.w)), fabsf(hi_bf(v1.w))))));
                m = fmaxf(wave_max(m), 1e-20f);
                const float s = 256.f / m;
                uint2 o0, o1;
                o0.x = pk4_fp8(lo_bf(v0.x) * s, hi_bf(v0.x) * s, lo_bf(v0.y) * s, hi_bf(v0.y) * s); o0.y = pk4_fp8(lo_bf(v0.z) * s, hi_bf(v0.z) * s, lo_bf(v0.w) * s, hi_bf(v0.w) * s);
                o1.x = pk4_fp8(lo_bf(v1.x) * s, hi_bf(v1.x) * s, lo_bf(v1.y) * s, hi_bf(v1.y) * s); o1.y = pk4_fp8(lo_bf(v1.z) * s, hi_bf(v1.z) * s, lo_bf(v1.w) * s, hi_bf(v1.w) * s);
                *(uint2*)(p.ws + OFF_H8 + (size_t)r * 1024 + 8 * lane) = o0;
                *(uint2*)(p.ws + OFF_H8 + (size_t)r * 1024 + 512 + 8 * lane) = o1;
                if (lane == 0) rs[r] = m * (1.f / (256.f * WG8_SCALE));
            }
        }
    }
}

constexpr int CJ_WIN = 0, CJ_WUQ = CJ_WIN + 8 * 102, CJ_WUKV = CJ_WUQ + 3 * 6, CJ_WBR = CJ_WUKV + 1 * 8, CJ_WOUT = CJ_WBR + 4 * 32, CJ_RT = CJ_WOUT + 128,
              CJ_EG = CJ_RT + 8, CJ_EU = CJ_EG + 65 * 32, CJ_ED = CJ_EU + 65 * 32, CJ_LW = CJ_ED + 65 * 32, CJ_END = CJ_LW + 16;
DEVI int win_map(int n) {
    if (n < 352) return n;
    if (n < 1120) { const int j = n - 352; return j < 256 ? ZC_NAQ + j : (j < 512 ? ZC_NAK + (j - 256) : ZLD + ZT_NAV + (j - 512)); }
    if (n < 1888) return ZLD + ZT_HY + (n - 1120);
    if (n < 2144) return ZC_LU + (n - 1888);
    if (n < 2400) return ZC_LG + (n - 2144);
    { const int np = n - 2400, g = np >> 10, col = np & 1023, pn = col >> 6, c64 = col & 63;
      return WIN_G0 + pn * 256 + 128 * (g >> 1) + 32 * (c64 >> 4) + 16 * (g & 1) + 4 * ((c64 >> 2) & 3) + (c64 & 3); }
}
template <int STAGE>
DEVI void conv_unit(const Params& p, int l, int cu, char* lds, float4 (&v)[4]) {
    const int tid = tidx();
    const float* src; int K, N, kt, nt, KH = 128; bf16_t* dst; int mode = 0; const float* ksc = nullptr;
    if (cu < CJ_WUQ) { const int t = cu - CJ_WIN; kt = t / 102; nt = t % 102; src = p.in[I_WIN] + (size_t)l * 1024 * 6496; K = 1024; N = 6496; dst = (bf16_t*)(p.ws + OFF_WIN); mode = 1; }
    else if (cu < CJ_WUKV) { const int t = cu - CJ_WUQ; kt = t / 6; nt = t % 6; src = p.in[I_WUQ] + (size_t)l * 192 * 384; K = 192; N = 384; dst = (bf16_t*)(p.ws + OFF_WUQ); ksc = p.in[I_GQ] + l * 192; KH = 64; }
    else if (cu < CJ_WBR) { const int t = cu - CJ_WUKV; kt = 0; nt = t; src = p.in[I_WUKV] + (size_t)l * 128 * 512; K = 128; N = 512; dst = (bf16_t*)(p.ws + OFF_WUKV); ksc = p.in[I_GKV] + l * 128; }
    else if (cu < CJ_WOUT) { const int t = cu - CJ_WBR, k = t >> 5, tt = t & 31; kt = tt >> 4; nt = tt & 15; src = p.in[I_WBR] + (size_t)(l * 4 + k) * 256 * 1024; K = 256; N = 1024; dst = (bf16_t*)(p.ws + OFF_WBR) + (size_t)k * 1024 * 256; }
    else if (cu < CJ_RT) { const int t = cu - CJ_WOUT; kt = t >> 4; nt = t & 15; src = p.in[I_WOUT] + (size_t)l * 1024 * 1024; K = 1024; N = 1024; dst = (bf16_t*)(p.ws + OFF_WOUT); }
    else if (cu < CJ_EG) { kt = cu - CJ_RT; nt = 0; src = p.in[I_RW] + (size_t)l * 1024 * 64; K = 1024; N = 64; dst = (bf16_t*)(p.ws + OFF_RT); mode = 4; }
    else if (cu < CJ_EU) { const int t = cu - CJ_EG, e = t >> 5, tt = t & 31; kt = tt >> 2; nt = tt & 3; src = e < 64 ? p.in[I_EG] + (size_t)(l * 64 + e) * 1024 * 256 : p.in[I_SG] + (size_t)l * 1024 * 256; K = 1024; N = 256; dst = (bf16_t*)(p.ws + OFF_WGU) + (size_t)e * 512 * 1024; mode = 2; }
    else if (cu < CJ_ED) { const int t = cu - CJ_EU, e = t >> 5, tt = t & 31; kt = tt >> 2; nt = tt & 3; src = e < 64 ? p.in[I_EU] + (size_t)(l * 64 + e) * 1024 * 256 : p.in[I_SU] + (size_t)l * 1024 * 256; K = 1024; N = 256; dst = (bf16_t*)(p.ws + OFF_WGU) + (size_t)e * 512 * 1024; mode = 3; }
    else if (cu >= CJ_LW) { const int t = cu - CJ_LW, d = t >> 3, g = (t >> 2) & 1, n = t & 3; kt = 0; nt = 0; src = p.in[g ? I_LWX : I_LWA] + (size_t)((l * 2 + d) * 4 + n) * 4096; K = 64; N = 64; dst = (bf16_t*)(p.ws + OFF_LWT) + (size_t)((d * 2 + g) * 4 + n) * 4096; KH = 64; }
    else { const int t = cu - CJ_ED, e = t >> 5, tt = t & 31; kt = tt >> 4; nt = tt & 15; src = e < 64 ? p.in[I_ED] + (size_t)(l * 64 + e) * 256 * 1024 : p.in[I_SD] + (size_t)l * 256 * 1024; K = 256; N = 1024; dst = (bf16_t*)(p.ws + OFF_WDT) + (size_t)e * 1024 * 256; }
    float* tl = (float*)lds;
    if constexpr (STAGE == 0) {
        const int kk = tid >> 4, n4 = (tid & 15) * 4, n = nt * 64 + n4, nc = min(n, N - 4);
#pragma unroll
        for (int ps = 0; ps < 4; ++ps) { const int pr = ps * 32 < KH ? ps : 0; v[ps] = *(const float4*)(src + (size_t)(kt * KH + kk + 32 * pr) * N + nc); }
        return;
    }
    __syncthreads();
    {
        const int kk = tid >> 4, n4 = (tid & 15) * 4, n = nt * 64 + n4;
        if (n >= N) {
#pragma unroll
            for (int ps = 0; ps < 4; ++ps) v[ps] = make_float4(0.f, 0.f, 0.f, 0.f);
        }
#pragma unroll
        for (int ps = 0; ps < 4; ++ps) if (ps * 32 < KH) {
            float4 x = v[ps];
            if (ksc) { const float s = ksc[kt * KH + kk + 32 * ps]; x.x *= s; x.y *= s; x.z *= s; x.w *= s; }
            float* t = tl + (kk + 32 * ps) * 65 + n4; t[0] = x.x; t[1] = x.y; t[2] = x.z; t[3] = x.w; }
    }
    __syncthreads();
    {
        const int nn = tid >> 3, n = nt * 64 + nn;
#pragma unroll
        for (int q = 0; q < 2; ++q) if (q * 64 < KH) {
            const int kc = (tid & 7) * 8 + 64 * q;
            if (n < N) {
                int dr = n;
                if (mode == 1) dr = win_map(n);
                else if (mode == 2 || mode == 3) { const int r = n & 127; dr = (n >> 7) * 256 + 128 * (r >> 6) + 32 * ((r >> 4) & 3) + 16 * (mode - 2) + 4 * ((r >> 2) & 3) + (r & 3); }
                if (mode == 1 && n >= 2400) {
                    uint2 o8;
                    o8.x = pk4_fp8(tl[(kc + 0) * 65 + nn] * WG8_SCALE, tl[(kc + 1) * 65 + nn] * WG8_SCALE, tl[(kc + 2) * 65 + nn] * WG8_SCALE, tl[(kc + 3) * 65 + nn] * WG8_SCALE);
                    o8.y = pk4_fp8(tl[(kc + 4) * 65 + nn] * WG8_SCALE, tl[(kc + 5) * 65 + nn] * WG8_SCALE, tl[(kc + 6) * 65 + nn] * WG8_SCALE, tl[(kc + 7) * 65 + nn] * WG8_SCALE);
                    *(uint2*)(p.ws + OFF_WG8 + (size_t)(dr - WIN_G0) * 1024 + kt * KH + kc) = o8;
                } else {
                uint4 o;
                o.x = pk2(tl[(kc + 0) * 65 + nn], tl[(kc + 1) * 65 + nn]); o.y = pk2(tl[(kc + 2) * 65 + nn], tl[(kc + 3) * 65 + nn]);
                o.z = pk2(tl[(kc + 4) * 65 + nn], tl[(kc + 5) * 65 + nn]); o.w = pk2(tl[(kc + 6) * 65 + nn], tl[(kc + 7) * 65 + nn]);
                *(uint4*)(dst + (size_t)dr * K + kt * KH + kc) = o;
                }
                if (mode == 4) *(uint4*)(dst + (size_t)(64 + n) * K + kt * KH + kc) = make_uint4(0u, 0u, 0u, 0u);
            }
            if (mode == 1 && nt == 0 && nn < 32) *(uint4*)(dst + (size_t)(352 + nn) * K + kt * KH + kc) = make_uint4(0u, 0u, 0u, 0u);
            if (mode == 1 && nt >= 1 && nt <= 2) *(uint4*)(dst + (size_t)(NIN + (nt - 1) * 64 + nn) * K + kt * KH + kc) = make_uint4(0u, 0u, 0u, 0u);
        }
    }
}
DEVI void h2tab_unit(const Params& p, int l, int hu, char* lds) {
    const int tid = tidx();
    const int L = hu < 64 ? 4096 : 256, pos0 = hu < 64 ? hu * 64 : (hu - 64) * 64, rbase = hu < 64 ? 0 : 4096;
    float* feats = (float*)lds; float* h1 = feats + 64 * 33;
    const float* w1 = p.in[I_HW1] + l * 33 * 64; const float* b1 = p.in[I_HB1] + l * 64;
    const float* w2 = p.in[I_HW2] + l * 64 * 64; const float* b2 = p.in[I_HB2] + l * 64;
    __syncthreads();
    for (int i = tid; i < 64 * 33; i += 512) {
        const int pl = i / 33, f = i % 33, pos = pos0 + pl; float v;
        if (f == 0) v = (float)pos / (float)(L - 1);
        else { const int j = (f - 1) & 15; const float wv = 6.283185307179586f * (float)pos / (float)L; const float fj = 1e-4f + (float)j * ((15.f - 1e-4f) / 15.f); const float zz = wv * fj; v = f <= 16 ? cosf(zz) : -sinf(zz); }
        feats[i] = v;
    }
    __syncthreads();
    const int pl = tid >> 3, og = tid & 7;
    float o[8];
#pragma unroll
    for (int j = 0; j < 8; ++j) o[j] = b1[og * 8 + j];
#pragma unroll 1
    for (int i = 0; i < 33; ++i) { const float f = feats[pl * 33 + i];
#pragma unroll
        for (int j = 0; j < 8; ++j) o[j] += f * w1[i * 64 + og * 8 + j]; }
#pragma unroll
    for (int j = 0; j < 8; ++j) h1[pl * 64 + og * 8 + j] = sinf(o[j]);
    __syncthreads();
#pragma unroll
    for (int j = 0; j < 8; ++j) o[j] = b2[og * 8 + j];
#pragma unroll 2
    for (int i = 0; i < 64; ++i) { const float f = h1[pl * 64 + i];
#pragma unroll
        for (int j = 0; j < 8; ++j) o[j] += f * w2[i * 64 + og * 8 + j]; }
    float* tab = (float*)(p.ws + OFF_H2T) + (size_t)(rbase + pos0 + pl) * 64 + og * 8;
#pragma unroll
    for (int j = 0; j < 8; ++j) tab[j] = sinf(o[j]);
}
DEVI void fft_twiddles(float2* tw) {
    for (int i = tidx(); i < 4096; i += 512) { float s, c; sincospif((float)i * (1.f / 4096.f), &s, &c); tw[i] = make_float2(c, -s); }
}

DEVI int PI(int i) { return i + (i >> 5); }
DEVI float2 cmul(float2 a, float2 b) { return make_float2(a.x * b.x - a.y * b.y, a.x * b.y + a.y * b.x); }
DEVI float2 cmulc(float2 a, float2 b) { return make_float2(a.x * b.x + a.y * b.y, a.y * b.x - a.x * b.y); }
template <int E> DEVI float2 mulw16(float2 d) {
    constexpr float C[8] = {1.f, 0.9238795325112867f, 0.7071067811865476f, 0.3826834323650898f, 0.f, -0.3826834323650898f, -0.7071067811865476f, -0.9238795325112867f};
    constexpr float S[8] = {0.f, 0.3826834323650898f, 0.7071067811865476f, 0.9238795325112867f, 1.f, 0.9238795325112867f, 0.7071067811865476f, 0.3826834323650898f};
    if (E == 0) return d;
    if (E == 4) return make_float2(d.y, -d.x);
    return make_float2(d.x * C[E] + d.y * S[E], d.y * C[E] - d.x * S[E]);
}
template <int I, int H> DEVI void bfly16(float2 (&v)[16]) { const float2 a = v[I], b = v[I + H]; v[I] = make_float2(a.x + b.x, a.y + b.y); v[I + H] = mulw16<(I & (H - 1)) * (8 / H)>(make_float2(a.x - b.x, a.y - b.y)); }
template <bool ZHI> DEVI void dft16(float2 (&v)[16]) {
    if (ZHI) { v[8] = v[0]; v[9] = mulw16<1>(v[1]); v[10] = mulw16<2>(v[2]); v[11] = mulw16<3>(v[3]); v[12] = mulw16<4>(v[4]); v[13] = mulw16<5>(v[5]); v[14] = mulw16<6>(v[6]); v[15] = mulw16<7>(v[7]); }
    else { bfly16<0, 8>(v); bfly16<1, 8>(v); bfly16<2, 8>(v); bfly16<3, 8>(v); bfly16<4, 8>(v); bfly16<5, 8>(v); bfly16<6, 8>(v); bfly16<7, 8>(v); }
    bfly16<0, 4>(v); bfly16<1, 4>(v); bfly16<2, 4>(v); bfly16<3, 4>(v); bfly16<8, 4>(v); bfly16<9, 4>(v); bfly16<10, 4>(v); bfly16<11, 4>(v);
    bfly16<0, 2>(v); bfly16<1, 2>(v); bfly16<4, 2>(v); bfly16<5, 2>(v); bfly16<8, 2>(v); bfly16<9, 2>(v); bfly16<12, 2>(v); bfly16<13, 2>(v);
    bfly16<0, 1>(v); bfly16<2, 1>(v); bfly16<4, 1>(v); bfly16<6, 1>(v); bfly16<8, 1>(v); bfly16<10, 1>(v); bfly16<12, 1>(v); bfly16<14, 1>(v);
}
#define BR4(k) ((((k) & 1) << 3) | (((k) & 2) << 1) | (((k) & 4) >> 1) | (((k) & 8) >> 3))
DEVI void fwd_store16(float2 (&v)[16], float2 w1, float2* X, int base, int S) {
    float2 w = w1;
    X[PI(base)] = v[0];
#pragma unroll
    for (int k = 1; k < 16; ++k) { X[PI(base + k * S)] = cmul(v[BR4(k)], w); if (k < 15) w = cmul(w, w1); }
}
DEVI void inv_load16(float2 (&v)[16], float2 w1, const float2* X, int base, int S) {
    float2 w = w1;
    { const float2 a = X[PI(base)]; v[0] = make_float2(a.x, -a.y); }
#pragma unroll
    for (int k = 1; k < 16; ++k) { const float2 a = cmulc(X[PI(base + k * S)], w); v[k] = make_float2(a.x, -a.y); if (k < 15) w = cmul(w, w1); }
}
DEVI float2 tw8192(const float2* tw, int idx) { const float2 t = tw[idx & 4095]; return (idx & 4096) ? make_float2(-t.x, -t.y) : t; }
DEVI void fft_fwd_C(float2* X, const float2* tw, int tid) {
    float2 v[16];
    const int n_lo = tid & 1, base = (tid >> 1) * 32 + n_lo;
#pragma unroll
    for (int r = 0; r < 16; ++r) v[r] = X[PI(base + 2 * r)];
    dft16<false>(v); fwd_store16(v, tw[256 * n_lo], X, base, 2);
    __syncthreads();
}
DEVI void fft_fwd_BC(float2* X, const float2* tw, int tid) {
    float2 v[16];
    { const int n_lo = tid & 31, base = (tid >> 5) * 512 + n_lo;
#pragma unroll
      for (int r = 0; r < 16; ++r) v[r] = X[PI(base + 32 * r)];
      dft16<false>(v); fwd_store16(v, tw[16 * n_lo], X, base, 32); }
    __syncthreads();
    fft_fwd_C(X, tw, tid);
}
DEVI void fft_inv_C(float2* X, const float2* tw, int tid) {
    float2 v[16];
    const int n_lo = tid & 1, base = (tid >> 1) * 32 + n_lo;
    inv_load16(v, tw[256 * n_lo], X, base, 2); dft16<false>(v);
#pragma unroll
    for (int n = 0; n < 16; ++n) X[PI(base + 2 * n)] = make_float2(v[BR4(n)].x, -v[BR4(n)].y);
    __syncthreads();
}
DEVI void fft_inv_CB(float2* X, const float2* tw, int tid) {
    fft_inv_C(X, tw, tid);
    float2 v[16];
    { const int n_lo = tid & 31, base = (tid >> 5) * 512 + n_lo;
      inv_load16(v, tw[16 * n_lo], X, base, 32); dft16<false>(v);
#pragma unroll
      for (int n = 0; n < 16; ++n) X[PI(base + 32 * n)] = make_float2(v[BR4(n)].x, -v[BR4(n)].y); }
    __syncthreads();
}
template <class HF>
DEVI void fft512x16_conv(float2 (&io)[8], const HF& Hq, float2* X, const float2* tw, int tid) {
    const int n_lo = tid & 31, baseB = (tid >> 5) * 512 + n_lo;
    {
        float2 v[16];
#pragma unroll
        for (int r = 0; r < 8; ++r) v[r] = io[r];
        dft16<true>(v);
        fwd_store16(v, tw[16 * n_lo], X, baseB, 32);
    }
    __syncthreads();
    fft_fwd_C(X, tw, tid);
#pragma unroll
    for (int i = 0; i < 8; ++i) {
        const int q = tid + 512 * i;
        const float4 hv = *(const float4*)(Hq(q >> 8) + 2 * (q & 255));
        const float2 a = X[PI(2 * q)], b = X[PI(2 * q + 1)];
        const float2 g0 = cmul(make_float2(a.x + b.x, a.y + b.y), make_float2(hv.x, hv.y)), g1 = cmul(make_float2(a.x - b.x, a.y - b.y), make_float2(hv.z, hv.w));
        X[PI(2 * q)] = make_float2(g0.x + g1.x, g0.y + g1.y); X[PI(2 * q + 1)] = make_float2(g0.x - g1.x, g0.y - g1.y);
    }
    __syncthreads();
    fft_inv_C(X, tw, tid);
    {
        float2 v[16];
        inv_load16(v, tw[16 * n_lo], X, baseB, 32); dft16<false>(v);
#pragma unroll
        for (int n = 0; n < 8; ++n) io[n] = make_float2(v[BR4(n)].x, -v[BR4(n)].y);
    }
    __syncthreads();
}
DEVI void fft_conv8192(float2 (&io)[8], const float2* __restrict__ H, float2* X, const float2* tw, int tid) {
    float4 hq[8];
#pragma unroll
    for (int i = 0; i < 8; ++i) hq[i] = *(const float4*)(H + 2 * (tid + 512 * i));
    {
        float2 v[16];
#pragma unroll
        for (int r = 0; r < 8; ++r) v[r] = io[r];
        dft16<true>(v);
        fwd_store16(v, tw[tid], X, tid, 512);
    }
    __syncthreads();
    fft_fwd_BC(X, tw, tid);
#pragma unroll
    for (int i = 0; i < 8; ++i) {
        const int q = tid + 512 * i;
        const float4 hv = hq[i];
        const float2 a = X[PI(2 * q)], b = X[PI(2 * q + 1)];
        const float2 g0 = cmul(make_float2(a.x + b.x, a.y + b.y), make_float2(hv.x, hv.y)), g1 = cmul(make_float2(a.x - b.x, a.y - b.y), make_float2(hv.z, hv.w));
        X[PI(2 * q)] = make_float2(g0.x + g1.x, g0.y + g1.y); X[PI(2 * q + 1)] = make_float2(g0.x - g1.x, g0.y - g1.y);
    }
    __syncthreads();
    fft_inv_CB(X, tw, tid);
    {
        float2 v[16];
        inv_load16(v, tw[tid], X, tid, 512); dft16<false>(v);
#pragma unroll
        for (int n = 0; n < 8; ++n) io[n] = make_float2(v[BR4(n)].x, -v[BR4(n)].y);
    }
    __syncthreads();
}
DEVI void fft_spectrum8192(float2 (&in)[16], float2* __restrict__ Hout, float2* X, const float2* tw, int tid) {
    dft16<false>(in);
    fwd_store16(in, tw[tid], X, tid, 512);
    __syncthreads();
    fft_fwd_BC(X, tw, tid);
#pragma unroll
    for (int i = 0; i < 8; ++i) {
        const int q = tid + 512 * i;
        const float2 a = X[PI(2 * q)], b = X[PI(2 * q + 1)];
        *(float4*)(Hout + 2 * q) = make_float4(a.x + b.x, a.y + b.y, a.x - b.x, a.y - b.y);
    }
    __syncthreads();
}


DEVI void spectrum8192_unit(const Params& p, int l, int n, int c, char* lds) {
    const int tid = tidx();
    float2* X = (float2*)lds; float2* tw = X + 8448; float* w3c = (float*)(tw + 4096);
    const float* h2tab = (const float*)(p.ws + OFF_H2T);
    __syncthreads();
    fft_twiddles(tw);
    if (tid < 128) { const int dir = tid >> 6, k = tid & 63; w3c[tid] = p.in[I_HW3][(size_t)(l * 64 + k) * 1024 + (n * 2 + dir) * 256 + c]; }
    const float dec0 = fabsf(p.in[I_HDEC][((l * 2 + n) * 2 + 0) * 256 + c]), dec1 = fabsf(p.in[I_HDEC][((l * 2 + n) * 2 + 1) * 256 + c]);
    __syncthreads();
    float* F = (float*)X;
    {
        const int part = tid & 7, rsub = tid >> 3;
        float w0[8], w1[8];
#pragma unroll
        for (int i = 0; i < 8; ++i) { w0[i] = w3c[part * 8 + i]; w1[i] = w3c[64 + part * 8 + i]; }
#pragma unroll 8
        for (int ch = 0; ch < 64; ++ch) {
            const int j = ch * 64 + rsub;
            const float4 a = *(const float4*)(h2tab + (size_t)j * 64 + part * 8), b = *(const float4*)(h2tab + (size_t)j * 64 + part * 8 + 4);
            float d0 = a.x * w0[0] + a.y * w0[1] + a.z * w0[2] + a.w * w0[3] + b.x * w0[4] + b.y * w0[5] + b.z * w0[6] + b.w * w0[7];
            float d1 = a.x * w1[0] + a.y * w1[1] + a.z * w1[2] + a.w * w1[3] + b.x * w1[4] + b.y * w1[5] + b.z * w1[6] + b.w * w1[7];
            d0 += __shfl_xor(d0, 1); d1 += __shfl_xor(d1, 1); d0 += __shfl_xor(d0, 2); d1 += __shfl_xor(d1, 2); d0 += __shfl_xor(d0, 4); d1 += __shfl_xor(d1, 4);
            F[j] = d0; F[4096 + j] = d1;
        }
    }
    __syncthreads();
    float2 v[16];
#pragma unroll
    for (int r = 0; r < 16; ++r) {
        const int t = tid + 512 * r;
        const int j = t < 4096 ? t : 8192 - t, dir = t < 4096 ? 0 : 1;
        const float f = F[dir * 4096 + (j & 4095)] * expf(-((float)j / 4095.f) * (dir ? dec1 : dec0));
        v[r] = make_float2(t != 4096 ? f : 0.f, 0.f);
    }
    __syncthreads();
    fft_spectrum8192(v, (float2*)(p.ws + OFF_HS) + (size_t)(n * 256 + c) * 8192, X, tw, tid);
}
DEVI float conv3(const bf16_t* r, int t, int L, float w0, float w1, float w2, float b) {
    const float c = bf2f(r[t]), lf = bf2f(r[max(t - 1, 0)]), rg = bf2f(r[min(t + 1, L - 1)]);
    return b + w1 * c + (t > 0 ? w0 : 0.f) * lf + (t < L - 1 ? w2 : 0.f) * rg;
}

DEVI void hyena8192_unit(const Params& p, int l, int c, int b0, char* lds) {
    const int tid = tidx();
    float2* X = (float2*)lds; float2* tw = X + 8448;
    const bf16_t* zT = (const bf16_t*)(p.ws + OFF_ZT);
    bf16_t* yT = (bf16_t*)(p.ws + OFF_YT);
    const float2* H0 = (const float2*)(p.ws + OFF_HS) + (size_t)c * 8192; const float2* H1 = H0 + (size_t)256 * 8192;
    const float* sw = p.in[I_HSW] + l * 3 * 768; const float* sb = p.in[I_HSB] + l * 768;
    const float bias0 = p.in[I_HBIAS][(l * 2 + 0) * 256 + c], bias1 = p.in[I_HBIAS][(l * 2 + 1) * 256 + c];
    const size_t base0 = (size_t)(b0 * 1024 + ZT_HY + c) * NKEY, base1 = base0 + (size_t)1024 * NKEY;
    const float inv = 1.f / 8192.f;
    float2 io[8], vr[8], x1[8], x2[8];
#pragma unroll
    for (int r = 0; r < 8; ++r) { const int t = tid + 512 * r;
        vr[r] = make_float2(conv3(zT + base0, t, 4096, sw[c], sw[768 + c], sw[1536 + c], sb[c]), conv3(zT + base1, t, 4096, sw[c], sw[768 + c], sw[1536 + c], sb[c]));
        x1[r] = make_float2(conv3(zT + base0 + (size_t)256 * NKEY, t, 4096, sw[256 + c], sw[768 + 256 + c], sw[1536 + 256 + c], sb[256 + c]),
                            conv3(zT + base1 + (size_t)256 * NKEY, t, 4096, sw[256 + c], sw[768 + 256 + c], sw[1536 + 256 + c], sb[256 + c]));
        x2[r] = make_float2(conv3(zT + base0 + (size_t)512 * NKEY, t, 4096, sw[512 + c], sw[768 + 512 + c], sw[1536 + 512 + c], sb[512 + c]),
                            conv3(zT + base1 + (size_t)512 * NKEY, t, 4096, sw[512 + c], sw[768 + 512 + c], sw[1536 + 512 + c], sb[512 + c]));
        io[r] = vr[r]; }
    fft_conv8192(io, H0, X, tw, tid);
#pragma unroll
    for (int r = 0; r < 8; ++r) {
        vr[r] = make_float2(x1[r].x * (io[r].x * inv + vr[r].x * bias0), x1[r].y * (io[r].y * inv + vr[r].y * bias0));
        io[r] = vr[r]; }
    fft_conv8192(io, H1, X, tw, tid);
#pragma unroll
    for (int r = 0; r < 8; ++r) {
        vr[r] = make_float2(x2[r].x * (io[r].x * inv + vr[r].x * bias1), x2[r].y * (io[r].y * inv + vr[r].y * bias1)); }
    __builtin_amdgcn_sched_barrier(0);
#pragma unroll
    for (int r = 0; r < 8; ++r) { const int t = tid + 512 * r;
        yT[(size_t)((b0 + 0) * 256 + c) * NKEY + t] = f2bf(vr[r].x);
        yT[(size_t)((b0 + 1) * 256 + c) * NKEY + t] = f2bf(vr[r].y); }
}

DEVI void spectrum512_unit(const Params& p, int l, int su, char* lds) {
    const int tid = tidx(), n_lo = tid & 31, blk = tid >> 5, f = su * 16 + blk, n = f >> 8, c = f & 255;
    float2* X = (float2*)lds; float2* tw = X + 8448;
    const float* h2tab = (const float*)(p.ws + OFF_H2T) + 4096 * 64;
    __syncthreads();
    fft_twiddles(tw);
    const float dec0 = fabsf(p.in[I_HDEC][((l * 2 + n) * 2 + 0) * 256 + c]), dec1 = fabsf(p.in[I_HDEC][((l * 2 + n) * 2 + 1) * 256 + c]);
    float* w3s = (float*)(tw + 4096);
    for (int i = tid; i < 16 * 128; i += 512) { const int fb = i >> 7, dir = (i >> 6) & 1, k = i & 63, ff = su * 16 + fb;
        w3s[i] = p.in[I_HW3][(size_t)(l * 64 + k) * 1024 + ((ff >> 8) * 2 + dir) * 256 + (ff & 255)]; }
    __syncthreads();
    float* T = (float*)X;
#pragma unroll
    for (int i = 0; i < 8; ++i) { const int idx = tid + 512 * i, row = idx >> 4, c4 = (idx & 15) * 4; const float4 hv = *(const float4*)(h2tab + (size_t)row * 64 + c4);
        float* d = T + row * 65 + c4; d[0] = hv.x; d[1] = hv.y; d[2] = hv.z; d[3] = hv.w; }
    __syncthreads();
    float2 v[16];
#pragma unroll
    for (int dir = 0; dir < 2; ++dir) {
        float fa[8]; int jr[8];
#pragma unroll
        for (int r = 0; r < 8; ++r) { const int t = n_lo + 32 * (r + 8 * dir); jr[r] = (dir ? 512 - t : t) & 255; fa[r] = 0.f; }
        const float* wc = w3s + blk * 128 + dir * 64;
#pragma unroll 4
        for (int k = 0; k < 64; ++k) { const float wk = wc[k];
#pragma unroll
            for (int r = 0; r < 8; ++r) fa[r] += T[jr[r] * 65 + k] * wk; }
#pragma unroll
        for (int r = 0; r < 8; ++r) { const int t = n_lo + 32 * (r + 8 * dir); const int jj = dir ? 512 - t : t;
            const float fv = fa[r] * expf(-((float)jj / 255.f) * (dir ? dec1 : dec0));
            v[r + 8 * dir] = make_float2(t != 256 ? fv : 0.f, 0.f); }
    }
    __syncthreads();
    dft16<false>(v);
    fwd_store16(v, tw[16 * n_lo], X, blk * 512 + n_lo, 32);
    __syncthreads();
    fft_fwd_C(X, tw, tid);
    float2* Hout = (float2*)(p.ws + OFF_HSC) + (size_t)su * 16 * 512;
#pragma unroll
    for (int i = 0; i < 8; ++i) { const int q = tid + 512 * i; const float2 a = X[PI(2 * q)], b = X[PI(2 * q + 1)];
        *(float4*)(Hout + 2 * q) = make_float4(a.x + b.x, a.y + b.y, a.x - b.x, a.y - b.y); }
    __syncthreads();
}
DEVI void hyena512_unit(const Params& p, int l, int hu, char* lds) {
    const int tid = tidx(), n_lo = tid & 31, blk = tid >> 5, c0 = hu * 4, c = c0 + (blk >> 2), b0 = 2 * (blk & 3);
    float2* X = (float2*)lds; float2* tw = X + 8448;
    const bf16_t* zT = (const bf16_t*)(p.ws + OFF_ZT);
    bf16_t* yT = (bf16_t*)(p.ws + OFF_YT);
    const float2* HC = (const float2*)(p.ws + OFF_HSC);
    const float* sw = p.in[I_HSW] + l * 3 * 768; const float* sb = p.in[I_HSB] + l * 768;
    const float bias0 = p.in[I_HBIAS][(l * 2 + 0) * 256 + c], bias1 = p.in[I_HBIAS][(l * 2 + 1) * 256 + c];
    const size_t base0 = (size_t)(b0 * 1024 + ZT_HY + c) * NKEY + 4096, base1 = base0 + (size_t)1024 * NKEY;
    const float inv = 1.f / 512.f;
    auto H0 = [&](int j) __attribute__((always_inline)) -> const float2* { return HC + (size_t)(c0 + (j >> 2)) * 512; };
    auto H1 = [&](int j) __attribute__((always_inline)) -> const float2* { return HC + (size_t)(256 + c0 + (j >> 2)) * 512; };
    float2 io[8], vr[8];
#pragma unroll
    for (int r = 0; r < 8; ++r) { const int t = n_lo + 32 * r;
        vr[r] = make_float2(conv3(zT + base0, t, 256, sw[c], sw[768 + c], sw[1536 + c], sb[c]), conv3(zT + base1, t, 256, sw[c], sw[768 + c], sw[1536 + c], sb[c]));
        io[r] = vr[r]; }
    fft512x16_conv(io, H0, X, tw, tid);
#pragma unroll
    for (int r = 0; r < 8; ++r) { const int t = n_lo + 32 * r;
        const float x10 = conv3(zT + base0 + (size_t)256 * NKEY, t, 256, sw[256 + c], sw[768 + 256 + c], sw[1536 + 256 + c], sb[256 + c]);
        const float x11 = conv3(zT + base1 + (size_t)256 * NKEY, t, 256, sw[256 + c], sw[768 + 256 + c], sw[1536 + 256 + c], sb[256 + c]);
        vr[r] = make_float2(x10 * (io[r].x * inv + vr[r].x * bias0), x11 * (io[r].y * inv + vr[r].y * bias0));
        io[r] = vr[r]; }
    fft512x16_conv(io, H1, X, tw, tid);
#pragma unroll
    for (int r = 0; r < 8; ++r) { const int t = n_lo + 32 * r;
        const float x20 = conv3(zT + base0 + (size_t)512 * NKEY, t, 256, sw[512 + c], sw[768 + 512 + c], sw[1536 + 512 + c], sb[512 + c]);
        const float x21 = conv3(zT + base1 + (size_t)512 * NKEY, t, 256, sw[512 + c], sw[768 + 512 + c], sw[1536 + 512 + c], sb[512 + c]);
        vr[r] = make_float2(x20 * (io[r].x * inv + vr[r].x * bias1), x21 * (io[r].y * inv + vr[r].y * bias1)); }
    __builtin_amdgcn_sched_barrier(0);
#pragma unroll
    for (int r = 0; r < 8; ++r) { const int t = n_lo + 32 * r;
        yT[(size_t)((b0 + 0) * 256 + c) * NKEY + 4096 + t] = f2bf(vr[r].x);
        yT[(size_t)((b0 + 1) * 256 + c) * NKEY + 4096 + t] = f2bf(vr[r].y); }
}
DEVI void hyena_unit(const Params& p, int l, int hu, char* lds) {
    float2* X = (float2*)lds; float2* tw = X + 8448;
    __syncthreads();
    fft_twiddles(tw);
    __syncthreads();
    if (hu < 1024) hyena8192_unit(p, l, hu & 255, 2 * (hu >> 8), lds);
    else hyena512_unit(p, l, hu - 1024, lds);
}

struct KVTile { const bf16_t* k; const bf16_t* vt; };
template <int DQ, bool NA, class TF>
DEVI void attn_core(const bf16x8 (&qf)[DQ / 16], int ntiles, const TF& tilefn, int kstride, int vstride,
                    int r_q, int qc, int kr_lo, int nloc, const float* rpb_s, f32x16 (&o)[2], float& lsum, char* lds) {
    constexpr int KLD = DQ + 8, KCH = DQ / 8, KSZ = 64 * KLD * 2, VSZ = 64 * 72 * 2, ST = KSZ + VSZ;
    constexpr int NKC = (64 * KCH + 511) / 512;
    const int tid = tidx(), lane = tid & 63, l31 = lane & 31, hh = lane >> 5;
    float m = -1e30f; lsum = 0.f;
#pragma unroll
    for (int e = 0; e < 16; ++e) { o[0][e] = 0.f; o[1][e] = 0.f; }
    const int r0 = min(max(r_q - 4, 0), 56), c0 = min(max(qc - 8, 0), 48);
    u32x4 rk0, rk1, rv, sk0, sk1, sv;
#define AT_ISSUE(j_, K0, K1, V_) do { const KVTile t = tilefn(j_); \
        { const int c = tid; const int key = c / KCH, ch = c % KCH; K0 = *(const u32x4*)(t.k + (size_t)key * kstride + ch * 8); } \
        if (NKC == 2) { const int c = min(tid + 512, 64 * KCH - 1); const int key = c / KCH, ch = c % KCH; K1 = *(const u32x4*)(t.k + (size_t)key * kstride + ch * 8); } \
        V_ = *(const u32x4*)(t.vt + (size_t)(tid >> 3) * vstride + (tid & 7) * 8); } while (0)
#define AT_COMMIT(buf_, K0, K1, V_) do { bf16_t* Ks_ = (bf16_t*)(lds + (buf_) * ST); bf16_t* Vs_ = (bf16_t*)(lds + (buf_) * ST + KSZ); \
        { const int c = tid; const int key = c / KCH, ch = c % KCH; *(u32x4*)(Ks_ + key * KLD + ch * 8) = K0; } \
        if (NKC == 2) { const int c = tid + 512; if (c < 64 * KCH) { const int key = c / KCH, ch = c % KCH; *(u32x4*)(Ks_ + key * KLD + ch * 8) = K1; } } \
        *(u32x4*)(Vs_ + (tid >> 3) * 72 + (tid & 7) * 8) = V_; } while (0)
    auto tile = [&](int j) __attribute__((always_inline)) {
        const int kr = kr_lo + j;
        const bool active = !NA || j >= nloc || (kr >= r0 && kr < r0 + 8);
        if (active) {
            const bf16_t* Ks = (const bf16_t*)(lds + (j & 1) * ST); const bf16_t* Vs = (const bf16_t*)(lds + (j & 1) * ST + KSZ);
            f32x16 s0, s1;
#pragma unroll
            for (int e = 0; e < 16; ++e) { s0[e] = 0.f; s1[e] = 0.f; }
#pragma unroll
            for (int ks = 0; ks < DQ / 16; ++ks) {
                const bf16x8 k0 = *(const bf16x8*)(Ks + l31 * KLD + ks * 16 + 8 * hh);
                const bf16x8 k1 = *(const bf16x8*)(Ks + (32 + l31) * KLD + ks * 16 + 8 * hh);
                s0 = MFMA(k0, qf[ks], s0); s1 = MFMA(k1, qf[ks], s1);
            }
            if (NA && j < nloc) {
                const float* rb = rpb_s + (kr - r_q + 7) * 31 + 15 - qc;
#pragma unroll
                for (int e = 0; e < 16; ++e) {
                    const int kc = (e & 3) + 8 * (e >> 2) + 4 * hh;
                    const bool v0 = kc >= c0 && kc < c0 + 16, v1 = (kc + 32) >= c0 && (kc + 32) < c0 + 16;
                    s0[e] = v0 ? s0[e] + rb[kc] : -1e30f;
                    s1[e] = v1 ? s1[e] + rb[kc + 32] : -1e30f;
                }
            }
            float mx = s0[0];
#pragma unroll
            for (int e = 1; e < 16; ++e) mx = fmaxf(mx, s0[e]);
#pragma unroll
            for (int e = 0; e < 16; ++e) mx = fmaxf(mx, s1[e]);
            mx = fmaxf(mx, __shfl_xor(mx, 32));
            const float mn = fmaxf(m, mx), alpha = __builtin_amdgcn_exp2f(m - mn);
            m = mn;
            float ps = 0.f;
#pragma unroll
            for (int e = 0; e < 16; ++e) { s0[e] = __builtin_amdgcn_exp2f(s0[e] - mn); s1[e] = __builtin_amdgcn_exp2f(s1[e] - mn); ps += s0[e] + s1[e]; }
            lsum = lsum * alpha + ps;
#pragma unroll
            for (int e = 0; e < 16; ++e) { o[0][e] *= alpha; o[1][e] *= alpha; }
#pragma unroll
            for (int s4 = 0; s4 < 4; ++s4) {
                const int bs = 8 * (s4 & 1);
                u32x4 pu;
                if (s4 < 2) { pu[0] = pk2(s0[bs], s0[bs + 1]); pu[1] = pk2(s0[bs + 2], s0[bs + 3]); pu[2] = pk2(s0[bs + 4], s0[bs + 5]); pu[3] = pk2(s0[bs + 6], s0[bs + 7]); }
                else        { pu[0] = pk2(s1[bs], s1[bs + 1]); pu[1] = pk2(s1[bs + 2], s1[bs + 3]); pu[2] = pk2(s1[bs + 4], s1[bs + 5]); pu[3] = pk2(s1[bs + 6], s1[bs + 7]); }
                const bf16x8 pfv = __builtin_bit_cast(bf16x8, pu);
#pragma unroll
                for (int dvt = 0; dvt < 2; ++dvt) {
                    const uint2 v0 = *(const uint2*)(Vs + (dvt * 32 + l31) * 72 + s4 * 16 + 4 * hh);
                    const uint2 v1 = *(const uint2*)(Vs + (dvt * 32 + l31) * 72 + s4 * 16 + 8 + 4 * hh);
                    u32x4 vu; vu[0] = v0.x; vu[1] = v0.y; vu[2] = v1.x; vu[3] = v1.y;
                    o[dvt] = MFMA(__builtin_bit_cast(bf16x8, vu), pfv, o[dvt]);
                }
            }
        }
    };
    __syncthreads();
    AT_ISSUE(0, rk0, rk1, rv); AT_COMMIT(0, rk0, rk1, rv);
    AT_ISSUE(min(1, ntiles - 1), sk0, sk1, sv);
    __syncthreads();
#pragma unroll 1
    for (int j = 0; j < ntiles; j += 2) {
        AT_ISSUE(min(j + 2, ntiles - 1), rk0, rk1, rv);
        tile(j);
        AT_COMMIT(1, sk0, sk1, sv);
        __syncthreads();
        if (j + 1 >= ntiles) break;
        AT_ISSUE(min(j + 3, ntiles - 1), sk0, sk1, sv);
        tile(j + 1);
        AT_COMMIT(0, rk0, rk1, rv);
        __syncthreads();
    }
#undef AT_ISSUE
#undef AT_COMMIT
    lsum += __shfl_xor(lsum, 32);
}
DEVI void attn_store(const f32x16 (&o)[2], float lsum, bf16_t* dst  ) {
    const int lane = tidx() & 63, hh = lane >> 5;
    const float il = 1.f / lsum;
#pragma unroll
    for (int dvt = 0; dvt < 2; ++dvt)
#pragma unroll
        for (int g = 0; g < 4; ++g) { uint2 v; v.x = pk2(o[dvt][4 * g] * il, o[dvt][4 * g + 1] * il); v.y = pk2(o[dvt][4 * g + 2] * il, o[dvt][4 * g + 3] * il);
            *(uint2*)(dst + dvt * 32 + 8 * g + 4 * hh) = v; }
}
DEVI void na_unit(const Params& p, int l, int au, char* lds) {
    const int tid = tidx(), lane = tid & 63, w = tid >> 6, l31 = lane & 31, hh = lane >> 5;
    const bf16_t* z = (const bf16_t*)(p.ws + OFF_Z); const bf16_t* zT = (const bf16_t*)(p.ws + OFF_ZT);
    bf16_t* br = (bf16_t*)(p.ws + OFF_BR);
    const bool isctx = au >= 512;
    int b, h, R;
    if (!isctx) { b = au >> 6; h = (au >> 4) & 3; R = au & 15; } else { b = (au - 512) >> 2; h = (au - 512) & 3; R = 0; }
    float* rpb_s = (float*)(lds + 2 * (64 * 72 * 2 + 64 * 72 * 2));
    __syncthreads();
    for (int i = tid; i < 465; i += 512) rpb_s[i] = p.in[I_RPB][(size_t)(l * 4 + h) * 465 + i] * 1.4426950408889634f;
    const int r_q = 4 * R + (w >> 1), qc = (w & 1) * 32 + l31;
    const int qrow = isctx ? TL + b * 256 + w * 32 + l31 : b * 4096 + r_q * 64 + qc;
    bf16x8 qf[4];
    {
        const bf16_t* qs = z + (size_t)qrow * ZLD + ZC_NAQ + h * 64 + 8 * hh;
        const float sc = 0.125f * 1.4426950408889634f;
#pragma unroll
        for (int ks = 0; ks < 4; ++ks) { const uint4 v = *(const uint4*)(qs + ks * 16); u32x4 t;
            t[0] = pk2(lo_bf(v.x) * sc, hi_bf(v.x) * sc); t[1] = pk2(lo_bf(v.y) * sc, hi_bf(v.y) * sc); t[2] = pk2(lo_bf(v.z) * sc, hi_bf(v.z) * sc); t[3] = pk2(lo_bf(v.w) * sc, hi_bf(v.w) * sc);
            qf[ks] = __builtin_bit_cast(bf16x8, t); }
    }
    int kr_lo = 0, nloc = 0;
    if (!isctx) { kr_lo = min(max(4 * R - 4, 0), 56); const int kr_hi = min(max(4 * R - 1, 0), 56) + 7; nloc = kr_hi - kr_lo + 1; }
    const bf16_t* kb = z + ZC_NAK + h * 64; const bf16_t* vb = zT + (size_t)(b * 1024 + ZT_NAV + h * 64) * NKEY;
    auto tf = [&](int j) { KVTile t;
        if (j < nloc) { const int kr = kr_lo + j; t.k = kb + (size_t)(b * 4096 + kr * 64) * ZLD; t.vt = vb + kr * 64; }
        else { const int i = j - nloc; t.k = kb + (size_t)(TL + b * 256 + 64 * i) * ZLD; t.vt = vb + 4096 + 64 * i; }
        return t; };
    f32x16 o[2]; float ls;
    attn_core<64, true>(qf, nloc + 4, tf, ZLD, NKEY, r_q, qc, kr_lo, nloc, rpb_s, o, ls, lds);
    attn_store(o, ls, br + (size_t)qrow * DM + 256 + h * 64);
}
DEVI void lru1_unit(const Params& p, int l, int lu, char* lds) {
    const int tid = tidx(), c = tid & 255, half = tid >> 8, lane = tid & 63, w = tid >> 6, l31 = lane & 31, hh = lane >> 5;
    const int tt = lu >> 1, d = lu & 1;
    const int row0 = tt * 64;
    const int s0 = row0 < TL ? (row0 & 4095) : ((row0 - TL) & 255);
    const int L = row0 < TL ? 4096 : 256;
    const bf16_t* z = (const bf16_t*)(p.ws + OFF_Z);
    constexpr int XLD = 264;
    bf16_t* xs = (bf16_t*)lds;
    float* As = (float*)(lds + 34816);
    bf16_t* Bs = (bf16_t*)(lds + 34816 + 65536);
    const int n = w & 3, th = w >> 2;
    bf16x8 wf[2][2][4];
    {
        const bf16_t* wt = (const bf16_t*)(p.ws + OFF_LWT);
#pragma unroll
        for (int g = 0; g < 2; ++g)
#pragma unroll
            for (int ct = 0; ct < 2; ++ct)
#pragma unroll
                for (int ks = 0; ks < 4; ++ks) wf[g][ct][ks] = *(const bf16x8*)(wt + (size_t)((d * 2 + g) * 4 + n) * 4096 + (ct * 32 + l31) * 64 + ks * 16 + 8 * hh);
    }
    float cba[2], cbx[2], csp[2];
#pragma unroll
    for (int ct = 0; ct < 2; ++ct) { const int ch = 64 * n + ct * 32 + l31; cba[ct] = p.in[I_LBA][(l * 2 + d) * 256 + ch]; cbx[ct] = p.in[I_LBX][(l * 2 + d) * 256 + ch]; csp[ct] = p.in[I_LLAM][(l * 2 + d) * 256 + ch]; }
    __syncthreads();
    {
        const float* cw = p.in[I_LCW] + (size_t)(l * 2 + d) * 4 * 256; const float cb = p.in[I_LCB][(l * 2 + d) * 256 + c];
        const float w0 = cw[c], w1 = cw[256 + c], w2 = cw[512 + c], w3 = cw[768 + c];
        const bf16_t* zu = z + (size_t)(row0 - s0) * ZLD + ZC_LU + c;
        auto U = [&](int s) -> float { const float v = bf2f(zu[(size_t)min(max(s, 0), L - 1) * ZLD]); return (s >= 0 && s < L) ? v : 0.f; };
        const int sb = s0 + 32 * half - (d == 0 ? 3 : 0);
        float uv[35];
#pragma unroll
        for (int i = 0; i < 35; ++i) uv[i] = U(sb + i);
#pragma unroll
        for (int i = 0; i < 32; ++i) xs[(32 * half + i) * XLD + c] = f2bf(cb + w0 * uv[i] + w1 * uv[i + 1] + w2 * uv[i + 2] + w3 * uv[i + 3]);
    }
    __syncthreads();
    {
        f32x16 acc[2][2];
#pragma unroll
        for (int g = 0; g < 2; ++g)
#pragma unroll
            for (int ct = 0; ct < 2; ++ct)
#pragma unroll
                for (int e = 0; e < 16; ++e) acc[g][ct][e] = 0.f;
#pragma unroll
        for (int ks = 0; ks < 4; ++ks) {
            const bf16x8 af = *(const bf16x8*)(xs + (th * 32 + l31) * XLD + 64 * n + ks * 16 + 8 * hh);
#pragma unroll
            for (int g = 0; g < 2; ++g)
#pragma unroll
                for (int ct = 0; ct < 2; ++ct) acc[g][ct] = MFMA(af, wf[g][ct][ks], acc[g][ct]);
        }
#pragma unroll
        for (int ct = 0; ct < 2; ++ct) {
            const int ch = 64 * n + ct * 32 + l31;
            const float ba = cba[ct], bx = cbx[ct];
            const float sp = log1pf(expf(-csp[ct]));
#pragma unroll
            for (int e = 0; e < 16; ++e) {
                const int tl = th * 32 + (e & 3) + 8 * (e >> 2) + 4 * hh;
                const float r = sigmoidf_(acc[0][ct][e] + ba), ig = sigmoidf_(acc[1][ct][e] + bx);
                const float la = -8.f * r * sp, a = __expf(la), mult = __builtin_amdgcn_sqrtf(fmaxf(1.f - a * a, 0.f));
                As[tl * 256 + ch] = a;
                Bs[tl * 256 + ch] = f2bf(mult * ig * bf2f(xs[tl * XLD + ch]));
            }
        }
    }
    __syncthreads();
    bf16_t* hloc = (bf16_t*)(p.ws + OFF_HLOC) + (size_t)d * TT * 256; bf16_t* cuma = (bf16_t*)(p.ws + OFF_CUMA) + (size_t)d * TT * 256;
    float hst = 0.f, cum = 1.f;
    for (int i = 0; i < 32; ++i) {
        const int tl = 32 * half + (d == 0 ? i : 31 - i);
        const float a = As[tl * 256 + c], bt = bf2f(Bs[tl * 256 + c]);
        hst = a * hst + bt; cum *= a;
        hloc[(size_t)(row0 + tl) * 256 + c] = f2bf(hst); cuma[(size_t)(row0 + tl) * 256 + c] = f2bf(cum);
    }
    const int seg = tt * 2 + half;
    ((float*)(p.ws + OFF_SEGA))[(size_t)(d * 1088 + seg) * 256 + c] = cum;
    ((float*)(p.ws + OFF_SEGB))[(size_t)(d * 1088 + seg) * 256 + c] = hst;
}
DEVI void qproj_unit(const Params& p, int qu, char* lds) {
    const int mt = qu >> 1, nh = qu & 1;
    const int tid = tidx(), lane = tid & 63, w = tid >> 6, wm = w >> 1, wn = w & 1, l31 = lane & 31, hh = lane >> 5;
    const bf16_t* z = (const bf16_t*)(p.ws + OFF_Z);
    const int row0 = mt_row0(mt);
    float* rs = (float*)(lds + 120 * 1024);
    KFragA<12> a;
    kx_load_a<12>(a, z + ZC_QL, ZLD, row0, lds, rs, 1e-6f);
    bf16_t* Q = (bf16_t*)(p.ws + OFF_Q);
    const float* cosT = (const float*)(p.ws + OFF_COS); const float* sinT = (const float*)(p.ws + OFF_SIN);
    const float QS = 0.10206207261596575f * 1.4426950408889634f;
    const bool lat = mt < 128;
    kx_stream<12>(a, (const bf16_t*)(p.ws + OFF_WUQ) + (size_t)nh * 192 * 192, 3, lds, [&](int j, const f32x16 (&acc)[2]) __attribute__((always_inline)) {
        const int ct = nh * 6 + j * 2 + wn, hd = ct / 3, part = ct % 3;
#pragma unroll
        for (int mi = 0; mi < 2; ++mi) {
            const int rl = wm * 64 + mi * 32 + l31, row = row0 + rl, b = row_b(row), key = row_key(row);
            const float rstd = rs[rl] * QS;
            float v[16];
#pragma unroll
            for (int e = 0; e < 16; ++e) v[e] = acc[mi][e] * rstd;
            if (part == 2 && lat) {
#pragma unroll
                for (int g = 0; g < 2; ++g)
#pragma unroll
                    for (int jj = 0; jj < 4; ++jj) { const int i = 8 * g + 4 * hh + jj; const float cs = cosT[key * 16 + i], sn = sinT[key * 16 + i];
                        const float x1 = v[4 * g + jj], x2 = v[4 * (g + 2) + jj]; v[4 * g + jj] = x1 * cs - x2 * sn; v[4 * (g + 2) + jj] = x1 * sn + x2 * cs; }
            }
            bf16_t* dst = Q + ((size_t)((b * 4 + hd) * NKEY + key)) * 96 + part * 32 + 4 * hh;
#pragma unroll
            for (int g = 0; g < 4; ++g) { uint2 o; o.x = pk2(v[4 * g], v[4 * g + 1]); o.y = pk2(v[4 * g + 2], v[4 * g + 3]); *(uint2*)(dst + 8 * g) = o; }
        }
    });
}
DEVI void kvproj_unit(const Params& p, int ku, char* lds) {
    const int mt = ku >> 1, nh = ku & 1;
    const int tid = tidx(), lane = tid & 63, w = tid >> 6, wm = w >> 1, wn = w & 1, l31 = lane & 31, hh = lane >> 5;
    const bf16_t* z = (const bf16_t*)(p.ws + OFF_Z);
    const int row0 = mt_row0(mt);
    float* rs = (float*)(lds + 120 * 1024);
    bf16_t* Kb = (bf16_t*)(p.ws + OFF_K); bf16_t* Vt = (bf16_t*)(p.ws + OFF_VT);
    const float* cosT = (const float*)(p.ws + OFF_COS); const float* sinT = (const float*)(p.ws + OFF_SIN);
    const bool lat = mt < 128;
    if (nh == 0) {
        const int rl = tid >> 1, part = tid & 1, row = row0 + rl, b = row_b(row), key = row_key(row);
        const bf16_t* zr = z + (size_t)row * ZLD + ZC_KR;
        const u32x4 q1 = *(const u32x4*)(zr + 8 * part), q2 = *(const u32x4*)(zr + 16 + 8 * part);
        const int kk = lat ? key : 0;
        const float4 ca = *(const float4*)(cosT + kk * 16 + 8 * part), cb = *(const float4*)(cosT + kk * 16 + 8 * part + 4);
        const float4 sa = *(const float4*)(sinT + kk * 16 + 8 * part), sb2 = *(const float4*)(sinT + kk * 16 + 8 * part + 4);
        const float csv[8] = {ca.x, ca.y, ca.z, ca.w, cb.x, cb.y, cb.z, cb.w}, snv[8] = {sa.x, sa.y, sa.z, sa.w, sb2.x, sb2.y, sb2.z, sb2.w};
        float y1[8], y2[8];
#pragma unroll
        for (int ii = 0; ii < 8; ++ii) { const float x1 = (ii & 1) ? hi_bf(q1[ii >> 1]) : lo_bf(q1[ii >> 1]), x2 = (ii & 1) ? hi_bf(q2[ii >> 1]) : lo_bf(q2[ii >> 1]);
            const float cs = lat ? csv[ii] : 1.f, sn = lat ? snv[ii] : 0.f; y1[ii] = x1 * cs - x2 * sn; y2[ii] = x1 * sn + x2 * cs; }
        u32x4 o1, o2;
#pragma unroll
        for (int j = 0; j < 4; ++j) { o1[j] = pk2(y1[2 * j], y1[2 * j + 1]); o2[j] = pk2(y2[2 * j], y2[2 * j + 1]); }
#pragma unroll
        for (int hd = 0; hd < 4; ++hd) { bf16_t* kd = Kb + ((size_t)((b * 4 + hd) * NKEY + key)) * 96 + 64 + 8 * part; *(u32x4*)kd = o1; *(u32x4*)(kd + 16) = o2; }
    }
    KFragA<8> a;
    kx_load_a<8>(a, z + ZC_KVL, ZLD, row0, lds, rs, 1e-6f);
    kx_stream<8>(a, (const bf16_t*)(p.ws + OFF_WUKV) + (size_t)nh * 256 * 128, 4, lds, [&](int j, const f32x16 (&acc)[2]) __attribute__((always_inline)) {
        const int hd = nh * 2 + (j >> 1), isv = j & 1;
#pragma unroll
        for (int mi = 0; mi < 2; ++mi) {
            const int rl = wm * 64 + mi * 32 + l31, row = row0 + rl, b = row_b(row), key = row_key(row);
            const float rstd = rs[rl];
            if (!isv) {
                bf16_t* dst = Kb + ((size_t)((b * 4 + hd) * NKEY + key)) * 96 + wn * 32 + 4 * hh;
#pragma unroll
                for (int g = 0; g < 4; ++g) { uint2 o; o.x = pk2(acc[mi][4 * g] * rstd, acc[mi][4 * g + 1] * rstd); o.y = pk2(acc[mi][4 * g + 2] * rstd, acc[mi][4 * g + 3] * rstd); *(uint2*)(dst + 8 * g) = o; }
            } else {
#pragma unroll
                for (int e = 0; e < 16; ++e) { const int dv = wn * 32 + (e & 3) + 8 * (e >> 2) + 4 * hh;
                    Vt[((size_t)((b * 4 + hd) * 64 + dv)) * NKEY + key] = f2bf(acc[mi][e] * rstd); }
            }
        }
    });
}
DEVI void mla_unit(const Params& p, int au, char* lds) {
    const int tid = tidx(), lane = tid & 63, w = tid >> 6, l31 = lane & 31, hh = lane >> 5;
    const bool isctx = au >= 512;
    int b, h, qb;
    if (!isctx) { b = au >> 6; h = (au >> 4) & 3; qb = au & 15; } else { b = (au - 512) >> 2; h = (au - 512) & 3; qb = 16; }
    const int q0 = qb * 256 + w * 32 + l31;
    const bf16_t* Qp = (const bf16_t*)(p.ws + OFF_Q) + ((size_t)((b * 4 + h) * NKEY + q0)) * 96 + 8 * hh;
    bf16x8 qf[6];
#pragma unroll
    for (int ks = 0; ks < 6; ++ks) qf[ks] = *(const bf16x8*)(Qp + ks * 16);
    const bf16_t* kb = (const bf16_t*)(p.ws + OFF_K) + (size_t)((b * 4 + h) * NKEY) * 96;
    const bf16_t* vb = (const bf16_t*)(p.ws + OFF_VT) + (size_t)((b * 4 + h) * 64) * NKEY;
    const int jt0 = isctx ? 64 : 0, ntl = isctx ? 4 : 68;
    auto tf = [&](int j) { KVTile t; t.k = kb + (size_t)(jt0 + j) * 64 * 96; t.vt = vb + (jt0 + j) * 64; return t; };
    f32x16 o[2]; float ls;
    attn_core<96, false>(qf, ntl, tf, 96, NKEY, 0, 0, 0, 0, nullptr, o, ls, lds);
    const int row = isctx ? TL + b * 256 + w * 32 + l31 : b * 4096 + q0;
    attn_store(o, ls, (bf16_t*)(p.ws + OFF_BR) + (size_t)row * DM + h * 64);
}

DEVI void ytrans_unit(const Params& p, int tu, char* lds) {
    const int tid = tidx();
    const int b = tu / 68, kt = tu % 68, key0 = kt * 64;
    const int row0 = kt < 64 ? b * 4096 + key0 : TL + b * 256 + (key0 - 4096);
    const bf16_t* yT = (const bf16_t*)(p.ws + OFF_YT) + (size_t)(b * 256) * NKEY + key0;
    bf16_t* br = (bf16_t*)(p.ws + OFF_BR);
    bf16_t* tl = (bf16_t*)lds;
    __syncthreads();
#pragma unroll
    for (int i = 0; i < 4; ++i) { const int cidx = tid + 512 * i, ch = cidx >> 3, kc = (cidx & 7) * 8; *(u32x4*)(tl + ch * 72 + kc) = *(const u32x4*)(yT + (size_t)ch * NKEY + kc); }
    __syncthreads();
#pragma unroll
    for (int i = 0; i < 4; ++i) { const int cidx = tid + 512 * i, t = cidx >> 5, c8 = (cidx & 31) * 8;
        u32x4 o;
#pragma unroll
        for (int j = 0; j < 4; ++j) o[j] = (unsigned)tl[(c8 + 2 * j) * 72 + t] | ((unsigned)tl[(c8 + 2 * j + 1) * 72 + t] << 16);
        *(u32x4*)(br + (size_t)(row0 + t) * DM + 512 + c8) = o; }
}
DEVI float gelu_tanh(float x) { const float u = 0.7978845608028654f * (x + 0.044715f * x * x * x); return x * __builtin_amdgcn_rcpf(1.f + __expf(-2.f * u)); }
DEVI void lru_carry_unit(const Params& p, int l, int b) {
    const int tid = tidx(), c = tid & 255, d = tid >> 8;
    const float* SA = (const float*)(p.ws + OFF_SEGA) + (size_t)d * 1088 * 256; const float* SB = (const float*)(p.ws + OFF_SEGB) + (size_t)d * 1088 * 256;
    float* HIN = (float*)(p.ws + OFF_HIN) + (size_t)d * 1088 * 256;
    const int cbase = 1024 + 8 * b, lbase = 128 * b;
    float h = 0.f;
#pragma unroll 1
    for (int k0 = 0; k0 < 136; k0 += 17) {
        float sa[17], sbv[17];
#pragma unroll
        for (int i = 0; i < 17; ++i) { const int k = k0 + i; const int seg = d == 0 ? (k < 8 ? cbase + k : lbase + (k - 8)) : (k < 8 ? cbase + 7 - k : lbase + 135 - k);
            const size_t o = (size_t)seg * 256 + c; sa[i] = SA[o]; sbv[i] = SB[o]; }
        __builtin_amdgcn_sched_barrier(0);
#pragma unroll
        for (int i = 0; i < 17; ++i) { const int k = k0 + i; const int seg = d == 0 ? (k < 8 ? cbase + k : lbase + (k - 8)) : (k < 8 ? cbase + 7 - k : lbase + 135 - k);
            const size_t o = (size_t)seg * 256 + c;
            __hip_atomic_store(HIN + o, h, __ATOMIC_RELAXED, __HIP_MEMORY_SCOPE_AGENT);
            h = sa[i] * h + sbv[i]; }
        __builtin_amdgcn_sched_barrier(0);
    }
    asm volatile("s_waitcnt vmcnt(0)" ::: "memory");
    __syncthreads();
    if (tid == 0) __hip_atomic_store((unsigned*)(p.ws + OFF_GCNT) + 768 + l * 8 + b, 1u, __ATOMIC_RELAXED, __HIP_MEMORY_SCOPE_AGENT);
}
DEVI void lru2_unit(const Params& p, int l, int tt) {
    const int tid = tidx(), c = tid & 255, half = tid >> 8;
    const int s0 = tt * 4 + half * 2;
    const bool lat = s0 < 1024;
    const int b = lat ? (s0 >> 7) : ((s0 - 1024) >> 3);
    if (tid == 0) {
        unsigned* flag = (unsigned*)(p.ws + OFF_GCNT) + 768 + l * 8 + b; unsigned sp = 0;
        while (__hip_atomic_load(flag, __ATOMIC_RELAXED, __HIP_MEMORY_SCOPE_AGENT) == 0u && ++sp < (1u << 22)) __builtin_amdgcn_s_sleep(2);
    }
    __syncthreads();
    const float* HIN = (const float*)(p.ws + OFF_HIN);
    float hin[2][2];
#pragma unroll
    for (int d = 0; d < 2; ++d)
#pragma unroll
        for (int sgi = 0; sgi < 2; ++sgi) hin[d][sgi] = __hip_atomic_load(HIN + ((size_t)d * 1088 + s0 + sgi) * 256 + c, __ATOMIC_RELAXED, __HIP_MEMORY_SCOPE_AGENT);
    const bf16_t* hl = (const bf16_t*)(p.ws + OFF_HLOC); const bf16_t* ca = (const bf16_t*)(p.ws + OFF_CUMA);
    const bf16_t* z = (const bf16_t*)(p.ws + OFF_Z); bf16_t* br = (bf16_t*)(p.ws + OFF_BR);
#pragma unroll 1
    for (int t8 = 0; t8 < 8; ++t8) {
        const int sgi = t8 >> 2; const size_t row0 = (size_t)(s0 + sgi) * 32 + (t8 & 3) * 8;
        bf16_t a0[8], a1[8], a2[8], a3[8], a4[8];
#pragma unroll
        for (int i = 0; i < 8; ++i) { const size_t row = row0 + i;
            a0[i] = hl[row * 256 + c]; a1[i] = ca[row * 256 + c]; a2[i] = hl[((size_t)TT + row) * 256 + c]; a3[i] = ca[((size_t)TT + row) * 256 + c]; a4[i] = z[row * ZLD + ZC_LG + c]; }
        __builtin_amdgcn_sched_barrier(0);
        const float h0 = sgi ? hin[0][1] : hin[0][0], h1 = sgi ? hin[1][1] : hin[1][0];
#pragma unroll
        for (int i = 0; i < 8; ++i) { const size_t row = row0 + i;
            const float hf = bf2f(a0[i]) + bf2f(a1[i]) * h0, hr = bf2f(a2[i]) + bf2f(a3[i]) * h1;
            br[row * DM + 768 + c] = f2bf((hf + hr) * gelu_tanh(bf2f(a4[i]))); }
        __builtin_amdgcn_sched_barrier(0);
    }
}
DEVI void pbranch_unit(const Params& p, int u, char* lds) {
    const int mt = u >> 3, g = (u >> 1) & 3, nh = u & 1;
    const int tid = tidx(), lane = tid & 63, w = tid >> 6, wm = w >> 1, wn = w & 1, l31 = lane & 31, hh = lane >> 5;
    const int row0 = mt_row0(mt);
    K256A a;
    k256_load_a(a, (const bf16_t*)(p.ws + OFF_BR) + g * 256, DM, row0, lds);
    bf16_t* P = (bf16_t*)(p.ws + (g < 2 ? OFF_PLO : OFF_PHI)) + (size_t)(g & 1) * 1024 + nh * 512;
    bf16_t* slab = (bf16_t*)(lds + 2 * K2_BUF) + w * (64 * 40);
    k256_stream(a, (const bf16_t*)(p.ws + OFF_WBR) + (size_t)(g * 1024 + nh * 512) * 256, 8, lds, [&](int j, const f32x16 (&acc)[2]) __attribute__((always_inline)) {
#pragma unroll
        for (int mi = 0; mi < 2; ++mi)
#pragma unroll
            for (int q = 0; q < 4; ++q) { uint2 o; o.x = pk2(acc[mi][4 * q], acc[mi][4 * q + 1]); o.y = pk2(acc[mi][4 * q + 2], acc[mi][4 * q + 3]);
                *(uint2*)(slab + (mi * 32 + l31) * 40 + 8 * q + 4 * hh) = o; }
        asm volatile("s_waitcnt lgkmcnt(0)" ::: "memory");
#pragma unroll
        for (int it = 0; it < 4; ++it) {
            const int r64 = it * 16 + (lane >> 2);
            const u32x4 v = *(const u32x4*)(slab + r64 * 40 + (lane & 3) * 8);
            *(u32x4*)(P + (size_t)(row0 + wm * 64 + r64) * 2048 + j * 64 + wn * 32 + (lane & 3) * 8) = v;
        }
        asm volatile("s_waitcnt lgkmcnt(0)" ::: "memory");
    });
}
DEVI void router_unit(const Params& p, int l, int r0, int r1, char* lds) {
    const int tid = tidx(), lane = tid & 63, w = tid >> 6, wm = w >> 1, wn = w & 1, l31 = lane & 31, hh = lane >> 5;
    const int nrows = r1 - r0;
    norm_rows(p, l, r0, r1, 1);
    asm volatile("s_waitcnt vmcnt(0)" ::: "memory");
    __syncthreads();
    const RowLoader al = make_rows((const bf16_t*)(p.ws + OFF_H), DM, r0);
    f32x16 acc[2][1];
    gemm_mainloop<true, 1>(acc, al, (const bf16_t*)(p.ws + OFF_RT), 1024, 1024, lds);
    float* lg = (float*)lds;
    int* cnt_l = (int*)(lds + 256 * 65 * 4);
    int* base_g = cnt_l + 64;
#pragma unroll
    for (int mi = 0; mi < 2; ++mi)
#pragma unroll
        for (int e = 0; e < 16; ++e) lg[(wm * 64 + mi * 32 + l31) * 65 + wn * 32 + (e & 3) + 8 * (e >> 2) + 4 * hh] = sigmoidf_(acc[mi][0][e]);
    float* rbs = (float*)(base_g + 64);
    if (tid < 64) { cnt_l[tid] = 0; rbs[tid] = p.in[I_RB][l * 64 + tid]; }
    __syncthreads();
    int se[6], spos[6]; float swt[6];
    if (tid < nrows) {
        const float* rb = rbs;
        float* my = lg + tid * 65;
        float ssum = 0.f;
#pragma unroll
        for (int k = 0; k < 6; ++k) {
            float best = -1e30f; int bi = 0;
#pragma unroll 8
            for (int e = 0; e < 64; ++e) { const float s = my[e] + rb[e]; if (s > best) { best = s; bi = e; } }
            const float sc = my[bi];
            se[k] = bi; swt[k] = sc; ssum += sc; my[bi] = -1e30f;
        }
        const float nrm = 2.5f / ssum;
#pragma unroll
        for (int k = 0; k < 6; ++k) { swt[k] *= nrm; spos[k] = atomicAdd(&cnt_l[se[k]], 1); }
    }
    __syncthreads();
    if (tid < 64) base_g[tid] = (int)__hip_atomic_fetch_add((unsigned*)(p.ws + OFF_GCNT) + l * 64 + tid, (unsigned)cnt_l[tid], __ATOMIC_RELAXED, __HIP_MEMORY_SCOPE_AGENT);
    __syncthreads();
    if (tid < nrows) {
        const int r = r0 + tid;
        int* list = (int*)(p.ws + OFF_LIST); unsigned* toks = (unsigned*)(p.ws + OFF_TOKS); float* wts = (float*)(p.ws + OFF_WTS);
#pragma unroll
        for (int k = 0; k < 6; ++k) { const int pos = base_g[se[k]] + spos[k]; list[(size_t)se[k] * TT + pos] = r; toks[(size_t)r * 6 + k] = ((unsigned)se[k] << 16) | (unsigned)pos; wts[(size_t)r * 6 + k] = swt[k]; }
    }
}
struct MoeTab { int* cnt; int* blkbase; int* cbase; };
DEVI MoeTab moe_tables(const Params& p, int l, int nact, char* lds) {
    MoeTab t; t.cnt = (int*)(lds + LDS_BYTES - 4096); t.blkbase = t.cnt + 80; t.cbase = t.blkbase + 80;
    __syncthreads();
    if (tidx() < 64) t.cnt[tidx()] = (int)__hip_atomic_load((unsigned*)(p.ws + OFF_GCNT) + l * 64 + tidx(), __ATOMIC_RELAXED, __HIP_MEMORY_SCOPE_AGENT);
    __syncthreads();
    if (tidx() == 0) {
        int bb = 0, cb = 0;
        for (int e = 0; e < 64; ++e) { const int c = t.cnt[e]; t.blkbase[e] = bb; t.cbase[e] = cb; bb += (c + 255) >> 8; cb += c; }
        t.cnt[64] = nact; t.blkbase[64] = bb; t.cbase[64] = cb; t.blkbase[65] = bb + (nact >> 8);
    }
    __syncthreads();
    {
        unsigned char* eb = (unsigned char*)(t.cbase + 80);
        const int nrb = t.blkbase[65];
        for (int rb = tidx(); rb < nrb; rb += 512) { int e = 0; while (e < 64 && rb >= t.blkbase[e + 1]) ++e; eb[rb] = (unsigned char)e; }
    }
    __syncthreads();
    return t;
}
DEVI int find_expert(const MoeTab& t, int rb) { return (int)((const unsigned char*)(t.cbase + 80))[rb]; }
DEVI void moe2_unit(const Params& p, int l, const MoeTab& t, int rb, char* lds) {
    const int tid = tidx(), lane = tid & 63, w = tid >> 6, wm = w >> 1, wn = w & 1, l31 = lane & 31, hh = lane >> 5;
    const int e = find_expert(t, rb), i0 = (rb - t.blkbase[e]) * 256, cnt = t.cnt[e], cbe = t.cbase[e];
    K256A a;
    k256_load_a(a, (const bf16_t*)(p.ws + OFF_HID), 256, rb * 256, lds);
    const bf16_t* Bt = (const bf16_t*)(p.ws + OFF_WDT) + (size_t)e * 1024 * 256;
    if (e < 64) {
        bf16_t* Y = (bf16_t*)(p.ws + OFF_Y);
        bf16_t* slab = (bf16_t*)(lds + 2 * K2_BUF) + w * (64 * 40);
        bf16_t* trash = (bf16_t*)(p.ws + OFF_SEGA + (size_t)blockIdx.x * 8192 + (size_t)tid * 16);
        k256_stream(a, Bt, 16, lds, [&](int j, const f32x16 (&acc)[2]) __attribute__((always_inline)) {
#pragma unroll
            for (int mi = 0; mi < 2; ++mi)
#pragma unroll
                for (int g = 0; g < 4; ++g) { uint2 o; o.x = pk2(acc[mi][4 * g], acc[mi][4 * g + 1]); o.y = pk2(acc[mi][4 * g + 2], acc[mi][4 * g + 3]);
                    *(uint2*)(slab + (mi * 32 + l31) * 40 + 8 * g + 4 * hh) = o; }
            asm volatile("s_waitcnt lgkmcnt(0)" ::: "memory");
#pragma unroll
            for (int it = 0; it < 4; ++it) {
                const int r64 = it * 16 + (lane >> 2), ii = i0 + wm * 64 + r64;
                const u32x4 v = *(const u32x4*)(slab + r64 * 40 + (lane & 3) * 8);
                *(u32x4*)(ii < cnt ? Y + (size_t)(cbe + ii) * DM + j * 64 + wn * 32 + (lane & 3) * 8 : trash) = v;
            }
            asm volatile("s_waitcnt lgkmcnt(0)" ::: "memory");
        });
    } else {
        const float* g2b = (const float*)(p.ws + OFF_MOD) + (size_t)l * 9 * 6144 + 5120 + (size_t)row_mod(i0) * 6144;
        bf16_t* slab = (bf16_t*)(lds + 2 * K2_BUF) + w * (64 * 40);
        k256_stream(a, Bt, 16, lds, [&](int j, const f32x16 (&acc)[2]) __attribute__((always_inline)) {
#pragma unroll
            for (int mi = 0; mi < 2; ++mi)
#pragma unroll
                for (int g = 0; g < 4; ++g) { uint2 o; o.x = pk2(acc[mi][4 * g], acc[mi][4 * g + 1]); o.y = pk2(acc[mi][4 * g + 2], acc[mi][4 * g + 3]);
                    *(uint2*)(slab + (mi * 32 + l31) * 40 + 8 * g + 4 * hh) = o; }
            const int c0 = j * 64 + wn * 32 + (lane & 3) * 8;
            const float4 ga = *(const float4*)(g2b + c0), gb = *(const float4*)(g2b + c0 + 4);
            asm volatile("s_waitcnt lgkmcnt(0)" ::: "memory");
#pragma unroll
            for (int h2 = 0; h2 < 2; ++h2) {
                float4 xa[2], xb[2];
#pragma unroll
                for (int i2 = 0; i2 < 2; ++i2) { const int r64 = (h2 * 2 + i2) * 16 + (lane >> 2); const float* xr = xdst(p, i0 + wm * 64 + r64) + c0; xa[i2] = *(const float4*)xr; xb[i2] = *(const float4*)(xr + 4); }
                __builtin_amdgcn_sched_barrier(0);
#pragma unroll
                for (int i2 = 0; i2 < 2; ++i2) { const int r64 = (h2 * 2 + i2) * 16 + (lane >> 2); float* xr = xdst(p, i0 + wm * 64 + r64) + c0;
                    const u32x4 v = *(const u32x4*)(slab + r64 * 40 + (lane & 3) * 8);
                    float4 oa = xa[i2], ob = xb[i2];
                    oa.x += ga.x * lo_bf(v[0]); oa.y += ga.y * hi_bf(v[0]); oa.z += ga.z * lo_bf(v[1]); oa.w += ga.w * hi_bf(v[1]);
                    ob.x += gb.x * lo_bf(v[2]); ob.y += gb.y * hi_bf(v[2]); ob.z += gb.z * lo_bf(v[3]); ob.w += gb.w * hi_bf(v[3]);
                    *(float4*)xr = oa; *(float4*)(xr + 4) = ob; }
                __builtin_amdgcn_sched_barrier(0);
            }
            asm volatile("s_waitcnt lgkmcnt(0)" ::: "memory");
        });
    }
}
DEVI void combine_unit(const Params& p, int l, const MoeTab& t, int r0, int r1) {
    const int lane = tidx() & 63, w = tidx() >> 6;
    const float* mod = (const float*)(p.ws + OFF_MOD);
    const bf16_t* Y = (const bf16_t*)(p.ws + OFF_Y);
    const unsigned* toks = (const unsigned*)(p.ws + OFF_TOKS); const float* wts = (const float*)(p.ws + OFF_WTS);
#pragma unroll 2
    for (int r = r0 + w; r < r1; r += 8) {
        float* xd = xdst(p, r);
        const float* g2 = mod + (size_t)(l * 9 + row_mod(r)) * 6144 + 5120;
        const bf16_t* yr[6]; float wk[6];
#pragma unroll
        for (int k = 0; k < 6; ++k) { const unsigned v = toks[(size_t)r * 6 + k]; yr[k] = Y + (size_t)(t.cbase[v >> 16] + (int)(v & 0xffffu)) * DM; wk[k] = wts[(size_t)r * 6 + k]; }
        float4 xo[4]; float ss = 0.f;
#pragma unroll
        for (int q = 0; q < 4; ++q) {
            const int k0 = 4 * lane + 256 * q;
            float f0 = 0.f, f1 = 0.f, f2 = 0.f, f3 = 0.f;
#pragma unroll
            for (int k = 0; k < 6; ++k) { const uint2 yv = *(const uint2*)(yr[k] + k0); f0 += wk[k] * lo_bf(yv.x); f1 += wk[k] * hi_bf(yv.x); f2 += wk[k] * lo_bf(yv.y); f3 += wk[k] * hi_bf(yv.y); }
            float4 xv = *(const float4*)(xd + k0); const float4 gv = *(const float4*)(g2 + k0);
            xv.x += gv.x * f0; xv.y += gv.y * f1; xv.z += gv.z * f2; xv.w += gv.w * f3;
            xo[q] = xv; ss += xv.x * xv.x + xv.y * xv.y + xv.z * xv.z + xv.w * xv.w;
        }
        if (l == 1) {
            ss = wave_sum(ss);
            const float rstd = rsqrtf(ss * (1.f / 1024.f) + 1e-6f);
#pragma unroll
            for (int q = 0; q < 4; ++q) { const int k0 = 4 * lane + 256 * q; const float4 gf = *(const float4*)(p.in[I_GF] + k0);
                float4 o; o.x = xo[q].x * rstd * gf.x; o.y = xo[q].y * rstd * gf.y; o.z = xo[q].z * rstd * gf.z; o.w = xo[q].w * rstd * gf.w; *(float4*)(xd + k0) = o; }
        } else {
#pragma unroll
            for (int q = 0; q < 4; ++q) *(float4*)(xd + 4 * lane + 256 * q) = xo[q];
        }
    }
}


namespace pg8 {
#define PG8_LAS __attribute__((address_space(3)))
typedef unsigned short bf16_t;
typedef short bf16x8 __attribute__((ext_vector_type(8)));
typedef float f32x4 __attribute__((ext_vector_type(4)));
typedef unsigned u32x4 __attribute__((ext_vector_type(4)));
typedef int i32x4 __attribute__((ext_vector_type(4)));
typedef int i32x8 __attribute__((ext_vector_type(8)));
constexpr int BM = 256, BK = 64, HALF = 128, HTB = HALF * BK * 2  , STAGE_BYTES = 8 * HTB, NXCD = 8, WGM = 8;

__host__ __device__ __forceinline__ int lds_byte(int r, int c) { const int st = (r >> 4) * 2 + (c >> 5), rr = r & 15, cc = c & 31, ob = rr * 64 + cc * 2; return st * 1024 + (ob ^ (((ob >> 9) & 1) << 5)); }
__host__ __device__ __forceinline__ void stage_rc(int b, int& R, int& C) { const int st = b / 1024, sb = b % 1024, swz = sb ^ (((sb >> 9) & 1) << 5); R = (st >> 1) * 16 + swz / 64; C = (st & 1) * 32 + (swz % 64) / 2; }
__host__ __device__ __forceinline__ int perm32(int rho) { const int n = rho >> 4, i = rho & 15; return 8 * (i >> 2) + 4 * n + (i & 3); }

struct Unit { int pm, pn; };
struct Gemm { const bf16_t* A; const bf16_t* Bt; int M, N, K; };

struct StaticOrder {
    int nM, nN, nwg, G, c;
    __host__ __device__ void init(int M, int N, int G_, int c_) { nM = M / BM; nN = N / BM; nwg = nM * nN; G = G_; c = c_; }
    __host__ __device__ bool next(int i, Unit& u) const {
        const long L = (long)i * G + c; if (L >= nwg) return false;
        int wgid = (int)L; { const int q = nwg / NXCD, r = nwg % NXCD, xcd = wgid % NXCD, off = wgid / NXCD; wgid = (xcd < r ? xcd * (q + 1) : r * (q + 1) + (xcd - r) * q) + off; }
        const int nig = WGM * nN, gid = wgid / nig, fm = gid * WGM, gsz = (nM - fm) < WGM ? (nM - fm) : WGM;
        u.pm = fm + ((wgid % nig) % gsz); u.pn = (wgid % nig) / gsz; return true;
    }
    __device__ __forceinline__ void a_ready(const Unit&) const {}
    __device__ __forceinline__ void done(const Unit&) const {}
};
template <class Epi, class Sched, bool STAMP = false, bool F8 = false>
__device__ __forceinline__ void gemm_phase(PG8_LAS unsigned char* lds, const Gemm g, const Sched& S, const Epi& E, unsigned long long* stamps) {
    const int tid = threadIdx.x, wid = __builtin_amdgcn_readfirstlane(tid >> 6), lane = tid & 63, wr = wid >> 2, wc = wid & 3, fr = lane & 15, fq = lane >> 4;
    int K = g.K; if constexpr (F8) asm volatile("" : "+s"(K));
    const int nt = K / BK;
    int ts_lo = 0, ts_hi = 0, nts = 0; const unsigned long long rt_entry = STAMP ? (unsigned long long)wall_clock64() : 0ull;
#define PG8_STAMP() do { if (STAMP && wid == 0 && nts < 64) { const unsigned long long _c = (unsigned long long)clock64(); \
        ts_lo = (lane == nts) ? (int)(unsigned)_c : ts_lo; ts_hi = (lane == nts) ? (int)(unsigned)(_c >> 32) : ts_hi; ++nts; } } while (0)
    PG8_STAMP();
    unsigned voffA[2], voffB[2];
#pragma unroll
    for (int i = 0; i < 2; ++i) { int R, C; stage_rc(tid * 16 + i * 8192, R, C); const int Rb = Epi::PERM ? ((R & ~31) + perm32(R & 31)) : R;
        voffA[i] = (unsigned)(R * K + C) * 2u; voffB[i] = (unsigned)(Rb * K + C) * 2u; }
    const size_t kstep = (size_t)(BK * 2);
    const size_t hstep = (size_t)HALF * K * 2;
    const size_t tstep = 2 * hstep;
    const unsigned ldsw = (unsigned)wid * 1024u;
    const int aoff = lds_byte(wr * 64 + fr, fq * 8), boff = lds_byte(wc * 32 + fr, fq * 8);
#define PG8_SA(b, h) (((b) * 2 + (h)) * HTB)
#define PG8_SB(b, h) ((4 + (b) * 2 + (h)) * HTB)
#define PG8_STAGE(bufoff, gbase, voff) do { _Pragma("unroll") for (int _i = 0; _i < 2; ++_i) \
        __builtin_amdgcn_global_load_lds((const unsigned*)((const char*)(gbase) + (voff)[_i]), (PG8_LAS unsigned*)(lds + (bufoff) + ldsw + _i * 8192), 16, 0, 0); } while (0)
#define PG8_CAT(x, y) __builtin_shufflevector(x, y, 0, 1, 2, 3, 4, 5, 6, 7)
#define PG8_LDA(dst, b, h) do { _Pragma("unroll") for (int m = 0; m < 4; ++m) { \
        if constexpr (F8) dst##8[m] = PG8_CAT(*(const PG8_LAS i32x4*)(lds + PG8_SA(b, h) + aoff + m * 2048), *(const PG8_LAS i32x4*)(lds + PG8_SA(b, h) + aoff + m * 2048 + 1024)); \
        else { _Pragma("unroll") for (int k = 0; k < 2; ++k) dst[m][k] = *(const PG8_LAS bf16x8*)(lds + PG8_SA(b, h) + aoff + m * 2048 + k * 1024); } } } while (0)
#define PG8_LDB(dst, b, h) do { _Pragma("unroll") for (int n = 0; n < 2; ++n) { \
        if constexpr (F8) dst##8[n] = PG8_CAT(*(const PG8_LAS i32x4*)(lds + PG8_SB(b, h) + boff + n * 2048), *(const PG8_LAS i32x4*)(lds + PG8_SB(b, h) + boff + n * 2048 + 1024)); \
        else { _Pragma("unroll") for (int k = 0; k < 2; ++k) dst[n][k] = *(const PG8_LAS bf16x8*)(lds + PG8_SB(b, h) + boff + n * 2048 + k * 1024); } } } while (0)
#define PG8_MMA(ai, bj, At, Bt) do { __builtin_amdgcn_s_setprio(1); _Pragma("unroll") for (int m = 0; m < 4; ++m) _Pragma("unroll") for (int n = 0; n < 2; ++n) { \
        if constexpr (F8) asm volatile("v_mfma_scale_f32_16x16x128_f8f6f4 %0, %1, %2, %0, %3, %3 op_sel_hi:[0,0,0]" : "+v"(acc[ai][bj][m][n]) : "v"(Bt##8[n]), "v"(At##8[m]), "v"(sc8)); \
        else { _Pragma("unroll") for (int k = 0; k < 2; ++k) acc[ai][bj][m][n] = __builtin_amdgcn_mfma_f32_16x16x32_bf16(Bt[n][k], At[m][k], acc[ai][bj][m][n], 0, 0, 0); } } __builtin_amdgcn_s_setprio(0); } while (0)
#define PG8_WAIT_V(n) asm volatile("s_waitcnt vmcnt(" #n ")" ::: "memory")
#define PG8_WAIT_L(n) asm volatile("s_waitcnt lgkmcnt(" #n ")" ::: "memory")
#define PG8_BAR __builtin_amdgcn_s_barrier()
#define PG8_SCHED __builtin_amdgcn_sched_barrier(0)
    Unit cur, nxt; int ui = 0;
    if (!S.next(0, cur)) return;
    f32x4 acc[2][2][4][2];
#pragma unroll
    for (int a = 0; a < 2; ++a)
#pragma unroll
        for (int b = 0; b < 2; ++b)
#pragma unroll
            for (int m = 0; m < 4; ++m)
#pragma unroll
                for (int n = 0; n < 2; ++n) acc[a][b][m][n] = (f32x4){0.f, 0.f, 0.f, 0.f};
    bf16x8 At[4][2], B0[2][2], B1[2][2];
    i32x8 At8[4], B08[2], B18[2];
    int sc8 = 0x7F7F7F7F; asm volatile("" : "+v"(sc8));
    const char* cA = (const char*)g.A + (size_t)cur.pm * tstep; const char* cB = (const char*)g.Bt + (size_t)cur.pn * tstep;
    S.a_ready(cur);
    PG8_STAGE(PG8_SB(0, 0), cB, voffB); PG8_STAGE(PG8_SA(0, 0), cA, voffA); PG8_STAGE(PG8_SB(0, 1), cB + hstep, voffB); PG8_STAGE(PG8_SA(0, 1), cA + hstep, voffA);
    if (wr == 1) PG8_BAR;
    PG8_WAIT_V(4); PG8_BAR;
    PG8_STAGE(PG8_SB(1, 0), cB + kstep, voffB); PG8_STAGE(PG8_SA(1, 0), cA + kstep, voffA); PG8_STAGE(PG8_SB(1, 1), cB + hstep + kstep, voffB);
    PG8_WAIT_V(6); PG8_BAR;
    PG8_STAMP();
    for (;;) {
        const bool has_next = S.next(ui + 1, nxt);
        const char* nA = has_next ? (const char*)g.A + (size_t)nxt.pm * tstep : cA; const char* nB = has_next ? (const char*)g.Bt + (size_t)nxt.pn * tstep : cB;
        for (int t = 0; t < nt; t += 2) {
            const bool last = (t == nt - 2);
            const char* a1 = cA + (size_t)(t + 1) * kstep;
            const char* a2 = last ? nA : cA + (size_t)(t + 2) * kstep; const char* b2 = last ? nB : cB + (size_t)(t + 2) * kstep;
            const char* a3 = a2 + kstep; const char* b3 = b2 + kstep;
            if (last && has_next) S.a_ready(nxt);
            PG8_LDB(B0, 0, 0); PG8_SCHED; PG8_LDA(At, 0, 0); PG8_STAGE(PG8_SA(1, 1), a1 + hstep, voffA);
            PG8_WAIT_L(8); PG8_BAR; PG8_WAIT_L(0); PG8_MMA(0, 0, At, B0); PG8_BAR; PG8_SCHED;
            PG8_LDB(B1, 0, 1); PG8_STAGE(PG8_SB(0, 0), b2, voffB);
            PG8_BAR; PG8_WAIT_L(0); PG8_MMA(0, 1, At, B1); PG8_BAR;
            PG8_LDA(At, 0, 1); PG8_STAGE(PG8_SA(0, 0), a2, voffA);
            PG8_BAR; PG8_WAIT_L(0); PG8_MMA(1, 0, At, B0); PG8_BAR; PG8_SCHED;
            PG8_STAGE(PG8_SB(0, 1), b2 + hstep, voffB);
            PG8_WAIT_V(6); PG8_BAR; PG8_MMA(1, 1, At, B1); PG8_BAR;
            PG8_LDB(B0, 1, 0); PG8_SCHED; PG8_LDA(At, 1, 0); PG8_STAGE(PG8_SA(0, 1), a2 + hstep, voffA);
            PG8_WAIT_L(8); PG8_BAR; PG8_WAIT_L(0); PG8_MMA(0, 0, At, B0); PG8_BAR; PG8_SCHED;
            PG8_LDB(B1, 1, 1); PG8_STAGE(PG8_SB(1, 0), b3, voffB);
            PG8_BAR; PG8_WAIT_L(0); PG8_MMA(0, 1, At, B1); PG8_BAR;
            PG8_LDA(At, 1, 1); PG8_STAGE(PG8_SA(1, 0), a3, voffA);
            PG8_BAR; PG8_WAIT_L(0); PG8_MMA(1, 0, At, B0); PG8_BAR; PG8_SCHED;
            PG8_STAGE(PG8_SB(1, 1), b3 + hstep, voffB);
            PG8_WAIT_V(6); PG8_BAR; PG8_MMA(1, 1, At, B1); PG8_BAR;
        }
        if constexpr (F8) asm volatile("s_nop 15\n\ts_nop 15" ::: "memory");
        PG8_STAMP();
        if constexpr (!Epi::AFTER_DRAIN) { E(acc, cur, wr, wc, fr, fq); S.done(cur); }
        PG8_STAMP();
        if (!has_next) break;
#pragma unroll
        for (int a = 0; a < 2; ++a)
#pragma unroll
            for (int b = 0; b < 2; ++b)
#pragma unroll
                for (int m = 0; m < 4; ++m)
#pragma unroll
                    for (int n = 0; n < 2; ++n) acc[a][b][m][n] = (f32x4){0.f, 0.f, 0.f, 0.f};
        cur = nxt; cA = nA; cB = nB; ++ui;
    }
    PG8_WAIT_V(0);
    if (wr == 0) PG8_BAR;
    PG8_BAR;
    if constexpr (Epi::AFTER_DRAIN) { E.fused(acc, cur, wr, wc, fr, fq, lds, wid, lane); S.done(cur); }
    PG8_STAMP();
    if (STAMP && wid == 0) { stamps[lane] = lane < nts ? (((unsigned long long)(unsigned)ts_hi << 32) | (unsigned)ts_lo) : 0ull;
        if (lane == 62) stamps[62] = rt_entry; if (lane == 63) stamps[63] = (unsigned long long)wall_clock64(); }
#undef PG8_STAMP
#undef PG8_SA
#undef PG8_SB
#undef PG8_STAGE
#undef PG8_LDA
#undef PG8_LDB
#undef PG8_MMA
#undef PG8_CAT
#undef PG8_WAIT_V
#undef PG8_WAIT_L
#undef PG8_BAR
#undef PG8_SCHED
}
template <class Epi, class Sched, bool STAMP = false>
__device__ __forceinline__ void gemm_phase_gather(PG8_LAS unsigned char* lds, const Gemm g, const Sched& S, const Epi& E, unsigned long long* stamps) {
    const int tid = threadIdx.x, wid = __builtin_amdgcn_readfirstlane(tid >> 6), lane = tid & 63, wr = wid >> 2, wc = wid & 3, fr = lane & 15, fq = lane >> 4;
    const int K = g.K, nt = K / BK;
    int ts_lo = 0, ts_hi = 0, nts = 0; const unsigned long long rt_entry = STAMP ? (unsigned long long)wall_clock64() : 0ull;
#define PG8_STAMP() do { if (STAMP && wid == 0 && nts < 64) { const unsigned long long _c = (unsigned long long)clock64(); \
        ts_lo = (lane == nts) ? (int)(unsigned)_c : ts_lo; ts_hi = (lane == nts) ? (int)(unsigned)(_c >> 32) : ts_hi; ++nts; } } while (0)
    PG8_STAMP();
    unsigned voffA[2], voffB[2];
#pragma unroll
    for (int i = 0; i < 2; ++i) { int R, C; stage_rc(tid * 16 + i * 8192, R, C); const int Rb = Epi::PERM ? ((R & ~31) + perm32(R & 31)) : R;
        voffA[i] = (unsigned)(R * K + C) * 2u; voffB[i] = (unsigned)(Rb * K + C) * 2u; }
    unsigned vc[2][2], vn[2][2];
    const char* gA = (const char*)g.A;
    const size_t kstep = (size_t)(BK * 2);
    const size_t hstep = (size_t)HALF * K * 2;
    const size_t tstep = 2 * hstep;
    const unsigned ldsw = (unsigned)wid * 1024u;
    const int aoff = lds_byte(wr * 64 + fr, fq * 8), boff = lds_byte(wc * 32 + fr, fq * 8);
#define PG8_SA(b, h) (((b) * 2 + (h)) * HTB)
#define PG8_SB(b, h) ((4 + (b) * 2 + (h)) * HTB)
#define PG8_STAGE(bufoff, gbase, voff) do { _Pragma("unroll") for (int _i = 0; _i < 2; ++_i) \
        __builtin_amdgcn_global_load_lds((const unsigned*)((const char*)(gbase) + (voff)[_i]), (PG8_LAS unsigned*)(lds + (bufoff) + ldsw + _i * 8192), 16, 0, 0); } while (0)
#define PG8_LDA(dst, b, h) do { _Pragma("unroll") for (int m = 0; m < 4; ++m) _Pragma("unroll") for (int k = 0; k < 2; ++k) dst[m][k] = *(const PG8_LAS bf16x8*)(lds + PG8_SA(b, h) + aoff + m * 2048 + k * 1024); } while (0)
#define PG8_LDB(dst, b, h) do { _Pragma("unroll") for (int n = 0; n < 2; ++n) _Pragma("unroll") for (int k = 0; k < 2; ++k) dst[n][k] = *(const PG8_LAS bf16x8*)(lds + PG8_SB(b, h) + boff + n * 2048 + k * 1024); } while (0)
#define PG8_MMA(ai, bj, At, Bt) do { __builtin_amdgcn_s_setprio(1); _Pragma("unroll") for (int m = 0; m < 4; ++m) _Pragma("unroll") for (int n = 0; n < 2; ++n) _Pragma("unroll") for (int k = 0; k < 2; ++k) \
        acc[ai][bj][m][n] = __builtin_amdgcn_mfma_f32_16x16x32_bf16(Bt[n][k], At[m][k], acc[ai][bj][m][n], 0, 0, 0); __builtin_amdgcn_s_setprio(0); } while (0)
#define PG8_WAIT_V(n) asm volatile("s_waitcnt vmcnt(" #n ")" ::: "memory")
#define PG8_WAIT_L(n) asm volatile("s_waitcnt lgkmcnt(" #n ")" ::: "memory")
#define PG8_BAR __builtin_amdgcn_s_barrier()
#define PG8_SCHED __builtin_amdgcn_sched_barrier(0)
    Unit cur, nxt; int ui = 0;
    if (!S.next(0, cur)) return;
    f32x4 acc[2][2][4][2];
#pragma unroll
    for (int a = 0; a < 2; ++a)
#pragma unroll
        for (int b = 0; b < 2; ++b)
#pragma unroll
            for (int m = 0; m < 4; ++m)
#pragma unroll
                for (int n = 0; n < 2; ++n) acc[a][b][m][n] = (f32x4){0.f, 0.f, 0.f, 0.f};
    bf16x8 At[4][2], B0[2][2], B1[2][2];
    const char* cA = (const char*)g.A + (size_t)cur.pm * tstep; const char* cB = S.bbase(g, cur, tstep);
    S.arows(cur, K, vc);
#pragma unroll
    for (int h_ = 0; h_ < 2; ++h_) { vn[h_][0] = vc[h_][0]; vn[h_][1] = vc[h_][1]; }
    PG8_STAGE(PG8_SB(0, 0), cB, voffB); PG8_STAGE(PG8_SA(0, 0), gA, vc[0]); PG8_STAGE(PG8_SB(0, 1), cB + hstep, voffB); PG8_STAGE(PG8_SA(0, 1), gA, vc[1]);
    if (wr == 1) PG8_BAR;
    PG8_WAIT_V(4); PG8_BAR;
    PG8_STAGE(PG8_SB(1, 0), cB + kstep, voffB); PG8_STAGE(PG8_SA(1, 0), gA + kstep, vc[0]); PG8_STAGE(PG8_SB(1, 1), cB + hstep + kstep, voffB);
    PG8_WAIT_V(6); PG8_BAR;
    PG8_STAMP();
    for (;;) {
        const bool has_next = S.next(ui + 1, nxt);
        const char* nA = has_next ? (const char*)g.A + (size_t)nxt.pm * tstep : cA; const char* nB = has_next ? S.bbase(g, nxt, tstep) : cB;
        for (int t = 0; t < nt; t += 2) {
            const bool last = (t == nt - 2);
            const char* a1 = gA + (size_t)(t + 1) * kstep;
            const char* a2 = last ? gA : gA + (size_t)(t + 2) * kstep; const char* b2 = last ? nB : cB + (size_t)(t + 2) * kstep;
            const char* a3 = a2 + kstep; const char* b3 = b2 + kstep;
            if (last && has_next) S.arows(nxt, K, vn);
            unsigned sel[2][2];
#pragma unroll
            for (int h_ = 0; h_ < 2; ++h_) { sel[h_][0] = last ? vn[h_][0] : vc[h_][0]; sel[h_][1] = last ? vn[h_][1] : vc[h_][1]; }
            PG8_LDB(B0, 0, 0); PG8_SCHED; PG8_LDA(At, 0, 0); PG8_STAGE(PG8_SA(1, 1), a1, vc[1]);
            PG8_WAIT_L(8); PG8_BAR; PG8_WAIT_L(0); PG8_MMA(0, 0, At, B0); PG8_BAR; PG8_SCHED;
            PG8_LDB(B1, 0, 1); PG8_STAGE(PG8_SB(0, 0), b2, voffB);
            PG8_BAR; PG8_WAIT_L(0); PG8_MMA(0, 1, At, B1); PG8_BAR;
            PG8_LDA(At, 0, 1); PG8_STAGE(PG8_SA(0, 0), a2, sel[0]);
            PG8_BAR; PG8_WAIT_L(0); PG8_MMA(1, 0, At, B0); PG8_BAR; PG8_SCHED;
            PG8_STAGE(PG8_SB(0, 1), b2 + hstep, voffB);
            PG8_WAIT_V(6); PG8_BAR; PG8_MMA(1, 1, At, B1); PG8_BAR;
            PG8_LDB(B0, 1, 0); PG8_SCHED; PG8_LDA(At, 1, 0); PG8_STAGE(PG8_SA(0, 1), a2, sel[1]);
            PG8_WAIT_L(8); PG8_BAR; PG8_WAIT_L(0); PG8_MMA(0, 0, At, B0); PG8_BAR; PG8_SCHED;
            PG8_LDB(B1, 1, 1); PG8_STAGE(PG8_SB(1, 0), b3, voffB);
            PG8_BAR; PG8_WAIT_L(0); PG8_MMA(0, 1, At, B1); PG8_BAR;
            PG8_LDA(At, 1, 1); PG8_STAGE(PG8_SA(1, 0), a3, sel[0]);
            PG8_BAR; PG8_WAIT_L(0); PG8_MMA(1, 0, At, B0); PG8_BAR; PG8_SCHED;
            PG8_STAGE(PG8_SB(1, 1), b3 + hstep, voffB);
            PG8_WAIT_V(6); PG8_BAR; PG8_MMA(1, 1, At, B1); PG8_BAR;
        }
        PG8_STAMP();
        if constexpr (!Epi::AFTER_DRAIN) { E(acc, cur, wr, wc, fr, fq); S.done(cur); }
        PG8_STAMP();
        if (!has_next) break;
#pragma unroll
        for (int a = 0; a < 2; ++a)
#pragma unroll
            for (int b = 0; b < 2; ++b)
#pragma unroll
                for (int m = 0; m < 4; ++m)
#pragma unroll
                    for (int n = 0; n < 2; ++n) acc[a][b][m][n] = (f32x4){0.f, 0.f, 0.f, 0.f};
        cur = nxt; cA = nA; cB = nB; ++ui;
#pragma unroll
        for (int h_ = 0; h_ < 2; ++h_) { vc[h_][0] = vn[h_][0]; vc[h_][1] = vn[h_][1]; }
    }
    PG8_WAIT_V(0);
    if (wr == 0) PG8_BAR;
    PG8_BAR;
    if constexpr (Epi::AFTER_DRAIN) { E.fused(acc, cur, wr, wc, fr, fq, lds, wid, lane); S.done(cur); }
    PG8_STAMP();
    if (STAMP && wid == 0) { stamps[lane] = lane < nts ? (((unsigned long long)(unsigned)ts_hi << 32) | (unsigned)ts_lo) : 0ull;
        if (lane == 62) stamps[62] = rt_entry; if (lane == 63) stamps[63] = (unsigned long long)wall_clock64(); }
#undef PG8_STAMP
#undef PG8_SA
#undef PG8_SB
#undef PG8_STAGE
#undef PG8_LDA
#undef PG8_LDB
#undef PG8_MMA
#undef PG8_WAIT_V
#undef PG8_WAIT_L
#undef PG8_BAR
#undef PG8_SCHED
}
}

struct EpiInproj {
    static constexpr bool PERM = false, AFTER_DRAIN = false;
    bf16_t* z; bf16_t* zT;
    __device__ __forceinline__ void operator()(const pg8::f32x4 (&acc)[2][2][4][2], const pg8::Unit& u, int wr, int wc, int fr, int fq) const {
        const int pm = u.pm, b = pm < 128 ? (pm >> 4) : (pm - 128), key0 = pm < 128 ? (pm & 15) * 256 : 4096, row0 = mt_row0(pm);
#pragma unroll
        for (int bj = 0; bj < 2; ++bj) {
            const int cb = u.pn * 256 + bj * 128;
            if (cb < ZLD) {
#pragma unroll
                for (int ai = 0; ai < 2; ++ai)
#pragma unroll
                    for (int m = 0; m < 4; ++m) { const int rl = ai * 128 + wr * 64 + m * 16 + fr;
#pragma unroll
                        for (int n = 0; n < 2; ++n) { const pg8::f32x4 v = acc[ai][bj][m][n]; uint2 o; o.x = pk2(v[0], v[1]); o.y = pk2(v[2], v[3]);
                            *(uint2*)(z + (size_t)(row0 + rl) * ZLD + cb + wc * 32 + n * 16 + fq * 4) = o; } }
            } else if (cb < NIN) {
#pragma unroll
                for (int ai = 0; ai < 2; ++ai)
#pragma unroll
                    for (int m = 0; m < 4; ++m) { const int rl = ai * 128 + wr * 64 + m * 16 + fr;
#pragma unroll
                        for (int n = 0; n < 2; ++n) { const pg8::f32x4 v = acc[ai][bj][m][n]; const int ch = cb - ZLD + wc * 32 + n * 16 + fq * 4;
                            bf16_t* d = zT + (size_t)(b * 1024 + ch) * NKEY + key0 + rl;
                            d[0] = f2bf(v[0]); d[NKEY] = f2bf(v[1]); d[2 * NKEY] = f2bf(v[2]); d[3 * NKEY] = f2bf(v[3]); } }
            }
        }
    }
};
struct EpiWout {
    static constexpr bool PERM = false, AFTER_DRAIN = false;
    const float* xs_lat; const float* xs_ctx; float* xd_lat; float* xd_ctx; const float* g1base;
    __device__ __forceinline__ void operator()(const pg8::f32x4 (&acc)[2][2][4][2], const pg8::Unit& u, int wr, int wc, int fr, int fq) const {
        const int row0 = mt_row0(u.pm);
        const float* xs = (row0 < TL ? xs_lat + (size_t)row0 * DM : xs_ctx + (size_t)(row0 - TL) * DM) + (size_t)(wr * 64 + fr) * DM + u.pn * 256 + wc * 32 + fq * 4;
        float* xd = (row0 < TL ? xd_lat + (size_t)row0 * DM : xd_ctx + (size_t)(row0 - TL) * DM) + (size_t)(wr * 64 + fr) * DM + u.pn * 256 + wc * 32 + fq * 4;
        const float* g1 = g1base + (size_t)row_mod(row0) * 6144 + u.pn * 256 + wc * 32 + fq * 4;
        float4 gv[2][2];
#pragma unroll
        for (int bj = 0; bj < 2; ++bj)
#pragma unroll
            for (int n = 0; n < 2; ++n) gv[bj][n] = *(const float4*)(g1 + bj * 128 + n * 16);
#pragma unroll
        for (int ai = 0; ai < 2; ++ai) {
            float4 xv[4][2][2];
#pragma unroll
            for (int m = 0; m < 4; ++m)
#pragma unroll
                for (int bj = 0; bj < 2; ++bj)
#pragma unroll
                    for (int n = 0; n < 2; ++n) xv[m][bj][n] = *(const float4*)(xs + (size_t)(ai * 128 + m * 16) * DM + bj * 128 + n * 16);
            __builtin_amdgcn_sched_barrier(0);
#pragma unroll
            for (int m = 0; m < 4; ++m)
#pragma unroll
                for (int bj = 0; bj < 2; ++bj)
#pragma unroll
                    for (int n = 0; n < 2; ++n) {
                        const pg8::f32x4 v = acc[ai][bj][m][n]; const float4 x4 = xv[m][bj][n], g4 = gv[bj][n];
                        float4 o; o.x = x4.x + g4.x * v[0]; o.y = x4.y + g4.y * v[1]; o.z = x4.z + g4.z * v[2]; o.w = x4.w + g4.w * v[3];
                        *(float4*)(xd + (size_t)(ai * 128 + m * 16) * DM + bj * 128 + n * 16) = o;
                    }
            __builtin_amdgcn_sched_barrier(0);
        }
    }
};

struct Moe1Order : pg8::StaticOrder {
    const unsigned char* eb; const int* blkbase; const int* cnt; const int* list;
    __device__ __forceinline__ const char* bbase(const pg8::Gemm& g, const pg8::Unit& u, size_t tstep) const { return (const char*)g.Bt + ((size_t)eb[u.pm] * 2 + u.pn) * tstep; }
    __device__ __forceinline__ void arows(const pg8::Unit& u, int K, unsigned (&vo)[2][2]) const {
        const int e = eb[u.pm], i0 = (u.pm - blkbase[e]) * 256, n_e = cnt[e];
        int lt[2][2];
#pragma unroll
        for (int h = 0; h < 2; ++h)
#pragma unroll
            for (int i = 0; i < 2; ++i) { int R, C; pg8::stage_rc((int)threadIdx.x * 16 + i * 8192, R, C);
                const int ii = i0 + h * 128 + R; lt[h][i] = list[(size_t)min(e, 63) * TT + min(ii, max(n_e - 1, 0))]; }
#pragma unroll
        for (int h = 0; h < 2; ++h)
#pragma unroll
            for (int i = 0; i < 2; ++i) { int R, C; pg8::stage_rc((int)threadIdx.x * 16 + i * 8192, R, C);
                const int ii = i0 + h * 128 + R; const int tok = e == 64 ? ii : (ii < n_e ? lt[h][i] : 0);
                vo[h][i] = (unsigned)(tok * K + C) * 2u; }
    }
};
struct EpiMoe1 {
    static constexpr bool PERM = false, AFTER_DRAIN = false;
    bf16_t* hid;
    __device__ __forceinline__ void operator()(const pg8::f32x4 (&acc)[2][2][4][2], const pg8::Unit& u, int wr, int wc, int fr, int fq) const {
#pragma unroll
        for (int ai = 0; ai < 2; ++ai)
#pragma unroll
            for (int m = 0; m < 4; ++m) { bf16_t* d = hid + ((size_t)u.pm * 256 + ai * 128 + wr * 64 + m * 16 + fr) * 256 + u.pn * 128 + 16 * wc + 4 * fq;
#pragma unroll
                for (int bj = 0; bj < 2; ++bj) { const pg8::f32x4 gt = acc[ai][bj][m][0], up = acc[ai][bj][m][1];
                    uint2 o; o.x = pk2(gt[0] * sigmoidf_(gt[0]) * up[0], gt[1] * sigmoidf_(gt[1]) * up[1]); o.y = pk2(gt[2] * sigmoidf_(gt[2]) * up[2], gt[3] * sigmoidf_(gt[3]) * up[3]);
                    *(uint2*)(d + 64 * bj) = o; } }
    }
};

struct EpiMerge {
    static constexpr bool PERM = false, AFTER_DRAIN = false;
    const bf16_t* plo; const bf16_t* phi; bf16_t* out; const float* rs;
    __device__ __forceinline__ void operator()(const pg8::f32x4 (&acc)[2][2][4][2], const pg8::Unit& u, int wr, int wc, int fr, int fq) const {
        const int row0 = mt_row0(u.pm) + wr * 64 + fr;
        const int col = u.pn * 64 + wc * 16 + fq * 4;
        uint2 pp[8][4]; float scv[8];
#pragma unroll
        for (int q = 0; q < 8; ++q) {
            const int row = row0 + (q >> 2) * 128 + (q & 3) * 16;
            pp[q][0] = *(const uint2*)(plo + (size_t)row * 2048 + col); pp[q][1] = *(const uint2*)(plo + (size_t)row * 2048 + 1024 + col);
            pp[q][2] = *(const uint2*)(phi + (size_t)row * 2048 + col); pp[q][3] = *(const uint2*)(phi + (size_t)row * 2048 + 1024 + col);
            scv[q] = rs[row];
        }
        __builtin_amdgcn_sched_barrier(0);
#pragma unroll
        for (int q = 0; q < 8; ++q) {
            const int ai = q >> 2, m = q & 3, row = row0 + ai * 128 + m * 16;
            const float sc = scv[q];
            float o0, o1, o2, o3;
            { const pg8::f32x4 v = acc[ai][0][m][0]; const uint2 pv = pp[q][0]; o0 = sigmoidf_(v[0] * sc) * lo_bf(pv.x); o1 = sigmoidf_(v[1] * sc) * hi_bf(pv.x); o2 = sigmoidf_(v[2] * sc) * lo_bf(pv.y); o3 = sigmoidf_(v[3] * sc) * hi_bf(pv.y); }
            { const pg8::f32x4 v = acc[ai][0][m][1]; const uint2 pv = pp[q][1]; o0 += sigmoidf_(v[0] * sc) * lo_bf(pv.x); o1 += sigmoidf_(v[1] * sc) * hi_bf(pv.x); o2 += sigmoidf_(v[2] * sc) * lo_bf(pv.y); o3 += sigmoidf_(v[3] * sc) * hi_bf(pv.y); }
            { const pg8::f32x4 v = acc[ai][1][m][0]; const uint2 pv = pp[q][2]; o0 += sigmoidf_(v[0] * sc) * lo_bf(pv.x); o1 += sigmoidf_(v[1] * sc) * hi_bf(pv.x); o2 += sigmoidf_(v[2] * sc) * lo_bf(pv.y); o3 += sigmoidf_(v[3] * sc) * hi_bf(pv.y); }
            { const pg8::f32x4 v = acc[ai][1][m][1]; const uint2 pv = pp[q][3]; o0 += sigmoidf_(v[0] * sc) * lo_bf(pv.x); o1 += sigmoidf_(v[1] * sc) * hi_bf(pv.x); o2 += sigmoidf_(v[2] * sc) * lo_bf(pv.y); o3 += sigmoidf_(v[3] * sc) * hi_bf(pv.y); }
            uint2 wv; wv.x = pk2(o0, o1); wv.y = pk2(o2, o3);
            *(uint2*)(out + (size_t)row * DM + col) = wv;
        }
    }
};
#define GEMM_TILE_LOOP(NM_, NN_, mt, nt, BODY) do { \
    const int _SN = ((NN_) + 3) >> 2, _SM = ((NM_) + 7) >> 3, _nx = (int)gridDim.x >> 3, _xcd = (int)blockIdx.x & 7; \
    if (((int)gridDim.x & 7) == 0) { \
        for (int _s = _xcd; _s < _SM * _SN; _s += 8) \
            for (int _jj = (int)blockIdx.x >> 3; _jj < 32; _jj += _nx) { \
                const int mt = (_s / _SN) * 8 + (_jj & 7), nt = (_s % _SN) * 4 + (_jj >> 3); \
                if (mt < (NM_) && nt < (NN_)) { BODY; } } \
    } else { for (int _u = (int)blockIdx.x; _u < (NM_) * (NN_); _u += (int)gridDim.x) { const int mt = _u / (NN_), nt = _u % (NN_); BODY; } } \
} while (0)
NOINL void f_p0() { const Params& p = kparams(); char* lds = lds_at(256); UNIT_LOOP(u, 320, 0) { if (u < 192) mod_unit(p, u, lds); else rope_unit(p, u - 192); } }
NOINL void f_norm1(int l) { const Params& p = kparams(); const int rpb = (TT + (int)gridDim.x - 1) / (int)gridDim.x, r0 = (int)blockIdx.x * rpb; norm_rows(p, l, r0, min(TT, r0 + rpb), 0); }
NOINL void f_conv(int l) {
    const Params& p = kparams(); char* lds = lds_at(256);
    const int G = (int)gridDim.x; int u = (int)((blockIdx.x + G - (544 % G)) % G);
    float4 va[4], vb[4];
    if (u < CJ_END) conv_unit<0>(p, l, u, lds, va);
    for (;;) {
        if (u >= CJ_END) break;
        { const int un = u + G; conv_unit<0>(p, l, un < CJ_END ? un : u, lds, vb); conv_unit<1>(p, l, u, lds, va); u = un; }
        if (u >= CJ_END) break;
        { const int un = u + G; conv_unit<0>(p, l, un < CJ_END ? un : u, lds, va); conv_unit<1>(p, l, u, lds, vb); u = un; }
    }
}
NOINL void f_h2tab(int l) { const Params& p = kparams(); char* lds = lds_at(256); UNIT_LOOP(u, 68, 544 + CJ_END) h2tab_unit(p, l, u, lds); }
NOINL void f_spectrum(int l) {
    const Params& p = kparams(); char* lds = lds_at(256);
    UNIT_LOOP(u, 512, 0) spectrum8192_unit(p, l, u >> 8, u & 255, lds);
}
NOINL void f_spectrum_ctx(int l) {
    const Params& p = kparams(); char* lds = lds_at(256);
    const int b0 = (int)gridDim.x >= 232 ? 200 : 0;
    for (int u = (int)blockIdx.x - b0; u >= 0 && u < 32; u += (int)gridDim.x) spectrum512_unit(p, l, u, lds);
}
NOINL void f_inproj(int off) {
    const Params& p = kparams();
    pg8::Gemm g{(const bf16_t*)(p.ws + OFF_H), (const bf16_t*)(p.ws + OFF_WIN), TT, WIN_G0, 1024};
    pg8::StaticOrder S; S.init(TT, WIN_G0, (int)gridDim.x, (int)blockIdx.x);
    EpiInproj E{(bf16_t*)(p.ws + OFF_Z), (bf16_t*)(p.ws + OFF_ZT)};
    __syncthreads();
    pg8::gemm_phase<EpiInproj, pg8::StaticOrder, false>((PG8_LAS unsigned char*)(uintptr_t)256, g, S, E, nullptr);
    __syncthreads();
}
NOINL void f_hyena(int l) { const Params& p = kparams(); char* lds = lds_at(256); const int n = l == 0 ? 1088 : 1024; UNIT_LOOP(u, n, 0) hyena_unit(p, l, u, lds); }
NOINL void f_na(int l, int off) { const Params& p = kparams(); char* lds = lds_at(256); const int n = l == 0 ? 544 : 512; UNIT_LOOP(u, n, off) na_unit(p, l, u, lds); }
NOINL void f_lru1(int l, int off) { const Params& p = kparams(); char* lds = lds_at(256); UNIT_LOOP(u, 1088, off) lru1_unit(p, l, u, lds); }
NOINL void f_qproj(int off) { const Params& p = kparams(); char* lds = lds_at(256); UNIT_LOOP(u, NMT * 2, off) qproj_unit(p, u, lds); }
NOINL void f_kvproj(int off) { const Params& p = kparams(); char* lds = lds_at(256); UNIT_LOOP(u, NMT * 2, off) kvproj_unit(p, u, lds); }
NOINL void f_mla(int l) { const Params& p = kparams(); char* lds = lds_at(256); const int n = l == 0 ? 544 : 512; UNIT_LOOP(u, n, 0) mla_unit(p, u, lds); }
NOINL void f_ytrans(int off) { const Params& p = kparams(); char* lds = lds_at(256); UNIT_LOOP(u, 544, off) ytrans_unit(p, u, lds); }
NOINL void f_lrucarry(int l) { const Params& p = kparams(); UNIT_LOOP(u, 8, 0) lru_carry_unit(p, l, u); }
NOINL void f_lru2(int l, int off) { const Params& p = kparams(); UNIT_LOOP(u, 272, off) lru2_unit(p, l, u); }
NOINL void f_quant(int nmt) {
    const Params& p = kparams(); const int rows = nmt * 256;
    int nb = (int)gridDim.x, b = (int)blockIdx.x;
    const int extra = nmt * 8 - (nmt * 8 / nb) * nb;
    if (extra > 0 && extra * 2 <= nb) { if (b < extra) return; b -= extra; nb -= extra; }
    const int rpb = (rows + nb - 1) / nb, r0 = b * rpb;
    quant_rows(p, r0, min(rows, r0 + rpb));
}
NOINL void f_pbranch(int nmt) { const Params& p = kparams(); char* lds = lds_at(256); UNIT_LOOP(u, nmt * 8, 0) pbranch_unit(p, u, lds); }
NOINL void f_merge(int nmt) {
    const Params& p = kparams();
    pg8::Gemm g{(const bf16_t*)(p.ws + OFF_H8), (const bf16_t*)(p.ws + OFF_WG8), nmt * 256, 4096, 512};
    pg8::StaticOrder S; S.init(nmt * 256, 4096, (int)gridDim.x, (int)blockIdx.x);
    EpiMerge E{(const bf16_t*)(p.ws + OFF_PLO), (const bf16_t*)(p.ws + OFF_PHI), (bf16_t*)(p.ws + OFF_ACC), (const float*)(p.ws + OFF_RS)};
    __syncthreads();
    pg8::gemm_phase<EpiMerge, pg8::StaticOrder, false, true>((PG8_LAS unsigned char*)(uintptr_t)256, g, S, E, nullptr);
    __syncthreads();
}
NOINL void f_wout(int l, int nmt) {
    const Params& p = kparams();
    pg8::Gemm g{(const bf16_t*)(p.ws + OFF_ACC), (const bf16_t*)(p.ws + OFF_WOUT), nmt * 256, 1024, 1024};
    pg8::StaticOrder S; S.init(nmt * 256, 1024, (int)gridDim.x, (int)blockIdx.x);
    EpiWout E{l == 0 ? p.in[I_X] : p.out, l == 0 ? p.in[I_CTX] : (const float*)(p.ws + OFF_XC), p.out, (float*)(p.ws + OFF_XC), (const float*)(p.ws + OFF_MOD) + (size_t)l * 9 * 6144 + 2048};
    __syncthreads();
    pg8::gemm_phase<EpiWout, pg8::StaticOrder, false>((PG8_LAS unsigned char*)(uintptr_t)256, g, S, E, nullptr);
    __syncthreads();
}
NOINL void f_router(int l, int nmt) { const Params& p = kparams(); char* lds = lds_at(256); const int tot = nmt * 256, rpb = (tot + (int)gridDim.x - 1) / (int)gridDim.x, r0 = (int)blockIdx.x * rpb; if (r0 < tot) router_unit(p, l, r0, min(tot, r0 + rpb), lds); }
NOINL void f_moe1(int l, int nmt) {
    const Params& p = kparams(); char* lds = lds_at(256);
    const MoeTab t = moe_tables(p, l, nmt * 256, lds);
    const int nrb = t.blkbase[65];
    pg8::Gemm g{(const bf16_t*)(p.ws + OFF_H), (const bf16_t*)(p.ws + OFF_WGU), nrb * 256, 512, 1024};
    Moe1Order S; S.init(nrb * 256, 512, (int)gridDim.x, (int)blockIdx.x);
    S.eb = (const unsigned char*)(t.cbase + 80); S.blkbase = t.blkbase; S.cnt = t.cnt; S.list = (const int*)(p.ws + OFF_LIST);
    EpiMoe1 E{(bf16_t*)(p.ws + OFF_HID)};
    __syncthreads();
    pg8::gemm_phase_gather<EpiMoe1, Moe1Order, false>((PG8_LAS unsigned char*)(uintptr_t)256, g, S, E, nullptr);
    __syncthreads();
}
NOINL void f_moe2(int l, int nmt) { const Params& p = kparams(); char* lds = lds_at(256); const MoeTab t = moe_tables(p, l, nmt * 256, lds); const int nrb = t.blkbase[65], s0 = t.blkbase[64];
    UNIT_LOOP(u, nrb, 0) { int rb = u + s0; if (rb >= nrb) rb -= nrb; moe2_unit(p, l, t, rb, lds); } }
NOINL void f_combine(int l, int nmt) { const Params& p = kparams(); char* lds = lds_at(256); const MoeTab t = moe_tables(p, l, nmt * 256, lds); const int tot = nmt * 256, rpb = (tot + (int)gridDim.x - 1) / (int)gridDim.x, r0 = (int)blockIdx.x * rpb; combine_unit(p, l, t, r0, min(tot, r0 + rpb)); }


#ifdef DIAG
struct DiagBuf { size_t off; size_t n; int kind; };
DEVI void diag_phase(const Params& p, const XcdBarrier& bar) {
    const DiagBuf bufs[] = {
        {OFF_MOD, 2 * 9 * 6144, 1}, {OFF_COS, 2 * 4096 * 16, 1}, {OFF_H2T, 4352 * 64, 1}, {OFF_WIN, (size_t)(WIN_G0 + 4096) * 1024, 0}, {OFF_WGU, (size_t)65 * 512 * 1024, 0},
        {OFF_WDT, (size_t)65 * 1024 * 256, 0}, {OFF_WUQ, (OFF_H - OFF_WUQ) / 2, 0}, {OFF_H, (size_t)TT * DM, 0}, {OFF_HS, (size_t)2 * 256 * 8192 * 2, 1}, {OFF_HSC, (size_t)2 * 256 * 512 * 2, 1},
        {OFF_Z, (size_t)TT * ZLD, 0}, {OFF_ZT, (size_t)8 * 1024 * NKEY, 0}, {OFF_YT, (size_t)8 * 256 * NKEY, 0}, {OFF_Q, (size_t)8 * 4 * NKEY * 96, 0}, {OFF_K, (size_t)8 * 4 * NKEY * 96, 0},
        {OFF_VT, (size_t)8 * 4 * 64 * NKEY, 0}, {OFF_HLOC, (size_t)2 * TT * 256, 0}, {OFF_CUMA, (size_t)2 * TT * 256, 0}, {OFF_SEGA, (size_t)4 * 1088 * 256, 1}, {OFF_BR, (size_t)TT * DM, 0},
        {OFF_XC, (size_t)TCX * DM, 1}, {OFF_WTS, (size_t)TT * 6, 1} };
    constexpr int NB = sizeof(bufs) / sizeof(bufs[0]);
    unsigned* flags = (unsigned*)(p.ws + OFF_GCNT) + 1024;
    xcd_barrier(bar);
    const size_t gtid = (size_t)blockIdx.x * 512 + threadIdx.x, gn = (size_t)gridDim.x * 512;
    for (int b = DIAG_FIRST; b < NB; ++b) {
        unsigned bad = 0, poi = 0;
        if (bufs[b].kind == 0) { const bf16_t* q = (const bf16_t*)(p.ws + bufs[b].off);
            for (size_t i = gtid; i < bufs[b].n; i += gn) { const unsigned v = q[i]; if ((v & 0x7F80u) == 0x7F80u || fabsf(bf2f((bf16_t)v)) > 1e5f) ++bad; if (v == 0xAAAAu) ++poi; } }
        else { const unsigned* q = (const unsigned*)(p.ws + bufs[b].off);
            for (size_t i = gtid; i < bufs[b].n; i += gn) { const unsigned v = q[i]; if ((v & 0x7F800000u) == 0x7F800000u || fabsf(__uint_as_float(v)) > 1e5f) ++bad; if (v == 0xAAAAAAAAu) ++poi; } }
        bad = (unsigned)wave_sum((float)bad); poi = (unsigned)wave_sum((float)poi);
        if ((threadIdx.x & 63) == 0) { if (bad) atomicAdd(&flags[2 * b], bad); if (poi) atomicAdd(&flags[2 * b + 1], poi); }
    }
    xcd_barrier(bar);
    float K = 1000.f, K2 = 0.f;
    for (int b = NB - 1; b >= DIAG_FIRST; --b) {
        const unsigned bad = __hip_atomic_load(&flags[2 * b], __ATOMIC_RELAXED, __HIP_MEMORY_SCOPE_AGENT), poi = __hip_atomic_load(&flags[2 * b + 1], __ATOMIC_RELAXED, __HIP_MEMORY_SCOPE_AGENT);
        if (bad) K = 1000.f * (float)(10 + b);
        else if ((size_t)poi * 2 > bufs[b].n) K = 1000.f * (float)(50 + b);
    }
#if DIAG_MODE == 1
    {
        float* acc = (float*)((unsigned*)(p.ws + OFF_GCNT) + 2048);
        float s = 0.f; const int b = DIAG_ARG;
        if (bufs[b].kind == 0) { const bf16_t* q = (const bf16_t*)(p.ws + bufs[b].off); for (size_t i = gtid; i < bufs[b].n; i += gn) { const float v = bf2f(q[i]); s += v * v; } }
        else { const float* q = (const float*)(p.ws + bufs[b].off); for (size_t i = gtid; i < bufs[b].n; i += gn) { const float v = q[i]; s += v * v; } }
        s = wave_sum(s); if ((threadIdx.x & 63) == 0) atomicAdd(acc, s);
        xcd_barrier(bar);
        K = 1000.f * sqrtf(__hip_atomic_load(acc, __ATOMIC_RELAXED, __HIP_MEMORY_SCOPE_AGENT) / (float)bufs[b].n);
    }
#elif DIAG_MODE == 5
    {
        unsigned* cn = (unsigned*)(p.ws + OFF_GCNT) + 2048;
        unsigned nn = 0, nz = 0;
        const unsigned char* q = (const unsigned char*)(p.ws + OFF_H8);
        for (size_t i = gtid; i < (size_t)TT * 1024; i += gn) { const unsigned v = q[i]; if ((v & 0x7Fu) == 0x7Fu) ++nz; }
        q = (const unsigned char*)(p.ws + OFF_WG8);
        for (size_t i = gtid; i < (size_t)4096 * 1024; i += gn) { const unsigned v = q[i]; if ((v & 0x7Fu) == 0x7Fu) ++nn; }
        nn = (unsigned)wave_sum((float)nn); nz = (unsigned)wave_sum((float)nz);
        if ((threadIdx.x & 63) == 0) { if (nn) atomicAdd(&cn[0], nn); if (nz) atomicAdd(&cn[1], nz); }
        xcd_barrier(bar);
        K = (float)__hip_atomic_load(&cn[0], __ATOMIC_RELAXED, __HIP_MEMORY_SCOPE_AGENT);
        K2 = (float)__hip_atomic_load(&cn[1], __ATOMIC_RELAXED, __HIP_MEMORY_SCOPE_AGENT);
    }
#elif DIAG_MODE == 2
    K = (float)__hip_atomic_load(&flags[2 * DIAG_ARG], __ATOMIC_RELAXED, __HIP_MEMORY_SCOPE_AGENT);
#elif DIAG_MODE == 3
    {
        unsigned* mn = (unsigned*)(p.ws + OFF_GCNT) + 2048;
        if (blockIdx.x == 0 && threadIdx.x == 0) __hip_atomic_store(mn, 0xFFFFFFFFu, __ATOMIC_RELAXED, __HIP_MEMORY_SCOPE_AGENT);
        xcd_barrier(bar);
        const int b = DIAG_ARG; unsigned best = 0xFFFFFFFFu;
        if (bufs[b].kind == 0) { const bf16_t* q = (const bf16_t*)(p.ws + bufs[b].off);
            for (size_t i = gtid; i < bufs[b].n; i += gn) { const unsigned v = q[i]; if (((v & 0x7F80u) == 0x7F80u || fabsf(bf2f((bf16_t)v)) > 1e5f) && (unsigned)i < best) best = (unsigned)i; } }
        if (best != 0xFFFFFFFFu) atomicMin(mn, best);
        xcd_barrier(bar);
        const unsigned r = __hip_atomic_load(mn, __ATOMIC_RELAXED, __HIP_MEMORY_SCOPE_AGENT);
        K = (float)((r / DIAG_DIV) % DIAG_MOD);
        K2 = 1000.f * (float)((r / DIAG_DIV2) % DIAG_MOD2);
#ifdef DIAG_ROW0
        { const bf16_t* q = (const bf16_t*)(p.ws + bufs[b].off); int cnt = 0, cnt2 = 0;
          for (int c2 = 0; c2 < ZLD; ++c2) { const unsigned v = q[(size_t)DIAG_ROW0 * ZLD + c2]; if ((v & 0x7F80u) == 0x7F80u) ++cnt; }
          for (int r2 = 0; r2 < 99; ++r2) { const unsigned v = q[(size_t)r2 * ZLD + DIAG_COL0]; if ((v & 0x7F80u) == 0x7F80u) ++cnt2; }
          K = (float)cnt; K2 = 1000.f * (float)cnt2; }
#endif
#ifdef DIAG_VAL
        { const unsigned v = ((const bf16_t*)(p.ws + bufs[b].off))[r]; const float f = fabsf(bf2f((bf16_t)v)); K = ((v & 0x7F80u) == 0x7F80u) ? ((v & 0x7Fu) ? 49.f : 48.f) : fminf(47.f, log2f(f) * 0.25f); }
#endif
    }
#endif
    for (size_t i = gtid; i < (size_t)TL * DM; i += gn) p.out[i] = (i == 12345 && K2 != 0.f) ? K2 : K;
}
#endif

__global__ void __launch_bounds__(512, 2) mega_fwd(Params p) {
    if (threadIdx.x == 0) *(uint4*)smem = make_uint4(0u, 0u, 0u, 0u);
    __syncthreads();
    XcdBarrier bar = xcd_barrier_post((unsigned*)(p.ws + OFF_BAR), (volatile LAS unsigned*)smem);
    int ph = 0;
#ifdef DIAGT
#define STAMP(i) do { if (blockIdx.x == 0 && threadIdx.x == 0) ((unsigned long long*)(p.ws + OFF_GCNT + 8192))[i] = wall_clock64(); } while (0)
#else
#define STAMP(i) do {} while (0)
#endif
#ifndef REP_PHASE
#define REP_PHASE -1
#endif
#define PHASE(...) do { if (ph >= p.ph_lo && ph < p.ph_hi) { STAMP(ph); __VA_ARGS__; if (ph == REP_PHASE) { xcd_barrier(bar); __VA_ARGS__; } if (ph + 1 < p.ph_hi) xcd_barrier(bar); } ++ph; } while (0)
    PHASE({ f_p0(); f_conv(0); f_h2tab(0); });
#define LAYER(l) do { \
        const int nmt = l == 0 ? NMT : 128; \
        PHASE({ f_norm1(l); if (l > 0) { f_conv(l); f_h2tab(l); } }); \
        PHASE({ f_spectrum(l); f_inproj(0); if (l == 0) f_spectrum_ctx(l); }); \
        PHASE({ const int nh = l == 0 ? 1088 : 1024, nn = l == 0 ? 544 : 512; f_hyena(l); f_na(l, nh); f_lru1(l, nh + nn); f_qproj(nh + nn + 1088); f_kvproj(nh + nn + 1088 + NMT * 2); }); \
        PHASE({ f_lrucarry(l); f_mla(l); f_lru2(l, l == 0 ? 544 : 512); f_ytrans((l == 0 ? 544 : 512) + 272); }); \
        PHASE({ f_quant(nmt); f_pbranch(nmt); }); \
        PHASE(f_merge(nmt)); \
        PHASE(f_wout(l, nmt)); \
        PHASE(f_router(l, nmt)); \
        PHASE(f_moe1(l, nmt)); \
        PHASE(f_moe2(l, nmt)); \
        PHASE(f_combine(l, nmt)); \
    } while (0)
    LAYER(0);
    LAYER(1);
#ifdef DIAG
    diag_phase(p, bar);
#endif
#ifdef DIAGT
    {
        xcd_barrier(bar); STAMP(ph); xcd_barrier(bar);
        const unsigned long long* ts = (const unsigned long long*)(p.ws + OFF_GCNT + 8192);
        const float K = (float)(__hip_atomic_load(ts + DIAGT_A + 1, __ATOMIC_RELAXED, __HIP_MEMORY_SCOPE_AGENT) - __hip_atomic_load(ts + DIAGT_A, __ATOMIC_RELAXED, __HIP_MEMORY_SCOPE_AGENT)) * 0.01f;
        const float K2 = (float)(__hip_atomic_load(ts + DIAGT_B + 1, __ATOMIC_RELAXED, __HIP_MEMORY_SCOPE_AGENT) - __hip_atomic_load(ts + DIAGT_B, __ATOMIC_RELAXED, __HIP_MEMORY_SCOPE_AGENT)) * 1.0f;
        const size_t gtid = (size_t)blockIdx.x * 512 + threadIdx.x, gn = (size_t)gridDim.x * 512;
        for (size_t i = gtid; i < (size_t)TL * DM; i += gn) p.out[i] = (i == 12345) ? K2 : K;
    }
#endif
}

extern "C" void kernel_launch(void* const* d_in, const int* in_sizes, int n_in, void* d_out, int out_size, void* d_ws, size_t ws_size, hipStream_t stream) {
    static int grid = 0;
    if (!grid) {
        int dev = 0, cus = 0, per_cu = 0;
        hipGetDevice(&dev);
        hipDeviceGetAttribute(&cus, hipDeviceAttributeMultiprocessorCount, dev);
        if (hipFuncSetAttribute((const void*)mega_fwd, hipFuncAttributeMaxDynamicSharedMemorySize, LDS_BYTES + 256) != hipSuccess) fprintf(stderr, "hipFuncSetAttribute failed\n");
        if (hipOccupancyMaxActiveBlocksPerMultiprocessor(&per_cu, (const void*)mega_fwd, 512, LDS_BYTES + 256) != hipSuccess || per_cu < 1) { fprintf(stderr, "occupancy query failed\n"); per_cu = 1; }
        grid = cus * 1;
        if (ws_size < WS_END) fprintf(stderr, "workspace too small: %zu < %zu\n", ws_size, (size_t)WS_END);
    }
    hipMemsetAsync(d_ws, 0, ZERO_BYTES, stream);
    Params p{};
    for (int i = 0; i < 41; ++i) p.in[i] = (const float*)d_in[i];
    p.out = (float*)d_out; p.ws = (char*)d_ws; p.ph_lo = 0; p.ph_hi = PH_HI;
    hipLaunchKernelGGL(mega_fwd, dim3(grid), dim3(512), LDS_BYTES + 256, stream, p);
}
```

```cpp
#include <hip/hip_runtime.h>
#include <stdint.h>
#include <stdio.h>

typedef unsigned short bf16_t;
typedef short bf16x8 __attribute__((ext_vector_type(8)));
typedef float f32x16 __attribute__((ext_vector_type(16)));
typedef unsigned u32x4 __attribute__((ext_vector_type(4)));

#define DEVI __device__ __forceinline__

constexpr int DM = 1024, TL = 32768, TCX = 2048, TT = 34816, NKEY = 4352;
constexpr int ZLD = 1408;
constexpr int NIN = 2432;
constexpr int WIN_G0 = 2560;
constexpr int NMT = 136;
constexpr int ZC_QL = 0, ZC_KVL = 192, ZC_KR = 320, ZC_NAQ = 384, ZC_NAK = 640, ZC_LU = 896, ZC_LG = 1152;
constexpr int ZT_NAV = 0, ZT_HY = 256;

constexpr size_t AL(size_t x) { return (x + 255) & ~(size_t)255; }
constexpr size_t OFF_BAR = 0;
constexpr size_t OFF_GCNT = 16384;
constexpr size_t ZERO_BYTES = 32768;
constexpr size_t OFF_MOD = 32768;
constexpr size_t OFF_COS = OFF_MOD + AL(2 * 9 * 6144 * 4);
constexpr size_t OFF_SIN = OFF_COS + 4096 * 16 * 4;
constexpr size_t OFF_H2T = OFF_SIN + 4096 * 16 * 4;
constexpr size_t OFF_SEGA = OFF_H2T + 4352 * 64 * 4;
constexpr size_t OFF_SEGB = OFF_SEGA + 2 * 1088 * 256 * 4;
constexpr size_t OFF_LWT = OFF_SEGB + 2 * 1088 * 256 * 4;
constexpr size_t OFF_HIN = OFF_LWT + 16 * 64 * 64 * 2;
constexpr size_t OFF_TOKS = OFF_HIN + 2 * 1088 * 256 * 4;
constexpr size_t OFF_WTS = OFF_TOKS + AL((size_t)TT * 6 * 4);
constexpr size_t OFF_XC = OFF_WTS + AL((size_t)TT * 6 * 4);
constexpr size_t OFF_LIST = OFF_XC + (size_t)TCX * DM * 4;
constexpr size_t OFF_WDT = OFF_LIST + (size_t)64 * TT * 4;
constexpr size_t OFF_ZBIG = OFF_WDT + (size_t)65 * 1024 * 256 * 2;
constexpr size_t OFF_Z = OFF_ZBIG;
constexpr size_t OFF_ZT = OFF_Z + (size_t)TT * ZLD * 2;
constexpr size_t ZBIG_BYTES = (size_t)TT * ZLD * 2 + (size_t)8 * 1024 * NKEY * 2;
constexpr size_t OFF_PHI = OFF_ZBIG;
constexpr size_t OFF_HID = OFF_ZBIG;
constexpr size_t HID_BYTES = (size_t)1016 * 256 * 256 * 2;
constexpr size_t OFF_Y = OFF_ZBIG + HID_BYTES;
constexpr size_t Y_BYTES = (size_t)TT * 6 * DM * 2;
constexpr size_t OFF_WGU = OFF_ZBIG + ZBIG_BYTES;
constexpr size_t OFF_WIN = OFF_WGU + (size_t)65 * 512 * 1024 * 2;
constexpr size_t OFF_WUQ = OFF_WIN + (size_t)(WIN_G0 + 4096) * 1024 * 2;
constexpr size_t OFF_WUKV = OFF_WUQ + 384 * 192 * 2;
constexpr size_t OFF_WBR = OFF_WUKV + 512 * 128 * 2;
constexpr size_t OFF_WOUT = OFF_WBR + 4 * 1024 * 256 * 2;
constexpr size_t OFF_RT = OFF_WOUT + 1024 * 1024 * 2;
constexpr size_t OFF_H = OFF_RT + 128 * 1024 * 2;
constexpr size_t OFF_BR = OFF_H + (size_t)TT * DM * 2;
constexpr size_t OFF_ACC = OFF_BR;
constexpr size_t OFF_YT = OFF_BR + (size_t)TT * DM * 2;
constexpr size_t OFF_PLO = OFF_YT;
constexpr size_t OFF_Q = OFF_YT + (size_t)8 * 256 * NKEY * 2;
constexpr size_t OFF_K = OFF_Q + (size_t)8 * 4 * NKEY * 96 * 2;
constexpr size_t OFF_VT = OFF_K + (size_t)8 * 4 * NKEY * 96 * 2;
constexpr size_t OFF_HS = OFF_VT + (size_t)8 * 4 * 64 * NKEY * 2;
constexpr size_t OFF_HSC = OFF_HS + (size_t)2 * 256 * 8192 * 8;
constexpr size_t OFF_HLOC = OFF_HSC + (size_t)2 * 256 * 512 * 8;
constexpr size_t OFF_CUMA = OFF_HLOC + (size_t)2 * TT * 256 * 2;
constexpr size_t WS_END = OFF_CUMA + (size_t)2 * TT * 256 * 2;
constexpr size_t OFF_WG8 = OFF_WIN + (size_t)WIN_G0 * 1024 * 2;
constexpr size_t OFF_H8 = OFF_CUMA;
static_assert(OFF_PLO + (size_t)TT * 4096 <= OFF_CUMA, "P_lo must not reach h8");
constexpr size_t OFF_RS = OFF_SEGA;
constexpr float WG8_SCALE = 512.f;
static_assert(OFF_Y + Y_BYTES <= WS_END, "Y must fit inside the workspace map");
static_assert(OFF_PLO + (size_t)TT * 4096 <= WS_END && OFF_PHI + (size_t)TT * 4096 <= OFF_ZBIG + ZBIG_BYTES, "P halves must fit the dead regions");
static_assert(OFF_Y >= OFF_HID + HID_BYTES, "Y vs hid");
static_assert(WS_END < (size_t)670 * 1000 * 1000, "workspace too large");

constexpr int LDS_BYTES = 147456;
#ifndef PH_HI
#define PH_HI 1000
#define DIAGT_A 1
#define DIAGT_B 2
#define DIAG_FIRST 0
#define DIAG_MODE 0
#define DIAG_ARG 10
#define DIAG_DIV 1408
#define DIAG_MOD 50
#define DIAG_DIV2 (1408 * 400)
#define DIAG_MOD2 100
#endif

struct Params {
    const float* in[41];
    float* out;
    char* ws;
    int ph_lo, ph_hi;
};

enum { I_X = 0, I_C, I_CTX, I_CCTX, I_WMOD, I_BMOD, I_GN1, I_GN2, I_WIN, I_GQ, I_WUQ, I_GKV, I_WUKV, I_RPB, I_HSW, I_HSB, I_HW1, I_HB1, I_HW2,
       I_HB2, I_HW3, I_HDEC, I_HBIAS, I_LCW, I_LCB, I_LWA, I_LBA, I_LWX, I_LBX, I_LLAM, I_WBR, I_WOUT, I_RW, I_RB, I_EG, I_EU, I_ED, I_SG, I_SU,
       I_SD, I_GF };

#define XB_TMO      128
#define XB_XCNT(j)  (256  + 64 * (j))
#define XB_XSUB(j)  (1280 + 64 * (j))
#define XB_XGEN(j)  (2304 + 64 * (j))
#define XB_TOP      3328
#define XB_TOPGEN   3392
#define XCD_BAR_WORDS 3456
#define XB_SPIN_CAP (1u << 18)
#define LAS __attribute__((address_space(3)))

__device__ __forceinline__ unsigned xb_ld(unsigned* p)              { return __hip_atomic_load(p, __ATOMIC_RELAXED, __HIP_MEMORY_SCOPE_AGENT); }
__device__ __forceinline__ unsigned xb_add(unsigned* p, unsigned v) { return __hip_atomic_fetch_add(p, v, __ATOMIC_RELAXED, __HIP_MEMORY_SCOPE_AGENT); }
__device__ __forceinline__ unsigned xb_xcc_id() { return (unsigned)__builtin_amdgcn_s_getreg((3 << 11) | 20) & 0xFu; }
#define XB_SPIN(cond, bar) do { unsigned _sp = 0; while (cond) { __builtin_amdgcn_s_sleep(1); \
    if ((++_sp & 255u) == 0u) { if (xb_ld(&(bar)[XB_TMO])) break; if (_sp > XB_SPIN_CAP) { atomicAdd(&(bar)[XB_TMO], 1u); break; } } } } while (0)

struct XcdBarrier { unsigned* bar; unsigned x; volatile LAS unsigned* st; };

__device__ __forceinline__ XcdBarrier xcd_barrier_post(unsigned* bar, volatile LAS unsigned* st) {
    XcdBarrier b; b.bar = bar; b.x = xb_xcc_id(); b.st = st;
    if (threadIdx.x == 0) (void)xb_add(&bar[XB_XCNT(b.x)], 1u);
    return b;
}
__device__ __forceinline__ void xcd_barrier_complete(unsigned* bar, unsigned x, unsigned& nloc, unsigned& nx) {
    const unsigned G = gridDim.x * gridDim.y * gridDim.z;
    unsigned sum, cnt, mine, sp = 0u;
    for (;;) {
        sum = 0u; cnt = 0u; mine = 0u;
#pragma unroll
        for (unsigned j = 0; j < 16; ++j) { const unsigned c = xb_ld(&bar[XB_XCNT(j)]); sum += c; cnt += (c > 0u) ? 1u : 0u; mine = (j == x) ? c : mine; }
        if (sum == G) break;
        __builtin_amdgcn_s_sleep(1);
        if ((++sp & 255u) == 0u) { if (xb_ld(&bar[XB_TMO])) break; if (sp > XB_SPIN_CAP) { atomicAdd(&bar[XB_TMO], 1u); break; } }
    }
    nloc = mine > 0u ? mine : 1u; nx = cnt > 0u ? cnt : 1u;
}
__device__ __forceinline__ void xcd_barrier(const XcdBarrier& b) {
    asm volatile("s_waitcnt vmcnt(0)" ::: "memory");
    __syncthreads();
    if (threadIdx.x == 0) {
        unsigned* bar = b.bar;
        __builtin_amdgcn_s_waitcnt(0);
        unsigned nloc = b.st[0], nx = b.st[1];
        if (nloc == 0u) { xcd_barrier_complete(bar, b.x, nloc, nx); b.st[0] = nloc; b.st[1] = nx; }
        const unsigned old = xb_add(&bar[XB_XSUB(b.x)], 1u);
        const unsigned gen = old / nloc;
        if (old + 1u == (gen + 1u) * nloc) {
            __builtin_amdgcn_fence(__ATOMIC_RELEASE, "agent");
            asm volatile("s_waitcnt vmcnt(0)" ::: "memory");
            const unsigned og = xb_add(&bar[XB_TOP], 1u);
            const unsigned tg = og / nx;
            if (og + 1u == (tg + 1u) * nx) xb_add(&bar[XB_TOPGEN], 1u);
            else XB_SPIN(xb_ld(&bar[XB_TOPGEN]) == tg, bar);
            __builtin_amdgcn_fence(__ATOMIC_ACQUIRE, "agent");
            xb_add(&bar[XB_XGEN(b.x)], 1u);
            asm volatile("s_waitcnt vmcnt(0)" ::: "memory");
        } else {
            XB_SPIN(xb_ld(&bar[XB_XGEN(b.x)]) == gen, bar);
            __builtin_amdgcn_fence(__ATOMIC_ACQUIRE, "agent");
            asm volatile("s_waitcnt vmcnt(0)" ::: "memory");
        }
    }
    __syncthreads();
}

extern __shared__ __attribute__((aligned(16))) char smem[];
typedef __attribute__((address_space(4))) const Params CParams;
__device__ __forceinline__ const Params& kparams() { CParams* q = (CParams*)__builtin_amdgcn_kernarg_segment_ptr(); asm volatile("" : "+s"(q)); return *(const Params*)q; }
__device__ __forceinline__ char* lds_at(unsigned off) { return (char*)(LAS char*)(uintptr_t)off; }
#define NOINL __device__ __forceinline__
#define UNIT_LOOP(u, n, off) for (int u = (int)((blockIdx.x + gridDim.x - ((off) % gridDim.x)) % gridDim.x); u < (n); u += gridDim.x)
DEVI int tidx() { int t = threadIdx.x; asm volatile("" : "+v"(t)); return t; }
DEVI float bf2f(bf16_t v) { return __uint_as_float((unsigned)v << 16); }
typedef __bf16 bf16v2 __attribute__((ext_vector_type(2)));
DEVI unsigned pk2(float lo, float hi) { bf16v2 v; v[0] = (__bf16)lo; v[1] = (__bf16)hi; return __builtin_bit_cast(unsigned, v); }
DEVI bf16_t f2bf(float v) { return (bf16_t)(pk2(v, 0.f) & 0xffffu); }
DEVI float lo_bf(unsigned u) { return __uint_as_float(u << 16); }
DEVI float hi_bf(unsigned u) { return __uint_as_float(u & 0xffff0000u); }
DEVI float sigmoidf_(float x) { return __builtin_amdgcn_rcpf(1.f + __expf(-x)); }
DEVI float wave_sum(float v) {
#pragma unroll
    for (int m = 32; m >= 1; m >>= 1) v += __shfl_xor(v, m);
    return v;
}
DEVI float wave_max(float v) {
#pragma unroll
    for (int m = 32; m >= 1; m >>= 1) v = fmaxf(v, __shfl_xor(v, m));
    return v;
}
DEVI unsigned f2e4m3(float x) {
    const unsigned s = (__float_as_uint(x) >> 24) & 0x80u;
    const float a = fminf(fabsf(x), 448.f);
    const unsigned au = __float_as_uint(a);
    const unsigned nrm = ((au + 0x7FFFFu + ((au >> 20) & 1u)) >> 20) - (120u << 3);
    const unsigned sub = (unsigned)__float2int_rn(a * 512.f);
    const unsigned mag = a < 0.015625f ? sub : nrm;
    return mag ? (s | mag) : 0u;
}
DEVI unsigned pk4_fp8(float a, float b, float c, float d) { return f2e4m3(a) | (f2e4m3(b) << 8) | (f2e4m3(c) << 16) | (f2e4m3(d) << 24); }
DEVI int row_b(int r) { return r < TL ? (r >> 12) : ((r - TL) >> 8); }
DEVI int row_key(int r) { return r < TL ? (r & 4095) : (4096 + ((r - TL) & 255)); }
DEVI int row_mod(int r) { return r < TL ? (r >> 12) : 8; }
DEVI const float* xsrc(const Params& p, int l, int r) {
    if (l == 0) return r < TL ? p.in[I_X] + (size_t)r * DM : p.in[I_CTX] + (size_t)(r - TL) * DM;
    return r < TL ? p.out + (size_t)r * DM : (const float*)(p.ws + OFF_XC) + (size_t)(r - TL) * DM;
}
DEVI float* xdst(const Params& p, int r) { return r < TL ? p.out + (size_t)r * DM : (float*)(p.ws + OFF_XC) + (size_t)(r - TL) * DM; }
DEVI int mt_row0(int mt) { return mt < 128 ? mt * 256 : TL + (mt - 128) * 256; }

#define MFMA(a, b, c) __builtin_amdgcn_mfma_f32_32x32x16_bf16((a), (b), (c), 0, 0, 0)

constexpr int G_LD = 72;
constexpr int G_ASZ = 256 * G_LD * 2;
constexpr int G_BSZ = 128 * G_LD * 2;
constexpr int G_STAGE = G_ASZ + G_BSZ;
constexpr int G_LDS = 2 * G_STAGE;

struct RowLoader {
    const bf16_t* p0; const bf16_t* p1; const bf16_t* p2; const bf16_t* p3; int soff;
    u32x4 r0, r1, r2, r3;
    DEVI void issue(int k0) { r0 = *(const u32x4*)(p0 + k0); r1 = *(const u32x4*)(p1 + k0); r2 = *(const u32x4*)(p2 + k0); r3 = *(const u32x4*)(p3 + k0); }
    DEVI void commit(bf16_t* As) const {
        *(u32x4*)(As + soff) = r0; *(u32x4*)(As + soff + 64 * G_LD) = r1; *(u32x4*)(As + soff + 128 * G_LD) = r2; *(u32x4*)(As + soff + 192 * G_LD) = r3;
    }
};

template <bool SW, int NI, class AL_>
DEVI void gemm_mainloop(f32x16 (&acc)[2][NI], AL_ al0, const bf16_t* __restrict__ Bt, int ldb, int K, char* lds) {
    const int tid = tidx(), lane = tid & 63, w = tid >> 6, wm = w >> 1, wn = w & 1, l31 = lane & 31, hh = lane >> 5;
    const int lr = tid >> 3, kc = (tid & 7) * 8;
    const bf16_t* bp0 = Bt + (size_t)lr * ldb + kc;
    const bf16_t* bp1 = Bt + (size_t)(lr + 64) * ldb + kc;
    AL_ al1 = al0;
    u32x4 b00, b01, b10, b11;
#pragma unroll
    for (int mi = 0; mi < 2; ++mi)
#pragma unroll
        for (int ni = 0; ni < NI; ++ni)
#pragma unroll
            for (int e = 0; e < 16; ++e) acc[mi][ni][e] = 0.f;
    const int nk = K >> 6;
    const int aoff = (wm * 64 + l31) * G_LD + 8 * hh, boff = (wn * 32 * NI + l31) * G_LD + 8 * hh, bst = lr * G_LD + kc;
    auto compute = [&](const char* st) __attribute__((always_inline)) {
        const bf16_t* As = (const bf16_t*)st; const bf16_t* Bs = (const bf16_t*)(st + G_ASZ);
#pragma unroll
        for (int ks = 0; ks < 4; ++ks) {
            bf16x8 af[2], bfr[NI];
#pragma unroll
            for (int mi = 0; mi < 2; ++mi) af[mi] = *(const bf16x8*)(As + aoff + mi * 32 * G_LD + ks * 16);
#pragma unroll
            for (int ni = 0; ni < NI; ++ni) bfr[ni] = *(const bf16x8*)(Bs + boff + ni * 32 * G_LD + ks * 16);
#pragma unroll
            for (int mi = 0; mi < 2; ++mi)
#pragma unroll
                for (int ni = 0; ni < NI; ++ni) {
                    if (SW) acc[mi][ni] = MFMA(bfr[ni], af[mi], acc[mi][ni]);
                    else    acc[mi][ni] = MFMA(af[mi], bfr[ni], acc[mi][ni]);
                }
            if (ks == 1) __builtin_amdgcn_sched_barrier(0);
        }
    };
    __syncthreads();
    al0.issue(0); b00 = *(const u32x4*)bp0; if (NI == 2) b01 = *(const u32x4*)bp1;
    if (nk > 1) { al1.issue(64); b10 = *(const u32x4*)(bp0 + 64); if (NI == 2) b11 = *(const u32x4*)(bp1 + 64); }
    {
        bf16_t* As = (bf16_t*)lds; bf16_t* Bs = (bf16_t*)(lds + G_ASZ);
        al0.commit(As);
        *(u32x4*)(Bs + bst) = b00; if (NI == 2) *(u32x4*)(Bs + bst + 64 * G_LD) = b01;
    }
    __syncthreads();
    for (int kt = 0; kt < nk; kt += 2) {
        if (kt + 2 < nk) { const int k0 = (kt + 2) << 6; al0.issue(k0); b00 = *(const u32x4*)(bp0 + k0); if (NI == 2) b01 = *(const u32x4*)(bp1 + k0); }
        compute(lds);
        if (kt + 1 < nk) {
            bf16_t* As = (bf16_t*)(lds + G_STAGE); bf16_t* Bs = (bf16_t*)(lds + G_STAGE + G_ASZ);
            al1.commit(As);
            *(u32x4*)(Bs + bst) = b10; if (NI == 2) *(u32x4*)(Bs + bst + 64 * G_LD) = b11;
        }
        __syncthreads();
        if (kt + 1 >= nk) break;
        if (kt + 3 < nk) { const int k0 = (kt + 3) << 6; al1.issue(k0); b10 = *(const u32x4*)(bp0 + k0); if (NI == 2) b11 = *(const u32x4*)(bp1 + k0); }
        compute(lds + G_STAGE);
        if (kt + 2 < nk) {
            bf16_t* As = (bf16_t*)lds; bf16_t* Bs = (bf16_t*)(lds + G_ASZ);
            al0.commit(As);
            *(u32x4*)(Bs + bst) = b00; if (NI == 2) *(u32x4*)(Bs + bst + 64 * G_LD) = b01;
        }
        __syncthreads();
    }
}
template <bool SW, int NI, class AL_>
DEVI void gemm_mainloop1(f32x16 (&acc)[2][NI], AL_ al, const bf16_t* __restrict__ Bt, int ldb, int K, char* lds, int bhalf = -1) {
    const int tid = tidx(), lane = tid & 63, w = tid >> 6, wm = w >> 1, wn = w & 1, l31 = lane & 31, hh = lane >> 5;
    const int lr = tid >> 3, kc = (tid & 7) * 8;
    const bf16_t* bp0 = Bt + (size_t)(bhalf < 0 ? lr : ((lr >> 5) * 64 + bhalf * 32 + (lr & 31))) * ldb + kc;
    const bf16_t* bp1 = Bt + (size_t)(lr + 64) * ldb + kc;
    u32x4 rb0, rb1;
#pragma unroll
    for (int mi = 0; mi < 2; ++mi)
#pragma unroll
        for (int ni = 0; ni < NI; ++ni)
#pragma unroll
            for (int e = 0; e < 16; ++e) acc[mi][ni][e] = 0.f;
    __syncthreads();
    al.issue(0); rb0 = *(const u32x4*)bp0; if (NI == 2) rb1 = *(const u32x4*)bp1;
    {
        bf16_t* As = (bf16_t*)lds; bf16_t* Bs = (bf16_t*)(lds + G_ASZ);
        al.commit(As);
        *(u32x4*)(Bs + lr * G_LD + kc) = rb0; if (NI == 2) *(u32x4*)(Bs + (lr + 64) * G_LD + kc) = rb1;
    }
    __syncthreads();
    const int nk = K >> 6;
#pragma unroll 1
    for (int kt = 0; kt < nk; ++kt) {
        const bf16_t* As = (const bf16_t*)(lds + (kt & 1) * G_STAGE);
        const bf16_t* Bs = (const bf16_t*)(lds + (kt & 1) * G_STAGE + G_ASZ);
        const bool more = kt + 1 < nk;
        if (more) { const int k0 = (kt + 1) << 6; al.issue(k0); rb0 = *(const u32x4*)(bp0 + k0); if (NI == 2) rb1 = *(const u32x4*)(bp1 + k0); }
#pragma unroll
        for (int ks = 0; ks < 4; ++ks) {
            bf16x8 af[2], bfr[NI];
#pragma unroll
            for (int mi = 0; mi < 2; ++mi) af[mi] = *(const bf16x8*)(As + (wm * 64 + mi * 32 + l31) * G_LD + ks * 16 + 8 * hh);
#pragma unroll
            for (int ni = 0; ni < NI; ++ni) bfr[ni] = *(const bf16x8*)(Bs + (wn * 32 * NI + ni * 32 + l31) * G_LD + ks * 16 + 8 * hh);
#pragma unroll
            for (int mi = 0; mi < 2; ++mi)
#pragma unroll
                for (int ni = 0; ni < NI; ++ni) {
                    if (SW) acc[mi][ni] = MFMA(bfr[ni], af[mi], acc[mi][ni]);
                    else    acc[mi][ni] = MFMA(af[mi], bfr[ni], acc[mi][ni]);
                }
        }
        if (more) {
            bf16_t* An = (bf16_t*)(lds + ((kt + 1) & 1) * G_STAGE); bf16_t* Bn = (bf16_t*)(lds + ((kt + 1) & 1) * G_STAGE + G_ASZ);
            al.commit(An);
            *(u32x4*)(Bn + lr * G_LD + kc) = rb0; if (NI == 2) *(u32x4*)(Bn + (lr + 64) * G_LD + kc) = rb1;
        }
        __syncthreads();
    }
}
DEVI RowLoader make_rows(const bf16_t* base, size_t ld, int row0) {
    RowLoader r; const int tid = tidx(), lr = tid >> 3, kc = (tid & 7) * 8;
    r.p0 = base + (size_t)(row0 + lr) * ld + kc; r.p1 = r.p0 + 64 * ld; r.p2 = r.p0 + 128 * ld; r.p3 = r.p0 + 192 * ld; r.soff = lr * G_LD + kc;
    return r;
}

constexpr int K2_LD = 264;
constexpr int K2_BUF = 64 * K2_LD * 2;
struct K256A { bf16x8 f[2][16]; };
DEVI void k256_load_a(K256A& a, const bf16_t* A, size_t lda, int row0, char* lds) {
    const int tid = tidx(), lane = tid & 63, w = tid >> 6, wm = w >> 1, l31 = lane & 31, hh = lane >> 5;
    bf16_t* As = (bf16_t*)lds;
#pragma unroll 1
    for (int half = 0; half < 2; ++half) {
        __syncthreads();
        u32x4 r[8];
#pragma unroll
        for (int i = 0; i < 8; ++i) { const int c = tid + 512 * i; r[i] = *(const u32x4*)(A + (size_t)(row0 + half * 128 + (c >> 5)) * lda + (c & 31) * 8); }
#pragma unroll
        for (int i = 0; i < 8; ++i) { const int c = tid + 512 * i; *(u32x4*)(As + (c >> 5) * K2_LD + (c & 31) * 8) = r[i]; }
        __syncthreads();
        if ((wm >> 1) == half) {
#pragma unroll
            for (int mi = 0; mi < 2; ++mi)
#pragma unroll
                for (int ks = 0; ks < 16; ++ks) a.f[mi][ks] = *(const bf16x8*)(As + ((wm & 1) * 64 + mi * 32 + l31) * K2_LD + ks * 16 + 8 * hh);
        }
    }
}
template <class EPI>
DEVI void k256_stream(const K256A& a, const bf16_t* Bt, int n_tiles, char* lds, const EPI& epi) {
    const int tid = tidx(), lane = tid & 63, w = tid >> 6, wn = w & 1, l31 = lane & 31, hh = lane >> 5;
    const int br = tid >> 3, bc = (tid & 7) * 8;
    const bf16_t* bp = Bt + (size_t)br * 256 + bc;
    const int sto = br * K2_LD + bc, fro = (wn * 32 + l31) * K2_LD + 8 * hh;
    u32x4 s0, s1, s2, s3, t0, t1, t2, t3;
#define K2_ISSUE(j_, A_, B_, C_, D_) do { const bf16_t* _q = bp + (size_t)(j_) * 64 * 256; A_ = *(const u32x4*)_q; B_ = *(const u32x4*)(_q + 64); C_ = *(const u32x4*)(_q + 128); D_ = *(const u32x4*)(_q + 192); } while (0)
#define K2_COMMIT(buf_, A_, B_, C_, D_) do { bf16_t* _b = (bf16_t*)(lds + (buf_) * K2_BUF) + sto; *(u32x4*)_b = A_; *(u32x4*)(_b + 64) = B_; *(u32x4*)(_b + 128) = C_; *(u32x4*)(_b + 192) = D_; } while (0)
#define K2_TILE(j_, buf_) do { const bf16_t* Bs = (const bf16_t*)(lds + (buf_) * K2_BUF) + fro; f32x16 acc[2]; \
        _Pragma("unroll") for (int e = 0; e < 16; ++e) { acc[0][e] = 0.f; acc[1][e] = 0.f; } \
        _Pragma("unroll") for (int ks = 0; ks < 16; ++ks) { const bf16x8 bf = *(const bf16x8*)(Bs + ks * 16); acc[0] = MFMA(bf, a.f[0][ks], acc[0]); acc[1] = MFMA(bf, a.f[1][ks], acc[1]); } \
        epi((j_), acc); } while (0)
    __syncthreads();
    K2_ISSUE(0, s0, s1, s2, s3);
    K2_ISSUE(min(1, n_tiles - 1), t0, t1, t2, t3);
    K2_COMMIT(0, s0, s1, s2, s3);
    __syncthreads();
#pragma unroll 1
    for (int j = 0; j < n_tiles; j += 2) {
        K2_ISSUE(min(j + 2, n_tiles - 1), s0, s1, s2, s3);
        K2_TILE(j, 0);
        if (j + 1 < n_tiles) K2_COMMIT(1, t0, t1, t2, t3);
        __syncthreads();
        if (j + 1 >= n_tiles) break;
        K2_ISSUE(min(j + 3, n_tiles - 1), t0, t1, t2, t3);
        K2_TILE(j + 1, 1);
        if (j + 2 < n_tiles) K2_COMMIT(0, s0, s1, s2, s3);
        __syncthreads();
    }
#undef K2_ISSUE
#undef K2_COMMIT
#undef K2_TILE
}

template <int KS> struct KFragA { bf16x8 f[2][KS]; };
template <int KS>
DEVI void kx_load_a(KFragA<KS>& a, const bf16_t* A, size_t lda, int row0, char* lds, float* rs, float eps) {
    constexpr int K = 16 * KS, LD = K + 8, CPR = K / 8, NCH = 256 * CPR / 512;
    const int tid = tidx(), lane = tid & 63, w = tid >> 6, wm = w >> 1, l31 = lane & 31, hh = lane >> 5;
    bf16_t* As = (bf16_t*)lds;
    __syncthreads();
    {
        u32x4 r[NCH];
#pragma unroll
        for (int i = 0; i < NCH; ++i) { const int c = tid + 512 * i; r[i] = *(const u32x4*)(A + (size_t)(row0 + c / CPR) * lda + (c % CPR) * 8); }
#pragma unroll
        for (int i = 0; i < NCH; ++i) { const int c = tid + 512 * i; *(u32x4*)(As + (c / CPR) * LD + (c % CPR) * 8) = r[i]; }
    }
    __syncthreads();
#pragma unroll
    for (int mi = 0; mi < 2; ++mi)
#pragma unroll
        for (int ks = 0; ks < KS; ++ks) a.f[mi][ks] = *(const bf16x8*)(As + (wm * 64 + mi * 32 + l31) * LD + ks * 16 + 8 * hh);
    if (tid < 256) { float ss = 0.f;
#pragma unroll
        for (int i = 0; i < CPR; ++i) { const u32x4 v = *(const u32x4*)(As + tid * LD + 8 * i);
#pragma unroll
            for (int j = 0; j < 4; ++j) { const float x = lo_bf(v[j]), y = hi_bf(v[j]); ss += x * x + y * y; } }
        rs[tid] = rsqrtf(ss * (1.f / (float)K) + eps); }
    __syncthreads();
}
template <int KS, class EPI>
DEVI void kx_stream(const KFragA<KS>& a, const bf16_t* Bt, int n_tiles, char* lds, const EPI& epi) {
    constexpr int K = 16 * KS, LD = K + 8, CPR = K / 8, NCH = 64 * CPR / 512, BUF = 64 * LD * 2;
    const int tid = tidx(), lane = tid & 63, w = tid >> 6, wn = w & 1, l31 = lane & 31, hh = lane >> 5;
    u32x4 s[NCH];
    auto issue = [&](int j) __attribute__((always_inline)) {
#pragma unroll
        for (int i = 0; i < NCH; ++i) { const int c = tid + 512 * i; s[i] = *(const u32x4*)(Bt + (size_t)(j * 64 + c / CPR) * K + (c % CPR) * 8); } };
    auto commit = [&](int buf) __attribute__((always_inline)) {
#pragma unroll
        for (int i = 0; i < NCH; ++i) { const int c = tid + 512 * i; *(u32x4*)((bf16_t*)(lds + buf * BUF) + (c / CPR) * LD + (c % CPR) * 8) = s[i]; } };
    __syncthreads();
    issue(0); commit(0);
    __syncthreads();
#pragma unroll 1
    for (int j = 0; j < n_tiles; ++j) {
        const bool more = j + 1 < n_tiles;
        issue(more ? j + 1 : j);
        const bf16_t* Bs = (const bf16_t*)(lds + (j & 1) * BUF) + (wn * 32 + l31) * LD + 8 * hh;
        f32x16 acc[2];
#pragma unroll
        for (int e = 0; e < 16; ++e) { acc[0][e] = 0.f; acc[1][e] = 0.f; }
#pragma unroll
        for (int ks = 0; ks < KS; ++ks) { const bf16x8 bf = *(const bf16x8*)(Bs + ks * 16); acc[0] = MFMA(bf, a.f[0][ks], acc[0]); acc[1] = MFMA(bf, a.f[1][ks], acc[1]); }
        epi(j, acc);
        if (more) commit((j + 1) & 1);
        __syncthreads();
    }
}
DEVI void mod_unit(const Params& p, int u, char* lds) {
    const int tid = tidx(), l = u / 96, j0 = (u % 96) * 64;
    float* sc = (float*)lds; float* red = sc + 9 * 1024;
    __syncthreads();
    for (int i = tid; i < 9 * 1024; i += 512) { const int row = i >> 10, k = i & 1023; const float v = row < 8 ? p.in[I_C][row * 1024 + k] : p.in[I_CCTX][k]; sc[i] = v / (1.f + expf(-v)); }
    __syncthreads();
    const int col = tid & 63, kg = tid >> 6;
    float a[9];
#pragma unroll
    for (int r = 0; r < 9; ++r) a[r] = 0.f;
    const float* w = p.in[I_WMOD] + (size_t)l * 1024 * 6144 + j0 + col;
    for (int k = kg * 128; k < kg * 128 + 128; ++k) {
        const float wv = w[(size_t)k * 6144];
#pragma unroll
        for (int r = 0; r < 9; ++r) a[r] += sc[r * 1024 + k] * wv;
    }
#pragma unroll
    for (int r = 0; r < 9; ++r) red[(kg * 9 + r) * 64 + col] = a[r];
    __syncthreads();
    float* mod = (float*)(p.ws + OFF_MOD);
    for (int i = tid; i < 9 * 64; i += 512) {
        const int r = i >> 6, cc = i & 63; float s = 0.f;
#pragma unroll
        for (int g = 0; g < 8; ++g) s += red[(g * 9 + r) * 64 + cc];
        mod[(size_t)(l * 9 + r) * 6144 + j0 + cc] = s + p.in[I_BMOD][l * 6144 + j0 + cc];
    }
}
DEVI void rope_unit(const Params& p, int v) {
    const int idx = v * 512 + tidx(), pos = idx >> 4, i = idx & 15, fi = i & 7;
    const float inv = powf(10000.f, -(float)fi / 8.f);
    const float coord = (float)(i < 8 ? (pos >> 6) : (pos & 63));
    const float ang = coord * inv;
    ((float*)(p.ws + OFF_COS))[idx] = cosf(ang);
    ((float*)(p.ws + OFF_SIN))[idx] = sinf(ang);
}
DEVI void norm_rows(const Params& p, int l, int r0, int r1, int which  ) {
    const int lane = tidx() & 63, w = tidx() >> 6;
    const float* mod = (const float*)(p.ws + OFF_MOD);
    bf16_t* h = (bf16_t*)(p.ws + OFF_H);
    const float* gn = p.in[which ? I_GN2 : I_GN1] + l * 1024;
#pragma unroll 1
    for (int r = r0 + w; r < r1; r += 16) {
        float4 xv[2][4], gq[4], shq[2][4], scq[2][4]; float ss[2] = {0.f, 0.f};
#pragma unroll
        for (int u = 0; u < 2; ++u) {
            const int rr = min(r + 8 * u, r1 - 1);
            const float* src = which ? (const float*)xdst(p, rr) : xsrc(p, l, rr);
            const float* mr = mod + (size_t)(l * 9 + row_mod(rr)) * 6144 + (which ? 3072 : 0);
#pragma unroll
            for (int q = 0; q < 4; ++q) { const int k = 4 * lane + 256 * q; xv[u][q] = *(const float4*)(src + k); shq[u][q] = *(const float4*)(mr + k); scq[u][q] = *(const float4*)(mr + 1024 + k); }
        }
#pragma unroll
        for (int q = 0; q < 4; ++q) gq[q] = *(const float4*)(gn + 4 * lane + 256 * q);
        __builtin_amdgcn_sched_barrier(0);
#pragma unroll
        for (int u = 0; u < 2; ++u) {
#pragma unroll
            for (int q = 0; q < 4; ++q) ss[u] += xv[u][q].x * xv[u][q].x + xv[u][q].y * xv[u][q].y + xv[u][q].z * xv[u][q].z + xv[u][q].w * xv[u][q].w;
            ss[u] = wave_sum(ss[u]);
        }
#pragma unroll
        for (int u = 0; u < 2; ++u) {
            const int rr = r + 8 * u;
            if (rr < r1) {
                const float rstd = rsqrtf(ss[u] * (1.f / 1024.f) + 1e-6f);
#pragma unroll
                for (int q = 0; q < 4; ++q) {
                    const int k = 4 * lane + 256 * q;
                    const float4 g = gq[q], sh = shq[u][q], sc = scq[u][q];
                    const float o0 = xv[u][q].x * rstd * g.x * (1.f + sc.x) + sh.x, o1 = xv[u][q].y * rstd * g.y * (1.f + sc.y) + sh.y;
                    const float o2 = xv[u][q].z * rstd * g.z * (1.f + sc.z) + sh.z, o3 = xv[u][q].w * rstd * g.w * (1.f + sc.w) + sh.w;
                    uint2 pk; pk.x = pk2(o0, o1); pk.y = pk2(o2, o3);
                    *(uint2*)(h + (size_t)rr * DM + k) = pk;
                }
            }
        }
    }
}

DEVI void quant_rows(const Params& p, int r0, int r1) {
    const int lane = tidx() & 63, w = tidx() >> 6;
    const bf16_t* h = (const bf16_t*)(p.ws + OFF_H);
    float* rs = (float*)(p.ws + OFF_RS);
#pragma unroll 1
    for (int rb = r0 + w; rb < r1; rb += 32) {
        uint4 a0[4], a1[4];
#pragma unroll
        for (int u = 0; u < 4; ++u) { const int r = min(rb + 8 * u, r1 - 1); a0[u] = *(const uint4*)(h + (size_t)r * DM + 8 * lane); a1[u] = *(const uint4*)(h + (size_t)r * DM + 512 + 8 * lane); }
        __builtin_amdgcn_sched_barrier(0);
#pragma unroll
        for (int u = 0; u < 4; ++u) {
            const int r = rb + 8 * u;
            if (r < r1) {
                const uint4 v0 = a0[u], v1 = a1[u];
                float m = fmaxf(fmaxf(fmaxf(fabsf(lo_bf(v0.x)), fabsf(hi_bf(v0.x))), fmaxf(fabsf(lo_bf(v0.y)), fabsf(hi_bf(v0.y)))), fmaxf(fmaxf(fabsf(lo_bf(v0.z)), fabsf(hi_bf(v0.z))), fmaxf(fabsf(lo_bf(v0.w)), fabsf(hi_bf(v0.w)))));
                m = fmaxf(m, fmaxf(fmaxf(fmaxf(fabsf(lo_bf(v1.x)), fabsf(hi_bf(v1.x))), fmaxf(fabsf(lo_bf(v1.y)), fabsf(hi_bf(v1.y)))), fmaxf(fmaxf(fabsf(lo_bf(v1.z)), fabsf(hi_bf(v1.z))), fmaxf(fabsf(lo_bf(v1.w)), fabsf(hi_bf(v1.w))))));
                m = fmaxf(wave_max(m), 1e-20f);
                const float s = 256.f / m;
                uint2 o0, o1;
                o0.x = pk4_fp8(lo_bf(v0.x) * s, hi_bf(v0.x) * s, lo_bf(v0.y) * s, hi_bf(v0.y) * s); o0.y = pk4_fp8(lo_bf(v0.z) * s, hi_bf(v0.z) * s, lo_bf(v0.w) * s, hi_bf(v0.w) * s);
                o1.x = pk4_fp8(lo_bf(v1.x) * s, hi_bf(v1.x) * s, lo_bf(v1.y) * s, hi_bf(v1.y) * s); o1.y = pk4_fp8(lo_bf(v1.z) * s, hi_bf(v1.z) * s, lo_bf(v1.w) * s, hi_bf(v1.w) * s);
                *(uint2*)(p.ws + OFF_H8 + (size_t)r * 1024 + 8 * lane) = o0;
                *(uint2*)(p.ws + OFF_H8 + (size_t)r * 1024 + 512 + 8 * lane) = o1;
                if (lane == 0) rs[r] = m * (1.f / (256.f * WG8_SCALE));
            }
        }
    }
}

constexpr int CJ_WIN = 0, CJ_WUQ = CJ_WIN + 8 * 102, CJ_WUKV = CJ_WUQ + 3 * 6, CJ_WBR = CJ_WUKV + 1 * 8, CJ_WOUT = CJ_WBR + 4 * 32, CJ_RT = CJ_WOUT + 128,
              CJ_EG = CJ_RT + 8, CJ_EU = CJ_EG + 65 * 32, CJ_ED = CJ_EU + 65 * 32, CJ_LW = CJ_ED + 65 * 32, CJ_END = CJ_LW + 16;
DEVI int win_map(int n) {
    if (n < 352) return n;
    if (n < 1120) { const int j = n - 352; return j < 256 ? ZC_NAQ + j : (j < 512 ? ZC_NAK + (j - 256) : ZLD + ZT_NAV + (j - 512)); }
    if (n < 1888) return ZLD + ZT_HY + (n - 1120);
    if (n < 2144) return ZC_LU + (n - 1888);
    if (n < 2400) return ZC_LG + (n - 2144);
    { const int np = n - 2400, g = np >> 10, col = np & 1023, pn = col >> 6, c64 = col & 63;
      return WIN_G0 + pn * 256 + 128 * (g >> 1) + 32 * (c64 >> 4) + 16 * (g & 1) + 4 * ((c64 >> 2) & 3) + (c64 & 3); }
}
template <int STAGE>
DEVI void conv_unit(const Params& p, int l, int cu, char* lds, float4 (&v)[4]) {
    const int tid = tidx();
    const float* src; int K, N, kt, nt, KH = 128; bf16_t* dst; int mode = 0; const float* ksc = nullptr;
    if (cu < CJ_WUQ) { const int t = cu - CJ_WIN; kt = t / 102; nt = t % 102; src = p.in[I_WIN] + (size_t)l * 1024 * 6496; K = 1024; N = 6496; dst = (bf16_t*)(p.ws + OFF_WIN); mode = 1; }
    else if (cu < CJ_WUKV) { const int t = cu - CJ_WUQ; kt = t / 6; nt = t % 6; src = p.in[I_WUQ] + (size_t)l * 192 * 384; K = 192; N = 384; dst = (bf16_t*)(p.ws + OFF_WUQ); ksc = p.in[I_GQ] + l * 192; KH = 64; }
    else if (cu < CJ_WBR) { const int t = cu - CJ_WUKV; kt = 0; nt = t; src = p.in[I_WUKV] + (size_t)l * 128 * 512; K = 128; N = 512; dst = (bf16_t*)(p.ws + OFF_WUKV); ksc = p.in[I_GKV] + l * 128; }
    else if (cu < CJ_WOUT) { const int t = cu - CJ_WBR, k = t >> 5, tt = t & 31; kt = tt >> 4; nt = tt & 15; src = p.in[I_WBR] + (size_t)(l * 4 + k) * 256 * 1024; K = 256; N = 1024; dst = (bf16_t*)(p.ws + OFF_WBR) + (size_t)k * 1024 * 256; }
    else if (cu < CJ_RT) { const int t = cu - CJ_WOUT; kt = t >> 4; nt = t & 15; src = p.in[I_WOUT] + (size_t)l * 1024 * 1024; K = 1024; N = 1024; dst = (bf16_t*)(p.ws + OFF_WOUT); }
    else if (cu < CJ_EG) { kt = cu - CJ_RT; nt = 0; src = p.in[I_RW] + (size_t)l * 1024 * 64; K = 1024; N = 64; dst = (bf16_t*)(p.ws + OFF_RT); mode = 4; }
    else if (cu < CJ_EU) { const int t = cu - CJ_EG, e = t >> 5, tt = t & 31; kt = tt >> 2; nt = tt & 3; src = e < 64 ? p.in[I_EG] + (size_t)(l * 64 + e) * 1024 * 256 : p.in[I_SG] + (size_t)l * 1024 * 256; K = 1024; N = 256; dst = (bf16_t*)(p.ws + OFF_WGU) + (size_t)e * 512 * 1024; mode = 2; }
    else if (cu < CJ_ED) { const int t = cu - CJ_EU, e = t >> 5, tt = t & 31; kt = tt >> 2; nt = tt & 3; src = e < 64 ? p.in[I_EU] + (size_t)(l * 64 + e) * 1024 * 256 : p.in[I_SU] + (size_t)l * 1024 * 256; K = 1024; N = 256; dst = (bf16_t*)(p.ws + OFF_WGU) + (size_t)e * 512 * 1024; mode = 3; }
    else if (cu >= CJ_LW) { const int t = cu - CJ_LW, d = t >> 3, g = (t >> 2) & 1, n = t & 3; kt = 0; nt = 0; src = p.in[g ? I_LWX : I_LWA] + (size_t)((l * 2 + d) * 4 + n) * 4096; K = 64; N = 64; dst = (bf16_t*)(p.ws + OFF_LWT) + (size_t)((d * 2 + g) * 4 + n) * 4096; KH = 64; }
    else { const int t = cu - CJ_ED, e = t >> 5, tt = t & 31; kt = tt >> 4; nt = tt & 15; src = e < 64 ? p.in[I_ED] + (size_t)(l * 64 + e) * 256 * 1024 : p.in[I_SD] + (size_t)l * 256 * 1024; K = 256; N = 1024; dst = (bf16_t*)(p.ws + OFF_WDT) + (size_t)e * 1024 * 256; }
    float* tl = (float*)lds;
    if constexpr (STAGE == 0) {
        const int kk = tid >> 4, n4 = (tid & 15) * 4, n = nt * 64 + n4, nc = min(n, N - 4);
#pragma unroll
        for (int ps = 0; ps < 4; ++ps) { const int pr = ps * 32 < KH ? ps : 0; v[ps] = *(const float4*)(src + (size_t)(kt * KH + kk + 32 * pr) * N + nc); }
        return;
    }
    __syncthreads();
    {
        const int kk = tid >> 4, n4 = (tid & 15) * 4, n = nt * 64 + n4;
        if (n >= N) {
#pragma unroll
            for (int ps = 0; ps < 4; ++ps) v[ps] = make_float4(0.f, 0.f, 0.f, 0.f);
        }
#pragma unroll
        for (int ps = 0; ps < 4; ++ps) if (ps * 32 < KH) {
            float4 x = v[ps];
            if (ksc) { const float s = ksc[kt * KH + kk + 32 * ps]; x.x *= s; x.y *= s; x.z *= s; x.w *= s; }
            float* t = tl + (kk + 32 * ps) * 65 + n4; t[0] = x.x; t[1] = x.y; t[2] = x.z; t[3] = x.w; }
    }
    __syncthreads();
    {
        const int nn = tid >> 3, n = nt * 64 + nn;
#pragma unroll
        for (int q = 0; q < 2; ++q) if (q * 64 < KH) {
            const int kc = (tid & 7) * 8 + 64 * q;
            if (n < N) {
                int dr = n;
                if (mode == 1) dr = win_map(n);
                else if (mode == 2 || mode == 3) { const int r = n & 127; dr = (n >> 7) * 256 + 128 * (r >> 6) + 32 * ((r >> 4) & 3) + 16 * (mode - 2) + 4 * ((r >> 2) & 3) + (r & 3); }
                if (mode == 1 && n >= 2400) {
                    uint2 o8;
                    o8.x = pk4_fp8(tl[(kc + 0) * 65 + nn] * WG8_SCALE, tl[(kc + 1) * 65 + nn] * WG8_SCALE, tl[(kc + 2) * 65 + nn] * WG8_SCALE, tl[(kc + 3) * 65 + nn] * WG8_SCALE);
                    o8.y = pk4_fp8(tl[(kc + 4) * 65 + nn] * WG8_SCALE, tl[(kc + 5) * 65 + nn] * WG8_SCALE, tl[(kc + 6) * 65 + nn] * WG8_SCALE, tl[(kc + 7) * 65 + nn] * WG8_SCALE);
                    *(uint2*)(p.ws + OFF_WG8 + (size_t)(dr - WIN_G0) * 1024 + kt * KH + kc) = o8;
                } else {
                uint4 o;
                o.x = pk2(tl[(kc + 0) * 65 + nn], tl[(kc + 1) * 65 + nn]); o.y = pk2(tl[(kc + 2) * 65 + nn], tl[(kc + 3) * 65 + nn]);
                o.z = pk2(tl[(kc + 4) * 65 + nn], tl[(kc + 5) * 65 + nn]); o.w = pk2(tl[(kc + 6) * 65 + nn], tl[(kc + 7) * 65 + nn]);
                *(uint4*)(dst + (size_t)dr * K + kt * KH + kc) = o;
                }
                if (mode == 4) *(uint4*)(dst + (size_t)(64 + n) * K + kt * KH + kc) = make_uint4(0u, 0u, 0u, 0u);
            }
            if (mode == 1 && nt == 0 && nn < 32) *(uint4*)(dst + (size_t)(352 + nn) * K + kt * KH + kc) = make_uint4(0u, 0u, 0u, 0u);
            if (mode == 1 && nt >= 1 && nt <= 2) *(uint4*)(dst + (size_t)(NIN + (nt - 1) * 64 + nn) * K + kt * KH + kc) = make_uint4(0u, 0u, 0u, 0u);
        }
    }
}
DEVI void h2tab_unit(const Params& p, int l, int hu, char* lds) {
    const int tid = tidx();
    const int L = hu < 64 ? 4096 : 256, pos0 = hu < 64 ? hu * 64 : (hu - 64) * 64, rbase = hu < 64 ? 0 : 4096;
    float* feats = (float*)lds; float* h1 = feats + 64 * 33;
    const float* w1 = p.in[I_HW1] + l * 33 * 64; const float* b1 = p.in[I_HB1] + l * 64;
    const float* w2 = p.in[I_HW2] + l * 64 * 64; const float* b2 = p.in[I_HB2] + l * 64;
    __syncthreads();
    for (int i = tid; i < 64 * 33; i += 512) {
        const int pl = i / 33, f = i % 33, pos = pos0 + pl; float v;
        if (f == 0) v = (float)pos / (float)(L - 1);
        else { const int j = (f - 1) & 15; const float wv = 6.283185307179586f * (float)pos / (float)L; const float fj = 1e-4f + (float)j * ((15.f - 1e-4f) / 15.f); const float zz = wv * fj; v = f <= 16 ? cosf(zz) : -sinf(zz); }
        feats[i] = v;
    }
    __syncthreads();
    const int pl = tid >> 3, og = tid & 7;
    float o[8];
#pragma unroll
    for (int j = 0; j < 8; ++j) o[j] = b1[og * 8 + j];
#pragma unroll 1
    for (int i = 0; i < 33; ++i) { const float f = feats[pl * 33 + i];
#pragma unroll
        for (int j = 0; j < 8; ++j) o[j] += f * w1[i * 64 + og * 8 + j]; }
#pragma unroll
    for (int j = 0; j < 8; ++j) h1[pl * 64 + og * 8 + j] = sinf(o[j]);
    __syncthreads();
#pragma unroll
    for (int j = 0; j < 8; ++j) o[j] = b2[og * 8 + j];
#pragma unroll 2
    for (int i = 0; i < 64; ++i) { const float f = h1[pl * 64 + i];
#pragma unroll
        for (int j = 0; j < 8; ++j) o[j] += f * w2[i * 64 + og * 8 + j]; }
    float* tab = (float*)(p.ws + OFF_H2T) + (size_t)(rbase + pos0 + pl) * 64 + og * 8;
#pragma unroll
    for (int j = 0; j < 8; ++j) tab[j] = sinf(o[j]);
}
DEVI void fft_twiddles(float2* tw) {
    for (int i = tidx(); i < 4096; i += 512) { float s, c; sincospif((float)i * (1.f / 4096.f), &s, &c); tw[i] = make_float2(c, -s); }
}

DEVI int PI(int i) { return i + (i >> 5); }
DEVI float2 cmul(float2 a, float2 b) { return make_float2(a.x * b.x - a.y * b.y, a.x * b.y + a.y * b.x); }
DEVI float2 cmulc(float2 a, float2 b) { return make_float2(a.x * b.x + a.y * b.y, a.y * b.x - a.x * b.y); }
template <int E> DEVI float2 mulw16(float2 d) {
    constexpr float C[8] = {1.f, 0.9238795325112867f, 0.7071067811865476f, 0.3826834323650898f, 0.f, -0.3826834323650898f, -0.7071067811865476f, -0.9238795325112867f};
    constexpr float S[8] = {0.f, 0.3826834323650898f, 0.7071067811865476f, 0.9238795325112867f, 1.f, 0.9238795325112867f, 0.7071067811865476f, 0.3826834323650898f};
    if (E == 0) return d;
    if (E == 4) return make_float2(d.y, -d.x);
    return make_float2(d.x * C[E] + d.y * S[E], d.y * C[E] - d.x * S[E]);
}
template <int I, int H> DEVI void bfly16(float2 (&v)[16]) { const float2 a = v[I], b = v[I + H]; v[I] = make_float2(a.x + b.x, a.y + b.y); v[I + H] = mulw16<(I & (H - 1)) * (8 / H)>(make_float2(a.x - b.x, a.y - b.y)); }
template <bool ZHI> DEVI void dft16(float2 (&v)[16]) {
    if (ZHI) { v[8] = v[0]; v[9] = mulw16<1>(v[1]); v[10] = mulw16<2>(v[2]); v[11] = mulw16<3>(v[3]); v[12] = mulw16<4>(v[4]); v[13] = mulw16<5>(v[5]); v[14] = mulw16<6>(v[6]); v[15] = mulw16<7>(v[7]); }
    else { bfly16<0, 8>(v); bfly16<1, 8>(v); bfly16<2, 8>(v); bfly16<3, 8>(v); bfly16<4, 8>(v); bfly16<5, 8>(v); bfly16<6, 8>(v); bfly16<7, 8>(v); }
    bfly16<0, 4>(v); bfly16<1, 4>(v); bfly16<2, 4>(v); bfly16<3, 4>(v); bfly16<8, 4>(v); bfly16<9, 4>(v); bfly16<10, 4>(v); bfly16<11, 4>(v);
    bfly16<0, 2>(v); bfly16<1, 2>(v); bfly16<4, 2>(v); bfly16<5, 2>(v); bfly16<8, 2>(v); bfly16<9, 2>(v); bfly16<12, 2>(v); bfly16<13, 2>(v);
    bfly16<0, 1>(v); bfly16<2, 1>(v); bfly16<4, 1>(v); bfly16<6, 1>(v); bfly16<8, 1>(v); bfly16<10, 1>(v); bfly16<12, 1>(v); bfly16<14, 1>(v);
}
#define BR4(k) ((((k) & 1) << 3) | (((k) & 2) << 1) | (((k) & 4) >> 1) | (((k) & 8) >> 3))
DEVI void fwd_store16(float2 (&v)[16], float2 w1, float2* X, int base, int S) {
    float2 w = w1;
    X[PI(base)] = v[0];
#pragma unroll
    for (int k = 1; k < 16; ++k) { X[PI(base + k * S)] = cmul(v[BR4(k)], w); if (k < 15) w = cmul(w, w1); }
}
DEVI void inv_load16(float2 (&v)[16], float2 w1, const float2* X, int base, int S) {
    float2 w = w1;
    { const float2 a = X[PI(base)]; v[0] = make_float2(a.x, -a.y); }
#pragma unroll
    for (int k = 1; k < 16; ++k) { const float2 a = cmulc(X[PI(base + k * S)], w); v[k] = make_float2(a.x, -a.y); if (k < 15) w = cmul(w, w1); }
}
DEVI float2 tw8192(const float2* tw, int idx) { const float2 t = tw[idx & 4095]; return (idx & 4096) ? make_float2(-t.x, -t.y) : t; }
DEVI void fft_fwd_C(float2* X, const float2* tw, int tid) {
    float2 v[16];
    const int n_lo = tid & 1, base = (tid >> 1) * 32 + n_lo;
#pragma unroll
    for (int r = 0; r < 16; ++r) v[r] = X[PI(base + 2 * r)];
    dft16<false>(v); fwd_store16(v, tw[256 * n_lo], X, base, 2);
    __syncthreads();
}
DEVI void fft_fwd_BC(float2* X, const float2* tw, int tid) {
    float2 v[16];
    { const int n_lo = tid & 31, base = (tid >> 5) * 512 + n_lo;
#pragma unroll
      for (int r = 0; r < 16; ++r) v[r] = X[PI(base + 32 * r)];
      dft16<false>(v); fwd_store16(v, tw[16 * n_lo], X, base, 32); }
    __syncthreads();
    fft_fwd_C(X, tw, tid);
}
DEVI void fft_inv_C(float2* X, const float2* tw, int tid) {
    float2 v[16];
    const int n_lo = tid & 1, base = (tid >> 1) * 32 + n_lo;
    inv_load16(v, tw[256 * n_lo], X, base, 2); dft16<false>(v);
#pragma unroll
    for (int n = 0; n < 16; ++n) X[PI(base + 2 * n)] = make_float2(v[BR4(n)].x, -v[BR4(n)].y);
    __syncthreads();
}
DEVI void fft_inv_CB(float2* X, const float2* tw, int tid) {
    fft_inv_C(X, tw, tid);
    float2 v[16];
    { const int n_lo = tid & 31, base = (tid >> 5) * 512 + n_lo;
      inv_load16(v, tw[16 * n_lo], X, base, 32); dft16<false>(v);
#pragma unroll
      for (int n = 0; n < 16; ++n) X[PI(base + 32 * n)] = make_float2(v[BR4(n)].x, -v[BR4(n)].y); }
    __syncthreads();
}
template <class HF>
DEVI void fft512x16_conv(float2 (&io)[8], const HF& Hq, float2* X, const float2* tw, int tid) {
    const int n_lo = tid & 31, baseB = (tid >> 5) * 512 + n_lo;
    {
        float2 v[16];
#pragma unroll
        for (int r = 0; r < 8; ++r) v[r] = io[r];
        dft16<true>(v);
        fwd_store16(v, tw[16 * n_lo], X, baseB, 32);
    }
    __syncthreads();
    fft_fwd_C(X, tw, tid);
#pragma unroll
    for (int i = 0; i < 8; ++i) {
        const int q = tid + 512 * i;
        const float4 hv = *(const float4*)(Hq(q >> 8) + 2 * (q & 255));
        const float2 a = X[PI(2 * q)], b = X[PI(2 * q + 1)];
        const float2 g0 = cmul(make_float2(a.x + b.x, a.y + b.y), make_float2(hv.x, hv.y)), g1 = cmul(make_float2(a.x - b.x, a.y - b.y), make_float2(hv.z, hv.w));
        X[PI(2 * q)] = make_float2(g0.x + g1.x, g0.y + g1.y); X[PI(2 * q + 1)] = make_float2(g0.x - g1.x, g0.y - g1.y);
    }
    __syncthreads();
    fft_inv_C(X, tw, tid);
    {
        float2 v[16];
        inv_load16(v, tw[16 * n_lo], X, baseB, 32); dft16<false>(v);
#pragma unroll
        for (int n = 0; n < 8; ++n) io[n] = make_float2(v[BR4(n)].x, -v[BR4(n)].y);
    }
    __syncthreads();
}
DEVI void fft_conv8192(float2 (&io)[8], const float2* __restrict__ H, float2* X, const float2* tw, int tid) {
    float4 hq[8];
#pragma unroll
    for (int i = 0; i < 8; ++i) hq[i] = *(const float4*)(H + 2 * (tid + 512 * i));
    {
        float2 v[16];
#pragma unroll
        for (int r = 0; r < 8; ++r) v[r] = io[r];
        dft16<true>(v);
        fwd_store16(v, tw[tid], X, tid, 512);
    }
    __syncthreads();
    fft_fwd_BC(X, tw, tid);
#pragma unroll
    for (int i = 0; i < 8; ++i) {
        const int q = tid + 512 * i;
        const float4 hv = hq[i];
        const float2 a = X[PI(2 * q)], b = X[PI(2 * q + 1)];
        const float2 g0 = cmul(make_float2(a.x + b.x, a.y + b.y), make_float2(hv.x, hv.y)), g1 = cmul(make_float2(a.x - b.x, a.y - b.y), make_float2(hv.z, hv.w));
        X[PI(2 * q)] = make_float2(g0.x + g1.x, g0.y + g1.y); X[PI(2 * q + 1)] = make_float2(g0.x - g1.x, g0.y - g1.y);
    }
    __syncthreads();
    fft_inv_CB(X, tw, tid);
    {
        float2 v[16];
        inv_load16(v, tw[tid], X, tid, 512); dft16<false>(v);
#pragma unroll
        for (int n = 0; n < 8; ++n) io[n] = make_float2(v[BR4(n)].x, -v[BR4(n)].y);
    }
    __syncthreads();
}
DEVI void fft_spectrum8192(float2 (&in)[16], float2* __restrict__ Hout, float2* X, const float2* tw, int tid) {
    dft16<false>(in);
    fwd_store16(in, tw[tid], X, tid, 512);
    __syncthreads();
    fft_fwd_BC(X, tw, tid);
#pragma unroll
    for (int i = 0; i < 8; ++i) {
        const int q = tid + 512 * i;
        const float2 a = X[PI(2 * q)], b = X[PI(2 * q + 1)];
        *(float4*)(Hout + 2 * q) = make_float4(a.x + b.x, a.y + b.y, a.x - b.x, a.y - b.y);
    }
    __syncthreads();
}


DEVI void spectrum8192_unit(const Params& p, int l, int n, int c, char* lds) {
    const int tid = tidx();
    float2* X = (float2*)lds; float2* tw = X + 8448; float* w3c = (float*)(tw + 4096);
    const float* h2tab = (const float*)(p.ws + OFF_H2T);
    __syncthreads();
    fft_twiddles(tw);
    if (tid < 128) { const int dir = tid >> 6, k = tid & 63; w3c[tid] = p.in[I_HW3][(size_t)(l * 64 + k) * 1024 + (n * 2 + dir) * 256 + c]; }
    const float dec0 = fabsf(p.in[I_HDEC][((l * 2 + n) * 2 + 0) * 256 + c]), dec1 = fabsf(p.in[I_HDEC][((l * 2 + n) * 2 + 1) * 256 + c]);
    __syncthreads();
    float* F = (float*)X;
    {
        const int part = tid & 7, rsub = tid >> 3;
        float w0[8], w1[8];
#pragma unroll
        for (int i = 0; i < 8; ++i) { w0[i] = w3c[part * 8 + i]; w1[i] = w3c[64 + part * 8 + i]; }
#pragma unroll 8
        for (int ch = 0; ch < 64; ++ch) {
            const int j = ch * 64 + rsub;
            const float4 a = *(const float4*)(h2tab + (size_t)j * 64 + part * 8), b = *(const float4*)(h2tab + (size_t)j * 64 + part * 8 + 4);
            float d0 = a.x * w0[0] + a.y * w0[1] + a.z * w0[2] + a.w * w0[3] + b.x * w0[4] + b.y * w0[5] + b.z * w0[6] + b.w * w0[7];
            float d1 = a.x * w1[0] + a.y * w1[1] + a.z * w1[2] + a.w * w1[3] + b.x * w1[4] + b.y * w1[5] + b.z * w1[6] + b.w * w1[7];
            d0 += __shfl_xor(d0, 1); d1 += __shfl_xor(d1, 1); d0 += __shfl_xor(d0, 2); d1 += __shfl_xor(d1, 2); d0 += __shfl_xor(d0, 4); d1 += __shfl_xor(d1, 4);
            F[j] = d0; F[4096 + j] = d1;
        }
    }
    __syncthreads();
    float2 v[16];
#pragma unroll
    for (int r = 0; r < 16; ++r) {
        const int t = tid + 512 * r;
        const int j = t < 4096 ? t : 8192 - t, dir = t < 4096 ? 0 : 1;
        const float f = F[dir * 4096 + (j & 4095)] * expf(-((float)j / 4095.f) * (dir ? dec1 : dec0));
        v[r] = make_float2(t != 4096 ? f : 0.f, 0.f);
    }
    __syncthreads();
    fft_spectrum8192(v, (float2*)(p.ws + OFF_HS) + (size_t)(n * 256 + c) * 8192, X, tw, tid);
}
DEVI float conv3(const bf16_t* r, int t, int L, float w0, float w1, float w2, float b) {
    const float c = bf2f(r[t]), lf = bf2f(r[max(t - 1, 0)]), rg = bf2f(r[min(t + 1, L - 1)]);
    return b + w1 * c + (t > 0 ? w0 : 0.f) * lf + (t < L - 1 ? w2 : 0.f) * rg;
}

DEVI void hyena8192_unit(const Params& p, int l, int c, int b0, char* lds) {
    const int tid = tidx();
    float2* X = (float2*)lds; float2* tw = X + 8448;
    const bf16_t* zT = (const bf16_t*)(p.ws + OFF_ZT);
    bf16_t* yT = (bf16_t*)(p.ws + OFF_YT);
    const float2* H0 = (const float2*)(p.ws + OFF_HS) + (size_t)c * 8192; const float2* H1 = H0 + (size_t)256 * 8192;
    const float* sw = p.in[I_HSW] + l * 3 * 768; const float* sb = p.in[I_HSB] + l * 768;
    const float bias0 = p.in[I_HBIAS][(l * 2 + 0) * 256 + c], bias1 = p.in[I_HBIAS][(l * 2 + 1) * 256 + c];
    const size_t base0 = (size_t)(b0 * 1024 + ZT_HY + c) * NKEY, base1 = base0 + (size_t)1024 * NKEY;
    const float inv = 1.f / 8192.f;
    float2 io[8], vr[8], x1[8], x2[8];
#pragma unroll
    for (int r = 0; r < 8; ++r) { const int t = tid + 512 * r;
        vr[r] = make_float2(conv3(zT + base0, t, 4096, sw[c], sw[768 + c], sw[1536 + c], sb[c]), conv3(zT + base1, t, 4096, sw[c], sw[768 + c], sw[1536 + c], sb[c]));
        x1[r] = make_float2(conv3(zT + base0 + (size_t)256 * NKEY, t, 4096, sw[256 + c], sw[768 + 256 + c], sw[1536 + 256 + c], sb[256 + c]),
                            conv3(zT + base1 + (size_t)256 * NKEY, t, 4096, sw[256 + c], sw[768 + 256 + c], sw[1536 + 256 + c], sb[256 + c]));
        x2[r] = make_float2(conv3(zT + base0 + (size_t)512 * NKEY, t, 4096, sw[512 + c], sw[768 + 512 + c], sw[1536 + 512 + c], sb[512 + c]),
                            conv3(zT + base1 + (size_t)512 * NKEY, t, 4096, sw[512 + c], sw[768 + 512 + c], sw[1536 + 512 + c], sb[512 + c]));
        io[r] = vr[r]; }
    fft_conv8192(io, H0, X, tw, tid);
#pragma unroll
    for (int r = 0; r < 8; ++r) {
        vr[r] = make_float2(x1[r].x * (io[r].x * inv + vr[r].x * bias0), x1[r].y * (io[r].y * inv + vr[r].y * bias0));
        io[r] = vr[r]; }
    fft_conv8192(io, H1, X, tw, tid);
#pragma unroll
    for (int r = 0; r < 8; ++r) {
        vr[r] = make_float2(x2[r].x * (io[r].x * inv + vr[r].x * bias1), x2[r].y * (io[r].y * inv + vr[r].y * bias1)); }
    __builtin_amdgcn_sched_barrier(0);
#pragma unroll
    for (int r = 0; r < 8; ++r) { const int t = tid + 512 * r;
        yT[(size_t)((b0 + 0) * 256 + c) * NKEY + t] = f2bf(vr[r].x);
        yT[(size_t)((b0 + 1) * 256 + c) * NKEY + t] = f2bf(vr[r].y); }
}

DEVI void spectrum512_unit(const Params& p, int l, int su, char* lds) {
    const int tid = tidx(), n_lo = tid & 31, blk = tid >> 5, f = su * 16 + blk, n = f >> 8, c = f & 255;
    float2* X = (float2*)lds; float2* tw = X + 8448;
    const float* h2tab = (const float*)(p.ws + OFF_H2T) + 4096 * 64;
    __syncthreads();
    fft_twiddles(tw);
    const float dec0 = fabsf(p.in[I_HDEC][((l * 2 + n) * 2 + 0) * 256 + c]), dec1 = fabsf(p.in[I_HDEC][((l * 2 + n) * 2 + 1) * 256 + c]);
    float* w3s = (float*)(tw + 4096);
    for (int i = tid; i < 16 * 128; i += 512) { const int fb = i >> 7, dir = (i >> 6) & 1, k = i & 63, ff = su * 16 + fb;
        w3s[i] = p.in[I_HW3][(size_t)(l * 64 + k) * 1024 + ((ff >> 8) * 2 + dir) * 256 + (ff & 255)]; }
    __syncthreads();
    float* T = (float*)X;
#pragma unroll
    for (int i = 0; i < 8; ++i) { const int idx = tid + 512 * i, row = idx >> 4, c4 = (idx & 15) * 4; const float4 hv = *(const float4*)(h2tab + (size_t)row * 64 + c4);
        float* d = T + row * 65 + c4; d[0] = hv.x; d[1] = hv.y; d[2] = hv.z; d[3] = hv.w; }
    __syncthreads();
    float2 v[16];
#pragma unroll
    for (int dir = 0; dir < 2; ++dir) {
        float fa[8]; int jr[8];
#pragma unroll
        for (int r = 0; r < 8; ++r) { const int t = n_lo + 32 * (r + 8 * dir); jr[r] = (dir ? 512 - t : t) & 255; fa[r] = 0.f; }
        const float* wc = w3s + blk * 128 + dir * 64;
#pragma unroll 4
        for (int k = 0; k < 64; ++k) { const float wk = wc[k];
#pragma unroll
            for (int r = 0; r < 8; ++r) fa[r] += T[jr[r] * 65 + k] * wk; }
#pragma unroll
        for (int r = 0; r < 8; ++r) { const int t = n_lo + 32 * (r + 8 * dir); const int jj = dir ? 512 - t : t;
            const float fv = fa[r] * expf(-((float)jj / 255.f) * (dir ? dec1 : dec0));
            v[r + 8 * dir] = make_float2(t != 256 ? fv : 0.f, 0.f); }
    }
    __syncthreads();
    dft16<false>(v);
    fwd_store16(v, tw[16 * n_lo], X, blk * 512 + n_lo, 32);
    __syncthreads();
    fft_fwd_C(X, tw, tid);
    float2* Hout = (float2*)(p.ws + OFF_HSC) + (size_t)su * 16 * 512;
#pragma unroll
    for (int i = 0; i < 8; ++i) { const int q = tid + 512 * i; const float2 a = X[PI(2 * q)], b = X[PI(2 * q + 1)];
        *(float4*)(Hout + 2 * q) = make_float4(a.x + b.x, a.y + b.y, a.x - b.x, a.y - b.y); }
    __syncthreads();
}
DEVI void hyena512_unit(const Params& p, int l, int hu, char* lds) {
    const int tid = tidx(), n_lo = tid & 31, blk = tid >> 5, c0 = hu * 4, c = c0 + (blk >> 2), b0 = 2 * (blk & 3);
    float2* X = (float2*)lds; float2* tw = X + 8448;
    const bf16_t* zT = (const bf16_t*)(p.ws + OFF_ZT);
    bf16_t* yT = (bf16_t*)(p.ws + OFF_YT);
    const float2* HC = (const float2*)(p.ws + OFF_HSC);
    const float* sw = p.in[I_HSW] + l * 3 * 768; const float* sb = p.in[I_HSB] + l * 768;
    const float bias0 = p.in[I_HBIAS][(l * 2 + 0) * 256 + c], bias1 = p.in[I_HBIAS][(l * 2 + 1) * 256 + c];
    const size_t base0 = (size_t)(b0 * 1024 + ZT_HY + c) * NKEY + 4096, base1 = base0 + (size_t)1024 * NKEY;
    const float inv = 1.f / 512.f;
    auto H0 = [&](int j) __attribute__((always_inline)) -> const float2* { return HC + (size_t)(c0 + (j >> 2)) * 512; };
    auto H1 = [&](int j) __attribute__((always_inline)) -> const float2* { return HC + (size_t)(256 + c0 + (j >> 2)) * 512; };
    float2 io[8], vr[8];
#pragma unroll
    for (int r = 0; r < 8; ++r) { const int t = n_lo + 32 * r;
        vr[r] = make_float2(conv3(zT + base0, t, 256, sw[c], sw[768 + c], sw[1536 + c], sb[c]), conv3(zT + base1, t, 256, sw[c], sw[768 + c], sw[1536 + c], sb[c]));
        io[r] = vr[r]; }
    fft512x16_conv(io, H0, X, tw, tid);
#pragma unroll
    for (int r = 0; r < 8; ++r) { const int t = n_lo + 32 * r;
        const float x10 = conv3(zT + base0 + (size_t)256 * NKEY, t, 256, sw[256 + c], sw[768 + 256 + c], sw[1536 + 256 + c], sb[256 + c]);
        const float x11 = conv3(zT + base1 + (size_t)256 * NKEY, t, 256, sw[256 + c], sw[768 + 256 + c], sw[1536 + 256 + c], sb[256 + c]);
        vr[r] = make_float2(x10 * (io[r].x * inv + vr[r].x * bias0), x11 * (io[r].y * inv + vr[r].y * bias0));
        io[r] = vr[r]; }
    fft512x16_conv(io, H1, X, tw, tid);
#pragma unroll
    for (int r = 0; r < 8; ++r) { const int t = n_lo + 32 * r;
        const float x20 = conv3(zT + base0 + (size_t)512 * NKEY, t, 256, sw[512 + c], sw[768 + 512 + c], sw[1536 + 512 + c], sb[512 + c]);
        const float x21 = conv3(zT + base1 + (size_t)512 * NKEY, t, 256, sw[512 + c], sw[768 + 512 + c], sw[1536 + 512 + c], sb[512 + c]);
        vr[r] = make_float2(x20 * (io[r].x * inv + vr[r].x * bias1), x21 * (io[r].y * inv + vr[r].y * bias1)); }
    __builtin_amdgcn_sched_barrier(0);
#pragma unroll
    for (int r = 0; r < 8; ++r) { const int t = n_lo + 32 * r;
        yT[(size_t)((b0 + 0) * 256 + c) * NKEY + 4096 + t] = f2bf(vr[r].x);
        yT[(size_t)((b0 + 1) * 256 + c) * NKEY + 4096 + t] = f2bf(vr[r].y); }
}
DEVI void hyena_unit(const Params& p, int l, int hu, char* lds) {
    float2* X = (float2*)lds; float2* tw = X + 8448;
    __syncthreads();
    fft_twiddles(tw);
    __syncthreads();
    if (hu < 1024) hyena8192_unit(p, l, hu & 255, 2 * (hu >> 8), lds);
    else hyena512_unit(p, l, hu - 1024, lds);
}

struct KVTile { const bf16_t* k; const bf16_t* vt; };
template <int DQ, bool NA, class TF>
DEVI void attn_core(const bf16x8 (&qf)[DQ / 16], int ntiles, const TF& tilefn, int kstride, int vstride,
                    int r_q, int qc, int kr_lo, int nloc, const float* rpb_s, f32x16 (&o)[2], float& lsum, char* lds) {
    constexpr int KLD = DQ + 8, KCH = DQ / 8, KSZ = 64 * KLD * 2, VSZ = 64 * 72 * 2, ST = KSZ + VSZ;
    constexpr int NKC = (64 * KCH + 511) / 512;
    const int tid = tidx(), lane = tid & 63, l31 = lane & 31, hh = lane >> 5;
    float m = -1e30f; lsum = 0.f;
#pragma unroll
    for (int e = 0; e < 16; ++e) { o[0][e] = 0.f; o[1][e] = 0.f; }
    const int r0 = min(max(r_q - 4, 0), 56), c0 = min(max(qc - 8, 0), 48);
    u32x4 rk0, rk1, rv, sk0, sk1, sv;
#define AT_ISSUE(j_, K0, K1, V_) do { const KVTile t = tilefn(j_); \
        { const int c = tid; const int key = c / KCH, ch = c % KCH; K0 = *(const u32x4*)(t.k + (size_t)key * kstride + ch * 8); } \
        if (NKC == 2) { const int c = min(tid + 512, 64 * KCH - 1); const int key = c / KCH, ch = c % KCH; K1 = *(const u32x4*)(t.k + (size_t)key * kstride + ch * 8); } \
        V_ = *(const u32x4*)(t.vt + (size_t)(tid >> 3) * vstride + (tid & 7) * 8); } while (0)
#define AT_COMMIT(buf_, K0, K1, V_) do { bf16_t* Ks_ = (bf16_t*)(lds + (buf_) * ST); bf16_t* Vs_ = (bf16_t*)(lds + (buf_) * ST + KSZ); \
        { const int c = tid; const int key = c / KCH, ch = c % KCH; *(u32x4*)(Ks_ + key * KLD + ch * 8) = K0; } \
        if (NKC == 2) { const int c = tid + 512; if (c < 64 * KCH) { const int key = c / KCH, ch = c % KCH; *(u32x4*)(Ks_ + key * KLD + ch * 8) = K1; } } \
        *(u32x4*)(Vs_ + (tid >> 3) * 72 + (tid & 7) * 8) = V_; } while (0)
    auto tile = [&](int j) __attribute__((always_inline)) {
        const int kr = kr_lo + j;
        const bool active = !NA || j >= nloc || (kr >= r0 && kr < r0 + 8);
        if (active) {
            const bf16_t* Ks = (const bf16_t*)(lds + (j & 1) * ST); const bf16_t* Vs = (const bf16_t*)(lds + (j & 1) * ST + KSZ);
            f32x16 s0, s1;
#pragma unroll
            for (int e = 0; e < 16; ++e) { s0[e] = 0.f; s1[e] = 0.f; }
#pragma unroll
            for (int ks = 0; ks < DQ / 16; ++ks) {
                const bf16x8 k0 = *(const bf16x8*)(Ks + l31 * KLD + ks * 16 + 8 * hh);
                const bf16x8 k1 = *(const bf16x8*)(Ks + (32 + l31) * KLD + ks * 16 + 8 * hh);
                s0 = MFMA(k0, qf[ks], s0); s1 = MFMA(k1, qf[ks], s1);
            }
            if (NA && j < nloc) {
                const float* rb = rpb_s + (kr - r_q + 7) * 31 + 15 - qc;
#pragma unroll
                for (int e = 0; e < 16; ++e) {
                    const int kc = (e & 3) + 8 * (e >> 2) + 4 * hh;
                    const bool v0 = kc >= c0 && kc < c0 + 16, v1 = (kc + 32) >= c0 && (kc + 32) < c0 + 16;
                    s0[e] = v0 ? s0[e] + rb[kc] : -1e30f;
                    s1[e] = v1 ? s1[e] + rb[kc + 32] : -1e30f;
                }
            }
            float mx = s0[0];
#pragma unroll
            for (int e = 1; e < 16; ++e) mx = fmaxf(mx, s0[e]);
#pragma unroll
            for (int e = 0; e < 16; ++e) mx = fmaxf(mx, s1[e]);
            mx = fmaxf(mx, __shfl_xor(mx, 32));
            const float mn = fmaxf(m, mx);
            if (__builtin_amdgcn_ballot_w64(mn != m) != 0ull) {
                const float alpha = __builtin_amdgcn_exp2f(m - mn);
                lsum *= alpha;
#pragma unroll
                for (int e = 0; e < 16; ++e) { o[0][e] *= alpha; o[1][e] *= alpha; }
                m = mn;
            }
            float ps = 0.f;
#pragma unroll
            for (int e = 0; e < 16; ++e) { s0[e] = __builtin_amdgcn_exp2f(s0[e] - mn); s1[e] = __builtin_amdgcn_exp2f(s1[e] - mn); ps += s0[e] + s1[e]; }
            lsum += ps;
#pragma unroll
            for (int s4 = 0; s4 < 4; ++s4) {
                const int bs = 8 * (s4 & 1);
                u32x4 pu;
                if (s4 < 2) { pu[0] = pk2(s0[bs], s0[bs + 1]); pu[1] = pk2(s0[bs + 2], s0[bs + 3]); pu[2] = pk2(s0[bs + 4], s0[bs + 5]); pu[3] = pk2(s0[bs + 6], s0[bs + 7]); }
                else        { pu[0] = pk2(s1[bs], s1[bs + 1]); pu[1] = pk2(s1[bs + 2], s1[bs + 3]); pu[2] = pk2(s1[bs + 4], s1[bs + 5]); pu[3] = pk2(s1[bs + 6], s1[bs + 7]); }
                const bf16x8 pfv = __builtin_bit_cast(bf16x8, pu);
#pragma unroll
                for (int dvt = 0; dvt < 2; ++dvt) {
                    const uint2 v0 = *(const uint2*)(Vs + (dvt * 32 + l31) * 72 + s4 * 16 + 4 * hh);
                    const uint2 v1 = *(const uint2*)(Vs + (dvt * 32 + l31) * 72 + s4 * 16 + 8 + 4 * hh);
                    u32x4 vu; vu[0] = v0.x; vu[1] = v0.y; vu[2] = v1.x; vu[3] = v1.y;
                    o[dvt] = MFMA(__builtin_bit_cast(bf16x8, vu), pfv, o[dvt]);
                }
            }
        }
    };
    __syncthreads();
    AT_ISSUE(0, rk0, rk1, rv); AT_COMMIT(0, rk0, rk1, rv);
    AT_ISSUE(min(1, ntiles - 1), sk0, sk1, sv);
    __syncthreads();
#pragma unroll 1
    for (int j = 0; j < ntiles; j += 2) {
        AT_ISSUE(min(j + 2, ntiles - 1), rk0, rk1, rv);
        tile(j);
        AT_COMMIT(1, sk0, sk1, sv);
        __syncthreads();
        if (j + 1 >= ntiles) break;
        AT_ISSUE(min(j + 3, ntiles - 1), sk0, sk1, sv);
        tile(j + 1);
        AT_COMMIT(0, rk0, rk1, rv);
        __syncthreads();
    }
#undef AT_ISSUE
#undef AT_COMMIT
    lsum += __shfl_xor(lsum, 32);
}
DEVI void attn_store(const f32x16 (&o)[2], float lsum, bf16_t* dst  ) {
    const int lane = tidx() & 63, hh = lane >> 5;
    const float il = 1.f / lsum;
#pragma unroll
    for (int dvt = 0; dvt < 2; ++dvt)
#pragma unroll
        for (int g = 0; g < 4; ++g) { uint2 v; v.x = pk2(o[dvt][4 * g] * il, o[dvt][4 * g + 1] * il); v.y = pk2(o[dvt][4 * g + 2] * il, o[dvt][4 * g + 3] * il);
            *(uint2*)(dst + dvt * 32 + 8 * g + 4 * hh) = v; }
}
DEVI void na_unit(const Params& p, int l, int au, char* lds) {
    const int tid = tidx(), lane = tid & 63, w = tid >> 6, l31 = lane & 31, hh = lane >> 5;
    const bf16_t* z = (const bf16_t*)(p.ws + OFF_Z); const bf16_t* zT = (const bf16_t*)(p.ws + OFF_ZT);
    bf16_t* br = (bf16_t*)(p.ws + OFF_BR);
    const bool isctx = au >= 512;
    int b, h, R;
    if (!isctx) { b = au >> 6; h = (au >> 4) & 3; R = au & 15; } else { b = (au - 512) >> 2; h = (au - 512) & 3; R = 0; }
    float* rpb_s = (float*)(lds + 2 * (64 * 72 * 2 + 64 * 72 * 2));
    __syncthreads();
    for (int i = tid; i < 465; i += 512) rpb_s[i] = p.in[I_RPB][(size_t)(l * 4 + h) * 465 + i] * 1.4426950408889634f;
    const int r_q = 4 * R + (w >> 1), qc = (w & 1) * 32 + l31;
    const int qrow = isctx ? TL + b * 256 + w * 32 + l31 : b * 4096 + r_q * 64 + qc;
    bf16x8 qf[4];
    {
        const bf16_t* qs = z + (size_t)qrow * ZLD + ZC_NAQ + h * 64 + 8 * hh;
        const float sc = 0.125f * 1.4426950408889634f;
#pragma unroll
        for (int ks = 0; ks < 4; ++ks) { const uint4 v = *(const uint4*)(qs + ks * 16); u32x4 t;
            t[0] = pk2(lo_bf(v.x) * sc, hi_bf(v.x) * sc); t[1] = pk2(lo_bf(v.y) * sc, hi_bf(v.y) * sc); t[2] = pk2(lo_bf(v.z) * sc, hi_bf(v.z) * sc); t[3] = pk2(lo_bf(v.w) * sc, hi_bf(v.w) * sc);
            qf[ks] = __builtin_bit_cast(bf16x8, t); }
    }
    int kr_lo = 0, nloc = 0;
    if (!isctx) { kr_lo = min(max(4 * R - 4, 0), 56); const int kr_hi = min(max(4 * R - 1, 0), 56) + 7; nloc = kr_hi - kr_lo + 1; }
    const bf16_t* kb = z + ZC_NAK + h * 64; const bf16_t* vb = zT + (size_t)(b * 1024 + ZT_NAV + h * 64) * NKEY;
    auto tf = [&](int j) { KVTile t;
        if (j < nloc) { const int kr = kr_lo + j; t.k = kb + (size_t)(b * 4096 + kr * 64) * ZLD; t.vt = vb + kr * 64; }
        else { const int i = j - nloc; t.k = kb + (size_t)(TL + b * 256 + 64 * i) * ZLD; t.vt = vb + 4096 + 64 * i; }
        return t; };
    f32x16 o[2]; float ls;
    attn_core<64, true>(qf, nloc + 4, tf, ZLD, NKEY, r_q, qc, kr_lo, nloc, rpb_s, o, ls, lds);
    attn_store(o, ls, br + (size_t)qrow * DM + 256 + h * 64);
}
DEVI void lru1_unit(const Params& p, int l, int lu, char* lds) {
    const int tid = tidx(), c = tid & 255, half = tid >> 8, lane = tid & 63, w = tid >> 6, l31 = lane & 31, hh = lane >> 5;
    const int tt = lu >> 1, d = lu & 1;
    const int row0 = tt * 64;
    const int s0 = row0 < TL ? (row0 & 4095) : ((row0 - TL) & 255);
    const int L = row0 < TL ? 4096 : 256;
    const bf16_t* z = (const bf16_t*)(p.ws + OFF_Z);
    constexpr int XLD = 264;
    bf16_t* xs = (bf16_t*)lds;
    float* As = (float*)(lds + 34816);
    bf16_t* Bs = (bf16_t*)(lds + 34816 + 65536);
    const int n = w & 3, th = w >> 2;
    bf16x8 wf[2][2][4];
    {
        const bf16_t* wt = (const bf16_t*)(p.ws + OFF_LWT);
#pragma unroll
        for (int g = 0; g < 2; ++g)
#pragma unroll
            for (int ct = 0; ct < 2; ++ct)
#pragma unroll
                for (int ks = 0; ks < 4; ++ks) wf[g][ct][ks] = *(const bf16x8*)(wt + (size_t)((d * 2 + g) * 4 + n) * 4096 + (ct * 32 + l31) * 64 + ks * 16 + 8 * hh);
    }
    float cba[2], cbx[2], csp[2];
#pragma unroll
    for (int ct = 0; ct < 2; ++ct) { const int ch = 64 * n + ct * 32 + l31; cba[ct] = p.in[I_LBA][(l * 2 + d) * 256 + ch]; cbx[ct] = p.in[I_LBX][(l * 2 + d) * 256 + ch]; csp[ct] = p.in[I_LLAM][(l * 2 + d) * 256 + ch]; }
    __syncthreads();
    {
        const float* cw = p.in[I_LCW] + (size_t)(l * 2 + d) * 4 * 256; const float cb = p.in[I_LCB][(l * 2 + d) * 256 + c];
        const float w0 = cw[c], w1 = cw[256 + c], w2 = cw[512 + c], w3 = cw[768 + c];
        const bf16_t* zu = z + (size_t)(row0 - s0) * ZLD + ZC_LU + c;
        auto U = [&](int s) -> float { const float v = bf2f(zu[(size_t)min(max(s, 0), L - 1) * ZLD]); return (s >= 0 && s < L) ? v : 0.f; };
        const int sb = s0 + 32 * half - (d == 0 ? 3 : 0);
        float uv[35];
#pragma unroll
        for (int i = 0; i < 35; ++i) uv[i] = U(sb + i);
#pragma unroll
        for (int i = 0; i < 32; ++i) xs[(32 * half + i) * XLD + c] = f2bf(cb + w0 * uv[i] + w1 * uv[i + 1] + w2 * uv[i + 2] + w3 * uv[i + 3]);
    }
    __syncthreads();
    {
        f32x16 acc[2][2];
#pragma unroll
        for (int g = 0; g < 2; ++g)
#pragma unroll
            for (int ct = 0; ct < 2; ++ct)
#pragma unroll
                for (int e = 0; e < 16; ++e) acc[g][ct][e] = 0.f;
#pragma unroll
        for (int ks = 0; ks < 4; ++ks) {
            const bf16x8 af = *(const bf16x8*)(xs + (th * 32 + l31) * XLD + 64 * n + ks * 16 + 8 * hh);
#pragma unroll
            for (int g = 0; g < 2; ++g)
#pragma unroll
                for (int ct = 0; ct < 2; ++ct) acc[g][ct] = MFMA(af, wf[g][ct][ks], acc[g][ct]);
        }
#pragma unroll
        for (int ct = 0; ct < 2; ++ct) {
            const int ch = 64 * n + ct * 32 + l31;
            const float ba = cba[ct], bx = cbx[ct];
            const float sp = log1pf(expf(-csp[ct]));
#pragma unroll
            for (int e = 0; e < 16; ++e) {
                const int tl = th * 32 + (e & 3) + 8 * (e >> 2) + 4 * hh;
                const float r = sigmoidf_(acc[0][ct][e] + ba), ig = sigmoidf_(acc[1][ct][e] + bx);
                const float la = -8.f * r * sp, a = __expf(la), mult = __builtin_amdgcn_sqrtf(fmaxf(1.f - a * a, 0.f));
                As[tl * 256 + ch] = a;
                Bs[tl * 256 + ch] = f2bf(mult * ig * bf2f(xs[tl * XLD + ch]));
            }
        }
    }
    __syncthreads();
    bf16_t* hloc = (bf16_t*)(p.ws + OFF_HLOC) + (size_t)d * TT * 256; bf16_t* cuma = (bf16_t*)(p.ws + OFF_CUMA) + (size_t)d * TT * 256;
    float hst = 0.f, cum = 1.f;
    for (int i = 0; i < 32; ++i) {
        const int tl = 32 * half + (d == 0 ? i : 31 - i);
        const float a = As[tl * 256 + c], bt = bf2f(Bs[tl * 256 + c]);
        hst = a * hst + bt; cum *= a;
        hloc[(size_t)(row0 + tl) * 256 + c] = f2bf(hst); cuma[(size_t)(row0 + tl) * 256 + c] = f2bf(cum);
    }
    const int seg = tt * 2 + half;
    ((float*)(p.ws + OFF_SEGA))[(size_t)(d * 1088 + seg) * 256 + c] = cum;
    ((float*)(p.ws + OFF_SEGB))[(size_t)(d * 1088 + seg) * 256 + c] = hst;
}
DEVI void qproj_unit(const Params& p, int qu, char* lds) {
    const int mt = qu >> 1, nh = qu & 1;
    const int tid = tidx(), lane = tid & 63, w = tid >> 6, wm = w >> 1, wn = w & 1, l31 = lane & 31, hh = lane >> 5;
    const bf16_t* z = (const bf16_t*)(p.ws + OFF_Z);
    const int row0 = mt_row0(mt);
    float* rs = (float*)(lds + 120 * 1024);
    KFragA<12> a;
    kx_load_a<12>(a, z + ZC_QL, ZLD, row0, lds, rs, 1e-6f);
    bf16_t* Q = (bf16_t*)(p.ws + OFF_Q);
    const float* cosT = (const float*)(p.ws + OFF_COS); const float* sinT = (const float*)(p.ws + OFF_SIN);
    const float QS = 0.10206207261596575f * 1.4426950408889634f;
    const bool lat = mt < 128;
    kx_stream<12>(a, (const bf16_t*)(p.ws + OFF_WUQ) + (size_t)nh * 192 * 192, 3, lds, [&](int j, const f32x16 (&acc)[2]) __attribute__((always_inline)) {
        const int ct = nh * 6 + j * 2 + wn, hd = ct / 3, part = ct % 3;
#pragma unroll
        for (int mi = 0; mi < 2; ++mi) {
            const int rl = wm * 64 + mi * 32 + l31, row = row0 + rl, b = row_b(row), key = row_key(row);
            const float rstd = rs[rl] * QS;
            float v[16];
#pragma unroll
            for (int e = 0; e < 16; ++e) v[e] = acc[mi][e] * rstd;
            if (part == 2 && lat) {
#pragma unroll
                for (int g = 0; g < 2; ++g)
#pragma unroll
                    for (int jj = 0; jj < 4; ++jj) { const int i = 8 * g + 4 * hh + jj; const float cs = cosT[key * 16 + i], sn = sinT[key * 16 + i];
                        const float x1 = v[4 * g + jj], x2 = v[4 * (g + 2) + jj]; v[4 * g + jj] = x1 * cs - x2 * sn; v[4 * (g + 2) + jj] = x1 * sn + x2 * cs; }
            }
            bf16_t* dst = Q + ((size_t)((b * 4 + hd) * NKEY + key)) * 96 + part * 32 + 4 * hh;
#pragma unroll
            for (int g = 0; g < 4; ++g) { uint2 o; o.x = pk2(v[4 * g], v[4 * g + 1]); o.y = pk2(v[4 * g + 2], v[4 * g + 3]); *(uint2*)(dst + 8 * g) = o; }
        }
    });
}
DEVI void kvproj_unit(const Params& p, int ku, char* lds) {
    const int mt = ku >> 1, nh = ku & 1;
    const int tid = tidx(), lane = tid & 63, w = tid >> 6, wm = w >> 1, wn = w & 1, l31 = lane & 31, hh = lane >> 5;
    const bf16_t* z = (const bf16_t*)(p.ws + OFF_Z);
    const int row0 = mt_row0(mt);
    float* rs = (float*)(lds + 120 * 1024);
    bf16_t* Kb = (bf16_t*)(p.ws + OFF_K); bf16_t* Vt = (bf16_t*)(p.ws + OFF_VT);
    const float* cosT = (const float*)(p.ws + OFF_COS); const float* sinT = (const float*)(p.ws + OFF_SIN);
    const bool lat = mt < 128;
    if (nh == 0) {
        const int rl = tid >> 1, part = tid & 1, row = row0 + rl, b = row_b(row), key = row_key(row);
        const bf16_t* zr = z + (size_t)row * ZLD + ZC_KR;
        const u32x4 q1 = *(const u32x4*)(zr + 8 * part), q2 = *(const u32x4*)(zr + 16 + 8 * part);
        const int kk = lat ? key : 0;
        const float4 ca = *(const float4*)(cosT + kk * 16 + 8 * part), cb = *(const float4*)(cosT + kk * 16 + 8 * part + 4);
        const float4 sa = *(const float4*)(sinT + kk * 16 + 8 * part), sb2 = *(const float4*)(sinT + kk * 16 + 8 * part + 4);
        const float csv[8] = {ca.x, ca.y, ca.z, ca.w, cb.x, cb.y, cb.z, cb.w}, snv[8] = {sa.x, sa.y, sa.z, sa.w, sb2.x, sb2.y, sb2.z, sb2.w};
        float y1[8], y2[8];
#pragma unroll
        for (int ii = 0; ii < 8; ++ii) { const float x1 = (ii & 1) ? hi_bf(q1[ii >> 1]) : lo_bf(q1[ii >> 1]), x2 = (ii & 1) ? hi_bf(q2[ii >> 1]) : lo_bf(q2[ii >> 1]);
            const float cs = lat ? csv[ii] : 1.f, sn = lat ? snv[ii] : 0.f; y1[ii] = x1 * cs - x2 * sn; y2[ii] = x1 * sn + x2 * cs; }
        u32x4 o1, o2;
#pragma unroll
        for (int j = 0; j < 4; ++j) { o1[j] = pk2(y1[2 * j], y1[2 * j + 1]); o2[j] = pk2(y2[2 * j], y2[2 * j + 1]); }
#pragma unroll
        for (int hd = 0; hd < 4; ++hd) { bf16_t* kd = Kb + ((size_t)((b * 4 + hd) * NKEY + key)) * 96 + 64 + 8 * part; *(u32x4*)kd = o1; *(u32x4*)(kd + 16) = o2; }
    }
    KFragA<8> a;
    kx_load_a<8>(a, z + ZC_KVL, ZLD, row0, lds, rs, 1e-6f);
    kx_stream<8>(a, (const bf16_t*)(p.ws + OFF_WUKV) + (size_t)nh * 256 * 128, 4, lds, [&](int j, const f32x16 (&acc)[2]) __attribute__((always_inline)) {
        const int hd = nh * 2 + (j >> 1), isv = j & 1;
#pragma unroll
        for (int mi = 0; mi < 2; ++mi) {
            const int rl = wm * 64 + mi * 32 + l31, row = row0 + rl, b = row_b(row), key = row_key(row);
            const float rstd = rs[rl];
            if (!isv) {
                bf16_t* dst = Kb + ((size_t)((b * 4 + hd) * NKEY + key)) * 96 + wn * 32 + 4 * hh;
#pragma unroll
                for (int g = 0; g < 4; ++g) { uint2 o; o.x = pk2(acc[mi][4 * g] * rstd, acc[mi][4 * g + 1] * rstd); o.y = pk2(acc[mi][4 * g + 2] * rstd, acc[mi][4 * g + 3] * rstd); *(uint2*)(dst + 8 * g) = o; }
            } else {
#pragma unroll
                for (int e = 0; e < 16; ++e) { const int dv = wn * 32 + (e & 3) + 8 * (e >> 2) + 4 * hh;
                    Vt[((size_t)((b * 4 + hd) * 64 + dv)) * NKEY + key] = f2bf(acc[mi][e] * rstd); }
            }
        }
    });
}
DEVI void mla_unit(const Params& p, int au, char* lds) {
    const int tid = tidx(), lane = tid & 63, w = tid >> 6, l31 = lane & 31, hh = lane >> 5;
    const bool isctx = au >= 512;
    int b, h, qb;
    if (!isctx) { b = au >> 6; h = (au >> 4) & 3; qb = au & 15; } else { b = (au - 512) >> 2; h = (au - 512) & 3; qb = 16; }
    const int q0 = qb * 256 + w * 32 + l31;
    const bf16_t* Qp = (const bf16_t*)(p.ws + OFF_Q) + ((size_t)((b * 4 + h) * NKEY + q0)) * 96 + 8 * hh;
    bf16x8 qf[6];
#pragma unroll
    for (int ks = 0; ks < 6; ++ks) qf[ks] = *(const bf16x8*)(Qp + ks * 16);
    const bf16_t* kb = (const bf16_t*)(p.ws + OFF_K) + (size_t)((b * 4 + h) * NKEY) * 96;
    const bf16_t* vb = (const bf16_t*)(p.ws + OFF_VT) + (size_t)((b * 4 + h) * 64) * NKEY;
    const int jt0 = isctx ? 64 : 0, ntl = isctx ? 4 : 68;
    auto tf = [&](int j) { KVTile t; t.k = kb + (size_t)(jt0 + j) * 64 * 96; t.vt = vb + (jt0 + j) * 64; return t; };
    f32x16 o[2]; float ls;
    attn_core<96, false>(qf, ntl, tf, 96, NKEY, 0, 0, 0, 0, nullptr, o, ls, lds);
    const int row = isctx ? TL + b * 256 + w * 32 + l31 : b * 4096 + q0;
    attn_store(o, ls, (bf16_t*)(p.ws + OFF_BR) + (size_t)row * DM + h * 64);
}

DEVI void ytrans_unit(const Params& p, int tu, char* lds) {
    const int tid = tidx();
    const int b = tu / 68, kt = tu % 68, key0 = kt * 64;
    const int row0 = kt < 64 ? b * 4096 + key0 : TL + b * 256 + (key0 - 4096);
    const bf16_t* yT = (const bf16_t*)(p.ws + OFF_YT) + (size_t)(b * 256) * NKEY + key0;
    bf16_t* br = (bf16_t*)(p.ws + OFF_BR);
    bf16_t* tl = (bf16_t*)lds;
    __syncthreads();
#pragma unroll
    for (int i = 0; i < 4; ++i) { const int cidx = tid + 512 * i, ch = cidx >> 3, kc = (cidx & 7) * 8; *(u32x4*)(tl + ch * 72 + kc) = *(const u32x4*)(yT + (size_t)ch * NKEY + kc); }
    __syncthreads();
#pragma unroll
    for (int i = 0; i < 4; ++i) { const int cidx = tid + 512 * i, t = cidx >> 5, c8 = (cidx & 31) * 8;
        u32x4 o;
#pragma unroll
        for (int j = 0; j < 4; ++j) o[j] = (unsigned)tl[(c8 + 2 * j) * 72 + t] | ((unsigned)tl[(c8 + 2 * j + 1) * 72 + t] << 16);
        *(u32x4*)(br + (size_t)(row0 + t) * DM + 512 + c8) = o; }
}
DEVI float gelu_tanh(float x) { const float u = 0.7978845608028654f * (x + 0.044715f * x * x * x); return x * __builtin_amdgcn_rcpf(1.f + __expf(-2.f * u)); }
DEVI void lru_carry_unit(const Params& p, int l, int b) {
    const int tid = tidx(), c = tid & 255, d = tid >> 8;
    const float* SA = (const float*)(p.ws + OFF_SEGA) + (size_t)d * 1088 * 256; const float* SB = (const float*)(p.ws + OFF_SEGB) + (size_t)d * 1088 * 256;
    float* HIN = (float*)(p.ws + OFF_HIN) + (size_t)d * 1088 * 256;
    const int cbase = 1024 + 8 * b, lbase = 128 * b;
    float h = 0.f;
#pragma unroll 1
    for (int k0 = 0; k0 < 136; k0 += 17) {
        float sa[17], sbv[17];
#pragma unroll
        for (int i = 0; i < 17; ++i) { const int k = k0 + i; const int seg = d == 0 ? (k < 8 ? cbase + k : lbase + (k - 8)) : (k < 8 ? cbase + 7 - k : lbase + 135 - k);
            const size_t o = (size_t)seg * 256 + c; sa[i] = SA[o]; sbv[i] = SB[o]; }
        __builtin_amdgcn_sched_barrier(0);
#pragma unroll
        for (int i = 0; i < 17; ++i) { const int k = k0 + i; const int seg = d == 0 ? (k < 8 ? cbase + k : lbase + (k - 8)) : (k < 8 ? cbase + 7 - k : lbase + 135 - k);
            const size_t o = (size_t)seg * 256 + c;
            __hip_atomic_store(HIN + o, h, __ATOMIC_RELAXED, __HIP_MEMORY_SCOPE_AGENT);
            h = sa[i] * h + sbv[i]; }
        __builtin_amdgcn_sched_barrier(0);
    }
    asm volatile("s_waitcnt vmcnt(0)" ::: "memory");
    __syncthreads();
    if (tid == 0) __hip_atomic_store((unsigned*)(p.ws + OFF_GCNT) + 768 + l * 8 + b, 1u, __ATOMIC_RELAXED, __HIP_MEMORY_SCOPE_AGENT);
}
DEVI void lru2_unit(const Params& p, int l, int tt) {
    const int tid = tidx(), c = tid & 255, half = tid >> 8;
    const int s0 = tt * 4 + half * 2;
    const bool lat = s0 < 1024;
    const int b = lat ? (s0 >> 7) : ((s0 - 1024) >> 3);
    if (tid == 0) {
        unsigned* flag = (unsigned*)(p.ws + OFF_GCNT) + 768 + l * 8 + b; unsigned sp = 0;
        while (__hip_atomic_load(flag, __ATOMIC_RELAXED, __HIP_MEMORY_SCOPE_AGENT) == 0u && ++sp < (1u << 22)) __builtin_amdgcn_s_sleep(2);
    }
    __syncthreads();
    const float* HIN = (const float*)(p.ws + OFF_HIN);
    float hin[2][2];
#pragma unroll
    for (int d = 0; d < 2; ++d)
#pragma unroll
        for (int sgi = 0; sgi < 2; ++sgi) hin[d][sgi] = __hip_atomic_load(HIN + ((size_t)d * 1088 + s0 + sgi) * 256 + c, __ATOMIC_RELAXED, __HIP_MEMORY_SCOPE_AGENT);
    const bf16_t* hl = (const bf16_t*)(p.ws + OFF_HLOC); const bf16_t* ca = (const bf16_t*)(p.ws + OFF_CUMA);
    const bf16_t* z = (const bf16_t*)(p.ws + OFF_Z); bf16_t* br = (bf16_t*)(p.ws + OFF_BR);
#pragma unroll 1
    for (int t8 = 0; t8 < 8; ++t8) {
        const int sgi = t8 >> 2; const size_t row0 = (size_t)(s0 + sgi) * 32 + (t8 & 3) * 8;
        bf16_t a0[8], a1[8], a2[8], a3[8], a4[8];
#pragma unroll
        for (int i = 0; i < 8; ++i) { const size_t row = row0 + i;
            a0[i] = hl[row * 256 + c]; a1[i] = ca[row * 256 + c]; a2[i] = hl[((size_t)TT + row) * 256 + c]; a3[i] = ca[((size_t)TT + row) * 256 + c]; a4[i] = z[row * ZLD + ZC_LG + c]; }
        __builtin_amdgcn_sched_barrier(0);
        const float h0 = sgi ? hin[0][1] : hin[0][0], h1 = sgi ? hin[1][1] : hin[1][0];
#pragma unroll
        for (int i = 0; i < 8; ++i) { const size_t row = row0 + i;
            const float hf = bf2f(a0[i]) + bf2f(a1[i]) * h0, hr = bf2f(a2[i]) + bf2f(a3[i]) * h1;
            br[row * DM + 768 + c] = f2bf((hf + hr) * gelu_tanh(bf2f(a4[i]))); }
        __builtin_amdgcn_sched_barrier(0);
    }
}
DEVI void pbranch_unit(const Params& p, int u, char* lds) {
    const int mt = u >> 3, g = (u >> 1) & 3, nh = u & 1;
    const int tid = tidx(), lane = tid & 63, w = tid >> 6, wm = w >> 1, wn = w & 1, l31 = lane & 31, hh = lane >> 5;
    const int row0 = mt_row0(mt);
    K256A a;
    k256_load_a(a, (const bf16_t*)(p.ws + OFF_BR) + g * 256, DM, row0, lds);
    bf16_t* P = (bf16_t*)(p.ws + (g < 2 ? OFF_PLO : OFF_PHI)) + (size_t)(g & 1) * 1024 + nh * 512;
    bf16_t* slab = (bf16_t*)(lds + 2 * K2_BUF) + w * (64 * 40);
    k256_stream(a, (const bf16_t*)(p.ws + OFF_WBR) + (size_t)(g * 1024 + nh * 512) * 256, 8, lds, [&](int j, const f32x16 (&acc)[2]) __attribute__((always_inline)) {
#pragma unroll
        for (int mi = 0; mi < 2; ++mi)
#pragma unroll
            for (int q = 0; q < 4; ++q) { uint2 o; o.x = pk2(acc[mi][4 * q], acc[mi][4 * q + 1]); o.y = pk2(acc[mi][4 * q + 2], acc[mi][4 * q + 3]);
                *(uint2*)(slab + (mi * 32 + l31) * 40 + 8 * q + 4 * hh) = o; }
        asm volatile("s_waitcnt lgkmcnt(0)" ::: "memory");
#pragma unroll
        for (int it = 0; it < 4; ++it) {
            const int r64 = it * 16 + (lane >> 2);
            const u32x4 v = *(const u32x4*)(slab + r64 * 40 + (lane & 3) * 8);
            *(u32x4*)(P + (size_t)(row0 + wm * 64 + r64) * 2048 + j * 64 + wn * 32 + (lane & 3) * 8) = v;
        }
        asm volatile("s_waitcnt lgkmcnt(0)" ::: "memory");
    });
}
DEVI void router_unit(const Params& p, int l, int r0, int r1, char* lds) {
    const int tid = tidx(), lane = tid & 63, w = tid >> 6, wm = w >> 1, wn = w & 1, l31 = lane & 31, hh = lane >> 5;
    const int nrows = r1 - r0;
    norm_rows(p, l, r0, r1, 1);
    asm volatile("s_waitcnt vmcnt(0)" ::: "memory");
    __syncthreads();
    const RowLoader al = make_rows((const bf16_t*)(p.ws + OFF_H), DM, r0);
    f32x16 acc[2][1];
    gemm_mainloop<true, 1>(acc, al, (const bf16_t*)(p.ws + OFF_RT), 1024, 1024, lds);
    float* lg = (float*)lds;
    int* cnt_l = (int*)(lds + 256 * 65 * 4);
    int* base_g = cnt_l + 64;
#pragma unroll
    for (int mi = 0; mi < 2; ++mi)
#pragma unroll
        for (int e = 0; e < 16; ++e) lg[(wm * 64 + mi * 32 + l31) * 65 + wn * 32 + (e & 3) + 8 * (e >> 2) + 4 * hh] = sigmoidf_(acc[mi][0][e]);
    float* rbs = (float*)(base_g + 64);
    if (tid < 64) { cnt_l[tid] = 0; rbs[tid] = p.in[I_RB][l * 64 + tid]; }
    __syncthreads();
    int se[6], spos[6]; float swt[6];
    if (tid < nrows) {
        const float* rb = rbs;
        float* my = lg + tid * 65;
        float ssum = 0.f;
#pragma unroll
        for (int k = 0; k < 6; ++k) {
            float best = -1e30f; int bi = 0;
#pragma unroll 8
            for (int e = 0; e < 64; ++e) { const float s = my[e] + rb[e]; if (s > best) { best = s; bi = e; } }
            const float sc = my[bi];
            se[k] = bi; swt[k] = sc; ssum += sc; my[bi] = -1e30f;
        }
        const float nrm = 2.5f / ssum;
#pragma unroll
        for (int k = 0; k < 6; ++k) { swt[k] *= nrm; spos[k] = atomicAdd(&cnt_l[se[k]], 1); }
    }
    __syncthreads();
    if (tid < 64) base_g[tid] = (int)__hip_atomic_fetch_add((unsigned*)(p.ws + OFF_GCNT) + l * 64 + tid, (unsigned)cnt_l[tid], __ATOMIC_RELAXED, __HIP_MEMORY_SCOPE_AGENT);
    __syncthreads();
    if (tid < nrows) {
        const int r = r0 + tid;
        int* list = (int*)(p.ws + OFF_LIST); unsigned* toks = (unsigned*)(p.ws + OFF_TOKS); float* wts = (float*)(p.ws + OFF_WTS);
#pragma unroll
        for (int k = 0; k < 6; ++k) { const int pos = base_g[se[k]] + spos[k]; list[(size_t)se[k] * TT + pos] = r; toks[(size_t)r * 6 + k] = ((unsigned)se[k] << 16) | (unsigned)pos; wts[(size_t)r * 6 + k] = swt[k]; }
    }
}
struct MoeTab { int* cnt; int* blkbase; int* cbase; };
DEVI MoeTab moe_tables(const Params& p, int l, int nact, char* lds) {
    MoeTab t; t.cnt = (int*)(lds + LDS_BYTES - 4096); t.blkbase = t.cnt + 80; t.cbase = t.blkbase + 80;
    __syncthreads();
    if (tidx() < 64) t.cnt[tidx()] = (int)__hip_atomic_load((unsigned*)(p.ws + OFF_GCNT) + l * 64 + tidx(), __ATOMIC_RELAXED, __HIP_MEMORY_SCOPE_AGENT);
    __syncthreads();
    if (tidx() == 0) {
        int bb = 0, cb = 0;
        for (int e = 0; e < 64; ++e) { const int c = t.cnt[e]; t.blkbase[e] = bb; t.cbase[e] = cb; bb += (c + 255) >> 8; cb += c; }
        t.cnt[64] = nact; t.blkbase[64] = bb; t.cbase[64] = cb; t.blkbase[65] = bb + (nact >> 8);
    }
    __syncthreads();
    {
        unsigned char* eb = (unsigned char*)(t.cbase + 80);
        const int nrb = t.blkbase[65];
        for (int rb = tidx(); rb < nrb; rb += 512) { int e = 0; while (e < 64 && rb >= t.blkbase[e + 1]) ++e; eb[rb] = (unsigned char)e; }
    }
    __syncthreads();
    return t;
}
DEVI int find_expert(const MoeTab& t, int rb) { return (int)((const unsigned char*)(t.cbase + 80))[rb]; }
DEVI void moe2_unit(const Params& p, int l, const MoeTab& t, int rb, char* lds) {
    const int tid = tidx(), lane = tid & 63, w = tid >> 6, wm = w >> 1, wn = w & 1, l31 = lane & 31, hh = lane >> 5;
    const int e = find_expert(t, rb), i0 = (rb - t.blkbase[e]) * 256, cnt = t.cnt[e], cbe = t.cbase[e];
    K256A a;
    k256_load_a(a, (const bf16_t*)(p.ws + OFF_HID), 256, rb * 256, lds);
    const bf16_t* Bt = (const bf16_t*)(p.ws + OFF_WDT) + (size_t)e * 1024 * 256;
    if (e < 64) {
        bf16_t* Y = (bf16_t*)(p.ws + OFF_Y);
        bf16_t* slab = (bf16_t*)(lds + 2 * K2_BUF) + w * (64 * 40);
        bf16_t* trash = (bf16_t*)(p.ws + OFF_SEGA + (size_t)blockIdx.x * 8192 + (size_t)tid * 16);
        k256_stream(a, Bt, 16, lds, [&](int j, const f32x16 (&acc)[2]) __attribute__((always_inline)) {
#pragma unroll
            for (int mi = 0; mi < 2; ++mi)
#pragma unroll
                for (int g = 0; g < 4; ++g) { uint2 o; o.x = pk2(acc[mi][4 * g], acc[mi][4 * g + 1]); o.y = pk2(acc[mi][4 * g + 2], acc[mi][4 * g + 3]);
                    *(uint2*)(slab + (mi * 32 + l31) * 40 + 8 * g + 4 * hh) = o; }
            asm volatile("s_waitcnt lgkmcnt(0)" ::: "memory");
#pragma unroll
            for (int it = 0; it < 4; ++it) {
                const int r64 = it * 16 + (lane >> 2), ii = i0 + wm * 64 + r64;
                const u32x4 v = *(const u32x4*)(slab + r64 * 40 + (lane & 3) * 8);
                *(u32x4*)(ii < cnt ? Y + (size_t)(cbe + ii) * DM + j * 64 + wn * 32 + (lane & 3) * 8 : trash) = v;
            }
            asm volatile("s_waitcnt lgkmcnt(0)" ::: "memory");
        });
    } else {
        const float* g2b = (const float*)(p.ws + OFF_MOD) + (size_t)l * 9 * 6144 + 5120 + (size_t)row_mod(i0) * 6144;
        bf16_t* slab = (bf16_t*)(lds + 2 * K2_BUF) + w * (64 * 40);
        k256_stream(a, Bt, 16, lds, [&](int j, const f32x16 (&acc)[2]) __attribute__((always_inline)) {
#pragma unroll
            for (int mi = 0; mi < 2; ++mi)
#pragma unroll
                for (int g = 0; g < 4; ++g) { uint2 o; o.x = pk2(acc[mi][4 * g], acc[mi][4 * g + 1]); o.y = pk2(acc[mi][4 * g + 2], acc[mi][4 * g + 3]);
                    *(uint2*)(slab + (mi * 32 + l31) * 40 + 8 * g + 4 * hh) = o; }
            const int c0 = j * 64 + wn * 32 + (lane & 3) * 8;
            const float4 ga = *(const float4*)(g2b + c0), gb = *(const float4*)(g2b + c0 + 4);
            asm volatile("s_waitcnt lgkmcnt(0)" ::: "memory");
#pragma unroll
            for (int h2 = 0; h2 < 2; ++h2) {
                float4 xa[2], xb[2];
#pragma unroll
                for (int i2 = 0; i2 < 2; ++i2) { const int r64 = (h2 * 2 + i2) * 16 + (lane >> 2); const float* xr = xdst(p, i0 + wm * 64 + r64) + c0; xa[i2] = *(const float4*)xr; xb[i2] = *(const float4*)(xr + 4); }
                __builtin_amdgcn_sched_barrier(0);
#pragma unroll
                for (int i2 = 0; i2 < 2; ++i2) { const int r64 = (h2 * 2 + i2) * 16 + (lane >> 2); float* xr = xdst(p, i0 + wm * 64 + r64) + c0;
                    const u32x4 v = *(const u32x4*)(slab + r64 * 40 + (lane & 3) * 8);
                    float4 oa = xa[i2], ob = xb[i2];
                    oa.x += ga.x * lo_bf(v[0]); oa.y += ga.y * hi_bf(v[0]); oa.z += ga.z * lo_bf(v[1]); oa.w += ga.w * hi_bf(v[1]);
                    ob.x += gb.x * lo_bf(v[2]); ob.y += gb.y * hi_bf(v[2]); ob.z += gb.z * lo_bf(v[3]); ob.w += gb.w * hi_bf(v[3]);
                    *(float4*)xr = oa; *(float4*)(xr + 4) = ob; }
                __builtin_amdgcn_sched_barrier(0);
            }
            asm volatile("s_waitcnt lgkmcnt(0)" ::: "memory");
        });
    }
}
DEVI void combine_unit(const Params& p, int l, const MoeTab& t, int r0, int r1) {
    const int lane = tidx() & 63, w = tidx() >> 6;
    const float* mod = (const float*)(p.ws + OFF_MOD);
    const bf16_t* Y = (const bf16_t*)(p.ws + OFF_Y);
    const unsigned* toks = (const unsigned*)(p.ws + OFF_TOKS); const float* wts = (const float*)(p.ws + OFF_WTS);
#pragma unroll 2
    for (int r = r0 + w; r < r1; r += 8) {
        float* xd = xdst(p, r);
        const float* g2 = mod + (size_t)(l * 9 + row_mod(r)) * 6144 + 5120;
        const bf16_t* yr[6]; float wk[6];
#pragma unroll
        for (int k = 0; k < 6; ++k) { const unsigned v = toks[(size_t)r * 6 + k]; yr[k] = Y + (size_t)(t.cbase[v >> 16] + (int)(v & 0xffffu)) * DM; wk[k] = wts[(size_t)r * 6 + k]; }
        float4 xo[4]; float ss = 0.f;
#pragma unroll
        for (int q = 0; q < 4; ++q) {
            const int k0 = 4 * lane + 256 * q;
            float f0 = 0.f, f1 = 0.f, f2 = 0.f, f3 = 0.f;
#pragma unroll
            for (int k = 0; k < 6; ++k) { const uint2 yv = *(const uint2*)(yr[k] + k0); f0 += wk[k] * lo_bf(yv.x); f1 += wk[k] * hi_bf(yv.x); f2 += wk[k] * lo_bf(yv.y); f3 += wk[k] * hi_bf(yv.y); }
            float4 xv = *(const float4*)(xd + k0); const float4 gv = *(const float4*)(g2 + k0);
            xv.x += gv.x * f0; xv.y += gv.y * f1; xv.z += gv.z * f2; xv.w += gv.w * f3;
            xo[q] = xv; ss += xv.x * xv.x + xv.y * xv.y + xv.z * xv.z + xv.w * xv.w;
        }
        if (l == 1) {
            ss = wave_sum(ss);
            const float rstd = rsqrtf(ss * (1.f / 1024.f) + 1e-6f);
#pragma unroll
            for (int q = 0; q < 4; ++q) { const int k0 = 4 * lane + 256 * q; const float4 gf = *(const float4*)(p.in[I_GF] + k0);
                float4 o; o.x = xo[q].x * rstd * gf.x; o.y = xo[q].y * rstd * gf.y; o.z = xo[q].z * rstd * gf.z; o.w = xo[q].w * rstd * gf.w; *(float4*)(xd + k0) = o; }
        } else {
#pragma unroll
            for (int q = 0; q < 4; ++q) *(float4*)(xd + 4 * lane + 256 * q) = xo[q];
        }
    }
}


namespace pg8 {
#define PG8_LAS __attribute__((address_space(3)))
typedef unsigned short bf16_t;
typedef short bf16x8 __attribute__((ext_vector_type(8)));
typedef float f32x4 __attribute__((ext_vector_type(4)));
typedef unsigned u32x4 __attribute__((ext_vector_type(4)));
typedef int i32x4 __attribute__((ext_vector_type(4)));
typedef int i32x8 __attribute__((ext_vector_type(8)));
constexpr int BM = 256, BK = 64, HALF = 128, HTB = HALF * BK * 2  , STAGE_BYTES = 8 * HTB, NXCD = 8, WGM = 8;

__host__ __device__ __forceinline__ int lds_byte(int r, int c) { const int st = (r >> 4) * 2 + (c >> 5), rr = r & 15, cc = c & 31, ob = rr * 64 + cc * 2; return st * 1024 + (ob ^ (((ob >> 9) & 1) << 5)); }
__host__ __device__ __forceinline__ void stage_rc(int b, int& R, int& C) { const int st = b / 1024, sb = b % 1024, swz = sb ^ (((sb >> 9) & 1) << 5); R = (st >> 1) * 16 + swz / 64; C = (st & 1) * 32 + (swz % 64) / 2; }
__host__ __device__ __forceinline__ int perm32(int rho) { const int n = rho >> 4, i = rho & 15; return 8 * (i >> 2) + 4 * n + (i & 3); }

struct Unit { int pm, pn; };
struct Gemm { const bf16_t* A; const bf16_t* Bt; int M, N, K; };

struct StaticOrder {
    int nM, nN, nwg, G, c;
    __host__ __device__ void init(int M, int N, int G_, int c_) { nM = M / BM; nN = N / BM; nwg = nM * nN; G = G_; c = c_; }
    __host__ __device__ bool next(int i, Unit& u) const {
        const long L = (long)i * G + c; if (L >= nwg) return false;
        int wgid = (int)L; { const int q = nwg / NXCD, r = nwg % NXCD, xcd = wgid % NXCD, off = wgid / NXCD; wgid = (xcd < r ? xcd * (q + 1) : r * (q + 1) + (xcd - r) * q) + off; }
        const int nig = WGM * nN, gid = wgid / nig, fm = gid * WGM, gsz = (nM - fm) < WGM ? (nM - fm) : WGM;
        u.pm = fm + ((wgid % nig) % gsz); u.pn = (wgid % nig) / gsz; return true;
    }
    __device__ __forceinline__ void a_ready(const Unit&) const {}
    __device__ __forceinline__ void done(const Unit&) const {}
};
template <class Epi, class Sched, bool STAMP = false, bool F8 = false>
__device__ __forceinline__ void gemm_phase(PG8_LAS unsigned char* lds, const Gemm g, const Sched& S, const Epi& E, unsigned long long* stamps) {
    const int tid = threadIdx.x, wid = __builtin_amdgcn_readfirstlane(tid >> 6), lane = tid & 63, wr = wid >> 2, wc = wid & 3, fr = lane & 15, fq = lane >> 4;
    int K = g.K; if constexpr (F8) asm volatile("" : "+s"(K));
    const int nt = K / BK;
    int ts_lo = 0, ts_hi = 0, nts = 0; const unsigned long long rt_entry = STAMP ? (unsigned long long)wall_clock64() : 0ull;
#define PG8_STAMP() do { if (STAMP && wid == 0 && nts < 64) { const unsigned long long _c = (unsigned long long)clock64(); \
        ts_lo = (lane == nts) ? (int)(unsigned)_c : ts_lo; ts_hi = (lane == nts) ? (int)(unsigned)(_c >> 32) : ts_hi; ++nts; } } while (0)
    PG8_STAMP();
    unsigned voffA[2], voffB[2];
#pragma unroll
    for (int i = 0; i < 2; ++i) { int R, C; stage_rc(tid * 16 + i * 8192, R, C); const int Rb = Epi::PERM ? ((R & ~31) + perm32(R & 31)) : R;
        voffA[i] = (unsigned)(R * K + C) * 2u; voffB[i] = (unsigned)(Rb * K + C) * 2u; }
    const size_t kstep = (size_t)(BK * 2);
    const size_t hstep = (size_t)HALF * K * 2;
    const size_t tstep = 2 * hstep;
    const unsigned ldsw = (unsigned)wid * 1024u;
    const int aoff = lds_byte(wr * 64 + fr, fq * 8), boff = lds_byte(wc * 32 + fr, fq * 8);
#define PG8_SA(b, h) (((b) * 2 + (h)) * HTB)
#define PG8_SB(b, h) ((4 + (b) * 2 + (h)) * HTB)
#define PG8_STAGE(bufoff, gbase, voff) do { _Pragma("unroll") for (int _i = 0; _i < 2; ++_i) \
        __builtin_amdgcn_global_load_lds((const unsigned*)((const char*)(gbase) + (voff)[_i]), (PG8_LAS unsigned*)(lds + (bufoff) + ldsw + _i * 8192), 16, 0, 0); } while (0)
#define PG8_CAT(x, y) __builtin_shufflevector(x, y, 0, 1, 2, 3, 4, 5, 6, 7)
#define PG8_LDA(dst, b, h) do { _Pragma("unroll") for (int m = 0; m < 4; ++m) { \
        if constexpr (F8) dst##8[m] = PG8_CAT(*(const PG8_LAS i32x4*)(lds + PG8_SA(b, h) + aoff + m * 2048), *(const PG8_LAS i32x4*)(lds + PG8_SA(b, h) + aoff + m * 2048 + 1024)); \
        else { _Pragma("unroll") for (int k = 0; k < 2; ++k) dst[m][k] = *(const PG8_LAS bf16x8*)(lds + PG8_SA(b, h) + aoff + m * 2048 + k * 1024); } } } while (0)
#define PG8_LDB(dst, b, h) do { _Pragma("unroll") for (int n = 0; n < 2; ++n) { \
        if constexpr (F8) dst##8[n] = PG8_CAT(*(const PG8_LAS i32x4*)(lds + PG8_SB(b, h) + boff + n * 2048), *(const PG8_LAS i32x4*)(lds + PG8_SB(b, h) + boff + n * 2048 + 1024)); \
        else { _Pragma("unroll") for (int k = 0; k < 2; ++k) dst[n][k] = *(const PG8_LAS bf16x8*)(lds + PG8_SB(b, h) + boff + n * 2048 + k * 1024); } } } while (0)
#define PG8_MMA(ai, bj, At, Bt) do { __builtin_amdgcn_s_setprio(1); _Pragma("unroll") for (int m = 0; m < 4; ++m) _Pragma("unroll") for (int n = 0; n < 2; ++n) { \
        if constexpr (F8) asm volatile("v_mfma_scale_f32_16x16x128_f8f6f4 %0, %1, %2, %0, %3, %3 op_sel_hi:[0,0,0]" : "+v"(acc[ai][bj][m][n]) : "v"(Bt##8[n]), "v"(At##8[m]), "v"(sc8)); \
        else { _Pragma("unroll") for (int k = 0; k < 2; ++k) acc[ai][bj][m][n] = __builtin_amdgcn_mfma_f32_16x16x32_bf16(Bt[n][k], At[m][k], acc[ai][bj][m][n], 0, 0, 0); } } __builtin_amdgcn_s_setprio(0); } while (0)
#define PG8_WAIT_V(n) asm volatile("s_waitcnt vmcnt(" #n ")" ::: "memory")
#define PG8_WAIT_L(n) asm volatile("s_waitcnt lgkmcnt(" #n ")" ::: "memory")
#define PG8_BAR __builtin_amdgcn_s_barrier()
#define PG8_SCHED __builtin_amdgcn_sched_barrier(0)
    Unit cur, nxt; int ui = 0;
    if (!S.next(0, cur)) return;
    f32x4 acc[2][2][4][2];
#pragma unroll
    for (int a = 0; a < 2; ++a)
#pragma unroll
        for (int b = 0; b < 2; ++b)
#pragma unroll
            for (int m = 0; m < 4; ++m)
#pragma unroll
                for (int n = 0; n < 2; ++n) acc[a][b][m][n] = (f32x4){0.f, 0.f, 0.f, 0.f};
    bf16x8 At[4][2], B0[2][2], B1[2][2];
    i32x8 At8[4], B08[2], B18[2];
    int sc8 = 0x7F7F7F7F; asm volatile("" : "+v"(sc8));
    const char* cA = (const char*)g.A + (size_t)cur.pm * tstep; const char* cB = (const char*)g.Bt + (size_t)cur.pn * tstep;
    S.a_ready(cur);
    PG8_STAGE(PG8_SB(0, 0), cB, voffB); PG8_STAGE(PG8_SA(0, 0), cA, voffA); PG8_STAGE(PG8_SB(0, 1), cB + hstep, voffB); PG8_STAGE(PG8_SA(0, 1), cA + hstep, voffA);
    if (wr == 1) PG8_BAR;
    PG8_WAIT_V(4); PG8_BAR;
    PG8_STAGE(PG8_SB(1, 0), cB + kstep, voffB); PG8_STAGE(PG8_SA(1, 0), cA + kstep, voffA); PG8_STAGE(PG8_SB(1, 1), cB + hstep + kstep, voffB);
    PG8_WAIT_V(6); PG8_BAR;
    PG8_STAMP();
    for (;;) {
        const bool has_next = S.next(ui + 1, nxt);
        const char* nA = has_next ? (const char*)g.A + (size_t)nxt.pm * tstep : cA; const char* nB = has_next ? (const char*)g.Bt + (size_t)nxt.pn * tstep : cB;
        for (int t = 0; t < nt; t += 2) {
            const bool last = (t == nt - 2);
            const char* a1 = cA + (size_t)(t + 1) * kstep;
            const char* a2 = last ? nA : cA + (size_t)(t + 2) * kstep; const char* b2 = last ? nB : cB + (size_t)(t + 2) * kstep;
            const char* a3 = a2 + kstep; const char* b3 = b2 + kstep;
            if (last && has_next) S.a_ready(nxt);
            PG8_LDB(B0, 0, 0); PG8_SCHED; PG8_LDA(At, 0, 0); PG8_STAGE(PG8_SA(1, 1), a1 + hstep, voffA);
            PG8_WAIT_L(8); PG8_BAR; PG8_WAIT_L(0); PG8_MMA(0, 0, At, B0); PG8_BAR; PG8_SCHED;
            PG8_LDB(B1, 0, 1); PG8_STAGE(PG8_SB(0, 0), b2, voffB);
            PG8_BAR; PG8_WAIT_L(0); PG8_MMA(0, 1, At, B1); PG8_BAR;
            PG8_LDA(At, 0, 1); PG8_STAGE(PG8_SA(0, 0), a2, voffA);
            PG8_BAR; PG8_WAIT_L(0); PG8_MMA(1, 0, At, B0); PG8_BAR; PG8_SCHED;
            PG8_STAGE(PG8_SB(0, 1), b2 + hstep, voffB);
            PG8_WAIT_V(6); PG8_BAR; PG8_MMA(1, 1, At, B1); PG8_BAR;
            PG8_LDB(B0, 1, 0); PG8_SCHED; PG8_LDA(At, 1, 0); PG8_STAGE(PG8_SA(0, 1), a2 + hstep, voffA);
            PG8_WAIT_L(8); PG8_BAR; PG8_WAIT_L(0); PG8_MMA(0, 0, At, B0); PG8_BAR; PG8_SCHED;
            PG8_LDB(B1, 1, 1); PG8_STAGE(PG8_SB(1, 0), b3, voffB);
            PG8_BAR; PG8_WAIT_L(0); PG8_MMA(0, 1, At, B1); PG8_BAR;
            PG8_LDA(At, 1, 1); PG8_STAGE(PG8_SA(1, 0), a3, voffA);
            PG8_BAR; PG8_WAIT_L(0); PG8_MMA(1, 0, At, B0); PG8_BAR; PG8_SCHED;
            PG8_STAGE(PG8_SB(1, 1), b3 + hstep, voffB);
            PG8_WAIT_V(6); PG8_BAR; PG8_MMA(1, 1, At, B1); PG8_BAR;
        }
        if constexpr (F8) asm volatile("s_nop 15\n\ts_nop 15" ::: "memory");
        PG8_STAMP();
        if constexpr (!Epi::AFTER_DRAIN) { E(acc, cur, wr, wc, fr, fq); S.done(cur); }
        PG8_STAMP();
        if (!has_next) break;
#pragma unroll
        for (int a = 0; a < 2; ++a)
#pragma unroll
            for (int b = 0; b < 2; ++b)
#pragma unroll
                for (int m = 0; m < 4; ++m)
#pragma unroll
                    for (int n = 0; n < 2; ++n) acc[a][b][m][n] = (f32x4){0.f, 0.f, 0.f, 0.f};
        cur = nxt; cA = nA; cB = nB; ++ui;
    }
    PG8_WAIT_V(0);
    if (wr == 0) PG8_BAR;
    PG8_BAR;
    if constexpr (Epi::AFTER_DRAIN) { E.fused(acc, cur, wr, wc, fr, fq, lds, wid, lane); S.done(cur); }
    PG8_STAMP();
    if (STAMP && wid == 0) { stamps[lane] = lane < nts ? (((unsigned long long)(unsigned)ts_hi << 32) | (unsigned)ts_lo) : 0ull;
        if (lane == 62) stamps[62] = rt_entry; if (lane == 63) stamps[63] = (unsigned long long)wall_clock64(); }
#undef PG8_STAMP
#undef PG8_SA
#undef PG8_SB
#undef PG8_STAGE
#undef PG8_LDA
#undef PG8_LDB
#undef PG8_MMA
#undef PG8_CAT
#undef PG8_WAIT_V
#undef PG8_WAIT_L
#undef PG8_BAR
#undef PG8_SCHED
}
template <class Epi, class Sched, bool STAMP = false>
__device__ __forceinline__ void gemm_phase_gather(PG8_LAS unsigned char* lds, const Gemm g, const Sched& S, const Epi& E, unsigned long long* stamps) {
    const int tid = threadIdx.x, wid = __builtin_amdgcn_readfirstlane(tid >> 6), lane = tid & 63, wr = wid >> 2, wc = wid & 3, fr = lane & 15, fq = lane >> 4;
    const int K = g.K, nt = K / BK;
    int ts_lo = 0, ts_hi = 0, nts = 0; const unsigned long long rt_entry = STAMP ? (unsigned long long)wall_clock64() : 0ull;
#define PG8_STAMP() do { if (STAMP && wid == 0 && nts < 64) { const unsigned long long _c = (unsigned long long)clock64(); \
        ts_lo = (lane == nts) ? (int)(unsigned)_c : ts_lo; ts_hi = (lane == nts) ? (int)(unsigned)(_c >> 32) : ts_hi; ++nts; } } while (0)
    PG8_STAMP();
    unsigned voffA[2], voffB[2];
#pragma unroll
    for (int i = 0; i < 2; ++i) { int R, C; stage_rc(tid * 16 + i * 8192, R, C); const int Rb = Epi::PERM ? ((R & ~31) + perm32(R & 31)) : R;
        voffA[i] = (unsigned)(R * K + C) * 2u; voffB[i] = (unsigned)(Rb * K + C) * 2u; }
    unsigned vc[2][2], vn[2][2];
    const char* gA = (const char*)g.A;
    const size_t kstep = (size_t)(BK * 2);
    const size_t hstep = (size_t)HALF * K * 2;
    const size_t tstep = 2 * hstep;
    const unsigned ldsw = (unsigned)wid * 1024u;
    const int aoff = lds_byte(wr * 64 + fr, fq * 8), boff = lds_byte(wc * 32 + fr, fq * 8);
#define PG8_SA(b, h) (((b) * 2 + (h)) * HTB)
#define PG8_SB(b, h) ((4 + (b) * 2 + (h)) * HTB)
#define PG8_STAGE(bufoff, gbase, voff) do { _Pragma("unroll") for (int _i = 0; _i < 2; ++_i) \
        __builtin_amdgcn_global_load_lds((const unsigned*)((const char*)(gbase) + (voff)[_i]), (PG8_LAS unsigned*)(lds + (bufoff) + ldsw + _i * 8192), 16, 0, 0); } while (0)
#define PG8_LDA(dst, b, h) do { _Pragma("unroll") for (int m = 0; m < 4; ++m) _Pragma("unroll") for (int k = 0; k < 2; ++k) dst[m][k] = *(const PG8_LAS bf16x8*)(lds + PG8_SA(b, h) + aoff + m * 2048 + k * 1024); } while (0)
#define PG8_LDB(dst, b, h) do { _Pragma("unroll") for (int n = 0; n < 2; ++n) _Pragma("unroll") for (int k = 0; k < 2; ++k) dst[n][k] = *(const PG8_LAS bf16x8*)(lds + PG8_SB(b, h) + boff + n * 2048 + k * 1024); } while (0)
#define PG8_MMA(ai, bj, At, Bt) do { __builtin_amdgcn_s_setprio(1); _Pragma("unroll") for (int m = 0; m < 4; ++m) _Pragma("unroll") for (int n = 0; n < 2; ++n) _Pragma("unroll") for (int k = 0; k < 2; ++k) \
        acc[ai][bj][m][n] = __builtin_amdgcn_mfma_f32_16x16x32_bf16(Bt[n][k], At[m][k], acc[ai][bj][m][n], 0, 0, 0); __builtin_amdgcn_s_setprio(0); } while (0)
#define PG8_WAIT_V(n) asm volatile("s_waitcnt vmcnt(" #n ")" ::: "memory")
#define PG8_WAIT_L(n) asm volatile("s_waitcnt lgkmcnt(" #n ")" ::: "memory")
#define PG8_BAR __builtin_amdgcn_s_barrier()
#define PG8_SCHED __builtin_amdgcn_sched_barrier(0)
    Unit cur, nxt; int ui = 0;
    if (!S.next(0, cur)) return;
    f32x4 acc[2][2][4][2];
#pragma unroll
    for (int a = 0; a < 2; ++a)
#pragma unroll
        for (int b = 0; b < 2; ++b)
#pragma unroll
            for (int m = 0; m < 4; ++m)
#pragma unroll
                for (int n = 0; n < 2; ++n) acc[a][b][m][n] = (f32x4){0.f, 0.f, 0.f, 0.f};
    bf16x8 At[4][2], B0[2][2], B1[2][2];
    const char* cA = (const char*)g.A + (size_t)cur.pm * tstep; const char* cB = S.bbase(g, cur, tstep);
    S.arows(cur, K, vc);
#pragma unroll
    for (int h_ = 0; h_ < 2; ++h_) { vn[h_][0] = vc[h_][0]; vn[h_][1] = vc[h_][1]; }
    PG8_STAGE(PG8_SB(0, 0), cB, voffB); PG8_STAGE(PG8_SA(0, 0), gA, vc[0]); PG8_STAGE(PG8_SB(0, 1), cB + hstep, voffB); PG8_STAGE(PG8_SA(0, 1), gA, vc[1]);
    if (wr == 1) PG8_BAR;
    PG8_WAIT_V(4); PG8_BAR;
    PG8_STAGE(PG8_SB(1, 0), cB + kstep, voffB); PG8_STAGE(PG8_SA(1, 0), gA + kstep, vc[0]); PG8_STAGE(PG8_SB(1, 1), cB + hstep + kstep, voffB);
    PG8_WAIT_V(6); PG8_BAR;
    PG8_STAMP();
    for (;;) {
        const bool has_next = S.next(ui + 1, nxt);
        const char* nA = has_next ? (const char*)g.A + (size_t)nxt.pm * tstep : cA; const char* nB = has_next ? S.bbase(g, nxt, tstep) : cB;
        for (int t = 0; t < nt; t += 2) {
            const bool last = (t == nt - 2);
            const char* a1 = gA + (size_t)(t + 1) * kstep;
            const char* a2 = last ? gA : gA + (size_t)(t + 2) * kstep; const char* b2 = last ? nB : cB + (size_t)(t + 2) * kstep;
            const char* a3 = a2 + kstep; const char* b3 = b2 + kstep;
            if (last && has_next) S.arows(nxt, K, vn);
            unsigned sel[2][2];
#pragma unroll
            for (int h_ = 0; h_ < 2; ++h_) { sel[h_][0] = last ? vn[h_][0] : vc[h_][0]; sel[h_][1] = last ? vn[h_][1] : vc[h_][1]; }
            PG8_LDB(B0, 0, 0); PG8_SCHED; PG8_LDA(At, 0, 0); PG8_STAGE(PG8_SA(1, 1), a1, vc[1]);
            PG8_WAIT_L(8); PG8_BAR; PG8_WAIT_L(0); PG8_MMA(0, 0, At, B0); PG8_BAR; PG8_SCHED;
            PG8_LDB(B1, 0, 1); PG8_STAGE(PG8_SB(0, 0), b2, voffB);
            PG8_BAR; PG8_WAIT_L(0); PG8_MMA(0, 1, At, B1); PG8_BAR;
            PG8_LDA(At, 0, 1); PG8_STAGE(PG8_SA(0, 0), a2, sel[0]);
            PG8_BAR; PG8_WAIT_L(0); PG8_MMA(1, 0, At, B0); PG8_BAR; PG8_SCHED;
            PG8_STAGE(PG8_SB(0, 1), b2 + hstep, voffB);
            PG8_WAIT_V(6); PG8_BAR; PG8_MMA(1, 1, At, B1); PG8_BAR;
            PG8_LDB(B0, 1, 0); PG8_SCHED; PG8_LDA(At, 1, 0); PG8_STAGE(PG8_SA(0, 1), a2, sel[1]);
            PG8_WAIT_L(8); PG8_BAR; PG8_WAIT_L(0); PG8_MMA(0, 0, At, B0); PG8_BAR; PG8_SCHED;
            PG8_LDB(B1, 1, 1); PG8_STAGE(PG8_SB(1, 0), b3, voffB);
            PG8_BAR; PG8_WAIT_L(0); PG8_MMA(0, 1, At, B1); PG8_BAR;
            PG8_LDA(At, 1, 1); PG8_STAGE(PG8_SA(1, 0), a3, sel[0]);
            PG8_BAR; PG8_WAIT_L(0); PG8_MMA(1, 0, At, B0); PG8_BAR; PG8_SCHED;
            PG8_STAGE(PG8_SB(1, 1), b3 + hstep, voffB);
            PG8_WAIT_V(6); PG8_BAR; PG8_MMA(1, 1, At, B1); PG8_BAR;
        }
        PG8_STAMP();
        if constexpr (!Epi::AFTER_DRAIN) { E(acc, cur, wr, wc, fr, fq); S.done(cur); }
        PG8_STAMP();
        if (!has_next) break;
#pragma unroll
        for (int a = 0; a < 2; ++a)
#pragma unroll
            for (int b = 0; b < 2; ++b)
#pragma unroll
                for (int m = 0; m < 4; ++m)
#pragma unroll
                    for (int n = 0; n < 2; ++n) acc[a][b][m][n] = (f32x4){0.f, 0.f, 0.f, 0.f};
        cur = nxt; cA = nA; cB = nB; ++ui;
#pragma unroll
        for (int h_ = 0; h_ < 2; ++h_) { vc[h_][0] = vn[h_][0]; vc[h_][1] = vn[h_][1]; }
    }
    PG8_WAIT_V(0);
    if (wr == 0) PG8_BAR;
    PG8_BAR;
    if constexpr (Epi::AFTER_DRAIN) { E.fused(acc, cur, wr, wc, fr, fq, lds, wid, lane); S.done(cur); }
    PG8_STAMP();
    if (STAMP && wid == 0) { stamps[lane] = lane < nts ? (((unsigned long long)(unsigned)ts_hi << 32) | (unsigned)ts_lo) : 0ull;
        if (lane == 62) stamps[62] = rt_entry; if (lane == 63) stamps[63] = (unsigned long long)wall_clock64(); }
#undef PG8_STAMP
#undef PG8_SA
#undef PG8_SB
#undef PG8_STAGE
#undef PG8_LDA
#undef PG8_LDB
#undef PG8_MMA
#undef PG8_WAIT_V
#undef PG8_WAIT_L
#undef PG8_BAR
#undef PG8_SCHED
}
}

struct EpiInproj {
    static constexpr bool PERM = false, AFTER_DRAIN = false;
    bf16_t* z; bf16_t* zT;
    __device__ __forceinline__ void operator()(const pg8::f32x4 (&acc)[2][2][4][2], const pg8::Unit& u, int wr, int wc, int fr, int fq) const {
        const int pm = u.pm, b = pm < 128 ? (pm >> 4) : (pm - 128), key0 = pm < 128 ? (pm & 15) * 256 : 4096, row0 = mt_row0(pm);
#pragma unroll
        for (int bj = 0; bj < 2; ++bj) {
            const int cb = u.pn * 256 + bj * 128;
            if (cb < ZLD) {
#pragma unroll
                for (int ai = 0; ai < 2; ++ai)
#pragma unroll
                    for (int m = 0; m < 4; ++m) { const int rl = ai * 128 + wr * 64 + m * 16 + fr;
#pragma unroll
                        for (int n = 0; n < 2; ++n) { const pg8::f32x4 v = acc[ai][bj][m][n]; uint2 o; o.x = pk2(v[0], v[1]); o.y = pk2(v[2], v[3]);
                            *(uint2*)(z + (size_t)(row0 + rl) * ZLD + cb + wc * 32 + n * 16 + fq * 4) = o; } }
            } else if (cb < NIN) {
#pragma unroll
                for (int ai = 0; ai < 2; ++ai)
#pragma unroll
                    for (int m = 0; m < 4; ++m) { const int rl = ai * 128 + wr * 64 + m * 16 + fr;
#pragma unroll
                        for (int n = 0; n < 2; ++n) { const pg8::f32x4 v = acc[ai][bj][m][n]; const int ch = cb - ZLD + wc * 32 + n * 16 + fq * 4;
                            bf16_t* d = zT + (size_t)(b * 1024 + ch) * NKEY + key0 + rl;
                            d[0] = f2bf(v[0]); d[NKEY] = f2bf(v[1]); d[2 * NKEY] = f2bf(v[2]); d[3 * NKEY] = f2bf(v[3]); } }
            }
        }
    }
};
struct EpiWout {
    static constexpr bool PERM = false, AFTER_DRAIN = false;
    const float* xs_lat; const float* xs_ctx; float* xd_lat; float* xd_ctx; const float* g1base;
    __device__ __forceinline__ void operator()(const pg8::f32x4 (&acc)[2][2][4][2], const pg8::Unit& u, int wr, int wc, int fr, int fq) const {
        const int row0 = mt_row0(u.pm);
        const float* xs = (row0 < TL ? xs_lat + (size_t)row0 * DM : xs_ctx + (size_t)(row0 - TL) * DM) + (size_t)(wr * 64 + fr) * DM + u.pn * 256 + wc * 32 + fq * 4;
        float* xd = (row0 < TL ? xd_lat + (size_t)row0 * DM : xd_ctx + (size_t)(row0 - TL) * DM) + (size_t)(wr * 64 + fr) * DM + u.pn * 256 + wc * 32 + fq * 4;
        const float* g1 = g1base + (size_t)row_mod(row0) * 6144 + u.pn * 256 + wc * 32 + fq * 4;
        float4 gv[2][2];
#pragma unroll
        for (int bj = 0; bj < 2; ++bj)
#pragma unroll
            for (int n = 0; n < 2; ++n) gv[bj][n] = *(const float4*)(g1 + bj * 128 + n * 16);
#pragma unroll
        for (int ai = 0; ai < 2; ++ai) {
            float4 xv[4][2][2];
#pragma unroll
            for (int m = 0; m < 4; ++m)
#pragma unroll
                for (int bj = 0; bj < 2; ++bj)
#pragma unroll
                    for (int n = 0; n < 2; ++n) xv[m][bj][n] = *(const float4*)(xs + (size_t)(ai * 128 + m * 16) * DM + bj * 128 + n * 16);
            __builtin_amdgcn_sched_barrier(0);
#pragma unroll
            for (int m = 0; m < 4; ++m)
#pragma unroll
                for (int bj = 0; bj < 2; ++bj)
#pragma unroll
                    for (int n = 0; n < 2; ++n) {
                        const pg8::f32x4 v = acc[ai][bj][m][n]; const float4 x4 = xv[m][bj][n], g4 = gv[bj][n];
                        float4 o; o.x = x4.x + g4.x * v[0]; o.y = x4.y + g4.y * v[1]; o.z = x4.z + g4.z * v[2]; o.w = x4.w + g4.w * v[3];
                        *(float4*)(xd + (size_t)(ai * 128 + m * 16) * DM + bj * 128 + n * 16) = o;
                    }
            __builtin_amdgcn_sched_barrier(0);
        }
    }
};

struct Moe1Order : pg8::StaticOrder {
    const unsigned char* eb; const int* blkbase; const int* cnt; const int* list;
    __device__ __forceinline__ const char* bbase(const pg8::Gemm& g, const pg8::Unit& u, size_t tstep) const { return (const char*)g.Bt + ((size_t)eb[u.pm] * 2 + u.pn) * tstep; }
    __device__ __forceinline__ void arows(const pg8::Unit& u, int K, unsigned (&vo)[2][2]) const {
        const int e = eb[u.pm], i0 = (u.pm - blkbase[e]) * 256, n_e = cnt[e];
        int lt[2][2];
#pragma unroll
        for (int h = 0; h < 2; ++h)
#pragma unroll
            for (int i = 0; i < 2; ++i) { int R, C; pg8::stage_rc((int)threadIdx.x * 16 + i * 8192, R, C);
                const int ii = i0 + h * 128 + R; lt[h][i] = list[(size_t)min(e, 63) * TT + min(ii, max(n_e - 1, 0))]; }
#pragma unroll
        for (int h = 0; h < 2; ++h)
#pragma unroll
            for (int i = 0; i < 2; ++i) { int R, C; pg8::stage_rc((int)threadIdx.x * 16 + i * 8192, R, C);
                const int ii = i0 + h * 128 + R; const int tok = e == 64 ? ii : (ii < n_e ? lt[h][i] : 0);
                vo[h][i] = (unsigned)(tok * K + C) * 2u; }
    }
};
struct EpiMoe1 {
    static constexpr bool PERM = false, AFTER_DRAIN = false;
    bf16_t* hid;
    __device__ __forceinline__ void operator()(const pg8::f32x4 (&acc)[2][2][4][2], const pg8::Unit& u, int wr, int wc, int fr, int fq) const {
#pragma unroll
        for (int ai = 0; ai < 2; ++ai)
#pragma unroll
            for (int m = 0; m < 4; ++m) { bf16_t* d = hid + ((size_t)u.pm * 256 + ai * 128 + wr * 64 + m * 16 + fr) * 256 + u.pn * 128 + 16 * wc + 4 * fq;
#pragma unroll
                for (int bj = 0; bj < 2; ++bj) { const pg8::f32x4 gt = acc[ai][bj][m][0], up = acc[ai][bj][m][1];
                    uint2 o; o.x = pk2(gt[0] * sigmoidf_(gt[0]) * up[0], gt[1] * sigmoidf_(gt[1]) * up[1]); o.y = pk2(gt[2] * sigmoidf_(gt[2]) * up[2], gt[3] * sigmoidf_(gt[3]) * up[3]);
                    *(uint2*)(d + 64 * bj) = o; } }
    }
};

struct EpiMerge {
    static constexpr bool PERM = false, AFTER_DRAIN = false;
    const bf16_t* plo; const bf16_t* phi; bf16_t* out; const float* rs;
    __device__ __forceinline__ void operator()(const pg8::f32x4 (&acc)[2][2][4][2], const pg8::Unit& u, int wr, int wc, int fr, int fq) const {
        const int row0 = mt_row0(u.pm) + wr * 64 + fr;
        const int col = u.pn * 64 + wc * 16 + fq * 4;
        uint2 pp[8][4]; float scv[8];
#pragma unroll
        for (int q = 0; q < 8; ++q) {
            const int row = row0 + (q >> 2) * 128 + (q & 3) * 16;
            pp[q][0] = *(const uint2*)(plo + (size_t)row * 2048 + col); pp[q][1] = *(const uint2*)(plo + (size_t)row * 2048 + 1024 + col);
            pp[q][2] = *(const uint2*)(phi + (size_t)row * 2048 + col); pp[q][3] = *(const uint2*)(phi + (size_t)row * 2048 + 1024 + col);
            scv[q] = rs[row];
        }
        __builtin_amdgcn_sched_barrier(0);
#pragma unroll
        for (int q = 0; q < 8; ++q) {
            const int ai = q >> 2, m = q & 3, row = row0 + ai * 128 + m * 16;
            const float sc = scv[q];
            float o0, o1, o2, o3;
            { const pg8::f32x4 v = acc[ai][0][m][0]; const uint2 pv = pp[q][0]; o0 = sigmoidf_(v[0] * sc) * lo_bf(pv.x); o1 = sigmoidf_(v[1] * sc) * hi_bf(pv.x); o2 = sigmoidf_(v[2] * sc) * lo_bf(pv.y); o3 = sigmoidf_(v[3] * sc) * hi_bf(pv.y); }
            { const pg8::f32x4 v = acc[ai][0][m][1]; const uint2 pv = pp[q][1]; o0 += sigmoidf_(v[0] * sc) * lo_bf(pv.x); o1 += sigmoidf_(v[1] * sc) * hi_bf(pv.x); o2 += sigmoidf_(v[2] * sc) * lo_bf(pv.y); o3 += sigmoidf_(v[3] * sc) * hi_bf(pv.y); }
            { const pg8::f32x4 v = acc[ai][1][m][0]; const uint2 pv = pp[q][2]; o0 += sigmoidf_(v[0] * sc) * lo_bf(pv.x); o1 += sigmoidf_(v[1] * sc) * hi_bf(pv.x); o2 += sigmoidf_(v[2] * sc) * lo_bf(pv.y); o3 += sigmoidf_(v[3] * sc) * hi_bf(pv.y); }
            { const pg8::f32x4 v = acc[ai][1][m][1]; const uint2 pv = pp[q][3]; o0 += sigmoidf_(v[0] * sc) * lo_bf(pv.x); o1 += sigmoidf_(v[1] * sc) * hi_bf(pv.x); o2 += sigmoidf_(v[2] * sc) * lo_bf(pv.y); o3 += sigmoidf_(v[3] * sc) * hi_bf(pv.y); }
            uint2 wv; wv.x = pk2(o0, o1); wv.y = pk2(o2, o3);
            *(uint2*)(out + (size_t)row * DM + col) = wv;
        }
    }
};
#define GEMM_TILE_LOOP(NM_, NN_, mt, nt, BODY) do { \
    const int _SN = ((NN_) + 3) >> 2, _SM = ((NM_) + 7) >> 3, _nx = (int)gridDim.x >> 3, _xcd = (int)blockIdx.x & 7; \
    if (((int)gridDim.x & 7) == 0) { \
        for (int _s = _xcd; _s < _SM * _SN; _s += 8) \
            for (int _jj = (int)blockIdx.x >> 3; _jj < 32; _jj += _nx) { \
                const int mt = (_s / _SN) * 8 + (_jj & 7), nt = (_s % _SN) * 4 + (_jj >> 3); \
                if (mt < (NM_) && nt < (NN_)) { BODY; } } \
    } else { for (int _u = (int)blockIdx.x; _u < (NM_) * (NN_); _u += (int)gridDim.x) { const int mt = _u / (NN_), nt = _u % (NN_); BODY; } } \
} while (0)
NOINL void f_p0() { const Params& p = kparams(); char* lds = lds_at(256); UNIT_LOOP(u, 320, 0) { if (u < 192) mod_unit(p, u, lds); else rope_unit(p, u - 192); } }
NOINL void f_norm1(int l) { const Params& p = kparams(); const int rpb = (TT + (int)gridDim.x - 1) / (int)gridDim.x, r0 = (int)blockIdx.x * rpb; norm_rows(p, l, r0, min(TT, r0 + rpb), 0); }
NOINL void f_conv(int l) {
    const Params& p = kparams(); char* lds = lds_at(256);
    const int G = (int)gridDim.x; int u = (int)((blockIdx.x + G - (544 % G)) % G);
    float4 va[4], vb[4];
    if (u < CJ_END) conv_unit<0>(p, l, u, lds, va);
    for (;;) {
        if (u >= CJ_END) break;
        { const int un = u + G; conv_unit<0>(p, l, un < CJ_END ? un : u, lds, vb); conv_unit<1>(p, l, u, lds, va); u = un; }
        if (u >= CJ_END) break;
        { const int un = u + G; conv_unit<0>(p, l, un < CJ_END ? un : u, lds, va); conv_unit<1>(p, l, u, lds, vb); u = un; }
    }
}
NOINL void f_h2tab(int l) { const Params& p = kparams(); char* lds = lds_at(256); UNIT_LOOP(u, 68, 544 + CJ_END) h2tab_unit(p, l, u, lds); }
NOINL void f_spectrum(int l) {
    const Params& p = kparams(); char* lds = lds_at(256);
    UNIT_LOOP(u, 512, 0) spectrum8192_unit(p, l, u >> 8, u & 255, lds);
}
NOINL void f_spectrum_ctx(int l) {
    const Params& p = kparams(); char* lds = lds_at(256);
    const int b0 = (int)gridDim.x >= 232 ? 200 : 0;
    for (int u = (int)blockIdx.x - b0; u >= 0 && u < 32; u += (int)gridDim.x) spectrum512_unit(p, l, u, lds);
}
NOINL void f_inproj(int off) {
    const Params& p = kparams();
    pg8::Gemm g{(const bf16_t*)(p.ws + OFF_H), (const bf16_t*)(p.ws + OFF_WIN), TT, WIN_G0, 1024};
    pg8::StaticOrder S; S.init(TT, WIN_G0, (int)gridDim.x, (int)blockIdx.x);
    EpiInproj E{(bf16_t*)(p.ws + OFF_Z), (bf16_t*)(p.ws + OFF_ZT)};
    __syncthreads();
    pg8::gemm_phase<EpiInproj, pg8::StaticOrder, false>((PG8_LAS unsigned char*)(uintptr_t)256, g, S, E, nullptr);
    __syncthreads();
}
NOINL void f_hyena(int l) { const Params& p = kparams(); char* lds = lds_at(256); const int n = l == 0 ? 1088 : 1024; UNIT_LOOP(u, n, 0) hyena_unit(p, l, u, lds); }
NOINL void f_na(int l, int off) { const Params& p = kparams(); char* lds = lds_at(256); const int n = l == 0 ? 544 : 512; UNIT_LOOP(u, n, off) na_unit(p, l, u, lds); }
NOINL void f_lru1(int l, int off) { const Params& p = kparams(); char* lds = lds_at(256); UNIT_LOOP(u, 1088, off) lru1_unit(p, l, u, lds); }
NOINL void f_qproj(int off) { const Params& p = kparams(); char* lds = lds_at(256); UNIT_LOOP(u, NMT * 2, off) qproj_unit(p, u, lds); }
NOINL void f_kvproj(int off) { const Params& p = kparams(); char* lds = lds_at(256); UNIT_LOOP(u, NMT * 2, off) kvproj_unit(p, u, lds); }
NOINL void f_mla(int l) { const Params& p = kparams(); char* lds = lds_at(256); const int n = l == 0 ? 544 : 512; UNIT_LOOP(u, n, 0) mla_unit(p, u, lds); }
NOINL void f_ytrans(int off) { const Params& p = kparams(); char* lds = lds_at(256); UNIT_LOOP(u, 544, off) ytrans_unit(p, u, lds); }
NOINL void f_lrucarry(int l) { const Params& p = kparams(); UNIT_LOOP(u, 8, 0) lru_carry_unit(p, l, u); }
NOINL void f_lru2(int l, int off) { const Params& p = kparams(); UNIT_LOOP(u, 272, off) lru2_unit(p, l, u); }
NOINL void f_quant(int nmt) {
    const Params& p = kparams(); const int rows = nmt * 256;
    int nb = (int)gridDim.x, b = (int)blockIdx.x;
    const int extra = nmt * 8 - (nmt * 8 / nb) * nb;
    if (extra > 0 && extra * 2 <= nb) { if (b < extra) return; b -= extra; nb -= extra; }
    const int rpb = (rows + nb - 1) / nb, r0 = b * rpb;
    quant_rows(p, r0, min(rows, r0 + rpb));
}
NOINL void f_pbranch(int nmt) { const Params& p = kparams(); char* lds = lds_at(256); UNIT_LOOP(u, nmt * 8, 0) pbranch_unit(p, u, lds); }
NOINL void f_merge(int nmt) {
    const Params& p = kparams();
    pg8::Gemm g{(const bf16_t*)(p.ws + OFF_H8), (const bf16_t*)(p.ws + OFF_WG8), nmt * 256, 4096, 512};
    pg8::StaticOrder S; S.init(nmt * 256, 4096, (int)gridDim.x, (int)blockIdx.x);
    EpiMerge E{(const bf16_t*)(p.ws + OFF_PLO), (const bf16_t*)(p.ws + OFF_PHI), (bf16_t*)(p.ws + OFF_ACC), (const float*)(p.ws + OFF_RS)};
    __syncthreads();
    pg8::gemm_phase<EpiMerge, pg8::StaticOrder, false, true>((PG8_LAS unsigned char*)(uintptr_t)256, g, S, E, nullptr);
    __syncthreads();
}
NOINL void f_wout(int l, int nmt) {
    const Params& p = kparams();
    pg8::Gemm g{(const bf16_t*)(p.ws + OFF_ACC), (const bf16_t*)(p.ws + OFF_WOUT), nmt * 256, 1024, 1024};
    pg8::StaticOrder S; S.init(nmt * 256, 1024, (int)gridDim.x, (int)blockIdx.x);
    EpiWout E{l == 0 ? p.in[I_X] : p.out, l == 0 ? p.in[I_CTX] : (const float*)(p.ws + OFF_XC), p.out, (float*)(p.ws + OFF_XC), (const float*)(p.ws + OFF_MOD) + (size_t)l * 9 * 6144 + 2048};
    __syncthreads();
    pg8::gemm_phase<EpiWout, pg8::StaticOrder, false>((PG8_LAS unsigned char*)(uintptr_t)256, g, S, E, nullptr);
    __syncthreads();
}
NOINL void f_router(int l, int nmt) { const Params& p = kparams(); char* lds = lds_at(256); const int tot = nmt * 256, rpb = (tot + (int)gridDim.x - 1) / (int)gridDim.x, r0 = (int)blockIdx.x * rpb; if (r0 < tot) router_unit(p, l, r0, min(tot, r0 + rpb), lds); }
NOINL void f_moe1(int l, int nmt) {
    const Params& p = kparams(); char* lds = lds_at(256);
    const MoeTab t = moe_tables(p, l, nmt * 256, lds);
    const int nrb = t.blkbase[65];
    pg8::Gemm g{(const bf16_t*)(p.ws + OFF_H), (const bf16_t*)(p.ws + OFF_WGU), nrb * 256, 512, 1024};
    Moe1Order S; S.init(nrb * 256, 512, (int)gridDim.x, (int)blockIdx.x);
    S.eb = (const unsigned char*)(t.cbase + 80); S.blkbase = t.blkbase; S.cnt = t.cnt; S.list = (const int*)(p.ws + OFF_LIST);
    EpiMoe1 E{(bf16_t*)(p.ws + OFF_HID)};
    __syncthreads();
    pg8::gemm_phase_gather<EpiMoe1, Moe1Order, false>((PG8_LAS unsigned char*)(uintptr_t)256, g, S, E, nullptr);
    __syncthreads();
}
NOINL void f_moe2(int l, int nmt) { const Params& p = kparams(); char* lds = lds_at(256); const MoeTab t = moe_tables(p, l, nmt * 256, lds); const int nrb = t.blkbase[65], s0 = t.blkbase[64];
    UNIT_LOOP(u, nrb, 0) { int rb = u + s0; if (rb >= nrb) rb -= nrb; moe2_unit(p, l, t, rb, lds); } }
NOINL void f_combine(int l, int nmt) { const Params& p = kparams(); char* lds = lds_at(256); const MoeTab t = moe_tables(p, l, nmt * 256, lds); const int tot = nmt * 256, rpb = (tot + (int)gridDim.x - 1) / (int)gridDim.x, r0 = (int)blockIdx.x * rpb; combine_unit(p, l, t, r0, min(tot, r0 + rpb)); }


#ifdef DIAG
struct DiagBuf { size_t off; size_t n; int kind; };
DEVI void diag_phase(const Params& p, const XcdBarrier& bar) {
    const DiagBuf bufs[] = {
        {OFF_MOD, 2 * 9 * 6144, 1}, {OFF_COS, 2 * 4096 * 16, 1}, {OFF_H2T, 4352 * 64, 1}, {OFF_WIN, (size_t)(WIN_G0 + 4096) * 1024, 0}, {OFF_WGU, (size_t)65 * 512 * 1024, 0},
        {OFF_WDT, (size_t)65 * 1024 * 256, 0}, {OFF_WUQ, (OFF_H - OFF_WUQ) / 2, 0}, {OFF_H, (size_t)TT * DM, 0}, {OFF_HS, (size_t)2 * 256 * 8192 * 2, 1}, {OFF_HSC, (size_t)2 * 256 * 512 * 2, 1},
        {OFF_Z, (size_t)TT * ZLD, 0}, {OFF_ZT, (size_t)8 * 1024 * NKEY, 0}, {OFF_YT, (size_t)8 * 256 * NKEY, 0}, {OFF_Q, (size_t)8 * 4 * NKEY * 96, 0}, {OFF_K, (size_t)8 * 4 * NKEY * 96, 0},
        {OFF_VT, (size_t)8 * 4 * 64 * NKEY, 0}, {OFF_HLOC, (size_t)2 * TT * 256, 0}, {OFF_CUMA, (size_t)2 * TT * 256, 0}, {OFF_SEGA, (size_t)4 * 1088 * 256, 1}, {OFF_BR, (size_t)TT * DM, 0},
        {OFF_XC, (size_t)TCX * DM, 1}, {OFF_WTS, (size_t)TT * 6, 1} };
    constexpr int NB = sizeof(bufs) / sizeof(bufs[0]);
    unsigned* flags = (unsigned*)(p.ws + OFF_GCNT) + 1024;
    xcd_barrier(bar);
    const size_t gtid = (size_t)blockIdx.x * 512 + threadIdx.x, gn = (size_t)gridDim.x * 512;
    for (int b = DIAG_FIRST; b < NB; ++b) {
        unsigned bad = 0, poi = 0;
        if (bufs[b].kind == 0) { const bf16_t* q = (const bf16_t*)(p.ws + bufs[b].off);
            for (size_t i = gtid; i < bufs[b].n; i += gn) { const unsigned v = q[i]; if ((v & 0x7F80u) == 0x7F80u || fabsf(bf2f((bf16_t)v)) > 1e5f) ++bad; if (v == 0xAAAAu) ++poi; } }
        else { const unsigned* q = (const unsigned*)(p.ws + bufs[b].off);
            for (size_t i = gtid; i < bufs[b].n; i += gn) { const unsigned v = q[i]; if ((v & 0x7F800000u) == 0x7F800000u || fabsf(__uint_as_float(v)) > 1e5f) ++bad; if (v == 0xAAAAAAAAu) ++poi; } }
        bad = (unsigned)wave_sum((float)bad); poi = (unsigned)wave_sum((float)poi);
        if ((threadIdx.x & 63) == 0) { if (bad) atomicAdd(&flags[2 * b], bad); if (poi) atomicAdd(&flags[2 * b + 1], poi); }
    }
    xcd_barrier(bar);
    float K = 1000.f, K2 = 0.f;
    for (int b = NB - 1; b >= DIAG_FIRST; --b) {
        const unsigned bad = __hip_atomic_load(&flags[2 * b], __ATOMIC_RELAXED, __HIP_MEMORY_SCOPE_AGENT), poi = __hip_atomic_load(&flags[2 * b + 1], __ATOMIC_RELAXED, __HIP_MEMORY_SCOPE_AGENT);
        if (bad) K = 1000.f * (float)(10 + b);
        else if ((size_t)poi * 2 > bufs[b].n) K = 1000.f * (float)(50 + b);
    }
#if DIAG_MODE == 1
    {
        float* acc = (float*)((unsigned*)(p.ws + OFF_GCNT) + 2048);
        float s = 0.f; const int b = DIAG_ARG;
        if (bufs[b].kind == 0) { const bf16_t* q = (const bf16_t*)(p.ws + bufs[b].off); for (size_t i = gtid; i < bufs[b].n; i += gn) { const float v = bf2f(q[i]); s += v * v; } }
        else { const float* q = (const float*)(p.ws + bufs[b].off); for (size_t i = gtid; i < bufs[b].n; i += gn) { const float v = q[i]; s += v * v; } }
        s = wave_sum(s); if ((threadIdx.x & 63) == 0) atomicAdd(acc, s);
        xcd_barrier(bar);
        K = 1000.f * sqrtf(__hip_atomic_load(acc, __ATOMIC_RELAXED, __HIP_MEMORY_SCOPE_AGENT) / (float)bufs[b].n);
    }
#elif DIAG_MODE == 5
    {
        unsigned* cn = (unsigned*)(p.ws + OFF_GCNT) + 2048;
        unsigned nn = 0, nz = 0;
        const unsigned char* q = (const unsigned char*)(p.ws + OFF_H8);
        for (size_t i = gtid; i < (size_t)TT * 1024; i += gn) { const unsigned v = q[i]; if ((v & 0x7Fu) == 0x7Fu) ++nz; }
        q = (const unsigned char*)(p.ws + OFF_WG8);
        for (size_t i = gtid; i < (size_t)4096 * 1024; i += gn) { const unsigned v = q[i]; if ((v & 0x7Fu) == 0x7Fu) ++nn; }
        nn = (unsigned)wave_sum((float)nn); nz = (unsigned)wave_sum((float)nz);
        if ((threadIdx.x & 63) == 0) { if (nn) atomicAdd(&cn[0], nn); if (nz) atomicAdd(&cn[1], nz); }
        xcd_barrier(bar);
        K = (float)__hip_atomic_load(&cn[0], __ATOMIC_RELAXED, __HIP_MEMORY_SCOPE_AGENT);
        K2 = (float)__hip_atomic_load(&cn[1], __ATOMIC_RELAXED, __HIP_MEMORY_SCOPE_AGENT);
    }
#elif DIAG_MODE == 2
    K = (float)__hip_atomic_load(&flags[2 * DIAG_ARG], __ATOMIC_RELAXED, __HIP_MEMORY_SCOPE_AGENT);
#elif DIAG_MODE == 3
    {
        unsigned* mn = (unsigned*)(p.ws + OFF_GCNT) + 2048;
        if (blockIdx.x == 0 && threadIdx.x == 0) __hip_atomic_store(mn, 0xFFFFFFFFu, __ATOMIC_RELAXED, __HIP_MEMORY_SCOPE_AGENT);
        xcd_barrier(bar);
        const int b = DIAG_ARG; unsigned best = 0xFFFFFFFFu;
        if (bufs[b].kind == 0) { const bf16_t* q = (const bf16_t*)(p.ws + bufs[b].off);
            for (size_t i = gtid; i < bufs[b].n; i += gn) { const unsigned v = q[i]; if (((v & 0x7F80u) == 0x7F80u || fabsf(bf2f((bf16_t)v)) > 1e5f) && (unsigned)i < best) best = (unsigned)i; } }
        if (best != 0xFFFFFFFFu) atomicMin(mn, best);
        xcd_barrier(bar);
        const unsigned r = __hip_atomic_load(mn, __ATOMIC_RELAXED, __HIP_MEMORY_SCOPE_AGENT);
        K = (float)((r / DIAG_DIV) % DIAG_MOD);
        K2 = 1000.f * (float)((r / DIAG_DIV2) % DIAG_MOD2);
#ifdef DIAG_ROW0
        { const bf16_t* q = (const bf16_t*)(p.ws + bufs[b].off); int cnt = 0, cnt2 = 0;
          for (int c2 = 0; c2 < ZLD; ++c2) { const unsigned v = q[(size_t)DIAG_ROW0 * ZLD + c2]; if ((v & 0x7F80u) == 0x7F80u) ++cnt; }
          for (int r2 = 0; r2 < 99; ++r2) { const unsigned v = q[(size_t)r2 * ZLD + DIAG_COL0]; if ((v & 0x7F80u) == 0x7F80u) ++cnt2; }
          K = (float)cnt; K2 = 1000.f * (float)cnt2; }
#endif
#ifdef DIAG_VAL
        { const unsigned v = ((const bf16_t*)(p.ws + bufs[b].off))[r]; const float f = fabsf(bf2f((bf16_t)v)); K = ((v & 0x7F80u) == 0x7F80u) ? ((v & 0x7Fu) ? 49.f : 48.f) : fminf(47.f, log2f(f) * 0.25f); }
#endif
    }
#endif
    for (size_t i = gtid; i < (size_t)TL * DM; i += gn) p.out[i] = (i == 12345 && K2 != 0.f) ? K2 : K;
}
#endif

__global__ void __launch_bounds__(512, 2) mega_fwd(Params p) {
    if (threadIdx.x == 0) *(uint4*)smem = make_uint4(0u, 0u, 0u, 0u);
    __syncthreads();
    XcdBarrier bar = xcd_barrier_post((unsigned*)(p.ws + OFF_BAR), (volatile LAS unsigned*)smem);
    int ph = 0;
#ifdef DIAGT
#define STAMP(i) do { if (blockIdx.x == 0 && threadIdx.x == 0) ((unsigned long long*)(p.ws + OFF_GCNT + 8192))[i] = wall_clock64(); } while (0)
#else
#define STAMP(i) do {} while (0)
#endif
#ifndef REP_PHASE
#define REP_PHASE -1
#endif
#define PHASE(...) do { if (ph >= p.ph_lo && ph < p.ph_hi) { STAMP(ph); __VA_ARGS__; if (ph == REP_PHASE) { xcd_barrier(bar); __VA_ARGS__; } if (ph + 1 < p.ph_hi) xcd_barrier(bar); } ++ph; } while (0)
    PHASE({ f_p0(); f_conv(0); f_h2tab(0); });
#define LAYER(l) do { \
        const int nmt = l == 0 ? NMT : 128; \
        PHASE({ f_norm1(l); if (l > 0) { f_conv(l); f_h2tab(l); } }); \
        PHASE({ f_spectrum(l); f_inproj(0); if (l == 0) f_spectrum_ctx(l); }); \
        PHASE({ const int nh = l == 0 ? 1088 : 1024, nn = l == 0 ? 544 : 512; f_hyena(l); f_na(l, nh); f_lru1(l, nh + nn); f_qproj(nh + nn + 1088); f_kvproj(nh + nn + 1088 + NMT * 2); }); \
        PHASE({ f_lrucarry(l); f_mla(l); f_lru2(l, l == 0 ? 544 : 512); f_ytrans((l == 0 ? 544 : 512) + 272); }); \
        PHASE({ f_quant(nmt); f_pbranch(nmt); }); \
        PHASE(f_merge(nmt)); \
        PHASE(f_wout(l, nmt)); \
        PHASE(f_router(l, nmt)); \
        PHASE(f_moe1(l, nmt)); \
        PHASE(f_moe2(l, nmt)); \
        PHASE(f_combine(l, nmt)); \
    } while (0)
    LAYER(0);
    LAYER(1);
#ifdef DIAG
    diag_phase(p, bar);
#endif
#ifdef DIAGT
    {
        xcd_barrier(bar); STAMP(ph); xcd_barrier(bar);
        const unsigned long long* ts = (const unsigned long long*)(p.ws + OFF_GCNT + 8192);
        const float K = (float)(__hip_atomic_load(ts + DIAGT_A + 1, __ATOMIC_RELAXED, __HIP_MEMORY_SCOPE_AGENT) - __hip_atomic_load(ts + DIAGT_A, __ATOMIC_RELAXED, __HIP_MEMORY_SCOPE_AGENT)) * 0.01f;
        const float K2 = (float)(__hip_atomic_load(ts + DIAGT_B + 1, __ATOMIC_RELAXED, __HIP_MEMORY_SCOPE_AGENT) - __hip_atomic_load(ts + DIAGT_B, __ATOMIC_RELAXED, __HIP_MEMORY_SCOPE_AGENT)) * 1.0f;
        const size_t gtid = (size_t)blockIdx.x * 512 + threadIdx.x, gn = (size_t)gridDim.x * 512;
        for (size_t i = gtid; i < (size_t)TL * DM; i += gn) p.out[i] = (i == 12345) ? K2 : K;
    }
#endif
}

extern "C" void kernel_launch(void* const* d_in, const int* in_sizes, int n_in, void* d_out, int out_size, void* d_ws, size_t ws_size, hipStream_t stream) {
    static int grid = 0;
    if (!grid) {
        int dev = 0, cus = 0, per_cu = 0;
        hipGetDevice(&dev);
        hipDeviceGetAttribute(&cus, hipDeviceAttributeMultiprocessorCount, dev);
        if (hipFuncSetAttribute((const void*)mega_fwd, hipFuncAttributeMaxDynamicSharedMemorySize, LDS_BYTES + 256) != hipSuccess) fprintf(stderr, "hipFuncSetAttribute failed\n");
        if (hipOccupancyMaxActiveBlocksPerMultiprocessor(&per_cu, (const void*)mega_fwd, 512, LDS_BYTES + 256) != hipSuccess || per_cu < 1) { fprintf(stderr, "occupancy query failed\n"); per_cu = 1; }
        grid = cus * 1;
        if (ws_size < WS_END) fprintf(stderr, "workspace too small: %zu < %zu\n", ws_size, (size_t)WS_END);
    }
    hipMemsetAsync(d_ws, 0, ZERO_BYTES, stream);
    Params p{};
    for (int i = 0; i < 41; ++i) p.in[i] = (const float*)d_in[i];
    p.out = (float*)d_out; p.ws = (char*)d_ws; p.ph_lo = 0; p.ph_hi = PH_HI;
    hipLaunchKernelGGL(mega_fwd, dim3(grid), dim3(512), LDS_BYTES + 256, stream, p);
}
```

```cpp
#include <hip/hip_runtime.h>
#include <stdint.h>
#include <stdio.h>

typedef unsigned short bf16_t;
typedef short bf16x8 __attribute__((ext_vector_type(8)));
typedef float f32x16 __attribute__((ext_vector_type(16)));
typedef unsigned u32x4 __attribute__((ext_vector_type(4)));

#define DEVI __device__ __forceinline__

constexpr int DM = 1024, TL = 32768, TCX = 2048, TT = 34816, NKEY = 4352;
constexpr int ZLD = 1408;
constexpr int NIN = 2432;
constexpr int WIN_G0 = 2560;
constexpr int NMT = 136;
constexpr int ZC_QL = 0, ZC_KVL = 192, ZC_KR = 320, ZC_NAQ = 384, ZC_NAK = 640, ZC_LU = 896, ZC_LG = 1152;
constexpr int ZT_NAV = 0, ZT_HY = 256;

constexpr size_t AL(size_t x) { return (x + 255) & ~(size_t)255; }
constexpr size_t OFF_BAR = 0;
constexpr size_t OFF_GCNT = 16384;
constexpr size_t ZERO_BYTES = 32768;
constexpr size_t OFF_MOD = 32768;
constexpr size_t OFF_COS = OFF_MOD + AL(2 * 9 * 6144 * 4);
constexpr size_t OFF_SIN = OFF_COS + 4096 * 16 * 4;
constexpr size_t OFF_H2T = OFF_SIN + 4096 * 16 * 4;
constexpr size_t OFF_SEGA = OFF_H2T + 4352 * 64 * 4;
constexpr size_t OFF_SEGB = OFF_SEGA + 2 * 1088 * 256 * 4;
constexpr size_t OFF_LWT = OFF_SEGB + 2 * 1088 * 256 * 4;
constexpr size_t OFF_HIN = OFF_LWT + 16 * 64 * 64 * 2;
constexpr size_t OFF_TOKS = OFF_HIN + 2 * 1088 * 256 * 4;
constexpr size_t OFF_WTS = OFF_TOKS + AL((size_t)TT * 6 * 4);
constexpr size_t OFF_XC = OFF_WTS + AL((size_t)TT * 6 * 4);
constexpr size_t OFF_LIST = OFF_XC + (size_t)TCX * DM * 4;
constexpr size_t OFF_WDT = OFF_LIST + (size_t)64 * TT * 4;
constexpr size_t OFF_ZBIG = OFF_WDT + (size_t)65 * 1024 * 256 * 2;
constexpr size_t OFF_Z = OFF_ZBIG;
constexpr size_t OFF_ZT = OFF_Z + (size_t)TT * ZLD * 2;
constexpr size_t ZBIG_BYTES = (size_t)TT * ZLD * 2 + (size_t)8 * 1024 * NKEY * 2;
constexpr size_t OFF_PHI = OFF_ZBIG;
constexpr size_t OFF_HID = OFF_ZBIG;
constexpr size_t HID_BYTES = (size_t)1016 * 256 * 256 * 2;
constexpr size_t OFF_Y = OFF_ZBIG + HID_BYTES;
constexpr size_t Y_BYTES = (size_t)TT * 6 * DM * 2;
constexpr size_t OFF_WGU = OFF_ZBIG + ZBIG_BYTES;
constexpr size_t OFF_WIN = OFF_WGU + (size_t)65 * 512 * 1024 * 2;
constexpr size_t OFF_WUQ = OFF_WIN + (size_t)(WIN_G0 + 4096) * 1024 * 2;
constexpr size_t OFF_WUKV = OFF_WUQ + 384 * 192 * 2;
constexpr size_t OFF_WBR = OFF_WUKV + 512 * 128 * 2;
constexpr size_t OFF_WOUT = OFF_WBR + 4 * 1024 * 256 * 2;
constexpr size_t OFF_RT = OFF_WOUT + 1024 * 1024 * 2;
constexpr size_t OFF_H = OFF_RT + 128 * 1024 * 2;
constexpr size_t OFF_BR = OFF_H + (size_t)TT * DM * 2;
constexpr size_t OFF_ACC = OFF_BR;
constexpr size_t OFF_YT = OFF_BR + (size_t)TT * DM * 2;
constexpr size_t OFF_PLO = OFF_YT;
constexpr size_t OFF_Q = OFF_YT + (size_t)8 * 256 * NKEY * 2;
constexpr size_t OFF_K = OFF_Q + (size_t)8 * 4 * NKEY * 96 * 2;
constexpr size_t OFF_VT = OFF_K + (size_t)8 * 4 * NKEY * 96 * 2;
constexpr size_t OFF_HS = OFF_VT + (size_t)8 * 4 * 64 * NKEY * 2;
constexpr size_t OFF_HSC = OFF_HS + (size_t)2 * 256 * 8192 * 8;
constexpr size_t OFF_HLOC = OFF_HSC + (size_t)2 * 256 * 512 * 8;
constexpr size_t OFF_CUMA = OFF_HLOC + (size_t)2 * TT * 256 * 2;
constexpr size_t WS_END = OFF_CUMA + (size_t)2 * TT * 256 * 2;
constexpr size_t OFF_WG8 = OFF_WIN + (size_t)WIN_G0 * 1024 * 2;
constexpr size_t OFF_H8 = OFF_CUMA;
static_assert(OFF_PLO + (size_t)TT * 4096 <= OFF_CUMA, "P_lo must not reach h8");
constexpr size_t OFF_RS = OFF_SEGA;
constexpr float WG8_SCALE = 512.f;
static_assert(OFF_Y + Y_BYTES <= WS_END, "Y must fit inside the workspace map");
static_assert(OFF_PLO + (size_t)TT * 4096 <= WS_END && OFF_PHI + (size_t)TT * 4096 <= OFF_ZBIG + ZBIG_BYTES, "P halves must fit the dead regions");
static_assert(OFF_Y >= OFF_HID + HID_BYTES, "Y vs hid");
static_assert(WS_END < (size_t)670 * 1000 * 1000, "workspace too large");

constexpr int LDS_BYTES = 147456;
#ifndef PH_HI
#define PH_HI 1000
#define DIAGT_A 1
#define DIAGT_B 2
#define DIAG_FIRST 0
#define DIAG_MODE 0
#define DIAG_ARG 10
#define DIAG_DIV 1408
#define DIAG_MOD 50
#define DIAG_DIV2 (1408 * 400)
#define DIAG_MOD2 100
#endif

struct Params {
    const float* in[41];
    float* out;
    char* ws;
    int ph_lo, ph_hi;
};

enum { I_X = 0, I_C, I_CTX, I_CCTX, I_WMOD, I_BMOD, I_GN1, I_GN2, I_WIN, I_GQ, I_WUQ, I_GKV, I_WUKV, I_RPB, I_HSW, I_HSB, I_HW1, I_HB1, I_HW2,
       I_HB2, I_HW3, I_HDEC, I_HBIAS, I_LCW, I_LCB, I_LWA, I_LBA, I_LWX, I_LBX, I_LLAM, I_WBR, I_WOUT, I_RW, I_RB, I_EG, I_EU, I_ED, I_SG, I_SU,
       I_SD, I_GF };

#define XB_TMO      128
#define XB_XCNT(j)  (256  + 64 * (j))
#define XB_XSUB(j)  (1280 + 64 * (j))
#define XB_XGEN(j)  (2304 + 64 * (j))
#define XB_TOP      3328
#define XB_TOPGEN   3392
#define XCD_BAR_WORDS 3456
#define XB_SPIN_CAP (1u << 18)
#define LAS __attribute__((address_space(3)))

__device__ __forceinline__ unsigned xb_ld(unsigned* p)              { return __hip_atomic_load(p, __ATOMIC_RELAXED, __HIP_MEMORY_SCOPE_AGENT); }
__device__ __forceinline__ unsigned xb_add(unsigned* p, unsigned v) { return __hip_atomic_fetch_add(p, v, __ATOMIC_RELAXED, __HIP_MEMORY_SCOPE_AGENT); }
__device__ __forceinline__ unsigned xb_xcc_id() { return (unsigned)__builtin_amdgcn_s_getreg((3 << 11) | 20) & 0xFu; }
#define XB_SPIN(cond, bar) do { unsigned _sp = 0; while (cond) { __builtin_amdgcn_s_sleep(1); \
    if ((++_sp & 255u) == 0u) { if (xb_ld(&(bar)[XB_TMO])) break; if (_sp > XB_SPIN_CAP) { atomicAdd(&(bar)[XB_TMO], 1u); break; } } } } while (0)

struct XcdBarrier { unsigned* bar; unsigned x; volatile LAS unsigned* st; };

__device__ __forceinline__ XcdBarrier xcd_barrier_post(unsigned* bar, volatile LAS unsigned* st) {
    XcdBarrier b; b.bar = bar; b.x = xb_xcc_id(); b.st = st;
    if (threadIdx.x == 0) (void)xb_add(&bar[XB_XCNT(b.x)], 1u);
    return b;
}
__device__ __forceinline__ void xcd_barrier_complete(unsigned* bar, unsigned x, unsigned& nloc, unsigned& nx) {
    const unsigned G = gridDim.x * gridDim.y * gridDim.z;
    unsigned sum, cnt, mine, sp = 0u;
    for (;;) {
        sum = 0u; cnt = 0u; mine = 0u;
#pragma unroll
        for (unsigned j = 0; j < 16; ++j) { const unsigned c = xb_ld(&bar[XB_XCNT(j)]); sum += c; cnt += (c > 0u) ? 1u : 0u; mine = (j == x) ? c : mine; }
        if (sum == G) break;
        __builtin_amdgcn_s_sleep(1);
        if ((++sp & 255u) == 0u) { if (xb_ld(&bar[XB_TMO])) break; if (sp > XB_SPIN_CAP) { atomicAdd(&bar[XB_TMO], 1u); break; } }
    }
    nloc = mine > 0u ? mine : 1u; nx = cnt > 0u ? cnt : 1u;
}
__device__ __forceinline__ void xcd_barrier(const XcdBarrier& b) {
    asm volatile("s_waitcnt vmcnt(0)" ::: "memory");
    __syncthreads();
    if (threadIdx.x == 0) {
        unsigned* bar = b.bar;
        __builtin_amdgcn_s_waitcnt(0);
        unsigned nloc = b.st[0], nx = b.st[1];
        if (nloc == 0u) { xcd_barrier_complete(bar, b.x, nloc, nx); b.st[0] = nloc; b.st[1] = nx; }
        const unsigned old = xb_add(&bar[XB_XSUB(b.x)], 1u);
        const unsigned gen = old / nloc;
        if (old + 1u == (gen + 1u) * nloc) {
            __builtin_amdgcn_fence(__ATOMIC_RELEASE, "agent");
            asm volatile("s_waitcnt vmcnt(0)" ::: "memory");
            const unsigned og = xb_add(&bar[XB_TOP], 1u);
            const unsigned tg = og / nx;
            if (og + 1u == (tg + 1u) * nx) xb_add(&bar[XB_TOPGEN], 1u);
            else XB_SPIN(xb_ld(&bar[XB_TOPGEN]) == tg, bar);
            __builtin_amdgcn_fence(__ATOMIC_ACQUIRE, "agent");
            xb_add(&bar[XB_XGEN(b.x)], 1u);
            asm volatile("s_waitcnt vmcnt(0)" ::: "memory");
        } else {
            XB_SPIN(xb_ld(&bar[XB_XGEN(b.x)]) == gen, bar);
            __builtin_amdgcn_fence(__ATOMIC_ACQUIRE, "agent");
            asm volatile("s_waitcnt vmcnt(0)" ::: "memory");
        }
    }
    __syncthreads();
}

extern __shared__ __attribute__((aligned(16))) char smem[];
typedef __attribute__((address_space(4))) const Params CParams;
__device__ __forceinline__ const Params& kparams() { CParams* q = (CParams*)__builtin_amdgcn_kernarg_segment_ptr(); asm volatile("" : "+s"(q)); return *(const Params*)q; }
__device__ __forceinline__ char* lds_at(unsigned off) { return (char*)(LAS char*)(uintptr_t)off; }
#define NOINL __device__ __forceinline__
#define UNIT_LOOP(u, n, off) for (int u = (int)((blockIdx.x + gridDim.x - ((off) % gridDim.x)) % gridDim.x); u < (n); u += gridDim.x)
DEVI int tidx() { int t = threadIdx.x; asm volatile("" : "+v"(t)); return t; }
DEVI float bf2f(bf16_t v) { return __uint_as_float((unsigned)v << 16); }
typedef __bf16 bf16v2 __attribute__((ext_vector_type(2)));
DEVI unsigned pk2(float lo, float hi) { bf16v2 v; v[0] = (__bf16)lo; v[1] = (__bf16)hi; return __builtin_bit_cast(unsigned, v); }
DEVI bf16_t f2bf(float v) { return (bf16_t)(pk2(v, 0.f) & 0xffffu); }
DEVI float lo_bf(unsigned u) { return __uint_as_float(u << 16); }
DEVI float hi_bf(unsigned u) { return __uint_as_float(u & 0xffff0000u); }
DEVI float sigmoidf_(float x) { return __builtin_amdgcn_rcpf(1.f + __expf(-x)); }
DEVI float wave_sum(float v) {
#pragma unroll
    for (int m = 32; m >= 1; m >>= 1) v += __shfl_xor(v, m);
    return v;
}
DEVI float wave_max(float v) {
#pragma unroll
    for (int m = 32; m >= 1; m >>= 1) v = fmaxf(v, __shfl_xor(v, m));
    return v;
}
DEVI unsigned f2e4m3(float x) {
    const unsigned s = (__float_as_uint(x) >> 24) & 0x80u;
    const float a = fminf(fabsf(x), 448.f);
    const unsigned au = __float_as_uint(a);
    const unsigned nrm = ((au + 0x7FFFFu + ((au >> 20) & 1u)) >> 20) - (120u << 3);
    const unsigned sub = (unsigned)__float2int_rn(a * 512.f);
    const unsigned mag = a < 0.015625f ? sub : nrm;
    return mag ? (s | mag) : 0u;
}
DEVI unsigned pk4_fp8(float a, float b, float c, float d) { return f2e4m3(a) | (f2e4m3(b) << 8) | (f2e4m3(c) << 16) | (f2e4m3(d) << 24); }
DEVI int row_b(int r) { return r < TL ? (r >> 12) : ((r - TL) >> 8); }
DEVI int row_key(int r) { return r < TL ? (r & 4095) : (4096 + ((r - TL) & 255)); }
DEVI int row_mod(int r) { return r < TL ? (r >> 12) : 8; }
DEVI const float* xsrc(const Params& p, int l, int r) {
    if (l == 0) return r < TL ? p.in[I_X] + (size_t)r * DM : p.in[I_CTX] + (size_t)(r - TL) * DM;
    return r < TL ? p.out + (size_t)r * DM : (const float*)(p.ws + OFF_XC) + (size_t)(r - TL) * DM;
}
DEVI float* xdst(const Params& p, int r) { return r < TL ? p.out + (size_t)r * DM : (float*)(p.ws + OFF_XC) + (size_t)(r - TL) * DM; }
DEVI int mt_row0(int mt) { return mt < 128 ? mt * 256 : TL + (mt - 128) * 256; }

#define MFMA(a, b, c) __builtin_amdgcn_mfma_f32_32x32x16_bf16((a), (b), (c), 0, 0, 0)

constexpr int G_LD = 72;
constexpr int G_ASZ = 256 * G_LD * 2;
constexpr int G_BSZ = 128 * G_LD * 2;
constexpr int G_STAGE = G_ASZ + G_BSZ;
constexpr int G_LDS = 2 * G_STAGE;

struct RowLoader {
    const bf16_t* p0; const bf16_t* p1; const bf16_t* p2; const bf16_t* p3; int soff;
    u32x4 r0, r1, r2, r3;
    DEVI void issue(int k0) { r0 = *(const u32x4*)(p0 + k0); r1 = *(const u32x4*)(p1 + k0); r2 = *(const u32x4*)(p2 + k0); r3 = *(const u32x4*)(p3 + k0); }
    DEVI void commit(bf16_t* As) const {
        *(u32x4*)(As + soff) = r0; *(u32x4*)(As + soff + 64 * G_LD) = r1; *(u32x4*)(As + soff + 128 * G_LD) = r2; *(u32x4*)(As + soff + 192 * G_LD) = r3;
    }
};

template <bool SW, int NI, class AL_>
DEVI void gemm_mainloop(f32x16 (&acc)[2][NI], AL_ al0, const bf16_t* __restrict__ Bt, int ldb, int K, char* lds) {
    const int tid = tidx(), lane = tid & 63, w = tid >> 6, wm = w >> 1, wn = w & 1, l31 = lane & 31, hh = lane >> 5;
    const int lr = tid >> 3, kc = (tid & 7) * 8;
    const bf16_t* bp0 = Bt + (size_t)lr * ldb + kc;
    const bf16_t* bp1 = Bt + (size_t)(lr + 64) * ldb + kc;
    AL_ al1 = al0;
    u32x4 b00, b01, b10, b11;
#pragma unroll
    for (int mi = 0; mi < 2; ++mi)
#pragma unroll
        for (int ni = 0; ni < NI; ++ni)
#pragma unroll
            for (int e = 0; e < 16; ++e) acc[mi][ni][e] = 0.f;
    const int nk = K >> 6;
    const int aoff = (wm * 64 + l31) * G_LD + 8 * hh, boff = (wn * 32 * NI + l31) * G_LD + 8 * hh, bst = lr * G_LD + kc;
    auto compute = [&](const char* st) __attribute__((always_inline)) {
        const bf16_t* As = (const bf16_t*)st; const bf16_t* Bs = (const bf16_t*)(st + G_ASZ);
#pragma unroll
        for (int ks = 0; ks < 4; ++ks) {
            bf16x8 af[2], bfr[NI];
#pragma unroll
            for (int mi = 0; mi < 2; ++mi) af[mi] = *(const bf16x8*)(As + aoff + mi * 32 * G_LD + ks * 16);
#pragma unroll
            for (int ni = 0; ni < NI; ++ni) bfr[ni] = *(const bf16x8*)(Bs + boff + ni * 32 * G_LD + ks * 16);
#pragma unroll
            for (int mi = 0; mi < 2; ++mi)
#pragma unroll
                for (int ni = 0; ni < NI; ++ni) {
                    if (SW) acc[mi][ni] = MFMA(bfr[ni], af[mi], acc[mi][ni]);
                    else    acc[mi][ni] = MFMA(af[mi], bfr[ni], acc[mi][ni]);
                }
            if (ks == 1) __builtin_amdgcn_sched_barrier(0);
        }
    };
    __syncthreads();
    al0.issue(0); b00 = *(const u32x4*)bp0; if (NI == 2) b01 = *(const u32x4*)bp1;
    if (nk > 1) { al1.issue(64); b10 = *(const u32x4*)(bp0 + 64); if (NI == 2) b11 = *(const u32x4*)(bp1 + 64); }
    {
        bf16_t* As = (bf16_t*)lds; bf16_t* Bs = (bf16_t*)(lds + G_ASZ);
        al0.commit(As);
        *(u32x4*)(Bs + bst) = b00; if (NI == 2) *(u32x4*)(Bs + bst + 64 * G_LD) = b01;
    }
    __syncthreads();
    for (int kt = 0; kt < nk; kt += 2) {
        if (kt + 2 < nk) { const int k0 = (kt + 2) << 6; al0.issue(k0); b00 = *(const u32x4*)(bp0 + k0); if (NI == 2) b01 = *(const u32x4*)(bp1 + k0); }
        compute(lds);
        if (kt + 1 < nk) {
            bf16_t* As = (bf16_t*)(lds + G_STAGE); bf16_t* Bs = (bf16_t*)(lds + G_STAGE + G_ASZ);
            al1.commit(As);
            *(u32x4*)(Bs + bst) = b10; if (NI == 2) *(u32x4*)(Bs + bst + 64 * G_LD) = b11;
        }
        __syncthreads();
        if (kt + 1 >= nk) break;
        if (kt + 3 < nk) { const int k0 = (kt + 3) << 6; al1.issue(k0); b10 = *(const u32x4*)(bp0 + k0); if (NI == 2) b11 = *(const u32x4*)(bp1 + k0); }
        compute(lds + G_STAGE);
        if (kt + 2 < nk) {
            bf16_t* As = (bf16_t*)lds; bf16_t* Bs = (bf16_t*)(lds + G_ASZ);
            al0.commit(As);
            *(u32x4*)(Bs + bst) = b00; if (NI == 2) *(u32x4*)(Bs + bst + 64 * G_LD) = b01;
        }
        __syncthreads();
    }
}
template <bool SW, int NI, class AL_>
DEVI void gemm_mainloop1(f32x16 (&acc)[2][NI], AL_ al, const bf16_t* __restrict__ Bt, int ldb, int K, char* lds, int bhalf = -1) {
    const int tid = tidx(), lane = tid & 63, w = tid >> 6, wm = w >> 1, wn = w & 1, l31 = lane & 31, hh = lane >> 5;
    const int lr = tid >> 3, kc = (tid & 7) * 8;
    const bf16_t* bp0 = Bt + (size_t)(bhalf < 0 ? lr : ((lr >> 5) * 64 + bhalf * 32 + (lr & 31))) * ldb + kc;
    const bf16_t* bp1 = Bt + (size_t)(lr + 64) * ldb + kc;
    u32x4 rb0, rb1;
#pragma unroll
    for (int mi = 0; mi < 2; ++mi)
#pragma unroll
        for (int ni = 0; ni < NI; ++ni)
#pragma unroll
            for (int e = 0; e < 16; ++e) acc[mi][ni][e] = 0.f;
    __syncthreads();
    al.issue(0); rb0 = *(const u32x4*)bp0; if (NI == 2) rb1 = *(const u32x4*)bp1;
    {
        bf16_t* As = (bf16_t*)lds; bf16_t* Bs = (bf16_t*)(lds + G_ASZ);
        al.commit(As);
        *(u32x4*)(Bs + lr * G_LD + kc) = rb0; if (NI == 2) *(u32x4*)(Bs + (lr + 64) * G_LD + kc) = rb1;
    }
    __syncthreads();
    const int nk = K >> 6;
#pragma unroll 1
    for (int kt = 0; kt < nk; ++kt) {
        const bf16_t* As = (const bf16_t*)(lds + (kt & 1) * G_STAGE);
        const bf16_t* Bs = (const bf16_t*)(lds + (kt & 1) * G_STAGE + G_ASZ);
        const bool more = kt + 1 < nk;
        if (more) { const int k0 = (kt + 1) << 6; al.issue(k0); rb0 = *(const u32x4*)(bp0 + k0); if (NI == 2) rb1 = *(const u32x4*)(bp1 + k0); }
#pragma unroll
        for (int ks = 0; ks < 4; ++ks) {
            bf16x8 af[2], bfr[NI];
#pragma unroll
            for (int mi = 0; mi < 2; ++mi) af[mi] = *(const bf16x8*)(As + (wm * 64 + mi * 32 + l31) * G_LD + ks * 16 + 8 * hh);
#pragma unroll
            for (int ni = 0; ni < NI; ++ni) bfr[ni] = *(const bf16x8*)(Bs + (wn * 32 * NI + ni * 32 + l31) * G_LD + ks * 16 + 8 * hh);
#pragma unroll
            for (int mi = 0; mi < 2; ++mi)
#pragma unroll
                for (int ni = 0; ni < NI; ++ni) {
                    if (SW) acc[mi][ni] = MFMA(bfr[ni], af[mi], acc[mi][ni]);
                    else    acc[mi][ni] = MFMA(af[mi], bfr[ni], acc[mi][ni]);
                }
        }
        if (more) {
            bf16_t* An = (bf16_t*)(lds + ((kt + 1) & 1) * G_STAGE); bf16_t* Bn = (bf16_t*)(lds + ((kt + 1) & 1) * G_STAGE + G_ASZ);
            al.commit(An);
            *(u32x4*)(Bn + lr * G_LD + kc) = rb0; if (NI == 2) *(u32x4*)(Bn + (lr + 64) * G_LD + kc) = rb1;
        }
        __syncthreads();
    }
}
DEVI RowLoader make_rows(const bf16_t* base, size_t ld, int row0) {
    RowLoader r; const int tid = tidx(), lr = tid >> 3, kc = (tid & 7) * 8;
    r.p0 = base + (size_t)(row0 + lr) * ld + kc; r.p1 = r.p0 + 64 * ld; r.p2 = r.p0 + 128 * ld; r.p3 = r.p0 + 192 * ld; r.soff = lr * G_LD + kc;
    return r;
}

constexpr int K2_LD = 264;
constexpr int K2_BUF = 64 * K2_LD * 2;
struct K256A { bf16x8 f[2][16]; };
DEVI void k256_load_a(K256A& a, const bf16_t* A, size_t lda, int row0, char* lds) {
    const int tid = tidx(), lane = tid & 63, w = tid >> 6, wm = w >> 1, l31 = lane & 31, hh = lane >> 5;
    bf16_t* As = (bf16_t*)lds;
#pragma unroll 1
    for (int half = 0; half < 2; ++half) {
        __syncthreads();
        u32x4 r[8];
#pragma unroll
        for (int i = 0; i < 8; ++i) { const int c = tid + 512 * i; r[i] = *(const u32x4*)(A + (size_t)(row0 + half * 128 + (c >> 5)) * lda + (c & 31) * 8); }
#pragma unroll
        for (int i = 0; i < 8; ++i) { const int c = tid + 512 * i; *(u32x4*)(As + (c >> 5) * K2_LD + (c & 31) * 8) = r[i]; }
        __syncthreads();
        if ((wm >> 1) == half) {
#pragma unroll
            for (int mi = 0; mi < 2; ++mi)
#pragma unroll
                for (int ks = 0; ks < 16; ++ks) a.f[mi][ks] = *(const bf16x8*)(As + ((wm & 1) * 64 + mi * 32 + l31) * K2_LD + ks * 16 + 8 * hh);
        }
    }
}
template <class EPI>
DEVI void k256_stream(const K256A& a, const bf16_t* Bt, int n_tiles, char* lds, const EPI& epi) {
    const int tid = tidx(), lane = tid & 63, w = tid >> 6, wn = w & 1, l31 = lane & 31, hh = lane >> 5;
    const int br = tid >> 3, bc = (tid & 7) * 8;
    const bf16_t* bp = Bt + (size_t)br * 256 + bc;
    const int sto = br * K2_LD + bc, fro = (wn * 32 + l31) * K2_LD + 8 * hh;
    u32x4 s0, s1, s2, s3, t0, t1, t2, t3;
#define K2_ISSUE(j_, A_, B_, C_, D_) do { const bf16_t* _q = bp + (size_t)(j_) * 64 * 256; A_ = *(const u32x4*)_q; B_ = *(const u32x4*)(_q + 64); C_ = *(const u32x4*)(_q + 128); D_ = *(const u32x4*)(_q + 192); } while (0)
#define K2_COMMIT(buf_, A_, B_, C_, D_) do { bf16_t* _b = (bf16_t*)(lds + (buf_) * K2_BUF) + sto; *(u32x4*)_b = A_; *(u32x4*)(_b + 64) = B_; *(u32x4*)(_b + 128) = C_; *(u32x4*)(_b + 192) = D_; } while (0)
#define K2_TILE(j_, buf_) do { const bf16_t* Bs = (const bf16_t*)(lds + (buf_) * K2_BUF) + fro; f32x16 acc[2]; \
        _Pragma("unroll") for (int e = 0; e < 16; ++e) { acc[0][e] = 0.f; acc[1][e] = 0.f; } \
        _Pragma("unroll") for (int ks = 0; ks < 16; ++ks) { const bf16x8 bf = *(const bf16x8*)(Bs + ks * 16); acc[0] = MFMA(bf, a.f[0][ks], acc[0]); acc[1] = MFMA(bf, a.f[1][ks], acc[1]); } \
        epi((j_), acc); } while (0)
    __syncthreads();
    K2_ISSUE(0, s0, s1, s2, s3);
    K2_ISSUE(min(1, n_tiles - 1), t0, t1, t2, t3);
    K2_COMMIT(0, s0, s1, s2, s3);
    __syncthreads();
#pragma unroll 1
    for (int j = 0; j < n_tiles; j += 2) {
        K2_ISSUE(min(j + 2, n_tiles - 1), s0, s1, s2, s3);
        K2_TILE(j, 0);
        if (j + 1 < n_tiles) K2_COMMIT(1, t0, t1, t2, t3);
        __syncthreads();
        if (j + 1 >= n_tiles) break;
        K2_ISSUE(min(j + 3, n_tiles - 1), t0, t1, t2, t3);
        K2_TILE(j + 1, 1);
        if (j + 2 < n_tiles) K2_COMMIT(0, s0, s1, s2, s3);
        __syncthreads();
    }
#undef K2_ISSUE
#undef K2_COMMIT
#undef K2_TILE
}

template <int KS> struct KFragA { bf16x8 f[2][KS]; };
template <int KS>
DEVI void kx_load_a(KFragA<KS>& a, const bf16_t* A, size_t lda, int row0, char* lds, float* rs, float eps) {
    constexpr int K = 16 * KS, LD = K + 8, CPR = K / 8, NCH = 256 * CPR / 512;
    const int tid = tidx(), lane = tid & 63, w = tid >> 6, wm = w >> 1, l31 = lane & 31, hh = lane >> 5;
    bf16_t* As = (bf16_t*)lds;
    __syncthreads();
    {
        u32x4 r[NCH];
#pragma unroll
        for (int i = 0; i < NCH; ++i) { const int c = tid + 512 * i; r[i] = *(const u32x4*)(A + (size_t)(row0 + c / CPR) * lda + (c % CPR) * 8); }
#pragma unroll
        for (int i = 0; i < NCH; ++i) { const int c = tid + 512 * i; *(u32x4*)(As + (c / CPR) * LD + (c % CPR) * 8) = r[i]; }
    }
    __syncthreads();
#pragma unroll
    for (int mi = 0; mi < 2; ++mi)
#pragma unroll
        for (int ks = 0; ks < KS; ++ks) a.f[mi][ks] = *(const bf16x8*)(As + (wm * 64 + mi * 32 + l31) * LD + ks * 16 + 8 * hh);
    if (tid < 256) { float ss = 0.f;
#pragma unroll
        for (int i = 0; i < CPR; ++i) { const u32x4 v = *(const u32x4*)(As + tid * LD + 8 * i);
#pragma unroll
            for (int j = 0; j < 4; ++j) { const float x = lo_bf(v[j]), y = hi_bf(v[j]); ss += x * x + y * y; } }
        rs[tid] = rsqrtf(ss * (1.f / (float)K) + eps); }
    __syncthreads();
}
template <int KS, class EPI>
DEVI void kx_stream(const KFragA<KS>& a, const bf16_t* Bt, int n_tiles, char* lds, const EPI& epi) {
    constexpr int K = 16 * KS, LD = K + 8, CPR = K / 8, NCH = 64 * CPR / 512, BUF = 64 * LD * 2;
    const int tid = tidx(), lane = tid & 63, w = tid >> 6, wn = w & 1, l31 = lane & 31, hh = lane >> 5;
    u32x4 s[NCH];
    auto issue = [&](int j) __attribute__((always_inline)) {
#pragma unroll
        for (int i = 0; i < NCH; ++i) { const int c = tid + 512 * i; s[i] = *(const u32x4*)(Bt + (size_t)(j * 64 + c / CPR) * K + (c % CPR) * 8); } };
    auto commit = [&](int buf) __attribute__((always_inline)) {
#pragma unroll
        for (int i = 0; i < NCH; ++i) { const int c = tid + 512 * i; *(u32x4*)((bf16_t*)(lds + buf * BUF) + (c / CPR) * LD + (c % CPR) * 8) = s[i]; } };
    __syncthreads();
    issue(0); commit(0);
    __syncthreads();
#pragma unroll 1
    for (int j = 0; j < n_tiles; ++j) {
        const bool more = j + 1 < n_tiles;
        issue(more ? j + 1 : j);
        const bf16_t* Bs = (const bf16_t*)(lds + (j & 1) * BUF) + (wn * 32 + l31) * LD + 8 * hh;
        f32x16 acc[2];
#pragma unroll
        for (int e = 0; e < 16; ++e) { acc[0][e] = 0.f; acc[1][e] = 0.f; }
#pragma unroll
        for (int ks = 0; ks < KS; ++ks) { const bf16x8 bf = *(const bf16x8*)(Bs + ks * 16); acc[0] = MFMA(bf, a.f[0][ks], acc[0]); acc[1] = MFMA(bf, a.f[1][ks], acc[1]); }
        epi(j, acc);
        if (more) commit((j + 1) & 1);
        __syncthreads();
    }
}
DEVI void mod_unit(const Params& p, int u, char* lds) {
    const int tid = tidx(), l = u / 96, j0 = (u % 96) * 64;
    float* sc = (float*)lds; float* red = sc + 9 * 1024;
    __syncthreads();
    for (int i = tid; i < 9 * 1024; i += 512) { const int row = i >> 10, k = i & 1023; const float v = row < 8 ? p.in[I_C][row * 1024 + k] : p.in[I_CCTX][k]; sc[i] = v / (1.f + expf(-v)); }
    __syncthreads();
    const int col = tid & 63, kg = tid >> 6;
    float a[9];
#pragma unroll
    for (int r = 0; r < 9; ++r) a[r] = 0.f;
    const float* w = p.in[I_WMOD] + (size_t)l * 1024 * 6144 + j0 + col;
    for (int k = kg * 128; k < kg * 128 + 128; ++k) {
        const float wv = w[(size_t)k * 6144];
#pragma unroll
        for (int r = 0; r < 9; ++r) a[r] += sc[r * 1024 + k] * wv;
    }
#pragma unroll
    for (int r = 0; r < 9; ++r) red[(kg * 9 + r) * 64 + col] = a[r];
    __syncthreads();
    float* mod = (float*)(p.ws + OFF_MOD);
    for (int i = tid; i < 9 * 64; i += 512) {
        const int r = i >> 6, cc = i & 63; float s = 0.f;
#pragma unroll
        for (int g = 0; g < 8; ++g) s += red[(g * 9 + r) * 64 + cc];
        mod[(size_t)(l * 9 + r) * 6144 + j0 + cc] = s + p.in[I_BMOD][l * 6144 + j0 + cc];
    }
}
DEVI void rope_unit(const Params& p, int v) {
    const int idx = v * 512 + tidx(), pos = idx >> 4, i = idx & 15, fi = i & 7;
    const float inv = powf(10000.f, -(float)fi / 8.f);
    const float coord = (float)(i < 8 ? (pos >> 6) : (pos & 63));
    const float ang = coord * inv;
    ((float*)(p.ws + OFF_COS))[idx] = cosf(ang);
    ((float*)(p.ws + OFF_SIN))[idx] = sinf(ang);
}
DEVI void norm_rows(const Params& p, int l, int r0, int r1, int which  ) {
    const int lane = tidx() & 63, w = tidx() >> 6;
    const float* mod = (const float*)(p.ws + OFF_MOD);
    bf16_t* h = (bf16_t*)(p.ws + OFF_H);
    const float* gn = p.in[which ? I_GN2 : I_GN1] + l * 1024;
#pragma unroll 1
    for (int r = r0 + w; r < r1; r += 16) {
        float4 xv[2][4], gq[4], shq[2][4], scq[2][4]; float ss[2] = {0.f, 0.f};
#pragma unroll
        for (int u = 0; u < 2; ++u) {
            const int rr = min(r + 8 * u, r1 - 1);
            const float* src = which ? (const float*)xdst(p, rr) : xsrc(p, l, rr);
            const float* mr = mod + (size_t)(l * 9 + row_mod(rr)) * 6144 + (which ? 3072 : 0);
#pragma unroll
            for (int q = 0; q < 4; ++q) { const int k = 4 * lane + 256 * q; xv[u][q] = *(const float4*)(src + k); shq[u][q] = *(const float4*)(mr + k); scq[u][q] = *(const float4*)(mr + 1024 + k); }
        }
#pragma unroll
        for (int q = 0; q < 4; ++q) gq[q] = *(const float4*)(gn + 4 * lane + 256 * q);
        __builtin_amdgcn_sched_barrier(0);
#pragma unroll
        for (int u = 0; u < 2; ++u) {
#pragma unroll
            for (int q = 0; q < 4; ++q) ss[u] += xv[u][q].x * xv[u][q].x + xv[u][q].y * xv[u][q].y + xv[u][q].z * xv[u][q].z + xv[u][q].w * xv[u][q].w;
            ss[u] = wave_sum(ss[u]);
        }
#pragma unroll
        for (int u = 0; u < 2; ++u) {
            const int rr = r + 8 * u;
            if (rr < r1) {
                const float rstd = rsqrtf(ss[u] * (1.f / 1024.f) + 1e-6f);
#pragma unroll
                for (int q = 0; q < 4; ++q) {
                    const int k = 4 * lane + 256 * q;
                    const float4 g = gq[q], sh = shq[u][q], sc = scq[u][q];
                    const float o0 = xv[u][q].x * rstd * g.x * (1.f + sc.x) + sh.x, o1 = xv[u][q].y * rstd * g.y * (1.f + sc.y) + sh.y;
                    const float o2 = xv[u][q].z * rstd * g.z * (1.f + sc.z) + sh.z, o3 = xv[u][q].w * rstd * g.w * (1.f + sc.w) + sh.w;
                    uint2 pk; pk.x = pk2(o0, o1); pk.y = pk2(o2, o3);
                    *(uint2*)(h + (size_t)rr * DM + k) = pk;
                }
            }
        }
    }
}

DEVI void quant_rows(const Params& p, int r0, int r1) {
    const int lane = tidx() & 63, w = tidx() >> 6;
    const bf16_t* h = (const bf16_t*)(p.ws + OFF_H);
    float* rs = (float*)(p.ws + OFF_RS);
#pragma unroll 1
    for (int rb = r0 + w; rb < r1; rb += 32) {
        uint4 a0[4], a1[4];
#pragma unroll
        for (int u = 0; u < 4; ++u) { const int r = min(rb + 8 * u, r1 - 1); a0[u] = *(const uint4*)(h + (size_t)r * DM + 8 * lane); a1[u] = *(const uint4*)(h + (size_t)r * DM + 512 + 8 * lane); }
        __builtin_amdgcn_sched_barrier(0);
#pragma unroll
        for (int u = 0; u < 4; ++u) {
            const int r = rb + 8 * u;
            if (r < r1) {
                const uint4 v0 = a0[u], v1 = a1[u];
                float m = fmaxf(fmaxf(fmaxf(fabsf(lo_bf(v0.x)), fabsf(hi_bf(v0.x))), fmaxf(fabsf(lo_bf(v0.y)), fabsf(hi_bf(v0.y)))), fmaxf(fmaxf(fabsf(lo_bf(v0.z)), fabsf(hi_bf(v0.z))), fmaxf(fabsf(lo_bf(v0.w)), fabsf(hi_bf(v0.w)))));
                m = fmaxf(m, fmaxf(fmaxf(fmaxf(fabsf(lo_bf(v1.x)), fabsf(hi_bf(v1.x))), fmaxf(fabsf(lo_bf(v1.y)), fabsf(hi_bf(v1.y)))), fmaxf(fmaxf(fabsf(lo_bf(v1.z)), fabsf(hi_bf(v1.z))), fmaxf(fabsf(lo_bf(v1.w)), fabsf(hi_bf(v1.w))))));
                m = fmaxf(wave_max(m), 1e-20f);
                const float s = 256.f / m;
                uint2 o0, o1;
                o0.x = pk4_fp8(lo_bf(v0.x) * s, hi_bf(v0.x) * s, lo_bf(v0.y) * s, hi_bf(v0.y) * s); o0.y = pk4_fp8(lo_bf(v0.z) * s, hi_bf(v0.z) * s, lo_bf(v0.w) * s, hi_bf(v0.w) * s);
                o1.x = pk4_fp8(lo_bf(v1.x) * s, hi_bf(v1.x) * s, lo_bf(v1.y) * s, hi_bf(v1.y) * s); o1.y = pk4_fp8(lo_bf(v1.z) * s, hi_bf(v1.z) * s, lo_bf(v1.w) * s, hi_bf(v1.w) * s);
                *(uint2*)(p.ws + OFF_H8 + (size_t)r * 1024 + 8 * lane) = o0;
                *(uint2*)(p.ws + OFF_H8 + (size_t)r * 1024 + 512 + 8 * lane) = o1;
                if (lane == 0) rs[r] = m * (1.f / (256.f * WG8_SCALE));
            }
        }
    }
}

constexpr int CJ_WIN = 0, CJ_WUQ = CJ_WIN + 8 * 102, CJ_WUKV = CJ_WUQ + 3 * 6, CJ_WBR = CJ_WUKV + 1 * 8, CJ_WOUT = CJ_WBR + 4 * 32, CJ_RT = CJ_WOUT + 128,
              CJ_EG = CJ_RT + 8, CJ_EU = CJ_EG + 65 * 32, CJ_ED = CJ_EU + 65 * 32, CJ_LW = CJ_ED + 65 * 32, CJ_END = CJ_LW + 16;
DEVI int win_map(int n) {
    if (n < 352) return n;
    if (n < 1120) { const int j = n - 352; return j < 256 ? ZC_NAQ + j : (j < 512 ? ZC_NAK + (j - 256) : ZLD + ZT_NAV + (j - 512)); }
    if (n < 1888) return ZLD + ZT_HY + (n - 1120);
    if (n < 2144) return ZC_LU + (n - 1888);
    if (n < 2400) return ZC_LG + (n - 2144);
    { const int np = n - 2400, g = np >> 10, col = np & 1023, pn = col >> 6, c64 = col & 63;
      return WIN_G0 + pn * 256 + 128 * (g >> 1) + 32 * (c64 >> 4) + 16 * (g & 1) + 4 * ((c64 >> 2) & 3) + (c64 & 3); }
}
template <int STAGE>
DEVI void conv_unit(const Params& p, int l, int cu, char* lds, float4 (&v)[4]) {
    const int tid = tidx();
    const float* src; int K, N, kt, nt, KH = 128; bf16_t* dst; int mode = 0; const float* ksc = nullptr;
    if (cu < CJ_WUQ) { const int t = cu - CJ_WIN; kt = t / 102; nt = t % 102; src = p.in[I_WIN] + (size_t)l * 1024 * 6496; K = 1024; N = 6496; dst = (bf16_t*)(p.ws + OFF_WIN); mode = 1; }
    else if (cu < CJ_WUKV) { const int t = cu - CJ_WUQ; kt = t / 6; nt = t % 6; src = p.in[I_WUQ] + (size_t)l * 192 * 384; K = 192; N = 384; dst = (bf16_t*)(p.ws + OFF_WUQ); ksc = p.in[I_GQ] + l * 192; KH = 64; }
    else if (cu < CJ_WBR) { const int t = cu - CJ_WUKV; kt = 0; nt = t; src = p.in[I_WUKV] + (size_t)l * 128 * 512; K = 128; N = 512; dst = (bf16_t*)(p.ws + OFF_WUKV); ksc = p.in[I_GKV] + l * 128; }
    else if (cu < CJ_WOUT) { const int t = cu - CJ_WBR, k = t >> 5, tt = t & 31; kt = tt >> 4; nt = tt & 15; src = p.in[I_WBR] + (size_t)(l * 4 + k) * 256 * 1024; K = 256; N = 1024; dst = (bf16_t*)(p.ws + OFF_WBR) + (size_t)k * 1024 * 256; }
    else if (cu < CJ_RT) { const int t = cu - CJ_WOUT; kt = t >> 4; nt = t & 15; src = p.in[I_WOUT] + (size_t)l * 1024 * 1024; K = 1024; N = 1024; dst = (bf16_t*)(p.ws + OFF_WOUT); }
    else if (cu < CJ_EG) { kt = cu - CJ_RT; nt = 0; src = p.in[I_RW] + (size_t)l * 1024 * 64; K = 1024; N = 64; dst = (bf16_t*)(p.ws + OFF_RT); mode = 4; }
    else if (cu < CJ_EU) { const int t = cu - CJ_EG, e = t >> 5, tt = t & 31; kt = tt >> 2; nt = tt & 3; src = e < 64 ? p.in[I_EG] + (size_t)(l * 64 + e) * 1024 * 256 : p.in[I_SG] + (size_t)l * 1024 * 256; K = 1024; N = 256; dst = (bf16_t*)(p.ws + OFF_WGU) + (size_t)e * 512 * 1024; mode = 2; }
    else if (cu < CJ_ED) { const int t = cu - CJ_EU, e = t >> 5, tt = t & 31; kt = tt >> 2; nt = tt & 3; src = e < 64 ? p.in[I_EU] + (size_t)(l * 64 + e) * 1024 * 256 : p.in[I_SU] + (size_t)l * 1024 * 256; K = 1024; N = 256; dst = (bf16_t*)(p.ws + OFF_WGU) + (size_t)e * 512 * 1024; mode = 3; }
    else if (cu >= CJ_LW) { const int t = cu - CJ_LW, d = t >> 3, g = (t >> 2) & 1, n = t & 3; kt = 0; nt = 0; src = p.in[g ? I_LWX : I_LWA] + (size_t)((l * 2 + d) * 4 + n) * 4096; K = 64; N = 64; dst = (bf16_t*)(p.ws + OFF_LWT) + (size_t)((d * 2 + g) * 4 + n) * 4096; KH = 64; }
    else { const int t = cu - CJ_ED, e = t >> 5, tt = t & 31; kt = tt >> 4; nt = tt & 15; src = e < 64 ? p.in[I_ED] + (size_t)(l * 64 + e) * 256 * 1024 : p.in[I_SD] + (size_t)l * 256 * 1024; K = 256; N = 1024; dst = (bf16_t*)(p.ws + OFF_WDT) + (size_t)e * 1024 * 256; }
    float* tl = (float*)lds;
    if constexpr (STAGE == 0) {
        const int kk = tid >> 4, n4 = (tid & 15) * 4, n = nt * 64 + n4, nc = min(n, N - 4);
#pragma unroll
        for (int ps = 0; ps < 4; ++ps) { const int pr = ps * 32 < KH ? ps : 0; v[ps] = *(const float4*)(src + (size_t)(kt * KH + kk + 32 * pr) * N + nc); }
        return;
    }
    __syncthreads();
    {
        const int kk = tid >> 4, n4 = (tid & 15) * 4, n = nt * 64 + n4;
        if (n >= N) {
#pragma unroll
            for (int ps = 0; ps < 4; ++ps) v[ps] = make_float4(0.f, 0.f, 0.f, 0.f);
        }
#pragma unroll
        for (int ps = 0; ps < 4; ++ps) if (ps * 32 < KH) {
            float4 x = v[ps];
            if (ksc) { const float s = ksc[kt * KH + kk + 32 * ps]; x.x *= s; x.y *= s; x.z *= s; x.w *= s; }
            float* t = tl + (kk + 32 * ps) * 65 + n4; t[0] = x.x; t[1] = x.y; t[2] = x.z; t[3] = x.w; }
    }
    __syncthreads();
    {
        const int nn = tid >> 3, n = nt * 64 + nn;
#pragma unroll
        for (int q = 0; q < 2; ++q) if (q * 64 < KH) {
            const int kc = (tid & 7) * 8 + 64 * q;
            if (n < N) {
                int dr = n;
                if (mode == 1) dr = win_map(n);
                else if (mode == 2 || mode == 3) { const int r = n & 127; dr = (n >> 7) * 256 + 128 * (r >> 6) + 32 * ((r >> 4) & 3) + 16 * (mode - 2) + 4 * ((r >> 2) & 3) + (r & 3); }
                if (mode == 1 && n >= 2400) {
                    uint2 o8;
                    o8.x = pk4_fp8(tl[(kc + 0) * 65 + nn] * WG8_SCALE, tl[(kc + 1) * 65 + nn] * WG8_SCALE, tl[(kc + 2) * 65 + nn] * WG8_SCALE, tl[(kc + 3) * 65 + nn] * WG8_SCALE);
                    o8.y = pk4_fp8(tl[(kc + 4) * 65 + nn] * WG8_SCALE, tl[(kc + 5) * 65 + nn] * WG8_SCALE, tl[(kc + 6) * 65 + nn] * WG8_SCALE, tl[(kc + 7) * 65 + nn] * WG8_SCALE);
                    *(uint2*)(p.ws + OFF_WG8 + (size_t)(dr - WIN_G0) * 1024 + kt * KH + kc) = o8;
                } else {
                uint4 o;
                o.x = pk2(tl[(kc + 0) * 65 + nn], tl[(kc + 1) * 65 + nn]); o.y = pk2(tl[(kc + 2) * 65 + nn], tl[(kc + 3) * 65 + nn]);
                o.z = pk2(tl[(kc + 4) * 65 + nn], tl[(kc + 5) * 65 + nn]); o.w = pk2(tl[(kc + 6) * 65 + nn], tl[(kc + 7) * 65 + nn]);
                *(uint4*)(dst + (size_t)dr * K + kt * KH + kc) = o;
                }
                if (mode == 4) *(uint4*)(dst + (size_t)(64 + n) * K + kt * KH + kc) = make_uint4(0u, 0u, 0u, 0u);
            }
            if (mode == 1 && nt == 0 && nn < 32) *(uint4*)(dst + (size_t)(352 + nn) * K + kt * KH + kc) = make_uint4(0u, 0u, 0u, 0u);
            if (mode == 1 && nt >= 1 && nt <= 2) *(uint4*)(dst + (size_t)(NIN + (nt - 1) * 64 + nn) * K + kt * KH + kc) = make_uint4(0u, 0u, 0u, 0u);
        }
    }
}
DEVI void h2tab_unit(const Params& p, int l, int hu, char* lds) {
    const int tid = tidx();
    const int L = hu < 64 ? 4096 : 256, pos0 = hu < 64 ? hu * 64 : (hu - 64) * 64, rbase = hu < 64 ? 0 : 4096;
    float* feats = (float*)lds; float* h1 = feats + 64 * 33;
    const float* w1 = p.in[I_HW1] + l * 33 * 64; const float* b1 = p.in[I_HB1] + l * 64;
    const float* w2 = p.in[I_HW2] + l * 64 * 64; const float* b2 = p.in[I_HB2] + l * 64;
    __syncthreads();
    for (int i = tid; i < 64 * 33; i += 512) {
        const int pl = i / 33, f = i % 33, pos = pos0 + pl; float v;
        if (f == 0) v = (float)pos / (float)(L - 1);
        else { const int j = (f - 1) & 15; const float wv = 6.283185307179586f * (float)pos / (float)L; const float fj = 1e-4f + (float)j * ((15.f - 1e-4f) / 15.f); const float zz = wv * fj; v = f <= 16 ? cosf(zz) : -sinf(zz); }
        feats[i] = v;
    }
    __syncthreads();
    const int pl = tid >> 3, og = tid & 7;
    float o[8];
#pragma unroll
    for (int j = 0; j < 8; ++j) o[j] = b1[og * 8 + j];
#pragma unroll 1
    for (int i = 0; i < 33; ++i) { const float f = feats[pl * 33 + i];
#pragma unroll
        for (int j = 0; j < 8; ++j) o[j] += f * w1[i * 64 + og * 8 + j]; }
#pragma unroll
    for (int j = 0; j < 8; ++j) h1[pl * 64 + og * 8 + j] = sinf(o[j]);
    __syncthreads();
#pragma unroll
    for (int j = 0; j < 8; ++j) o[j] = b2[og * 8 + j];
#pragma unroll 2
    for (int i = 0; i < 64; ++i) { const float f = h1[pl * 64 + i];
#pragma unroll
        for (int j = 0; j < 8; ++j) o[j] += f * w2[i * 64 + og * 8 + j]; }
    float* tab = (float*)(p.ws + OFF_H2T) + (size_t)(rbase + pos0 + pl) * 64 + og * 8;
#pragma unroll
    for (int j = 0; j < 8; ++j) tab[j] = sinf(o[j]);
}
DEVI void fft_twiddles(float2* tw) {
    for (int i = tidx(); i < 4096; i += 512) { float s, c; sincospif((float)i * (1.f / 4096.f), &s, &c); tw[i] = make_float2(c, -s); }
}

DEVI int PI(int i) { return i + (i >> 5); }
DEVI float2 cmul(float2 a, float2 b) { return make_float2(a.x * b.x - a.y * b.y, a.x * b.y + a.y * b.x); }
DEVI float2 cmulc(float2 a, float2 b) { return make_float2(a.x * b.x + a.y * b.y, a.y * b.x - a.x * b.y); }
template <int E> DEVI float2 mulw16(float2 d) {
    constexpr float C[8] = {1.f, 0.9238795325112867f, 0.7071067811865476f, 0.3826834323650898f, 0.f, -0.3826834323650898f, -0.7071067811865476f, -0.9238795325112867f};
    constexpr float S[8] = {0.f, 0.3826834323650898f, 0.7071067811865476f, 0.9238795325112867f, 1.f, 0.9238795325112867f, 0.7071067811865476f, 0.3826834323650898f};
    if (E == 0) return d;
    if (E == 4) return make_float2(d.y, -d.x);
    return make_float2(d.x * C[E] + d.y * S[E], d.y * C[E] - d.x * S[E]);
}
template <int I, int H> DEVI void bfly16(float2 (&v)[16]) { const float2 a = v[I], b = v[I + H]; v[I] = make_float2(a.x + b.x, a.y + b.y); v[I + H] = mulw16<(I & (H - 1)) * (8 / H)>(make_float2(a.x - b.x, a.y - b.y)); }
template <bool ZHI> DEVI void dft16(float2 (&v)[16]) {
    if (ZHI) { v[8] = v[0]; v[9] = mulw16<1>(v[1]); v[10] = mulw16<2>(v[2]); v[11] = mulw16<3>(v[3]); v[12] = mulw16<4>(v[4]); v[13] = mulw16<5>(v[5]); v[14] = mulw16<6>(v[6]); v[15] = mulw16<7>(v[7]); }
    else { bfly16<0, 8>(v); bfly16<1, 8>(v); bfly16<2, 8>(v); bfly16<3, 8>(v); bfly16<4, 8>(v); bfly16<5, 8>(v); bfly16<6, 8>(v); bfly16<7, 8>(v); }
    bfly16<0, 4>(v); bfly16<1, 4>(v); bfly16<2, 4>(v); bfly16<3, 4>(v); bfly16<8, 4>(v); bfly16<9, 4>(v); bfly16<10, 4>(v); bfly16<11, 4>(v);
    bfly16<0, 2>(v); bfly16<1, 2>(v); bfly16<4, 2>(v); bfly16<5, 2>(v); bfly16<8, 2>(v); bfly16<9, 2>(v); bfly16<12, 2>(v); bfly16<13, 2>(v);
    bfly16<0, 1>(v); bfly16<2, 1>(v); bfly16<4, 1>(v); bfly16<6, 1>(v); bfly16<8, 1>(v); bfly16<10, 1>(v); bfly16<12, 1>(v); bfly16<14, 1>(v);
}
#define BR4(k) ((((k) & 1) << 3) | (((k) & 2) << 1) | (((k) & 4) >> 1) | (((k) & 8) >> 3))
DEVI void fwd_store16(float2 (&v)[16], float2 w1, float2* X, int base, int S) {
    float2 w = w1;
    X[PI(base)] = v[0];
#pragma unroll
    for (int k = 1; k < 16; ++k) { X[PI(base + k * S)] = cmul(v[BR4(k)], w); if (k < 15) w = cmul(w, w1); }
}
DEVI void inv_load16(float2 (&v)[16], float2 w1, const float2* X, int base, int S) {
    float2 w = w1;
    { const float2 a = X[PI(base)]; v[0] = make_float2(a.x, -a.y); }
#pragma unroll
    for (int k = 1; k < 16; ++k) { const float2 a = cmulc(X[PI(base + k * S)], w); v[k] = make_float2(a.x, -a.y); if (k < 15) w = cmul(w, w1); }
}
DEVI float2 tw8192(const float2* tw, int idx) { const float2 t = tw[idx & 4095]; return (idx & 4096) ? make_float2(-t.x, -t.y) : t; }
DEVI void fft_fwd_C(float2* X, const float2* tw, int tid) {
    float2 v[16];
    const int n_lo = tid & 1, base = (tid >> 1) * 32 + n_lo;
#pragma unroll
    for (int r = 0; r < 16; ++r) v[r] = X[PI(base + 2 * r)];
    dft16<false>(v); fwd_store16(v, tw[256 * n_lo], X, base, 2);
    __syncthreads();
}
DEVI void fft_fwd_BC(float2* X, const float2* tw, int tid) {
    float2 v[16];
    { const int n_lo = tid & 31, base = (tid >> 5) * 512 + n_lo;
#pragma unroll
      for (int r = 0; r < 16; ++r) v[r] = X[PI(base + 32 * r)];
      dft16<false>(v); fwd_store16(v, tw[16 * n_lo], X, base, 32); }
    __syncthreads();
    fft_fwd_C(X, tw, tid);
}
DEVI void fft_inv_C(float2* X, const float2* tw, int tid) {
    float2 v[16];
    const int n_lo = tid & 1, base = (tid >> 1) * 32 + n_lo;
    inv_load16(v, tw[256 * n_lo], X, base, 2); dft16<false>(v);
#pragma unroll
    for (int n = 0; n < 16; ++n) X[PI(base + 2 * n)] = make_float2(v[BR4(n)].x, -v[BR4(n)].y);
    __syncthreads();
}
DEVI void fft_inv_CB(float2* X, const float2* tw, int tid) {
    fft_inv_C(X, tw, tid);
    float2 v[16];
    { const int n_lo = tid & 31, base = (tid >> 5) * 512 + n_lo;
      inv_load16(v, tw[16 * n_lo], X, base, 32); dft16<false>(v);
#pragma unroll
      for (int n = 0; n < 16; ++n) X[PI(base + 32 * n)] = make_float2(v[BR4(n)].x, -v[BR4(n)].y); }
    __syncthreads();
}
template <class HF>
DEVI void fft512x16_conv(float2 (&io)[8], const HF& Hq, float2* X, const float2* tw, int tid) {
    const int n_lo = tid & 31, baseB = (tid >> 5) * 512 + n_lo;
    {
        float2 v[16];
#pragma unroll
        for (int r = 0; r < 8; ++r) v[r] = io[r];
        dft16<true>(v);
        fwd_store16(v, tw[16 * n_lo], X, baseB, 32);
    }
    __syncthreads();
    fft_fwd_C(X, tw, tid);
#pragma unroll
    for (int i = 0; i < 8; ++i) {
        const int q = tid + 512 * i;
        const float4 hv = *(const float4*)(Hq(q >> 8) + 2 * (q & 255));
        const float2 a = X[PI(2 * q)], b = X[PI(2 * q + 1)];
        const float2 g0 = cmul(make_float2(a.x + b.x, a.y + b.y), make_float2(hv.x, hv.y)), g1 = cmul(make_float2(a.x - b.x, a.y - b.y), make_float2(hv.z, hv.w));
        X[PI(2 * q)] = make_float2(g0.x + g1.x, g0.y + g1.y); X[PI(2 * q + 1)] = make_float2(g0.x - g1.x, g0.y - g1.y);
    }
    __syncthreads();
    fft_inv_C(X, tw, tid);
    {
        float2 v[16];
        inv_load16(v, tw[16 * n_lo], X, baseB, 32); dft16<false>(v);
#pragma unroll
        for (int n = 0; n < 8; ++n) io[n] = make_float2(v[BR4(n)].x, -v[BR4(n)].y);
    }
    __syncthreads();
}
DEVI void fft_conv8192(float2 (&io)[8], const float2* __restrict__ H, float2* X, const float2* tw, int tid) {
    float4 hq[8];
#pragma unroll
    for (int i = 0; i < 8; ++i) hq[i] = *(const float4*)(H + 2 * (tid + 512 * i));
    {
        float2 v[16];
#pragma unroll
        for (int r = 0; r < 8; ++r) v[r] = io[r];
        dft16<true>(v);
        fwd_store16(v, tw[tid], X, tid, 512);
    }
    __syncthreads();
    fft_fwd_BC(X, tw, tid);
#pragma unroll
    for (int i = 0; i < 8; ++i) {
        const int q = tid + 512 * i;
        const float4 hv = hq[i];
        const float2 a = X[PI(2 * q)], b = X[PI(2 * q + 1)];
        const float2 g0 = cmul(make_float2(a.x + b.x, a.y + b.y), make_float2(hv.x, hv.y)), g1 = cmul(make_float2(a.x - b.x, a.y - b.y), make_float2(hv.z, hv.w));
        X[PI(2 * q)] = make_float2(g0.x + g1.x, g0.y + g1.y); X[PI(2 * q + 1)] = make_float2(g0.x - g1.x, g0.y - g1.y);
    }
    __syncthreads();
    fft_inv_CB(X, tw, tid);
    {
        float2 v[16];
        inv_load16(v, tw[tid], X, tid, 512); dft16<false>(v);
#pragma unroll
        for (int n = 0; n < 8; ++n) io[n] = make_float2(v[BR4(n)].x, -v[BR4(n)].y);
    }
    __syncthreads();
}
DEVI void fft_spectrum8192(float2 (&in)[16], float2* __restrict__ Hout, float2* X, const float2* tw, int tid) {
    dft16<false>(in);
    fwd_store16(in, tw[tid], X, tid, 512);
    __syncthreads();
    fft_fwd_BC(X, tw, tid);
#pragma unroll
    for (int i = 0; i < 8; ++i) {
        const int q = tid + 512 * i;
        const float2 a = X[PI(2 * q)], b = X[PI(2 * q + 1)];
        *(float4*)(Hout + 2 * q) = make_float4(a.x + b.x, a.y + b.y, a.x - b.x, a.y - b.y);
    }
    __syncthreads();
}


DEVI void spectrum8192_unit(const Params& p, int l, int n, int c, char* lds) {
    const int tid = tidx();
    float2* X = (float2*)lds; float2* tw = X + 8448; float* w3c = (float*)(tw + 4096);
    const float* h2tab = (const float*)(p.ws + OFF_H2T);
    __syncthreads();
    fft_twiddles(tw);
    if (tid < 128) { const int dir = tid >> 6, k = tid & 63; w3c[tid] = p.in[I_HW3][(size_t)(l * 64 + k) * 1024 + (n * 2 + dir) * 256 + c]; }
    const float dec0 = fabsf(p.in[I_HDEC][((l * 2 + n) * 2 + 0) * 256 + c]), dec1 = fabsf(p.in[I_HDEC][((l * 2 + n) * 2 + 1) * 256 + c]);
    __syncthreads();
    float* F = (float*)X;
    {
        const int part = tid & 7, rsub = tid >> 3;
        float w0[8], w1[8];
#pragma unroll
        for (int i = 0; i < 8; ++i) { w0[i] = w3c[part * 8 + i]; w1[i] = w3c[64 + part * 8 + i]; }
#pragma unroll 8
        for (int ch = 0; ch < 64; ++ch) {
            const int j = ch * 64 + rsub;
            const float4 a = *(const float4*)(h2tab + (size_t)j * 64 + part * 8), b = *(const float4*)(h2tab + (size_t)j * 64 + part * 8 + 4);
            float d0 = a.x * w0[0] + a.y * w0[1] + a.z * w0[2] + a.w * w0[3] + b.x * w0[4] + b.y * w0[5] + b.z * w0[6] + b.w * w0[7];
            float d1 = a.x * w1[0] + a.y * w1[1] + a.z * w1[2] + a.w * w1[3] + b.x * w1[4] + b.y * w1[5] + b.z * w1[6] + b.w * w1[7];
            d0 += __shfl_xor(d0, 1); d1 += __shfl_xor(d1, 1); d0 += __shfl_xor(d0, 2); d1 += __shfl_xor(d1, 2); d0 += __shfl_xor(d0, 4); d1 += __shfl_xor(d1, 4);
            F[j] = d0; F[4096 + j] = d1;
        }
    }
    __syncthreads();
    float2 v[16];
#pragma unroll
    for (int r = 0; r < 16; ++r) {
        const int t = tid + 512 * r;
        const int j = t < 4096 ? t : 8192 - t, dir = t < 4096 ? 0 : 1;
        const float f = F[dir * 4096 + (j & 4095)] * expf(-((float)j / 4095.f) * (dir ? dec1 : dec0));
        v[r] = make_float2(t != 4096 ? f : 0.f, 0.f);
    }
    __syncthreads();
    fft_spectrum8192(v, (float2*)(p.ws + OFF_HS) + (size_t)(n * 256 + c) * 8192, X, tw, tid);
}
DEVI float conv3(const bf16_t* r, int t, int L, float w0, float w1, float w2, float b) {
    const float c = bf2f(r[t]), lf = bf2f(r[max(t - 1, 0)]), rg = bf2f(r[min(t + 1, L - 1)]);
    return b + w1 * c + (t > 0 ? w0 : 0.f) * lf + (t < L - 1 ? w2 : 0.f) * rg;
}

DEVI void hyena8192_unit(const Params& p, int l, int c, int b0, char* lds) {
    const int tid = tidx();
    float2* X = (float2*)lds; float2* tw = X + 8448;
    const bf16_t* zT = (const bf16_t*)(p.ws + OFF_ZT);
    bf16_t* yT = (bf16_t*)(p.ws + OFF_YT);
    const float2* H0 = (const float2*)(p.ws + OFF_HS) + (size_t)c * 8192; const float2* H1 = H0 + (size_t)256 * 8192;
    const float* sw = p.in[I_HSW] + l * 3 * 768; const float* sb = p.in[I_HSB] + l * 768;
    const float bias0 = p.in[I_HBIAS][(l * 2 + 0) * 256 + c], bias1 = p.in[I_HBIAS][(l * 2 + 1) * 256 + c];
    const size_t base0 = (size_t)(b0 * 1024 + ZT_HY + c) * NKEY, base1 = base0 + (size_t)1024 * NKEY;
    const float inv = 1.f / 8192.f;
    float2 io[8], vr[8], x1[8], x2[8];
#pragma unroll
    for (int r = 0; r < 8; ++r) { const int t = tid + 512 * r;
        vr[r] = make_float2(conv3(zT + base0, t, 4096, sw[c], sw[768 + c], sw[1536 + c], sb[c]), conv3(zT + base1, t, 4096, sw[c], sw[768 + c], sw[1536 + c], sb[c]));
        x1[r] = make_float2(conv3(zT + base0 + (size_t)256 * NKEY, t, 4096, sw[256 + c], sw[768 + 256 + c], sw[1536 + 256 + c], sb[256 + c]),
                            conv3(zT + base1 + (size_t)256 * NKEY, t, 4096, sw[256 + c], sw[768 + 256 + c], sw[1536 + 256 + c], sb[256 + c]));
        x2[r] = make_float2(conv3(zT + base0 + (size_t)512 * NKEY, t, 4096, sw[512 + c], sw[768 + 512 + c], sw[1536 + 512 + c], sb[512 + c]),
                            conv3(zT + base1 + (size_t)512 * NKEY, t, 4096, sw[512 + c], sw[768 + 512 + c], sw[1536 + 512 + c], sb[512 + c]));
        io[r] = vr[r]; }
    fft_conv8192(io, H0, X, tw, tid);
#pragma unroll
    for (int r = 0; r < 8; ++r) {
        vr[r] = make_float2(x1[r].x * (io[r].x * inv + vr[r].x * bias0), x1[r].y * (io[r].y * inv + vr[r].y * bias0));
        io[r] = vr[r]; }
    fft_conv8192(io, H1, X, tw, tid);
#pragma unroll
    for (int r = 0; r < 8; ++r) {
        vr[r] = make_float2(x2[r].x * (io[r].x * inv + vr[r].x * bias1), x2[r].y * (io[r].y * inv + vr[r].y * bias1)); }
    __builtin_amdgcn_sched_barrier(0);
#pragma unroll
    for (int r = 0; r < 8; ++r) { const int t = tid + 512 * r;
        yT[(size_t)((b0 + 0) * 256 + c) * NKEY + t] = f2bf(vr[r].x);
        yT[(size_t)((b0 + 1) * 256 + c) * NKEY + t] = f2bf(vr[r].y); }
}

DEVI void spectrum512_unit(const Params& p, int l, int su, char* lds) {
    const int tid = tidx(), n_lo = tid & 31, blk = tid >> 5, f = su * 16 + blk, n = f >> 8, c = f & 255;
    float2* X = (float2*)lds; float2* tw = X + 8448;
    const float* h2tab = (const float*)(p.ws + OFF_H2T) + 4096 * 64;
    __syncthreads();
    fft_twiddles(tw);
    const float dec0 = fabsf(p.in[I_HDEC][((l * 2 + n) * 2 + 0) * 256 + c]), dec1 = fabsf(p.in[I_HDEC][((l * 2 + n) * 2 + 1) * 256 + c]);
    float* w3s = (float*)(tw + 4096);
    for (int i = tid; i < 16 * 128; i += 512) { const int fb = i >> 7, dir = (i >> 6) & 1, k = i & 63, ff = su * 16 + fb;
        w3s[i] = p.in[I_HW3][(size_t)(l * 64 + k) * 1024 + ((ff >> 8) * 2 + dir) * 256 + (ff & 255)]; }
    __syncthreads();
    float* T = (float*)X;
#pragma unroll
    for (int i = 0; i < 8; ++i) { const int idx = tid + 512 * i, row = idx >> 4, c4 = (idx & 15) * 4; const float4 hv = *(const float4*)(h2tab + (size_t)row * 64 + c4);
        float* d = T + row * 65 + c4; d[0] = hv.x; d[1] = hv.y; d[2] = hv.z; d[3] = hv.w; }
    __syncthreads();
    float2 v[16];
#pragma unroll
    for (int dir = 0; dir < 2; ++dir) {
        float fa[8]; int jr[8];
#pragma unroll
        for (int r = 0; r < 8; ++r) { const int t = n_lo + 32 * (r + 8 * dir); jr[r] = (dir ? 512 - t : t) & 255; fa[r] = 0.f; }
        const float* wc = w3s + blk * 128 + dir * 64;
#pragma unroll 4
        for (int k = 0; k < 64; ++k) { const float wk = wc[k];
#pragma unroll
            for (int r = 0; r < 8; ++r) fa[r] += T[jr[r] * 65 + k] * wk; }
#pragma unroll
        for (int r = 0; r < 8; ++r) { const int t = n_lo + 32 * (r + 8 * dir); const int jj = dir ? 512 - t : t;
            const float fv = fa[r] * expf(-((float)jj / 255.f) * (dir ? dec1 : dec0));
            v[r + 8 * dir] = make_float2(t != 256 ? fv : 0.f, 0.f); }
    }
    __syncthreads();
    dft16<false>(v);
    fwd_store16(v, tw[16 * n_lo], X, blk * 512 + n_lo, 32);
    __syncthreads();
    fft_fwd_C(X, tw, tid);
    float2* Hout = (float2*)(p.ws + OFF_HSC) + (size_t)su * 16 * 512;
#pragma unroll
    for (int i = 0; i < 8; ++i) { const int q = tid + 512 * i; const float2 a = X[PI(2 * q)], b = X[PI(2 * q + 1)];
        *(float4*)(Hout + 2 * q) = make_float4(a.x + b.x, a.y + b.y, a.x - b.x, a.y - b.y); }
    __syncthreads();
}
DEVI void hyena512_unit(const Params& p, int l, int hu, char* lds) {
    const int tid = tidx(), n_lo = tid & 31, blk = tid >> 5, c0 = hu * 4, c = c0 + (blk >> 2), b0 = 2 * (blk & 3);
    float2* X = (float2*)lds; float2* tw = X + 8448;
    const bf16_t* zT = (const bf16_t*)(p.ws + OFF_ZT);
    bf16_t* yT = (bf16_t*)(p.ws + OFF_YT);
    const float2* HC = (const float2*)(p.ws + OFF_HSC);
    const float* sw = p.in[I_HSW] + l * 3 * 768; const float* sb = p.in[I_HSB] + l * 768;
    const float bias0 = p.in[I_HBIAS][(l * 2 + 0) * 256 + c], bias1 = p.in[I_HBIAS][(l * 2 + 1) * 256 + c];
    const size_t base0 = (size_t)(b0 * 1024 + ZT_HY + c) * NKEY + 4096, base1 = base0 + (size_t)1024 * NKEY;
    const float inv = 1.f / 512.f;
    auto H0 = [&](int j) __attribute__((always_inline)) -> const float2* { return HC + (size_t)(c0 + (j >> 2)) * 512; };
    auto H1 = [&](int j) __attribute__((always_inline)) -> const float2* { return HC + (size_t)(256 + c0 + (j >> 2)) * 512; };
    float2 io[8], vr[8];
#pragma unroll
    for (int r = 0; r < 8; ++r) { const int t = n_lo + 32 * r;
        vr[r] = make_float2(conv3(zT + base0, t, 256, sw[c], sw[768 + c], sw[1536 + c], sb[c]), conv3(zT + base1, t, 256, sw[c], sw[768 + c], sw[1536 + c], sb[c]));
        io[r] = vr[r]; }
    fft512x16_conv(io, H0, X, tw, tid);
#pragma unroll
    for (int r = 0; r < 8; ++r) { const int t = n_lo + 32 * r;
        const float x10 = conv3(zT + base0 + (size_t)256 * NKEY, t, 256, sw[256 + c], sw[768 + 256 + c], sw[1536 + 256 + c], sb[256 + c]);
        const float x11 = conv3(zT + base1 + (size_t)256 * NKEY, t, 256, sw[256 + c], sw[768 + 256 + c], sw[1536 + 256 + c], sb[256 + c]);
        vr[r] = make_float2(x10 * (io[r].x * inv + vr[r].x * bias0), x11 * (io[r].y * inv + vr[r].y * bias0));
        io[r] = vr[r]; }
    fft512x16_conv(io, H1, X, tw, tid);
#pragma unroll
    for (int r = 0; r < 8; ++r) { const int t = n_lo + 32 * r;
        const float x20 = conv3(zT + base0 + (size_t)512 * NKEY, t, 256, sw[512 + c], sw[768 + 512 + c], sw[1536 + 512 + c], sb[512 + c]);
        const float x21 = conv3(zT + base1 + (size_t)512 * NKEY, t, 256, sw[512 + c], sw[768 + 512 + c], sw[1536 + 512 + c], sb[512 + c]);
        vr[r] = make_float2(x20 * (io[r].x * inv + vr[r].x * bias1), x21 * (io[r].y * inv + vr[r].y * bias1)); }
    __builtin_amdgcn_sched_barrier(0);
#pragma unroll
    for (int r = 0; r < 8; ++r) { const int t = n_lo + 32 * r;
        yT[(size_t)((b0 + 0) * 256 + c) * NKEY + 4096 + t] = f2bf(vr[r].x);
        yT[(size_t)((b0 + 1) * 256 + c) * NKEY + 4096 + t] = f2bf(vr[r].y); }
}
DEVI void hyena_unit(const Params& p, int l, int hu, char* lds) {
    float2* X = (float2*)lds; float2* tw = X + 8448;
    __syncthreads();
    fft_twiddles(tw);
    __syncthreads();
    if (hu < 1024) hyena8192_unit(p, l, hu & 255, 2 * (hu >> 8), lds);
    else hyena512_unit(p, l, hu - 1024, lds);
}

struct KVTile { const bf16_t* k; const bf16_t* vt; };
template <int DQ, bool NA, class TF>
DEVI void attn_core(const bf16x8 (&qf)[DQ / 16], int ntiles, const TF& tilefn, int kstride, int vstride,
                    int r_q, int qc, int kr_lo, int nloc, const float* rpb_s, f32x16 (&o)[2], float& lsum, char* lds) {
    constexpr int KLD = DQ + 8, KCH = DQ / 8, KSZ = 64 * KLD * 2, VSZ = 64 * 72 * 2, ST = KSZ + VSZ;
    constexpr int NKC = (64 * KCH + 511) / 512;
    const int tid = tidx(), lane = tid & 63, l31 = lane & 31, hh = lane >> 5;
    float m = -1e30f; lsum = 0.f;
#pragma unroll
    for (int e = 0; e < 16; ++e) { o[0][e] = 0.f; o[1][e] = 0.f; }
    const int r0 = min(max(r_q - 4, 0), 56), c0 = min(max(qc - 8, 0), 48);
    u32x4 rk0, rk1, rv, sk0, sk1, sv;
#define AT_ISSUE(j_, K0, K1, V_) do { const KVTile t = tilefn(j_); \
        { const int c = tid; const int key = c / KCH, ch = c % KCH; K0 = *(const u32x4*)(t.k + (size_t)key * kstride + ch * 8); } \
        if (NKC == 2) { const int c = min(tid + 512, 64 * KCH - 1); const int key = c / KCH, ch = c % KCH; K1 = *(const u32x4*)(t.k + (size_t)key * kstride + ch * 8); } \
        V_ = *(const u32x4*)(t.vt + (size_t)(tid >> 3) * vstride + (tid & 7) * 8); } while (0)
#define AT_COMMIT(buf_, K0, K1, V_) do { bf16_t* Ks_ = (bf16_t*)(lds + (buf_) * ST); bf16_t* Vs_ = (bf16_t*)(lds + (buf_) * ST + KSZ); \
        { const int c = tid; const int key = c / KCH, ch = c % KCH; *(u32x4*)(Ks_ + key * KLD + ch * 8) = K0; } \
        if (NKC == 2) { const int c = tid + 512; if (c < 64 * KCH) { const int key = c / KCH, ch = c % KCH; *(u32x4*)(Ks_ + key * KLD + ch * 8) = K1; } } \
        *(u32x4*)(Vs_ + (tid >> 3) * 72 + (tid & 7) * 8) = V_; } while (0)
    auto tile = [&](int j) __attribute__((always_inline)) {
        const int kr = kr_lo + j;
        const bool active = !NA || j >= nloc || (kr >= r0 && kr < r0 + 8);
        if (active) {
            const bf16_t* Ks = (const bf16_t*)(lds + (j & 1) * ST); const bf16_t* Vs = (const bf16_t*)(lds + (j & 1) * ST + KSZ);
            f32x16 s0, s1;
#pragma unroll
            for (int e = 0; e < 16; ++e) { s0[e] = 0.f; s1[e] = 0.f; }
            __builtin_amdgcn_s_setprio(1);
#pragma unroll
            for (int ks = 0; ks < DQ / 16; ++ks) {
                const bf16x8 k0 = *(const bf16x8*)(Ks + l31 * KLD + ks * 16 + 8 * hh);
                const bf16x8 k1 = *(const bf16x8*)(Ks + (32 + l31) * KLD + ks * 16 + 8 * hh);
                s0 = MFMA(k0, qf[ks], s0); s1 = MFMA(k1, qf[ks], s1);
            }
            __builtin_amdgcn_s_setprio(0);
            if (NA && j < nloc) {
                const float* rb = rpb_s + (kr - r_q + 7) * 31 + 15 - qc;
#pragma unroll
                for (int e = 0; e < 16; ++e) {
                    const int kc = (e & 3) + 8 * (e >> 2) + 4 * hh;
                    const bool v0 = kc >= c0 && kc < c0 + 16, v1 = (kc + 32) >= c0 && (kc + 32) < c0 + 16;
                    s0[e] = v0 ? s0[e] + rb[kc] : -1e30f;
                    s1[e] = v1 ? s1[e] + rb[kc + 32] : -1e30f;
                }
            }
            float mx = s0[0];
#pragma unroll
            for (int e = 1; e < 16; ++e) mx = fmaxf(mx, s0[e]);
#pragma unroll
            for (int e = 0; e < 16; ++e) mx = fmaxf(mx, s1[e]);
            mx = fmaxf(mx, __shfl_xor(mx, 32));
            const float mn = fmaxf(m, mx);
            if (__builtin_amdgcn_ballot_w64(mn != m) != 0ull) {
                const float alpha = __builtin_amdgcn_exp2f(m - mn);
                lsum *= alpha;
#pragma unroll
                for (int e = 0; e < 16; ++e) { o[0][e] *= alpha; o[1][e] *= alpha; }
                m = mn;
            }
            float ps = 0.f;
#pragma unroll
            for (int e = 0; e < 16; ++e) { s0[e] = __builtin_amdgcn_exp2f(s0[e] - mn); s1[e] = __builtin_amdgcn_exp2f(s1[e] - mn); ps += s0[e] + s1[e]; }
            lsum += ps;
#pragma unroll
            for (int s4 = 0; s4 < 4; ++s4) {
                const int bs = 8 * (s4 & 1);
                u32x4 pu;
                if (s4 < 2) { pu[0] = pk2(s0[bs], s0[bs + 1]); pu[1] = pk2(s0[bs + 2], s0[bs + 3]); pu[2] = pk2(s0[bs + 4], s0[bs + 5]); pu[3] = pk2(s0[bs + 6], s0[bs + 7]); }
                else        { pu[0] = pk2(s1[bs], s1[bs + 1]); pu[1] = pk2(s1[bs + 2], s1[bs + 3]); pu[2] = pk2(s1[bs + 4], s1[bs + 5]); pu[3] = pk2(s1[bs + 6], s1[bs + 7]); }
                const bf16x8 pfv = __builtin_bit_cast(bf16x8, pu);
#pragma unroll
                for (int dvt = 0; dvt < 2; ++dvt) {
                    const uint2 v0 = *(const uint2*)(Vs + (dvt * 32 + l31) * 72 + s4 * 16 + 4 * hh);
                    const uint2 v1 = *(const uint2*)(Vs + (dvt * 32 + l31) * 72 + s4 * 16 + 8 + 4 * hh);
                    u32x4 vu; vu[0] = v0.x; vu[1] = v0.y; vu[2] = v1.x; vu[3] = v1.y;
                    o[dvt] = MFMA(__builtin_bit_cast(bf16x8, vu), pfv, o[dvt]);
                }
            }
        }
    };
    __syncthreads();
    AT_ISSUE(0, rk0, rk1, rv); AT_COMMIT(0, rk0, rk1, rv);
    AT_ISSUE(min(1, ntiles - 1), sk0, sk1, sv);
    __syncthreads();
#pragma unroll 1
    for (int j = 0; j < ntiles; j += 2) {
        AT_ISSUE(min(j + 2, ntiles - 1), rk0, rk1, rv);
        tile(j);
        AT_COMMIT(1, sk0, sk1, sv);
        __syncthreads();
        if (j + 1 >= ntiles) break;
        AT_ISSUE(min(j + 3, ntiles - 1), sk0, sk1, sv);
        tile(j + 1);
        AT_COMMIT(0, rk0, rk1, rv);
        __syncthreads();
    }
#undef AT_ISSUE
#undef AT_COMMIT
    lsum += __shfl_xor(lsum, 32);
}
DEVI void attn_store(const f32x16 (&o)[2], float lsum, bf16_t* dst  ) {
    const int lane = tidx() & 63, hh = lane >> 5;
    const float il = 1.f / lsum;
#pragma unroll
    for (int dvt = 0; dvt < 2; ++dvt)
#pragma unroll
        for (int g = 0; g < 4; ++g) { uint2 v; v.x = pk2(o[dvt][4 * g] * il, o[dvt][4 * g + 1] * il); v.y = pk2(o[dvt][4 * g + 2] * il, o[dvt][4 * g + 3] * il);
            *(uint2*)(dst + dvt * 32 + 8 * g + 4 * hh) = v; }
}
DEVI void na_unit(const Params& p, int l, int au, char* lds) {
    const int tid = tidx(), lane = tid & 63, w = tid >> 6, l31 = lane & 31, hh = lane >> 5;
    const bf16_t* z = (const bf16_t*)(p.ws + OFF_Z); const bf16_t* zT = (const bf16_t*)(p.ws + OFF_ZT);
    bf16_t* br = (bf16_t*)(p.ws + OFF_BR);
    const bool isctx = au >= 512;
    int b, h, R;
    if (!isctx) { b = au >> 6; h = (au >> 4) & 3; R = au & 15; } else { b = (au - 512) >> 2; h = (au - 512) & 3; R = 0; }
    float* rpb_s = (float*)(lds + 2 * (64 * 72 * 2 + 64 * 72 * 2));
    __syncthreads();
    for (int i = tid; i < 465; i += 512) rpb_s[i] = p.in[I_RPB][(size_t)(l * 4 + h) * 465 + i] * 1.4426950408889634f;
    const int r_q = 4 * R + (w >> 1), qc = (w & 1) * 32 + l31;
    const int qrow = isctx ? TL + b * 256 + w * 32 + l31 : b * 4096 + r_q * 64 + qc;
    bf16x8 qf[4];
    {
        const bf16_t* qs = z + (size_t)qrow * ZLD + ZC_NAQ + h * 64 + 8 * hh;
        const float sc = 0.125f * 1.4426950408889634f;
#pragma unroll
        for (int ks = 0; ks < 4; ++ks) { const uint4 v = *(const uint4*)(qs + ks * 16); u32x4 t;
            t[0] = pk2(lo_bf(v.x) * sc, hi_bf(v.x) * sc); t[1] = pk2(lo_bf(v.y) * sc, hi_bf(v.y) * sc); t[2] = pk2(lo_bf(v.z) * sc, hi_bf(v.z) * sc); t[3] = pk2(lo_bf(v.w) * sc, hi_bf(v.w) * sc);
            qf[ks] = __builtin_bit_cast(bf16x8, t); }
    }
    int kr_lo = 0, nloc = 0;
    if (!isctx) { kr_lo = min(max(4 * R - 4, 0), 56); const int kr_hi = min(max(4 * R - 1, 0), 56) + 7; nloc = kr_hi - kr_lo + 1; }
    const bf16_t* kb = z + ZC_NAK + h * 64; const bf16_t* vb = zT + (size_t)(b * 1024 + ZT_NAV + h * 64) * NKEY;
    auto tf = [&](int j) { KVTile t;
        if (j < nloc) { const int kr = kr_lo + j; t.k = kb + (size_t)(b * 4096 + kr * 64) * ZLD; t.vt = vb + kr * 64; }
        else { const int i = j - nloc; t.k = kb + (size_t)(TL + b * 256 + 64 * i) * ZLD; t.vt = vb + 4096 + 64 * i; }
        return t; };
    f32x16 o[2]; float ls;
    attn_core<64, true>(qf, nloc + 4, tf, ZLD, NKEY, r_q, qc, kr_lo, nloc, rpb_s, o, ls, lds);
    attn_store(o, ls, br + (size_t)qrow * DM + 256 + h * 64);
}
DEVI void lru1_unit(const Params& p, int l, int lu, char* lds) {
    const int tid = tidx(), c = tid & 255, half = tid >> 8, lane = tid & 63, w = tid >> 6, l31 = lane & 31, hh = lane >> 5;
    const int tt = lu >> 1, d = lu & 1;
    const int row0 = tt * 64;
    const int s0 = row0 < TL ? (row0 & 4095) : ((row0 - TL) & 255);
    const int L = row0 < TL ? 4096 : 256;
    const bf16_t* z = (const bf16_t*)(p.ws + OFF_Z);
    constexpr int XLD = 264;
    bf16_t* xs = (bf16_t*)lds;
    float* As = (float*)(lds + 34816);
    bf16_t* Bs = (bf16_t*)(lds + 34816 + 65536);
    const int n = w & 3, th = w >> 2;
    bf16x8 wf[2][2][4];
    {
        const bf16_t* wt = (const bf16_t*)(p.ws + OFF_LWT);
#pragma unroll
        for (int g = 0; g < 2; ++g)
#pragma unroll
            for (int ct = 0; ct < 2; ++ct)
#pragma unroll
                for (int ks = 0; ks < 4; ++ks) wf[g][ct][ks] = *(const bf16x8*)(wt + (size_t)((d * 2 + g) * 4 + n) * 4096 + (ct * 32 + l31) * 64 + ks * 16 + 8 * hh);
    }
    float cba[2], cbx[2], csp[2];
#pragma unroll
    for (int ct = 0; ct < 2; ++ct) { const int ch = 64 * n + ct * 32 + l31; cba[ct] = p.in[I_LBA][(l * 2 + d) * 256 + ch]; cbx[ct] = p.in[I_LBX][(l * 2 + d) * 256 + ch]; csp[ct] = p.in[I_LLAM][(l * 2 + d) * 256 + ch]; }
    __syncthreads();
    {
        const float* cw = p.in[I_LCW] + (size_t)(l * 2 + d) * 4 * 256; const float cb = p.in[I_LCB][(l * 2 + d) * 256 + c];
        const float w0 = cw[c], w1 = cw[256 + c], w2 = cw[512 + c], w3 = cw[768 + c];
        const bf16_t* zu = z + (size_t)(row0 - s0) * ZLD + ZC_LU + c;
        auto U = [&](int s) -> float { const float v = bf2f(zu[(size_t)min(max(s, 0), L - 1) * ZLD]); return (s >= 0 && s < L) ? v : 0.f; };
        const int sb = s0 + 32 * half - (d == 0 ? 3 : 0);
        float uv[35];
#pragma unroll
        for (int i = 0; i < 35; ++i) uv[i] = U(sb + i);
#pragma unroll
        for (int i = 0; i < 32; ++i) xs[(32 * half + i) * XLD + c] = f2bf(cb + w0 * uv[i] + w1 * uv[i + 1] + w2 * uv[i + 2] + w3 * uv[i + 3]);
    }
    __syncthreads();
    {
        f32x16 acc[2][2];
#pragma unroll
        for (int g = 0; g < 2; ++g)
#pragma unroll
            for (int ct = 0; ct < 2; ++ct)
#pragma unroll
                for (int e = 0; e < 16; ++e) acc[g][ct][e] = 0.f;
#pragma unroll
        for (int ks = 0; ks < 4; ++ks) {
            const bf16x8 af = *(const bf16x8*)(xs + (th * 32 + l31) * XLD + 64 * n + ks * 16 + 8 * hh);
#pragma unroll
            for (int g = 0; g < 2; ++g)
#pragma unroll
                for (int ct = 0; ct < 2; ++ct) acc[g][ct] = MFMA(af, wf[g][ct][ks], acc[g][ct]);
        }
#pragma unroll
        for (int ct = 0; ct < 2; ++ct) {
            const int ch = 64 * n + ct * 32 + l31;
            const float ba = cba[ct], bx = cbx[ct];
            const float sp = log1pf(expf(-csp[ct]));
#pragma unroll
            for (int e = 0; e < 16; ++e) {
                const int tl = th * 32 + (e & 3) + 8 * (e >> 2) + 4 * hh;
                const float r = sigmoidf_(acc[0][ct][e] + ba), ig = sigmoidf_(acc[1][ct][e] + bx);
                const float la = -8.f * r * sp, a = __expf(la), mult = __builtin_amdgcn_sqrtf(fmaxf(1.f - a * a, 0.f));
                As[tl * 256 + ch] = a;
                Bs[tl * 256 + ch] = f2bf(mult * ig * bf2f(xs[tl * XLD + ch]));
            }
        }
    }
    __syncthreads();
    bf16_t* hloc = (bf16_t*)(p.ws + OFF_HLOC) + (size_t)d * TT * 256; bf16_t* cuma = (bf16_t*)(p.ws + OFF_CUMA) + (size_t)d * TT * 256;
    float hst = 0.f, cum = 1.f;
    for (int i = 0; i < 32; ++i) {
        const int tl = 32 * half + (d == 0 ? i : 31 - i);
        const float a = As[tl * 256 + c], bt = bf2f(Bs[tl * 256 + c]);
        hst = a * hst + bt; cum *= a;
        hloc[(size_t)(row0 + tl) * 256 + c] = f2bf(hst); cuma[(size_t)(row0 + tl) * 256 + c] = f2bf(cum);
    }
    const int seg = tt * 2 + half;
    ((float*)(p.ws + OFF_SEGA))[(size_t)(d * 1088 + seg) * 256 + c] = cum;
    ((float*)(p.ws + OFF_SEGB))[(size_t)(d * 1088 + seg) * 256 + c] = hst;
}
DEVI void qproj_unit(const Params& p, int qu, char* lds) {
    const int mt = qu >> 1, nh = qu & 1;
    const int tid = tidx(), lane = tid & 63, w = tid >> 6, wm = w >> 1, wn = w & 1, l31 = lane & 31, hh = lane >> 5;
    const bf16_t* z = (const bf16_t*)(p.ws + OFF_Z);
    const int row0 = mt_row0(mt);
    float* rs = (float*)(lds + 120 * 1024);
    KFragA<12> a;
    kx_load_a<12>(a, z + ZC_QL, ZLD, row0, lds, rs, 1e-6f);
    bf16_t* Q = (bf16_t*)(p.ws + OFF_Q);
    const float* cosT = (const float*)(p.ws + OFF_COS); const float* sinT = (const float*)(p.ws + OFF_SIN);
    const float QS = 0.10206207261596575f * 1.4426950408889634f;
    const bool lat = mt < 128;
    kx_stream<12>(a, (const bf16_t*)(p.ws + OFF_WUQ) + (size_t)nh * 192 * 192, 3, lds, [&](int j, const f32x16 (&acc)[2]) __attribute__((always_inline)) {
        const int ct = nh * 6 + j * 2 + wn, hd = ct / 3, part = ct % 3;
#pragma unroll
        for (int mi = 0; mi < 2; ++mi) {
            const int rl = wm * 64 + mi * 32 + l31, row = row0 + rl, b = row_b(row), key = row_key(row);
            const float rstd = rs[rl] * QS;
            float v[16];
#pragma unroll
            for (int e = 0; e < 16; ++e) v[e] = acc[mi][e] * rstd;
            if (part == 2 && lat) {
#pragma unroll
                for (int g = 0; g < 2; ++g)
#pragma unroll
                    for (int jj = 0; jj < 4; ++jj) { const int i = 8 * g + 4 * hh + jj; const float cs = cosT[key * 16 + i], sn = sinT[key * 16 + i];
                        const float x1 = v[4 * g + jj], x2 = v[4 * (g + 2) + jj]; v[4 * g + jj] = x1 * cs - x2 * sn; v[4 * (g + 2) + jj] = x1 * sn + x2 * cs; }
            }
            bf16_t* dst = Q + ((size_t)((b * 4 + hd) * NKEY + key)) * 96 + part * 32 + 4 * hh;
#pragma unroll
            for (int g = 0; g < 4; ++g) { uint2 o; o.x = pk2(v[4 * g], v[4 * g + 1]); o.y = pk2(v[4 * g + 2], v[4 * g + 3]); *(uint2*)(dst + 8 * g) = o; }
        }
    });
}
DEVI void kvproj_unit(const Params& p, int ku, char* lds) {
    const int mt = ku >> 1, nh = ku & 1;
    const int tid = tidx(), lane = tid & 63, w = tid >> 6, wm = w >> 1, wn = w & 1, l31 = lane & 31, hh = lane >> 5;
    const bf16_t* z = (const bf16_t*)(p.ws + OFF_Z);
    const int row0 = mt_row0(mt);
    float* rs = (float*)(lds + 120 * 1024);
    bf16_t* Kb = (bf16_t*)(p.ws + OFF_K); bf16_t* Vt = (bf16_t*)(p.ws + OFF_VT);
    const float* cosT = (const float*)(p.ws + OFF_COS); const float* sinT = (const float*)(p.ws + OFF_SIN);
    const bool lat = mt < 128;
    if (nh == 0) {
        const int rl = tid >> 1, part = tid & 1, row = row0 + rl, b = row_b(row), key = row_key(row);
        const bf16_t* zr = z + (size_t)row * ZLD + ZC_KR;
        const u32x4 q1 = *(const u32x4*)(zr + 8 * part), q2 = *(const u32x4*)(zr + 16 + 8 * part);
        const int kk = lat ? key : 0;
        const float4 ca = *(const float4*)(cosT + kk * 16 + 8 * part), cb = *(const float4*)(cosT + kk * 16 + 8 * part + 4);
        const float4 sa = *(const float4*)(sinT + kk * 16 + 8 * part), sb2 = *(const float4*)(sinT + kk * 16 + 8 * part + 4);
        const float csv[8] = {ca.x, ca.y, ca.z, ca.w, cb.x, cb.y, cb.z, cb.w}, snv[8] = {sa.x, sa.y, sa.z, sa.w, sb2.x, sb2.y, sb2.z, sb2.w};
        float y1[8], y2[8];
#pragma unroll
        for (int ii = 0; ii < 8; ++ii) { const float x1 = (ii & 1) ? hi_bf(q1[ii >> 1]) : lo_bf(q1[ii >> 1]), x2 = (ii & 1) ? hi_bf(q2[ii >> 1]) : lo_bf(q2[ii >> 1]);
            const float cs = lat ? csv[ii] : 1.f, sn = lat ? snv[ii] : 0.f; y1[ii] = x1 * cs - x2 * sn; y2[ii] = x1 * sn + x2 * cs; }
        u32x4 o1, o2;
#pragma unroll
        for (int j = 0; j < 4; ++j) { o1[j] = pk2(y1[2 * j], y1[2 * j + 1]); o2[j] = pk2(y2[2 * j], y2[2 * j + 1]); }
#pragma unroll
        for (int hd = 0; hd < 4; ++hd) { bf16_t* kd = Kb + ((size_t)((b * 4 + hd) * NKEY + key)) * 96 + 64 + 8 * part; *(u32x4*)kd = o1; *(u32x4*)(kd + 16) = o2; }
    }
    KFragA<8> a;
    kx_load_a<8>(a, z + ZC_KVL, ZLD, row0, lds, rs, 1e-6f);
    kx_stream<8>(a, (const bf16_t*)(p.ws + OFF_WUKV) + (size_t)nh * 256 * 128, 4, lds, [&](int j, const f32x16 (&acc)[2]) __attribute__((always_inline)) {
        const int hd = nh * 2 + (j >> 1), isv = j & 1;
#pragma unroll
        for (int mi = 0; mi < 2; ++mi) {
            const int rl = wm * 64 + mi * 32 + l31, row = row0 + rl, b = row_b(row), key = row_key(row);
            const float rstd = rs[rl];
            if (!isv) {
                bf16_t* dst = Kb + ((size_t)((b * 4 + hd) * NKEY + key)) * 96 + wn * 32 + 4 * hh;
#pragma unroll
                for (int g = 0; g < 4; ++g) { uint2 o; o.x = pk2(acc[mi][4 * g] * rstd, acc[mi][4 * g + 1] * rstd); o.y = pk2(acc[mi][4 * g + 2] * rstd, acc[mi][4 * g + 3] * rstd); *(uint2*)(dst + 8 * g) = o; }
            } else {
#pragma unroll
                for (int e = 0; e < 16; ++e) { const int dv = wn * 32 + (e & 3) + 8 * (e >> 2) + 4 * hh;
                    Vt[((size_t)((b * 4 + hd) * 64 + dv)) * NKEY + key] = f2bf(acc[mi][e] * rstd); }
            }
        }
    });
}
DEVI void mla_unit(const Params& p, int au, char* lds) {
    const int tid = tidx(), lane = tid & 63, w = tid >> 6, l31 = lane & 31, hh = lane >> 5;
    const bool isctx = au >= 512;
    int b, h, qb;
    if (!isctx) { b = au >> 6; h = (au >> 4) & 3; qb = au & 15; } else { b = (au - 512) >> 2; h = (au - 512) & 3; qb = 16; }
    const int q0 = qb * 256 + w * 32 + l31;
    const bf16_t* Qp = (const bf16_t*)(p.ws + OFF_Q) + ((size_t)((b * 4 + h) * NKEY + q0)) * 96 + 8 * hh;
    bf16x8 qf[6];
#pragma unroll
    for (int ks = 0; ks < 6; ++ks) qf[ks] = *(const bf16x8*)(Qp + ks * 16);
    const bf16_t* kb = (const bf16_t*)(p.ws + OFF_K) + (size_t)((b * 4 + h) * NKEY) * 96;
    const bf16_t* vb = (const bf16_t*)(p.ws + OFF_VT) + (size_t)((b * 4 + h) * 64) * NKEY;
    const int jt0 = isctx ? 64 : 0, ntl = isctx ? 4 : 68;
    auto tf = [&](int j) { KVTile t; t.k = kb + (size_t)(jt0 + j) * 64 * 96; t.vt = vb + (jt0 + j) * 64; return t; };
    f32x16 o[2]; float ls;
    attn_core<96, false>(qf, ntl, tf, 96, NKEY, 0, 0, 0, 0, nullptr, o, ls, lds);
    const int row = isctx ? TL + b * 256 + w * 32 + l31 : b * 4096 + q0;
    attn_store(o, ls, (bf16_t*)(p.ws + OFF_BR) + (size_t)row * DM + h * 64);
}

DEVI void ytrans_unit(const Params& p, int tu, char* lds) {
    const int tid = tidx();
    const int b = tu / 68, kt = tu % 68, key0 = kt * 64;
    const int row0 = kt < 64 ? b * 4096 + key0 : TL + b * 256 + (key0 - 4096);
    const bf16_t* yT = (const bf16_t*)(p.ws + OFF_YT) + (size_t)(b * 256) * NKEY + key0;
    bf16_t* br = (bf16_t*)(p.ws + OFF_BR);
    bf16_t* tl = (bf16_t*)lds;
    __syncthreads();
#pragma unroll
    for (int i = 0; i < 4; ++i) { const int cidx = tid + 512 * i, ch = cidx >> 3, kc = (cidx & 7) * 8; *(u32x4*)(tl + ch * 72 + kc) = *(const u32x4*)(yT + (size_t)ch * NKEY + kc); }
    __syncthreads();
#pragma unroll
    for (int i = 0; i < 4; ++i) { const int cidx = tid + 512 * i, t = cidx >> 5, c8 = (cidx & 31) * 8;
        u32x4 o;
#pragma unroll
        for (int j = 0; j < 4; ++j) o[j] = (unsigned)tl[(c8 + 2 * j) * 72 + t] | ((unsigned)tl[(c8 + 2 * j + 1) * 72 + t] << 16);
        *(u32x4*)(br + (size_t)(row0 + t) * DM + 512 + c8) = o; }
}
DEVI float gelu_tanh(float x) { const float u = 0.7978845608028654f * (x + 0.044715f * x * x * x); return x * __builtin_amdgcn_rcpf(1.f + __expf(-2.f * u)); }
DEVI void lru_carry_unit(const Params& p, int l, int b) {
    const int tid = tidx(), c = tid & 255, d = tid >> 8;
    const float* SA = (const float*)(p.ws + OFF_SEGA) + (size_t)d * 1088 * 256; const float* SB = (const float*)(p.ws + OFF_SEGB) + (size_t)d * 1088 * 256;
    float* HIN = (float*)(p.ws + OFF_HIN) + (size_t)d * 1088 * 256;
    const int cbase = 1024 + 8 * b, lbase = 128 * b;
    float h = 0.f;
#pragma unroll 1
    for (int k0 = 0; k0 < 136; k0 += 17) {
        float sa[17], sbv[17];
#pragma unroll
        for (int i = 0; i < 17; ++i) { const int k = k0 + i; const int seg = d == 0 ? (k < 8 ? cbase + k : lbase + (k - 8)) : (k < 8 ? cbase + 7 - k : lbase + 135 - k);
            const size_t o = (size_t)seg * 256 + c; sa[i] = SA[o]; sbv[i] = SB[o]; }
        __builtin_amdgcn_sched_barrier(0);
#pragma unroll
        for (int i = 0; i < 17; ++i) { const int k = k0 + i; const int seg = d == 0 ? (k < 8 ? cbase + k : lbase + (k - 8)) : (k < 8 ? cbase + 7 - k : lbase + 135 - k);
            const size_t o = (size_t)seg * 256 + c;
            __hip_atomic_store(HIN + o, h, __ATOMIC_RELAXED, __HIP_MEMORY_SCOPE_AGENT);
            h = sa[i] * h + sbv[i]; }
        __builtin_amdgcn_sched_barrier(0);
    }
    asm volatile("s_waitcnt vmcnt(0)" ::: "memory");
    __syncthreads();
    if (tid == 0) __hip_atomic_store((unsigned*)(p.ws + OFF_GCNT) + 768 + l * 8 + b, 1u, __ATOMIC_RELAXED, __HIP_MEMORY_SCOPE_AGENT);
}
DEVI void lru2_unit(const Params& p, int l, int tt) {
    const int tid = tidx(), c = tid & 255, half = tid >> 8;
    const int s0 = tt * 4 + half * 2;
    const bool lat = s0 < 1024;
    const int b = lat ? (s0 >> 7) : ((s0 - 1024) >> 3);
    if (tid == 0) {
        unsigned* flag = (unsigned*)(p.ws + OFF_GCNT) + 768 + l * 8 + b; unsigned sp = 0;
        while (__hip_atomic_load(flag, __ATOMIC_RELAXED, __HIP_MEMORY_SCOPE_AGENT) == 0u && ++sp < (1u << 22)) __builtin_amdgcn_s_sleep(2);
    }
    __syncthreads();
    const float* HIN = (const float*)(p.ws + OFF_HIN);
    float hin[2][2];
#pragma unroll
    for (int d = 0; d < 2; ++d)
#pragma unroll
        for (int sgi = 0; sgi < 2; ++sgi) hin[d][sgi] = __hip_atomic_load(HIN + ((size_t)d * 1088 + s0 + sgi) * 256 + c, __ATOMIC_RELAXED, __HIP_MEMORY_SCOPE_AGENT);
    const bf16_t* hl = (const bf16_t*)(p.ws + OFF_HLOC); const bf16_t* ca = (const bf16_t*)(p.ws + OFF_CUMA);
    const bf16_t* z = (const bf16_t*)(p.ws + OFF_Z); bf16_t* br = (bf16_t*)(p.ws + OFF_BR);
#pragma unroll 1
    for (int t8 = 0; t8 < 8; ++t8) {
        const int sgi = t8 >> 2; const size_t row0 = (size_t)(s0 + sgi) * 32 + (t8 & 3) * 8;
        bf16_t a0[8], a1[8], a2[8], a3[8], a4[8];
#pragma unroll
        for (int i = 0; i < 8; ++i) { const size_t row = row0 + i;
            a0[i] = hl[row * 256 + c]; a1[i] = ca[row * 256 + c]; a2[i] = hl[((size_t)TT + row) * 256 + c]; a3[i] = ca[((size_t)TT + row) * 256 + c]; a4[i] = z[row * ZLD + ZC_LG + c]; }
        __builtin_amdgcn_sched_barrier(0);
        const float h0 = sgi ? hin[0][1] : hin[0][0], h1 = sgi ? hin[1][1] : hin[1][0];
#pragma unroll
        for (int i = 0; i < 8; ++i) { const size_t row = row0 + i;
            const float hf = bf2f(a0[i]) + bf2f(a1[i]) * h0, hr = bf2f(a2[i]) + bf2f(a3[i]) * h1;
            br[row * DM + 768 + c] = f2bf((hf + hr) * gelu_tanh(bf2f(a4[i]))); }
        __builtin_amdgcn_sched_barrier(0);
    }
}
DEVI void pbranch_unit(const Params& p, int u, char* lds) {
    const int mt = u >> 3, g = (u >> 1) & 3, nh = u & 1;
    const int tid = tidx(), lane = tid & 63, w = tid >> 6, wm = w >> 1, wn = w & 1, l31 = lane & 31, hh = lane >> 5;
    const int row0 = mt_row0(mt);
    K256A a;
    k256_load_a(a, (const bf16_t*)(p.ws + OFF_BR) + g * 256, DM, row0, lds);
    bf16_t* P = (bf16_t*)(p.ws + (g < 2 ? OFF_PLO : OFF_PHI)) + (size_t)(g & 1) * 1024 + nh * 512;
    bf16_t* slab = (bf16_t*)(lds + 2 * K2_BUF) + w * (64 * 40);
    k256_stream(a, (const bf16_t*)(p.ws + OFF_WBR) + (size_t)(g * 1024 + nh * 512) * 256, 8, lds, [&](int j, const f32x16 (&acc)[2]) __attribute__((always_inline)) {
#pragma unroll
        for (int mi = 0; mi < 2; ++mi)
#pragma unroll
            for (int q = 0; q < 4; ++q) { uint2 o; o.x = pk2(acc[mi][4 * q], acc[mi][4 * q + 1]); o.y = pk2(acc[mi][4 * q + 2], acc[mi][4 * q + 3]);
                *(uint2*)(slab + (mi * 32 + l31) * 40 + 8 * q + 4 * hh) = o; }
        asm volatile("s_waitcnt lgkmcnt(0)" ::: "memory");
#pragma unroll
        for (int it = 0; it < 4; ++it) {
            const int r64 = it * 16 + (lane >> 2);
            const u32x4 v = *(const u32x4*)(slab + r64 * 40 + (lane & 3) * 8);
            *(u32x4*)(P + (size_t)(row0 + wm * 64 + r64) * 2048 + j * 64 + wn * 32 + (lane & 3) * 8) = v;
        }
        asm volatile("s_waitcnt lgkmcnt(0)" ::: "memory");
    });
}
DEVI void router_unit(const Params& p, int l, int r0, int r1, char* lds) {
    const int tid = tidx(), lane = tid & 63, w = tid >> 6, wm = w >> 1, wn = w & 1, l31 = lane & 31, hh = lane >> 5;
    const int nrows = r1 - r0;
    norm_rows(p, l, r0, r1, 1);
    asm volatile("s_waitcnt vmcnt(0)" ::: "memory");
    __syncthreads();
    const RowLoader al = make_rows((const bf16_t*)(p.ws + OFF_H), DM, r0);
    f32x16 acc[2][1];
    gemm_mainloop<true, 1>(acc, al, (const bf16_t*)(p.ws + OFF_RT), 1024, 1024, lds);
    float* lg = (float*)lds;
    int* cnt_l = (int*)(lds + 256 * 65 * 4);
    int* base_g = cnt_l + 64;
#pragma unroll
    for (int mi = 0; mi < 2; ++mi)
#pragma unroll
        for (int e = 0; e < 16; ++e) lg[(wm * 64 + mi * 32 + l31) * 65 + wn * 32 + (e & 3) + 8 * (e >> 2) + 4 * hh] = sigmoidf_(acc[mi][0][e]);
    float* rbs = (float*)(base_g + 64);
    if (tid < 64) { cnt_l[tid] = 0; rbs[tid] = p.in[I_RB][l * 64 + tid]; }
    __syncthreads();
    int se[6], spos[6]; float swt[6];
    if (tid < nrows) {
        const float* rb = rbs;
        float* my = lg + tid * 65;
        float ssum = 0.f;
#pragma unroll
        for (int k = 0; k < 6; ++k) {
            float best = -1e30f; int bi = 0;
#pragma unroll 8
            for (int e = 0; e < 64; ++e) { const float s = my[e] + rb[e]; if (s > best) { best = s; bi = e; } }
            const float sc = my[bi];
            se[k] = bi; swt[k] = sc; ssum += sc; my[bi] = -1e30f;
        }
        const float nrm = 2.5f / ssum;
#pragma unroll
        for (int k = 0; k < 6; ++k) { swt[k] *= nrm; spos[k] = atomicAdd(&cnt_l[se[k]], 1); }
    }
    __syncthreads();
    if (tid < 64) base_g[tid] = (int)__hip_atomic_fetch_add((unsigned*)(p.ws + OFF_GCNT) + l * 64 + tid, (unsigned)cnt_l[tid], __ATOMIC_RELAXED, __HIP_MEMORY_SCOPE_AGENT);
    __syncthreads();
    if (tid < nrows) {
        const int r = r0 + tid;
        int* list = (int*)(p.ws + OFF_LIST); unsigned* toks = (unsigned*)(p.ws + OFF_TOKS); float* wts = (float*)(p.ws + OFF_WTS);
#pragma unroll
        for (int k = 0; k < 6; ++k) { const int pos = base_g[se[k]] + spos[k]; list[(size_t)se[k] * TT + pos] = r; toks[(size_t)r * 6 + k] = ((unsigned)se[k] << 16) | (unsigned)pos; wts[(size_t)r * 6 + k] = swt[k]; }
    }
}
struct MoeTab { int* cnt; int* blkbase; int* cbase; };
DEVI MoeTab moe_tables(const Params& p, int l, int nact, char* lds) {
    MoeTab t; t.cnt = (int*)(lds + LDS_BYTES - 4096); t.blkbase = t.cnt + 80; t.cbase = t.blkbase + 80;
    __syncthreads();
    if (tidx() < 64) t.cnt[tidx()] = (int)__hip_atomic_load((unsigned*)(p.ws + OFF_GCNT) + l * 64 + tidx(), __ATOMIC_RELAXED, __HIP_MEMORY_SCOPE_AGENT);
    __syncthreads();
    if (tidx() == 0) {
        int bb = 0, cb = 0;
        for (int e = 0; e < 64; ++e) { const int c = t.cnt[e]; t.blkbase[e] = bb; t.cbase[e] = cb; bb += (c + 255) >> 8; cb += c; }
        t.cnt[64] = nact; t.blkbase[64] = bb; t.cbase[64] = cb; t.blkbase[65] = bb + (nact >> 8);
    }
    __syncthreads();
    {
        unsigned char* eb = (unsigned char*)(t.cbase + 80);
        const int nrb = t.blkbase[65];
        for (int rb = tidx(); rb < nrb; rb += 512) { int e = 0; while (e < 64 && rb >= t.blkbase[e + 1]) ++e; eb[rb] = (unsigned char)e; }
    }
    __syncthreads();
    return t;
}
DEVI int find_expert(const MoeTab& t, int rb) { return (int)((const unsigned char*)(t.cbase + 80))[rb]; }
DEVI void moe2_unit(const Params& p, int l, const MoeTab& t, int rb, char* lds) {
    const int tid = tidx(), lane = tid & 63, w = tid >> 6, wm = w >> 1, wn = w & 1, l31 = lane & 31, hh = lane >> 5;
    const int e = find_expert(t, rb), i0 = (rb - t.blkbase[e]) * 256, cnt = t.cnt[e], cbe = t.cbase[e];
    K256A a;
    k256_load_a(a, (const bf16_t*)(p.ws + OFF_HID), 256, rb * 256, lds);
    const bf16_t* Bt = (const bf16_t*)(p.ws + OFF_WDT) + (size_t)e * 1024 * 256;
    if (e < 64) {
        bf16_t* Y = (bf16_t*)(p.ws + OFF_Y);
        bf16_t* slab = (bf16_t*)(lds + 2 * K2_BUF) + w * (64 * 40);
        bf16_t* trash = (bf16_t*)(p.ws + OFF_SEGA + (size_t)blockIdx.x * 8192 + (size_t)tid * 16);
        k256_stream(a, Bt, 16, lds, [&](int j, const f32x16 (&acc)[2]) __attribute__((always_inline)) {
#pragma unroll
            for (int mi = 0; mi < 2; ++mi)
#pragma unroll
                for (int g = 0; g < 4; ++g) { uint2 o; o.x = pk2(acc[mi][4 * g], acc[mi][4 * g + 1]); o.y = pk2(acc[mi][4 * g + 2], acc[mi][4 * g + 3]);
                    *(uint2*)(slab + (mi * 32 + l31) * 40 + 8 * g + 4 * hh) = o; }
            asm volatile("s_waitcnt lgkmcnt(0)" ::: "memory");
#pragma unroll
            for (int it = 0; it < 4; ++it) {
                const int r64 = it * 16 + (lane >> 2), ii = i0 + wm * 64 + r64;
                const u32x4 v = *(const u32x4*)(slab + r64 * 40 + (lane & 3) * 8);
                *(u32x4*)(ii < cnt ? Y + (size_t)(cbe + ii) * DM + j * 64 + wn * 32 + (lane & 3) * 8 : trash) = v;
            }
            asm volatile("s_waitcnt lgkmcnt(0)" ::: "memory");
        });
    } else {
        const float* g2b = (const float*)(p.ws + OFF_MOD) + (size_t)l * 9 * 6144 + 5120 + (size_t)row_mod(i0) * 6144;
        bf16_t* slab = (bf16_t*)(lds + 2 * K2_BUF) + w * (64 * 40);
        k256_stream(a, Bt, 16, lds, [&](int j, const f32x16 (&acc)[2]) __attribute__((always_inline)) {
#pragma unroll
            for (int mi = 0; mi < 2; ++mi)
#pragma unroll
                for (int g = 0; g < 4; ++g) { uint2 o; o.x = pk2(acc[mi][4 * g], acc[mi][4 * g + 1]); o.y = pk2(acc[mi][4 * g + 2], acc[mi][4 * g + 3]);
                    *(uint2*)(slab + (mi * 32 + l31) * 40 + 8 * g + 4 * hh) = o; }
            const int c0 = j * 64 + wn * 32 + (lane & 3) * 8;
            const float4 ga = *(const float4*)(g2b + c0), gb = *(const float4*)(g2b + c0 + 4);
            asm volatile("s_waitcnt lgkmcnt(0)" ::: "memory");
#pragma unroll
            for (int h2 = 0; h2 < 2; ++h2) {
                float4 xa[2], xb[2];
#pragma unroll
                for (int i2 = 0; i2 < 2; ++i2) { const int r64 = (h2 * 2 + i2) * 16 + (lane >> 2); const float* xr = xdst(p, i0 + wm * 64 + r64) + c0; xa[i2] = *(const float4*)xr; xb[i2] = *(const float4*)(xr + 4); }
                __builtin_amdgcn_sched_barrier(0);
#pragma unroll
                for (int i2 = 0; i2 < 2; ++i2) { const int r64 = (h2 * 2 + i2) * 16 + (lane >> 2); float* xr = xdst(p, i0 + wm * 64 + r64) + c0;
                    const u32x4 v = *(const u32x4*)(slab + r64 * 40 + (lane & 3) * 8);
                    float4 oa = xa[i2], ob = xb[i2];
                    oa.x += ga.x * lo_bf(v[0]); oa.y += ga.y * hi_bf(v[0]); oa.z += ga.z * lo_bf(v[1]); oa.w += ga.w * hi_bf(v[1]);
                    ob.x += gb.x * lo_bf(v[2]); ob.y += gb.y * hi_bf(v[2]); ob.z += gb.z * lo_bf(v[3]); ob.w += gb.w * hi_bf(v[3]);
                    *(float4*)xr = oa; *(float4*)(xr + 4) = ob; }
                __builtin_amdgcn_sched_barrier(0);
            }
            asm volatile("s_waitcnt lgkmcnt(0)" ::: "memory");
        });
    }
}
DEVI void combine_unit(const Params& p, int l, const MoeTab& t, int r0, int r1) {
    const int lane = tidx() & 63, w = tidx() >> 6;
    const float* mod = (const float*)(p.ws + OFF_MOD);
    const bf16_t* Y = (const bf16_t*)(p.ws + OFF_Y);
    const unsigned* toks = (const unsigned*)(p.ws + OFF_TOKS); const float* wts = (const float*)(p.ws + OFF_WTS);
#pragma unroll 2
    for (int r = r0 + w; r < r1; r += 8) {
        float* xd = xdst(p, r);
        const float* g2 = mod + (size_t)(l * 9 + row_mod(r)) * 6144 + 5120;
        const bf16_t* yr[6]; float wk[6];
#pragma unroll
        for (int k = 0; k < 6; ++k) { const unsigned v = toks[(size_t)r * 6 + k]; yr[k] = Y + (size_t)(t.cbase[v >> 16] + (int)(v & 0xffffu)) * DM; wk[k] = wts[(size_t)r * 6 + k]; }
        float4 xo[4]; float ss = 0.f;
#pragma unroll
        for (int q = 0; q < 4; ++q) {
            const int k0 = 4 * lane + 256 * q;
            float f0 = 0.f, f1 = 0.f, f2 = 0.f, f3 = 0.f;
#pragma unroll
            for (int k = 0; k < 6; ++k) { const uint2 yv = *(const uint2*)(yr[k] + k0); f0 += wk[k] * lo_bf(yv.x); f1 += wk[k] * hi_bf(yv.x); f2 += wk[k] * lo_bf(yv.y); f3 += wk[k] * hi_bf(yv.y); }
            float4 xv = *(const float4*)(xd + k0); const float4 gv = *(const float4*)(g2 + k0);
            xv.x += gv.x * f0; xv.y += gv.y * f1; xv.z += gv.z * f2; xv.w += gv.w * f3;
            xo[q] = xv; ss += xv.x * xv.x + xv.y * xv.y + xv.z * xv.z + xv.w * xv.w;
        }
        if (l == 1) {
            ss = wave_sum(ss);
            const float rstd = rsqrtf(ss * (1.f / 1024.f) + 1e-6f);
#pragma unroll
            for (int q = 0; q < 4; ++q) { const int k0 = 4 * lane + 256 * q; const float4 gf = *(const float4*)(p.in[I_GF] + k0);
                float4 o; o.x = xo[q].x * rstd * gf.x; o.y = xo[q].y * rstd * gf.y; o.z = xo[q].z * rstd * gf.z; o.w = xo[q].w * rstd * gf.w; *(float4*)(xd + k0) = o; }
        } else {
#pragma unroll
            for (int q = 0; q < 4; ++q) *(float4*)(xd + 4 * lane + 256 * q) = xo[q];
        }
    }
}


namespace pg8 {
#define PG8_LAS __attribute__((address_space(3)))
typedef unsigned short bf16_t;
typedef short bf16x8 __attribute__((ext_vector_type(8)));
typedef float f32x4 __attribute__((ext_vector_type(4)));
typedef unsigned u32x4 __attribute__((ext_vector_type(4)));
typedef int i32x4 __attribute__((ext_vector_type(4)));
typedef int i32x8 __attribute__((ext_vector_type(8)));
constexpr int BM = 256, BK = 64, HALF = 128, HTB = HALF * BK * 2  , STAGE_BYTES = 8 * HTB, NXCD = 8, WGM = 8;

__host__ __device__ __forceinline__ int lds_byte(int r, int c) { const int st = (r >> 4) * 2 + (c >> 5), rr = r & 15, cc = c & 31, ob = rr * 64 + cc * 2; return st * 1024 + (ob ^ (((ob >> 9) & 1) << 5)); }
__host__ __device__ __forceinline__ void stage_rc(int b, int& R, int& C) { const int st = b / 1024, sb = b % 1024, swz = sb ^ (((sb >> 9) & 1) << 5); R = (st >> 1) * 16 + swz / 64; C = (st & 1) * 32 + (swz % 64) / 2; }
__host__ __device__ __forceinline__ int perm32(int rho) { const int n = rho >> 4, i = rho & 15; return 8 * (i >> 2) + 4 * n + (i & 3); }

struct Unit { int pm, pn; };
struct Gemm { const bf16_t* A; const bf16_t* Bt; int M, N, K; };

struct StaticOrder {
    int nM, nN, nwg, G, c;
    __host__ __device__ void init(int M, int N, int G_, int c_) { nM = M / BM; nN = N / BM; nwg = nM * nN; G = G_; c = c_; }
    __host__ __device__ bool next(int i, Unit& u) const {
        const long L = (long)i * G + c; if (L >= nwg) return false;
        int wgid = (int)L; { const int q = nwg / NXCD, r = nwg % NXCD, xcd = wgid % NXCD, off = wgid / NXCD; wgid = (xcd < r ? xcd * (q + 1) : r * (q + 1) + (xcd - r) * q) + off; }
        const int nig = WGM * nN, gid = wgid / nig, fm = gid * WGM, gsz = (nM - fm) < WGM ? (nM - fm) : WGM;
        u.pm = fm + ((wgid % nig) % gsz); u.pn = (wgid % nig) / gsz; return true;
    }
    __device__ __forceinline__ void a_ready(const Unit&) const {}
    __device__ __forceinline__ void done(const Unit&) const {}
};
template <class Epi, class Sched, bool STAMP = false, bool F8 = false>
__device__ __forceinline__ void gemm_phase(PG8_LAS unsigned char* lds, const Gemm g, const Sched& S, const Epi& E, unsigned long long* stamps) {
    const int tid = threadIdx.x, wid = __builtin_amdgcn_readfirstlane(tid >> 6), lane = tid & 63, wr = wid >> 2, wc = wid & 3, fr = lane & 15, fq = lane >> 4;
    int K = g.K; if constexpr (F8) asm volatile("" : "+s"(K));
    const int nt = K / BK;
    int ts_lo = 0, ts_hi = 0, nts = 0; const unsigned long long rt_entry = STAMP ? (unsigned long long)wall_clock64() : 0ull;
#define PG8_STAMP() do { if (STAMP && wid == 0 && nts < 64) { const unsigned long long _c = (unsigned long long)clock64(); \
        ts_lo = (lane == nts) ? (int)(unsigned)_c : ts_lo; ts_hi = (lane == nts) ? (int)(unsigned)(_c >> 32) : ts_hi; ++nts; } } while (0)
    PG8_STAMP();
    unsigned voffA[2], voffB[2];
#pragma unroll
    for (int i = 0; i < 2; ++i) { int R, C; stage_rc(tid * 16 + i * 8192, R, C); const int Rb = Epi::PERM ? ((R & ~31) + perm32(R & 31)) : R;
        voffA[i] = (unsigned)(R * K + C) * 2u; voffB[i] = (unsigned)(Rb * K + C) * 2u; }
    const size_t kstep = (size_t)(BK * 2);
    const size_t hstep = (size_t)HALF * K * 2;
    const size_t tstep = 2 * hstep;
    const unsigned ldsw = (unsigned)wid * 1024u;
    const int aoff = lds_byte(wr * 64 + fr, fq * 8), boff = lds_byte(wc * 32 + fr, fq * 8);
#define PG8_SA(b, h) (((b) * 2 + (h)) * HTB)
#define PG8_SB(b, h) ((4 + (b) * 2 + (h)) * HTB)
#define PG8_STAGE(bufoff, gbase, voff) do { _Pragma("unroll") for (int _i = 0; _i < 2; ++_i) \
        __builtin_amdgcn_global_load_lds((const unsigned*)((const char*)(gbase) + (voff)[_i]), (PG8_LAS unsigned*)(lds + (bufoff) + ldsw + _i * 8192), 16, 0, 0); } while (0)
#define PG8_CAT(x, y) __builtin_shufflevector(x, y, 0, 1, 2, 3, 4, 5, 6, 7)
#define PG8_LDA(dst, b, h) do { _Pragma("unroll") for (int m = 0; m < 4; ++m) { \
        if constexpr (F8) dst##8[m] = PG8_CAT(*(const PG8_LAS i32x4*)(lds + PG8_SA(b, h) + aoff + m * 2048), *(const PG8_LAS i32x4*)(lds + PG8_SA(b, h) + aoff + m * 2048 + 1024)); \
        else { _Pragma("unroll") for (int k = 0; k < 2; ++k) dst[m][k] = *(const PG8_LAS bf16x8*)(lds + PG8_SA(b, h) + aoff + m * 2048 + k * 1024); } } } while (0)
#define PG8_LDB(dst, b, h) do { _Pragma("unroll") for (int n = 0; n < 2; ++n) { \
        if constexpr (F8) dst##8[n] = PG8_CAT(*(const PG8_LAS i32x4*)(lds + PG8_SB(b, h) + boff + n * 2048), *(const PG8_LAS i32x4*)(lds + PG8_SB(b, h) + boff + n * 2048 + 1024)); \
        else { _Pragma("unroll") for (int k = 0; k < 2; ++k) dst[n][k] = *(const PG8_LAS bf16x8*)(lds + PG8_SB(b, h) + boff + n * 2048 + k * 1024); } } } while (0)
#define PG8_MMA(ai, bj, At, Bt) do { __builtin_amdgcn_s_setprio(1); _Pragma("unroll") for (int m = 0; m < 4; ++m) _Pragma("unroll") for (int n = 0; n < 2; ++n) { \
        if constexpr (F8) asm volatile("v_mfma_scale_f32_16x16x128_f8f6f4 %0, %1, %2, %0, %3, %3 op_sel_hi:[0,0,0]" : "+v"(acc[ai][bj][m][n]) : "v"(Bt##8[n]), "v"(At##8[m]), "v"(sc8)); \
        else { _Pragma("unroll") for (int k = 0; k < 2; ++k) acc[ai][bj][m][n] = __builtin_amdgcn_mfma_f32_16x16x32_bf16(Bt[n][k], At[m][k], acc[ai][bj][m][n], 0, 0, 0); } } __builtin_amdgcn_s_setprio(0); } while (0)
#define PG8_WAIT_V(n) asm volatile("s_waitcnt vmcnt(" #n ")" ::: "memory")
#define PG8_WAIT_L(n) asm volatile("s_waitcnt lgkmcnt(" #n ")" ::: "memory")
#define PG8_BAR __builtin_amdgcn_s_barrier()
#define PG8_SCHED __builtin_amdgcn_sched_barrier(0)
    Unit cur, nxt; int ui = 0;
    if (!S.next(0, cur)) return;
    f32x4 acc[2][2][4][2];
#pragma unroll
    for (int a = 0; a < 2; ++a)
#pragma unroll
        for (int b = 0; b < 2; ++b)
#pragma unroll
            for (int m = 0; m < 4; ++m)
#pragma unroll
                for (int n = 0; n < 2; ++n) acc[a][b][m][n] = (f32x4){0.f, 0.f, 0.f, 0.f};
    bf16x8 At[4][2], B0[2][2], B1[2][2];
    i32x8 At8[4], B08[2], B18[2];
    int sc8 = 0x7F7F7F7F; asm volatile("" : "+v"(sc8));
    const char* cA = (const char*)g.A + (size_t)cur.pm * tstep; const char* cB = (const char*)g.Bt + (size_t)cur.pn * tstep;
    S.a_ready(cur);
    PG8_STAGE(PG8_SB(0, 0), cB, voffB); PG8_STAGE(PG8_SA(0, 0), cA, voffA); PG8_STAGE(PG8_SB(0, 1), cB + hstep, voffB); PG8_STAGE(PG8_SA(0, 1), cA + hstep, voffA);
    if (wr == 1) PG8_BAR;
    PG8_WAIT_V(4); PG8_BAR;
    PG8_STAGE(PG8_SB(1, 0), cB + kstep, voffB); PG8_STAGE(PG8_SA(1, 0), cA + kstep, voffA); PG8_STAGE(PG8_SB(1, 1), cB + hstep + kstep, voffB);
    PG8_WAIT_V(6); PG8_BAR;
    PG8_STAMP();
    for (;;) {
        const bool has_next = S.next(ui + 1, nxt);
        const char* nA = has_next ? (const char*)g.A + (size_t)nxt.pm * tstep : cA; const char* nB = has_next ? (const char*)g.Bt + (size_t)nxt.pn * tstep : cB;
        for (int t = 0; t < nt; t += 2) {
            const bool last = (t == nt - 2);
            const char* a1 = cA + (size_t)(t + 1) * kstep;
            const char* a2 = last ? nA : cA + (size_t)(t + 2) * kstep; const char* b2 = last ? nB : cB + (size_t)(t + 2) * kstep;
            const char* a3 = a2 + kstep; const char* b3 = b2 + kstep;
            if (last && has_next) S.a_ready(nxt);
            PG8_LDB(B0, 0, 0); PG8_SCHED; PG8_LDA(At, 0, 0); PG8_STAGE(PG8_SA(1, 1), a1 + hstep, voffA);
            PG8_WAIT_L(8); PG8_BAR; PG8_WAIT_L(0); PG8_MMA(0, 0, At, B0); PG8_BAR; PG8_SCHED;
            PG8_LDB(B1, 0, 1); PG8_STAGE(PG8_SB(0, 0), b2, voffB);
            PG8_BAR; PG8_WAIT_L(0); PG8_MMA(0, 1, At, B1); PG8_BAR;
            PG8_LDA(At, 0, 1); PG8_STAGE(PG8_SA(0, 0), a2, voffA);
            PG8_BAR; PG8_WAIT_L(0); PG8_MMA(1, 0, At, B0); PG8_BAR; PG8_SCHED;
            PG8_STAGE(PG8_SB(0, 1), b2 + hstep, voffB);
            PG8_WAIT_V(6); PG8_BAR; PG8_MMA(1, 1, At, B1); PG8_BAR;
            PG8_LDB(B0, 1, 0); PG8_SCHED; PG8_LDA(At, 1, 0); PG8_STAGE(PG8_SA(0, 1), a2 + hstep, voffA);
            PG8_WAIT_L(8); PG8_BAR; PG8_WAIT_L(0); PG8_MMA(0, 0, At, B0); PG8_BAR; PG8_SCHED;
            PG8_LDB(B1, 1, 1); PG8_STAGE(PG8_SB(1, 0), b3, voffB);
            PG8_BAR; PG8_WAIT_L(0); PG8_MMA(0, 1, At, B1); PG8_BAR;
            PG8_LDA(At, 1, 1); PG8_STAGE(PG8_SA(1, 0), a3, voffA);
            PG8_BAR; PG8_WAIT_L(0); PG8_MMA(1, 0, At, B0); PG8_BAR; PG8_SCHED;
            PG8_STAGE(PG8_SB(1, 1), b3 + hstep, voffB);
            PG8_WAIT_V(6); PG8_BAR; PG8_MMA(1, 1, At, B1); PG8_BAR;
        }
        if constexpr (F8) asm volatile("s_nop 15\n\ts_nop 15" ::: "memory");
        PG8_STAMP();
        if constexpr (!Epi::AFTER_DRAIN) { E(acc, cur, wr, wc, fr, fq); S.done(cur); }
        PG8_STAMP();
        if (!has_next) break;
#pragma unroll
        for (int a = 0; a < 2; ++a)
#pragma unroll
            for (int b = 0; b < 2; ++b)
#pragma unroll
                for (int m = 0; m < 4; ++m)
#pragma unroll
                    for (int n = 0; n < 2; ++n) acc[a][b][m][n] = (f32x4){0.f, 0.f, 0.f, 0.f};
        cur = nxt; cA = nA; cB = nB; ++ui;
    }
    PG8_WAIT_V(0);
    if (wr == 0) PG8_BAR;
    PG8_BAR;
    if constexpr (Epi::AFTER_DRAIN) { E.fused(acc, cur, wr, wc, fr, fq, lds, wid, lane); S.done(cur); }
    PG8_STAMP();
    if (STAMP && wid == 0) { stamps[lane] = lane < nts ? (((unsigned long long)(unsigned)ts_hi << 32) | (unsigned)ts_lo) : 0ull;
        if (lane == 62) stamps[62] = rt_entry; if (lane == 63) stamps[63] = (unsigned long long)wall_clock64(); }
#undef PG8_STAMP
#undef PG8_SA
#undef PG8_SB
#undef PG8_STAGE
#undef PG8_LDA
#undef PG8_LDB
#undef PG8_MMA
#undef PG8_CAT
#undef PG8_WAIT_V
#undef PG8_WAIT_L
#undef PG8_BAR
#undef PG8_SCHED
}
template <class Epi, class Sched, bool STAMP = false>
__device__ __forceinline__ void gemm_phase_gather(PG8_LAS unsigned char* lds, const Gemm g, const Sched& S, const Epi& E, unsigned long long* stamps) {
    const int tid = threadIdx.x, wid = __builtin_amdgcn_readfirstlane(tid >> 6), lane = tid & 63, wr = wid >> 2, wc = wid & 3, fr = lane & 15, fq = lane >> 4;
    const int K = g.K, nt = K / BK;
    int ts_lo = 0, ts_hi = 0, nts = 0; const unsigned long long rt_entry = STAMP ? (unsigned long long)wall_clock64() : 0ull;
#define PG8_STAMP() do { if (STAMP && wid == 0 && nts < 64) { const unsigned long long _c = (unsigned long long)clock64(); \
        ts_lo = (lane == nts) ? (int)(unsigned)_c : ts_lo; ts_hi = (lane == nts) ? (int)(unsigned)(_c >> 32) : ts_hi; ++nts; } } while (0)
    PG8_STAMP();
    unsigned voffA[2], voffB[2];
#pragma unroll
    for (int i = 0; i < 2; ++i) { int R, C; stage_rc(tid * 16 + i * 8192, R, C); const int Rb = Epi::PERM ? ((R & ~31) + perm32(R & 31)) : R;
        voffA[i] = (unsigned)(R * K + C) * 2u; voffB[i] = (unsigned)(Rb * K + C) * 2u; }
    unsigned vc[2][2], vn[2][2];
    const char* gA = (const char*)g.A;
    const size_t kstep = (size_t)(BK * 2);
    const size_t hstep = (size_t)HALF * K * 2;
    const size_t tstep = 2 * hstep;
    const unsigned ldsw = (unsigned)wid * 1024u;
    const int aoff = lds_byte(wr * 64 + fr, fq * 8), boff = lds_byte(wc * 32 + fr, fq * 8);
#define PG8_SA(b, h) (((b) * 2 + (h)) * HTB)
#define PG8_SB(b, h) ((4 + (b) * 2 + (h)) * HTB)
#define PG8_STAGE(bufoff, gbase, voff) do { _Pragma("unroll") for (int _i = 0; _i < 2; ++_i) \
        __builtin_amdgcn_global_load_lds((const unsigned*)((const char*)(gbase) + (voff)[_i]), (PG8_LAS unsigned*)(lds + (bufoff) + ldsw + _i * 8192), 16, 0, 0); } while (0)
#define PG8_LDA(dst, b, h) do { _Pragma("unroll") for (int m = 0; m < 4; ++m) _Pragma("unroll") for (int k = 0; k < 2; ++k) dst[m][k] = *(const PG8_LAS bf16x8*)(lds + PG8_SA(b, h) + aoff + m * 2048 + k * 1024); } while (0)
#define PG8_LDB(dst, b, h) do { _Pragma("unroll") for (int n = 0; n < 2; ++n) _Pragma("unroll") for (int k = 0; k < 2; ++k) dst[n][k] = *(const PG8_LAS bf16x8*)(lds + PG8_SB(b, h) + boff + n * 2048 + k * 1024); } while (0)
#define PG8_MMA(ai, bj, At, Bt) do { __builtin_amdgcn_s_setprio(1); _Pragma("unroll") for (int m = 0; m < 4; ++m) _Pragma("unroll") for (int n = 0; n < 2; ++n) _Pragma("unroll") for (int k = 0; k < 2; ++k) \
        acc[ai][bj][m][n] = __builtin_amdgcn_mfma_f32_16x16x32_bf16(Bt[n][k], At[m][k], acc[ai][bj][m][n], 0, 0, 0); __builtin_amdgcn_s_setprio(0); } while (0)
#define PG8_WAIT_V(n) asm volatile("s_waitcnt vmcnt(" #n ")" ::: "memory")
#define PG8_WAIT_L(n) asm volatile("s_waitcnt lgkmcnt(" #n ")" ::: "memory")
#define PG8_BAR __builtin_amdgcn_s_barrier()
#define PG8_SCHED __builtin_amdgcn_sched_barrier(0)
    Unit cur, nxt; int ui = 0;
    if (!S.next(0, cur)) return;
    f32x4 acc[2][2][4][2];
#pragma unroll
    for (int a = 0; a < 2; ++a)
#pragma unroll
        for (int b = 0; b < 2; ++b)
#pragma unroll
            for (int m = 0; m < 4; ++m)
#pragma unroll
                for (int n = 0; n < 2; ++n) acc[a][b][m][n] = (f32x4){0.f, 0.f, 0.f, 0.f};
    bf16x8 At[4][2], B0[2][2], B1[2][2];
    const char* cA = (const char*)g.A + (size_t)cur.pm * tstep; const char* cB = S.bbase(g, cur, tstep);
    S.arows(cur, K, vc);
#pragma unroll
    for (int h_ = 0; h_ < 2; ++h_) { vn[h_][0] = vc[h_][0]; vn[h_][1] = vc[h_][1]; }
    PG8_STAGE(PG8_SB(0, 0), cB, voffB); PG8_STAGE(PG8_SA(0, 0), gA, vc[0]); PG8_STAGE(PG8_SB(0, 1), cB + hstep, voffB); PG8_STAGE(PG8_SA(0, 1), gA, vc[1]);
    if (wr == 1) PG8_BAR;
    PG8_WAIT_V(4); PG8_BAR;
    PG8_STAGE(PG8_SB(1, 0), cB + kstep, voffB); PG8_STAGE(PG8_SA(1, 0), gA + kstep, vc[0]); PG8_STAGE(PG8_SB(1, 1), cB + hstep + kstep, voffB);
    PG8_WAIT_V(6); PG8_BAR;
    PG8_STAMP();
    for (;;) {
        const bool has_next = S.next(ui + 1, nxt);
        const char* nA = has_next ? (const char*)g.A + (size_t)nxt.pm * tstep : cA; const char* nB = has_next ? S.bbase(g, nxt, tstep) : cB;
        for (int t = 0; t < nt; t += 2) {
            const bool last = (t == nt - 2);
            const char* a1 = gA + (size_t)(t + 1) * kstep;
            const char* a2 = last ? gA : gA + (size_t)(t + 2) * kstep; const char* b2 = last ? nB : cB + (size_t)(t + 2) * kstep;
            const char* a3 = a2 + kstep; const char* b3 = b2 + kstep;
            if (last && has_next) S.arows(nxt, K, vn);
            unsigned sel[2][2];
#pragma unroll
            for (int h_ = 0; h_ < 2; ++h_) { sel[h_][0] = last ? vn[h_][0] : vc[h_][0]; sel[h_][1] = last ? vn[h_][1] : vc[h_][1]; }
            PG8_LDB(B0, 0, 0); PG8_SCHED; PG8_LDA(At, 0, 0); PG8_STAGE(PG8_SA(1, 1), a1, vc[1]);
            PG8_WAIT_L(8); PG8_BAR; PG8_WAIT_L(0); PG8_MMA(0, 0, At, B0); PG8_BAR; PG8_SCHED;
            PG8_LDB(B1, 0, 1); PG8_STAGE(PG8_SB(0, 0), b2, voffB);
            PG8_BAR; PG8_WAIT_L(0); PG8_MMA(0, 1, At, B1); PG8_BAR;
            PG8_LDA(At, 0, 1); PG8_STAGE(PG8_SA(0, 0), a2, sel[0]);
            PG8_BAR; PG8_WAIT_L(0); PG8_MMA(1, 0, At, B0); PG8_BAR; PG8_SCHED;
            PG8_STAGE(PG8_SB(0, 1), b2 + hstep, voffB);
            PG8_WAIT_V(6); PG8_BAR; PG8_MMA(1, 1, At, B1); PG8_BAR;
            PG8_LDB(B0, 1, 0); PG8_SCHED; PG8_LDA(At, 1, 0); PG8_STAGE(PG8_SA(0, 1), a2, sel[1]);
            PG8_WAIT_L(8); PG8_BAR; PG8_WAIT_L(0); PG8_MMA(0, 0, At, B0); PG8_BAR; PG8_SCHED;
            PG8_LDB(B1, 1, 1); PG8_STAGE(PG8_SB(1, 0), b3, voffB);
            PG8_BAR; PG8_WAIT_L(0); PG8_MMA(0, 1, At, B1); PG8_BAR;
            PG8_LDA(At, 1, 1); PG8_STAGE(PG8_SA(1, 0), a3, sel[0]);
            PG8_BAR; PG8_WAIT_L(0); PG8_MMA(1, 0, At, B0); PG8_BAR; PG8_SCHED;
            PG8_STAGE(PG8_SB(1, 1), b3 + hstep, voffB);
            PG8_WAIT_V(6); PG8_BAR; PG8_MMA(1, 1, At, B1); PG8_BAR;
        }
        PG8_STAMP();
        if constexpr (!Epi::AFTER_DRAIN) { E(acc, cur, wr, wc, fr, fq); S.done(cur); }
        PG8_STAMP();
        if (!has_next) break;
#pragma unroll
        for (int a = 0; a < 2; ++a)
#pragma unroll
            for (int b = 0; b < 2; ++b)
#pragma unroll
                for (int m = 0; m < 4; ++m)
#pragma unroll
                    for (int n = 0; n < 2; ++n) acc[a][b][m][n] = (f32x4){0.f, 0.f, 0.f, 0.f};
        cur = nxt; cA = nA; cB = nB; ++ui;
#pragma unroll
        for (int h_ = 0; h_ < 2; ++h_) { vc[h_][0] = vn[h_][0]; vc[h_][1] = vn[h_][1]; }
    }
    PG8_WAIT_V(0);
    if (wr == 0) PG8_BAR;
    PG8_BAR;
    if constexpr (Epi::AFTER_DRAIN) { E.fused(acc, cur, wr, wc, fr, fq, lds, wid, lane); S.done(cur); }
    PG8_STAMP();
    if (STAMP && wid == 0) { stamps[lane] = lane < nts ? (((unsigned long long)(unsigned)ts_hi << 32) | (unsigned)ts_lo) : 0ull;
        if (lane == 62) stamps[62] = rt_entry; if (lane == 63) stamps[63] = (unsigned long long)wall_clock64(); }
#undef PG8_STAMP
#undef PG8_SA
#undef PG8_SB
#undef PG8_STAGE
#undef PG8_LDA
#undef PG8_LDB
#undef PG8_MMA
#undef PG8_WAIT_V
#undef PG8_WAIT_L
#undef PG8_BAR
#undef PG8_SCHED
}
}

struct EpiInproj {
    static constexpr bool PERM = false, AFTER_DRAIN = false;
    bf16_t* z; bf16_t* zT;
    __device__ __forceinline__ void operator()(const pg8::f32x4 (&acc)[2][2][4][2], const pg8::Unit& u, int wr, int wc, int fr, int fq) const {
        const int pm = u.pm, b = pm < 128 ? (pm >> 4) : (pm - 128), key0 = pm < 128 ? (pm & 15) * 256 : 4096, row0 = mt_row0(pm);
#pragma unroll
        for (int bj = 0; bj < 2; ++bj) {
            const int cb = u.pn * 256 + bj * 128;
            if (cb < ZLD) {
#pragma unroll
                for (int ai = 0; ai < 2; ++ai)
#pragma unroll
                    for (int m = 0; m < 4; ++m) { const int rl = ai * 128 + wr * 64 + m * 16 + fr;
#pragma unroll
                        for (int n = 0; n < 2; ++n) { const pg8::f32x4 v = acc[ai][bj][m][n]; uint2 o; o.x = pk2(v[0], v[1]); o.y = pk2(v[2], v[3]);
                            *(uint2*)(z + (size_t)(row0 + rl) * ZLD + cb + wc * 32 + n * 16 + fq * 4) = o; } }
            } else if (cb < NIN) {
#pragma unroll
                for (int ai = 0; ai < 2; ++ai)
#pragma unroll
                    for (int m = 0; m < 4; ++m) { const int rl = ai * 128 + wr * 64 + m * 16 + fr;
#pragma unroll
                        for (int n = 0; n < 2; ++n) { const pg8::f32x4 v = acc[ai][bj][m][n]; const int ch = cb - ZLD + wc * 32 + n * 16 + fq * 4;
                            bf16_t* d = zT + (size_t)(b * 1024 + ch) * NKEY + key0 + rl;
                            d[0] = f2bf(v[0]); d[NKEY] = f2bf(v[1]); d[2 * NKEY] = f2bf(v[2]); d[3 * NKEY] = f2bf(v[3]); } }
            }
        }
    }
};
struct EpiWout {
    static constexpr bool PERM = false, AFTER_DRAIN = false;
    const float* xs_lat; const float* xs_ctx; float* xd_lat; float* xd_ctx; const float* g1base;
    __device__ __forceinline__ void operator()(const pg8::f32x4 (&acc)[2][2][4][2], const pg8::Unit& u, int wr, int wc, int fr, int fq) const {
        const int row0 = mt_row0(u.pm);
        const float* xs = (row0 < TL ? xs_lat + (size_t)row0 * DM : xs_ctx + (size_t)(row0 - TL) * DM) + (size_t)(wr * 64 + fr) * DM + u.pn * 256 + wc * 32 + fq * 4;
        float* xd = (row0 < TL ? xd_lat + (size_t)row0 * DM : xd_ctx + (size_t)(row0 - TL) * DM) + (size_t)(wr * 64 + fr) * DM + u.pn * 256 + wc * 32 + fq * 4;
        const float* g1 = g1base + (size_t)row_mod(row0) * 6144 + u.pn * 256 + wc * 32 + fq * 4;
        float4 gv[2][2];
#pragma unroll
        for (int bj = 0; bj < 2; ++bj)
#pragma unroll
            for (int n = 0; n < 2; ++n) gv[bj][n] = *(const float4*)(g1 + bj * 128 + n * 16);
#pragma unroll
        for (int ai = 0; ai < 2; ++ai) {
            float4 xv[4][2][2];
#pragma unroll
            for (int m = 0; m < 4; ++m)
#pragma unroll
                for (int bj = 0; bj < 2; ++bj)
#pragma unroll
                    for (int n = 0; n < 2; ++n) xv[m][bj][n] = *(const float4*)(xs + (size_t)(ai * 128 + m * 16) * DM + bj * 128 + n * 16);
            __builtin_amdgcn_sched_barrier(0);
#pragma unroll
            for (int m = 0; m < 4; ++m)
#pragma unroll
                for (int bj = 0; bj < 2; ++bj)
#pragma unroll
                    for (int n = 0; n < 2; ++n) {
                        const pg8::f32x4 v = acc[ai][bj][m][n]; const float4 x4 = xv[m][bj][n], g4 = gv[bj][n];
                        float4 o; o.x = x4.x + g4.x * v[0]; o.y = x4.y + g4.y * v[1]; o.z = x4.z + g4.z * v[2]; o.w = x4.w + g4.w * v[3];
                        *(float4*)(xd + (size_t)(ai * 128 + m * 16) * DM + bj * 128 + n * 16) = o;
                    }
            __builtin_amdgcn_sched_barrier(0);
        }
    }
};

struct Moe1Order : pg8::StaticOrder {
    const unsigned char* eb; const int* blkbase; const int* cnt; const int* list;
    __device__ __forceinline__ const char* bbase(const pg8::Gemm& g, const pg8::Unit& u, size_t tstep) const { return (const char*)g.Bt + ((size_t)eb[u.pm] * 2 + u.pn) * tstep; }
    __device__ __forceinline__ void arows(const pg8::Unit& u, int K, unsigned (&vo)[2][2]) const {
        const int e = eb[u.pm], i0 = (u.pm - blkbase[e]) * 256, n_e = cnt[e];
        int lt[2][2];
#pragma unroll
        for (int h = 0; h < 2; ++h)
#pragma unroll
            for (int i = 0; i < 2; ++i) { int R, C; pg8::stage_rc((int)threadIdx.x * 16 + i * 8192, R, C);
                const int ii = i0 + h * 128 + R; lt[h][i] = list[(size_t)min(e, 63) * TT + min(ii, max(n_e - 1, 0))]; }
#pragma unroll
        for (int h = 0; h < 2; ++h)
#pragma unroll
            for (int i = 0; i < 2; ++i) { int R, C; pg8::stage_rc((int)threadIdx.x * 16 + i * 8192, R, C);
                const int ii = i0 + h * 128 + R; const int tok = e == 64 ? ii : (ii < n_e ? lt[h][i] : 0);
                vo[h][i] = (unsigned)(tok * K + C) * 2u; }
    }
};
struct EpiMoe1 {
    static constexpr bool PERM = false, AFTER_DRAIN = false;
    bf16_t* hid;
    __device__ __forceinline__ void operator()(const pg8::f32x4 (&acc)[2][2][4][2], const pg8::Unit& u, int wr, int wc, int fr, int fq) const {
#pragma unroll
        for (int ai = 0; ai < 2; ++ai)
#pragma unroll
            for (int m = 0; m < 4; ++m) { bf16_t* d = hid + ((size_t)u.pm * 256 + ai * 128 + wr * 64 + m * 16 + fr) * 256 + u.pn * 128 + 16 * wc + 4 * fq;
#pragma unroll
                for (int bj = 0; bj < 2; ++bj) { const pg8::f32x4 gt = acc[ai][bj][m][0], up = acc[ai][bj][m][1];
                    uint2 o; o.x = pk2(gt[0] * sigmoidf_(gt[0]) * up[0], gt[1] * sigmoidf_(gt[1]) * up[1]); o.y = pk2(gt[2] * sigmoidf_(gt[2]) * up[2], gt[3] * sigmoidf_(gt[3]) * up[3]);
                    *(uint2*)(d + 64 * bj) = o; } }
    }
};

struct EpiMerge {
    static constexpr bool PERM = false, AFTER_DRAIN = false;
    const bf16_t* plo; const bf16_t* phi; bf16_t* out; const float* rs;
    __device__ __forceinline__ void operator()(const pg8::f32x4 (&acc)[2][2][4][2], const pg8::Unit& u, int wr, int wc, int fr, int fq) const {
        const int row0 = mt_row0(u.pm) + wr * 64 + fr;
        const int col = u.pn * 64 + wc * 16 + fq * 4;
        uint2 pp[8][4]; float scv[8];
#pragma unroll
        for (int q = 0; q < 8; ++q) {
            const int row = row0 + (q >> 2) * 128 + (q & 3) * 16;
            pp[q][0] = *(const uint2*)(plo + (size_t)row * 2048 + col); pp[q][1] = *(const uint2*)(plo + (size_t)row * 2048 + 1024 + col);
            pp[q][2] = *(const uint2*)(phi + (size_t)row * 2048 + col); pp[q][3] = *(const uint2*)(phi + (size_t)row * 2048 + 1024 + col);
            scv[q] = rs[row];
        }
        __builtin_amdgcn_sched_barrier(0);
#pragma unroll
        for (int q = 0; q < 8; ++q) {
            const int ai = q >> 2, m = q & 3, row = row0 + ai * 128 + m * 16;
            const float sc = scv[q];
            float o0, o1, o2, o3;
            { const pg8::f32x4 v = acc[ai][0][m][0]; const uint2 pv = pp[q][0]; o0 = sigmoidf_(v[0] * sc) * lo_bf(pv.x); o1 = sigmoidf_(v[1] * sc) * hi_bf(pv.x); o2 = sigmoidf_(v[2] * sc) * lo_bf(pv.y); o3 = sigmoidf_(v[3] * sc) * hi_bf(pv.y); }
            { const pg8::f32x4 v = acc[ai][0][m][1]; const uint2 pv = pp[q][1]; o0 += sigmoidf_(v[0] * sc) * lo_bf(pv.x); o1 += sigmoidf_(v[1] * sc) * hi_bf(pv.x); o2 += sigmoidf_(v[2] * sc) * lo_bf(pv.y); o3 += sigmoidf_(v[3] * sc) * hi_bf(pv.y); }
            { const pg8::f32x4 v = acc[ai][1][m][0]; const uint2 pv = pp[q][2]; o0 += sigmoidf_(v[0] * sc) * lo_bf(pv.x); o1 += sigmoidf_(v[1] * sc) * hi_bf(pv.x); o2 += sigmoidf_(v[2] * sc) * lo_bf(pv.y); o3 += sigmoidf_(v[3] * sc) * hi_bf(pv.y); }
            { const pg8::f32x4 v = acc[ai][1][m][1]; const uint2 pv = pp[q][3]; o0 += sigmoidf_(v[0] * sc) * lo_bf(pv.x); o1 += sigmoidf_(v[1] * sc) * hi_bf(pv.x); o2 += sigmoidf_(v[2] * sc) * lo_bf(pv.y); o3 += sigmoidf_(v[3] * sc) * hi_bf(pv.y); }
            uint2 wv; wv.x = pk2(o0, o1); wv.y = pk2(o2, o3);
            *(uint2*)(out + (size_t)row * DM + col) = wv;
        }
    }
};
#define GEMM_TILE_LOOP(NM_, NN_, mt, nt, BODY) do { \
    const int _SN = ((NN_) + 3) >> 2, _SM = ((NM_) + 7) >> 3, _nx = (int)gridDim.x >> 3, _xcd = (int)blockIdx.x & 7; \
    if (((int)gridDim.x & 7) == 0) { \
        for (int _s = _xcd; _s < _SM * _SN; _s += 8) \
            for (int _jj = (int)blockIdx.x >> 3; _jj < 32; _jj += _nx) { \
                const int mt = (_s / _SN) * 8 + (_jj & 7), nt = (_s % _SN) * 4 + (_jj >> 3); \
                if (mt < (NM_) && nt < (NN_)) { BODY; } } \
    } else { for (int _u = (int)blockIdx.x; _u < (NM_) * (NN_); _u += (int)gridDim.x) { const int mt = _u / (NN_), nt = _u % (NN_); BODY; } } \
} while (0)
NOINL void f_p0() { const Params& p = kparams(); char* lds = lds_at(256); UNIT_LOOP(u, 320, 0) { if (u < 192) mod_unit(p, u, lds); else rope_unit(p, u - 192); } }
NOINL void f_norm1(int l) { const Params& p = kparams(); const int rpb = (TT + (int)gridDim.x - 1) / (int)gridDim.x, r0 = (int)blockIdx.x * rpb; norm_rows(p, l, r0, min(TT, r0 + rpb), 0); }
NOINL void f_conv(int l) {
    const Params& p = kparams(); char* lds = lds_at(256);
    const int G = (int)gridDim.x; int u = (int)((blockIdx.x + G - (544 % G)) % G);
    float4 va[4], vb[4];
    if (u < CJ_END) conv_unit<0>(p, l, u, lds, va);
    for (;;) {
        if (u >= CJ_END) break;
        { const int un = u + G; conv_unit<0>(p, l, un < CJ_END ? un : u, lds, vb); conv_unit<1>(p, l, u, lds, va); u = un; }
        if (u >= CJ_END) break;
        { const int un = u + G; conv_unit<0>(p, l, un < CJ_END ? un : u, lds, va); conv_unit<1>(p, l, u, lds, vb); u = un; }
    }
}
NOINL void f_h2tab(int l) { const Params& p = kparams(); char* lds = lds_at(256); UNIT_LOOP(u, 68, 544 + CJ_END) h2tab_unit(p, l, u, lds); }
NOINL void f_spectrum(int l) {
    const Params& p = kparams(); char* lds = lds_at(256);
    UNIT_LOOP(u, 512, 0) spectrum8192_unit(p, l, u >> 8, u & 255, lds);
}
NOINL void f_spectrum_ctx(int l) {
    const Params& p = kparams(); char* lds = lds_at(256);
    const int b0 = (int)gridDim.x >= 232 ? 200 : 0;
    for (int u = (int)blockIdx.x - b0; u >= 0 && u < 32; u += (int)gridDim.x) spectrum512_unit(p, l, u, lds);
}
NOINL void f_inproj(int off) {
    const Params& p = kparams();
    pg8::Gemm g{(const bf16_t*)(p.ws + OFF_H), (const bf16_t*)(p.ws + OFF_WIN), TT, WIN_G0, 1024};
    pg8::StaticOrder S; S.init(TT, WIN_G0, (int)gridDim.x, (int)blockIdx.x);
    EpiInproj E{(bf16_t*)(p.ws + OFF_Z), (bf16_t*)(p.ws + OFF_ZT)};
    __syncthreads();
    pg8::gemm_phase<EpiInproj, pg8::StaticOrder, false>((PG8_LAS unsigned char*)(uintptr_t)256, g, S, E, nullptr);
    __syncthreads();
}
NOINL void f_hyena(int l) { const Params& p = kparams(); char* lds = lds_at(256); const int n = l == 0 ? 1088 : 1024; UNIT_LOOP(u, n, 0) hyena_unit(p, l, u, lds); }
NOINL void f_na(int l, int off) { const Params& p = kparams(); char* lds = lds_at(256); const int n = l == 0 ? 544 : 512; UNIT_LOOP(u, n, off) na_unit(p, l, u, lds); }
NOINL void f_lru1(int l, int off) { const Params& p = kparams(); char* lds = lds_at(256); UNIT_LOOP(u, 1088, off) lru1_unit(p, l, u, lds); }
NOINL void f_qproj(int off) { const Params& p = kparams(); char* lds = lds_at(256); UNIT_LOOP(u, NMT * 2, off) qproj_unit(p, u, lds); }
NOINL void f_kvproj(int off) { const Params& p = kparams(); char* lds = lds_at(256); UNIT_LOOP(u, NMT * 2, off) kvproj_unit(p, u, lds); }
NOINL void f_mla(int l) { const Params& p = kparams(); char* lds = lds_at(256); const int n = l == 0 ? 544 : 512; UNIT_LOOP(u, n, 0) mla_unit(p, u, lds); }
NOINL void f_ytrans(int off) { const Params& p = kparams(); char* lds = lds_at(256); UNIT_LOOP(u, 544, off) ytrans_unit(p, u, lds); }
NOINL void f_lrucarry(int l) { const Params& p = kparams(); UNIT_LOOP(u, 8, 0) lru_carry_unit(p, l, u); }
NOINL void f_lru2(int l, int off) { const Params& p = kparams(); UNIT_LOOP(u, 272, off) lru2_unit(p, l, u); }
NOINL void f_quant(int nmt) {
    const Params& p = kparams(); const int rows = nmt * 256;
    int nb = (int)gridDim.x, b = (int)blockIdx.x;
    const int extra = nmt * 8 - (nmt * 8 / nb) * nb;
    if (extra > 0 && extra * 2 <= nb) { if (b < extra) return; b -= extra; nb -= extra; }
    const int rpb = (rows + nb - 1) / nb, r0 = b * rpb;
    quant_rows(p, r0, min(rows, r0 + rpb));
}
NOINL void f_pbranch(int nmt) { const Params& p = kparams(); char* lds = lds_at(256); UNIT_LOOP(u, nmt * 8, 0) pbranch_unit(p, u, lds); }
NOINL void f_merge(int nmt) {
    const Params& p = kparams();
    pg8::Gemm g{(const bf16_t*)(p.ws + OFF_H8), (const bf16_t*)(p.ws + OFF_WG8), nmt * 256, 4096, 512};
    pg8::StaticOrder S; S.init(nmt * 256, 4096, (int)gridDim.x, (int)blockIdx.x);
    EpiMerge E{(const bf16_t*)(p.ws + OFF_PLO), (const bf16_t*)(p.ws + OFF_PHI), (bf16_t*)(p.ws + OFF_ACC), (const float*)(p.ws + OFF_RS)};
    __syncthreads();
    pg8::gemm_phase<EpiMerge, pg8::StaticOrder, false, true>((PG8_LAS unsigned char*)(uintptr_t)256, g, S, E, nullptr);
    __syncthreads();
}
NOINL void f_wout(int l, int nmt) {
    const Params& p = kparams();
    pg8::Gemm g{(const bf16_t*)(p.ws + OFF_ACC), (const bf16_t*)(p.ws + OFF_WOUT), nmt * 256, 1024, 1024};
    pg8::StaticOrder S; S.init(nmt * 256, 1024, (int)gridDim.x, (int)blockIdx.x);
    EpiWout E{l == 0 ? p.in[I_X] : p.out, l == 0 ? p.in[I_CTX] : (const float*)(p.ws + OFF_XC), p.out, (float*)(p.ws + OFF_XC), (const float*)(p.ws + OFF_MOD) + (size_t)l * 9 * 6144 + 2048};
    __syncthreads();
    pg8::gemm_phase<EpiWout, pg8::StaticOrder, false>((PG8_LAS unsigned char*)(uintptr_t)256, g, S, E, nullptr);
    __syncthreads();
}
NOINL void f_router(int l, int nmt) { const Params& p = kparams(); char* lds = lds_at(256); const int tot = nmt * 256, rpb = (tot + (int)gridDim.x - 1) / (int)gridDim.x, r0 = (int)blockIdx.x * rpb; if (r0 < tot) router_unit(p, l, r0, min(tot, r0 + rpb), lds); }
NOINL void f_moe1(int l, int nmt) {
    const Params& p = kparams(); char* lds = lds_at(256);
    const MoeTab t = moe_tables(p, l, nmt * 256, lds);
    const int nrb = t.blkbase[65];
    pg8::Gemm g{(const bf16_t*)(p.ws + OFF_H), (const bf16_t*)(p.ws + OFF_WGU), nrb * 256, 512, 1024};
    Moe1Order S; S.init(nrb * 256, 512, (int)gridDim.x, (int)blockIdx.x);
    S.eb = (const unsigned char*)(t.cbase + 80); S.blkbase = t.blkbase; S.cnt = t.cnt; S.list = (const int*)(p.ws + OFF_LIST);
    EpiMoe1 E{(bf16_t*)(p.ws + OFF_HID)};
    __syncthreads();
    pg8::gemm_phase_gather<EpiMoe1, Moe1Order, false>((PG8_LAS unsigned char*)(uintptr_t)256, g, S, E, nullptr);
    __syncthreads();
}
NOINL void f_moe2(int l, int nmt) { const Params& p = kparams(); char* lds = lds_at(256); const MoeTab t = moe_tables(p, l, nmt * 256, lds); const int nrb = t.blkbase[65], s0 = t.blkbase[64];
    UNIT_LOOP(u, nrb, 0) { int rb = u + s0; if (rb >= nrb) rb -= nrb; moe2_unit(p, l, t, rb, lds); } }
NOINL void f_combine(int l, int nmt) { const Params& p = kparams(); char* lds = lds_at(256); const MoeTab t = moe_tables(p, l, nmt * 256, lds); const int tot = nmt * 256, rpb = (tot + (int)gridDim.x - 1) / (int)gridDim.x, r0 = (int)blockIdx.x * rpb; combine_unit(p, l, t, r0, min(tot, r0 + rpb)); }


#ifdef DIAG
struct DiagBuf { size_t off; size_t n; int kind; };
DEVI void diag_phase(const Params& p, const XcdBarrier& bar) {
    const DiagBuf bufs[] = {
        {OFF_MOD, 2 * 9 * 6144, 1}, {OFF_COS, 2 * 4096 * 16, 1}, {OFF_H2T, 4352 * 64, 1}, {OFF_WIN, (size_t)(WIN_G0 + 4096) * 1024, 0}, {OFF_WGU, (size_t)65 * 512 * 1024, 0},
        {OFF_WDT, (size_t)65 * 1024 * 256, 0}, {OFF_WUQ, (OFF_H - OFF_WUQ) / 2, 0}, {OFF_H, (size_t)TT * DM, 0}, {OFF_HS, (size_t)2 * 256 * 8192 * 2, 1}, {OFF_HSC, (size_t)2 * 256 * 512 * 2, 1},
        {OFF_Z, (size_t)TT * ZLD, 0}, {OFF_ZT, (size_t)8 * 1024 * NKEY, 0}, {OFF_YT, (size_t)8 * 256 * NKEY, 0}, {OFF_Q, (size_t)8 * 4 * NKEY * 96, 0}, {OFF_K, (size_t)8 * 4 * NKEY * 96, 0},
        {OFF_VT, (size_t)8 * 4 * 64 * NKEY, 0}, {OFF_HLOC, (size_t)2 * TT * 256, 0}, {OFF_CUMA, (size_t)2 * TT * 256, 0}, {OFF_SEGA, (size_t)4 * 1088 * 256, 1}, {OFF_BR, (size_t)TT * DM, 0},
        {OFF_XC, (size_t)TCX * DM, 1}, {OFF_WTS, (size_t)TT * 6, 1} };
    constexpr int NB = sizeof(bufs) / sizeof(bufs[0]);
    unsigned* flags = (unsigned*)(p.ws + OFF_GCNT) + 1024;
    xcd_barrier(bar);
    const size_t gtid = (size_t)blockIdx.x * 512 + threadIdx.x, gn = (size_t)gridDim.x * 512;
    for (int b = DIAG_FIRST; b < NB; ++b) {
        unsigned bad = 0, poi = 0;
        if (bufs[b].kind == 0) { const bf16_t* q = (const bf16_t*)(p.ws + bufs[b].off);
            for (size_t i = gtid; i < bufs[b].n; i += gn) { const unsigned v = q[i]; if ((v & 0x7F80u) == 0x7F80u || fabsf(bf2f((bf16_t)v)) > 1e5f) ++bad; if (v == 0xAAAAu) ++poi; } }
        else { const unsigned* q = (const unsigned*)(p.ws + bufs[b].off);
            for (size_t i = gtid; i < bufs[b].n; i += gn) { const unsigned v = q[i]; if ((v & 0x7F800000u) == 0x7F800000u || fabsf(__uint_as_float(v)) > 1e5f) ++bad; if (v == 0xAAAAAAAAu) ++poi; } }
        bad = (unsigned)wave_sum((float)bad); poi = (unsigned)wave_sum((float)poi);
        if ((threadIdx.x & 63) == 0) { if (bad) atomicAdd(&flags[2 * b], bad); if (poi) atomicAdd(&flags[2 * b + 1], poi); }
    }
    xcd_barrier(bar);
    float K = 1000.f, K2 = 0.f;
    for (int b = NB - 1; b >= DIAG_FIRST; --b) {
        const unsigned bad = __hip_atomic_load(&flags[2 * b], __ATOMIC_RELAXED, __HIP_MEMORY_SCOPE_AGENT), poi = __hip_atomic_load(&flags[2 * b + 1], __ATOMIC_RELAXED, __HIP_MEMORY_SCOPE_AGENT);
        if (bad) K = 1000.f * (float)(10 + b);
        else if ((size_t)poi * 2 > bufs[b].n) K = 1000.f * (float)(50 + b);
    }
#if DIAG_MODE == 1
    {
        float* acc = (float*)((unsigned*)(p.ws + OFF_GCNT) + 2048);
        float s = 0.f; const int b = DIAG_ARG;
        if (bufs[b].kind == 0) { const bf16_t* q = (const bf16_t*)(p.ws + bufs[b].off); for (size_t i = gtid; i < bufs[b].n; i += gn) { const float v = bf2f(q[i]); s += v * v; } }
        else { const float* q = (const float*)(p.ws + bufs[b].off); for (size_t i = gtid; i < bufs[b].n; i += gn) { const float v = q[i]; s += v * v; } }
        s = wave_sum(s); if ((threadIdx.x & 63) == 0) atomicAdd(acc, s);
        xcd_barrier(bar);
        K = 1000.f * sqrtf(__hip_atomic_load(acc, __ATOMIC_RELAXED, __HIP_MEMORY_SCOPE_AGENT) / (float)bufs[b].n);
    }
#elif DIAG_MODE == 5
    {
        unsigned* cn = (unsigned*)(p.ws + OFF_GCNT) + 2048;
        unsigned nn = 0, nz = 0;
        const unsigned char* q = (const unsigned char*)(p.ws + OFF_H8);
        for (size_t i = gtid; i < (size_t)TT * 1024; i += gn) { const unsigned v = q[i]; if ((v & 0x7Fu) == 0x7Fu) ++nz; }
        q = (const unsigned char*)(p.ws + OFF_WG8);
        for (size_t i = gtid; i < (size_t)4096 * 1024; i += gn) { const unsigned v = q[i]; if ((v & 0x7Fu) == 0x7Fu) ++nn; }
        nn = (unsigned)wave_sum((float)nn); nz = (unsigned)wave_sum((float)nz);
        if ((threadIdx.x & 63) == 0) { if (nn) atomicAdd(&cn[0], nn); if (nz) atomicAdd(&cn[1], nz); }
        xcd_barrier(bar);
        K = (float)__hip_atomic_load(&cn[0], __ATOMIC_RELAXED, __HIP_MEMORY_SCOPE_AGENT);
        K2 = (float)__hip_atomic_load(&cn[1], __ATOMIC_RELAXED, __HIP_MEMORY_SCOPE_AGENT);
    }
#elif DIAG_MODE == 2
    K = (float)__hip_atomic_load(&flags[2 * DIAG_ARG], __ATOMIC_RELAXED, __HIP_MEMORY_SCOPE_AGENT);
#elif DIAG_MODE == 3
    {
        unsigned* mn = (unsigned*)(p.ws + OFF_GCNT) + 2048;
        if (blockIdx.x == 0 && threadIdx.x == 0) __hip_atomic_store(mn, 0xFFFFFFFFu, __ATOMIC_RELAXED, __HIP_MEMORY_SCOPE_AGENT);
        xcd_barrier(bar);
        const int b = DIAG_ARG; unsigned best = 0xFFFFFFFFu;
        if (bufs[b].kind == 0) { const bf16_t* q = (const bf16_t*)(p.ws + bufs[b].off);
            for (size_t i = gtid; i < bufs[b].n; i += gn) { const unsigned v = q[i]; if (((v & 0x7F80u) == 0x7F80u || fabsf(bf2f((bf16_t)v)) > 1e5f) && (unsigned)i < best) best = (unsigned)i; } }
        if (best != 0xFFFFFFFFu) atomicMin(mn, best);
        xcd_barrier(bar);
        const unsigned r = __hip_atomic_load(mn, __ATOMIC_RELAXED, __HIP_MEMORY_SCOPE_AGENT);
        K = (float)((r / DIAG_DIV) % DIAG_MOD);
        K2 = 1000.f * (float)((r / DIAG_DIV2) % DIAG_MOD2);
#ifdef DIAG_ROW0
        { const bf16_t* q = (const bf16_t*)(p.ws + bufs[b].off); int cnt = 0, cnt2 = 0;
          for (int c2 = 0; c2 < ZLD; ++c2) { const unsigned v = q[(size_t)DIAG_ROW0 * ZLD + c2]; if ((v & 0x7F80u) == 0x7F80u) ++cnt; }
          for (int r2 = 0; r2 < 99; ++r2) { const unsigned v = q[(size_t)r2 * ZLD + DIAG_COL0]; if ((v & 0x7F80u) == 0x7F80u) ++cnt2; }
          K = (float)cnt; K2 = 1000.f * (float)cnt2; }
#endif
#ifdef DIAG_VAL
        { const unsigned v = ((const bf16_t*)(p.ws + bufs[b].off))[r]; const float f = fabsf(bf2f((bf16_t)v)); K = ((v & 0x7F80u) == 0x7F80u) ? ((v & 0x7Fu) ? 49.f : 48.f) : fminf(47.f, log2f(f) * 0.25f); }
#endif
    }
#endif
    for (size_t i = gtid; i < (size_t)TL * DM; i += gn) p.out[i] = (i == 12345 && K2 != 0.f) ? K2 : K;
}
#endif

__global__ void __launch_bounds__(512, 2) mega_fwd(Params p) {
    if (threadIdx.x == 0) *(uint4*)smem = make_uint4(0u, 0u, 0u, 0u);
    __syncthreads();
    XcdBarrier bar = xcd_barrier_post((unsigned*)(p.ws + OFF_BAR), (volatile LAS unsigned*)smem);
    int ph = 0;
#ifdef DIAGT
#define STAMP(i) do { if (blockIdx.x == 0 && threadIdx.x == 0) ((unsigned long long*)(p.ws + OFF_GCNT + 8192))[i] = wall_clock64(); } while (0)
#else
#define STAMP(i) do {} while (0)
#endif
#ifndef REP_PHASE
#define REP_PHASE -1
#endif
#define PHASE(...) do { if (ph >= p.ph_lo && ph < p.ph_hi) { STAMP(ph); __VA_ARGS__; if (ph == REP_PHASE) { xcd_barrier(bar); __VA_ARGS__; } if (ph + 1 < p.ph_hi) xcd_barrier(bar); } ++ph; } while (0)
    PHASE({ f_p0(); f_conv(0); f_h2tab(0); });
#define LAYER(l) do { \
        const int nmt = l == 0 ? NMT : 128; \
        PHASE({ f_norm1(l); if (l > 0) { f_conv(l); f_h2tab(l); } }); \
        PHASE({ f_spectrum(l); f_inproj(0); if (l == 0) f_spectrum_ctx(l); }); \
        PHASE({ const int nh = l == 0 ? 1088 : 1024, nn = l == 0 ? 544 : 512; f_hyena(l); f_na(l, nh); f_lru1(l, nh + nn); f_qproj(nh + nn + 1088); f_kvproj(nh + nn + 1088 + NMT * 2); }); \
        PHASE({ f_lrucarry(l); f_mla(l); f_lru2(l, l == 0 ? 544 : 512); f_ytrans((l == 0 ? 544 : 512) + 272); }); \
        PHASE({ f_quant(nmt); f_pbranch(nmt); }); \
        PHASE(f_merge(nmt)); \
        PHASE(f_wout(l, nmt)); \
        PHASE(f_router(l, nmt)); \
        PHASE(f_moe1(l, nmt)); \
        PHASE(f_moe2(l, nmt)); \
        PHASE(f_combine(l, nmt)); \
    } while (0)
    LAYER(0);
    LAYER(1);
#ifdef DIAG
    diag_phase(p, bar);
#endif
#ifdef DIAGT
    {
        xcd_barrier(bar); STAMP(ph); xcd_barrier(bar);
        const unsigned long long* ts = (const unsigned long long*)(p.ws + OFF_GCNT + 8192);
        const float K = (float)(__hip_atomic_load(ts + DIAGT_A + 1, __ATOMIC_RELAXED, __HIP_MEMORY_SCOPE_AGENT) - __hip_atomic_load(ts + DIAGT_A, __ATOMIC_RELAXED, __HIP_MEMORY_SCOPE_AGENT)) * 0.01f;
        const float K2 = (float)(__hip_atomic_load(ts + DIAGT_B + 1, __ATOMIC_RELAXED, __HIP_MEMORY_SCOPE_AGENT) - __hip_atomic_load(ts + DIAGT_B, __ATOMIC_RELAXED, __HIP_MEMORY_SCOPE_AGENT)) * 1.0f;
        const size_t gtid = (size_t)blockIdx.x * 512 + threadIdx.x, gn = (size_t)gridDim.x * 512;
        for (size_t i = gtid; i < (size_t)TL * DM; i += gn) p.out[i] = (i == 12345) ? K2 : K;
    }
#endif
}

extern "C" void kernel_launch(void* const* d_in, const int* in_sizes, int n_in, void* d_out, int out_size, void* d_ws, size_t ws_size, hipStream_t stream) {
    static int grid = 0;
    if (!grid) {
        int dev = 0, cus = 0, per_cu = 0;
        hipGetDevice(&dev);
        hipDeviceGetAttribute(&cus, hipDeviceAttributeMultiprocessorCount, dev);
        if (hipFuncSetAttribute((const void*)mega_fwd, hipFuncAttributeMaxDynamicSharedMemorySize, LDS_BYTES + 256) != hipSuccess) fprintf(stderr, "hipFuncSetAttribute failed\n");
        if (hipOccupancyMaxActiveBlocksPerMultiprocessor(&per_cu, (const void*)mega_fwd, 512, LDS_BYTES + 256) != hipSuccess || per_cu < 1) { fprintf(stderr, "occupancy query failed\n"); per_cu = 1; }
        grid = cus * 1;
        if (ws_size < WS_END) fprintf(stderr, "workspace too small: %zu < %zu\n", ws_size, (size_t)WS_END);
    }
    hipMemsetAsync(d_ws, 0, ZERO_BYTES, stream);
    Params p{};
    for (int i = 0; i < 41; ++i) p.in[i] = (const float*)d_in[i];
    p.out = (float*)d_out; p.ws = (char*)d_ws; p.ph_lo = 0; p.ph_hi = PH_HI;
    hipLaunchKernelGGL(mega_fwd, dim3(grid), dim3(512), LDS_BYTES + 256, stream, p);
}
```

```cpp
#include <hip/hip_runtime.h>
#include <stdint.h>
#include <stdio.h>

typedef unsigned short bf16_t;
typedef short bf16x8 __attribute__((ext_vector_type(8)));
typedef float f32x16 __attribute__((ext_vector_type(16)));
typedef unsigned u32x4 __attribute__((ext_vector_type(4)));

#define DEVI __device__ __forceinline__

constexpr int DM = 1024, TL = 32768, TCX = 2048, TT = 34816, NKEY = 4352;
constexpr int ZLD = 1408;
constexpr int NIN = 2432;
constexpr int WIN_G0 = 2560;
constexpr int NMT = 136;
constexpr int ZC_QL = 0, ZC_KVL = 192, ZC_KR = 320, ZC_NAQ = 384, ZC_NAK = 640, ZC_LU = 896, ZC_LG = 1152;
constexpr int ZT_NAV = 0, ZT_HY = 256;

constexpr size_t AL(size_t x) { return (x + 255) & ~(size_t)255; }
constexpr size_t OFF_BAR = 0;
constexpr size_t OFF_GCNT = 16384;
constexpr size_t ZERO_BYTES = 32768;
constexpr size_t OFF_MOD = 32768;
constexpr size_t OFF_COS = OFF_MOD + AL(2 * 9 * 6144 * 4);
constexpr size_t OFF_SIN = OFF_COS + 4096 * 16 * 4;
constexpr size_t OFF_H2T = OFF_SIN + 4096 * 16 * 4;
constexpr size_t OFF_SEGA = OFF_H2T + 4352 * 64 * 4;
constexpr size_t OFF_SEGB = OFF_SEGA + 2 * 1088 * 256 * 4;
constexpr size_t OFF_LWT = OFF_SEGB + 2 * 1088 * 256 * 4;
constexpr size_t OFF_HIN = OFF_LWT + 16 * 64 * 64 * 2;
constexpr size_t OFF_TOKS = OFF_HIN + 2 * 1088 * 256 * 4;
constexpr size_t OFF_WTS = OFF_TOKS + AL((size_t)TT * 6 * 4);
constexpr size_t OFF_XC = OFF_WTS + AL((size_t)TT * 6 * 4);
constexpr size_t OFF_LIST = OFF_XC + (size_t)TCX * DM * 4;
constexpr size_t OFF_WDT = OFF_LIST + (size_t)64 * TT * 4;
constexpr size_t OFF_ZBIG = OFF_WDT + (size_t)65 * 1024 * 256 * 2;
constexpr size_t OFF_Z = OFF_ZBIG;
constexpr size_t OFF_ZT = OFF_Z + (size_t)TT * ZLD * 2;
constexpr size_t ZBIG_BYTES = (size_t)TT * ZLD * 2 + (size_t)8 * 1024 * NKEY * 2;
constexpr size_t OFF_PHI = OFF_ZBIG;
constexpr size_t OFF_HID = OFF_ZBIG;
constexpr size_t HID_BYTES = (size_t)1016 * 256 * 256 * 2;
constexpr size_t OFF_Y = OFF_ZBIG + HID_BYTES;
constexpr size_t Y_BYTES = (size_t)TT * 6 * DM * 2;
constexpr size_t OFF_WGU = OFF_ZBIG + ZBIG_BYTES;
constexpr size_t OFF_WIN = OFF_WGU + (size_t)65 * 512 * 1024 * 2;
constexpr size_t OFF_WUQ = OFF_WIN + (size_t)(WIN_G0 + 4096) * 1024 * 2;
constexpr size_t OFF_WUKV = OFF_WUQ + 384 * 192 * 2;
constexpr size_t OFF_WBR = OFF_WUKV + 512 * 128 * 2;
constexpr size_t OFF_WOUT = OFF_WBR + 4 * 1024 * 256 * 2;
constexpr size_t OFF_RT = OFF_WOUT + 1024 * 1024 * 2;
constexpr size_t OFF_H = OFF_RT + 128 * 1024 * 2;
constexpr size_t OFF_BR = OFF_H + (size_t)TT * DM * 2;
constexpr size_t OFF_ACC = OFF_BR;
constexpr size_t OFF_YT = OFF_BR + (size_t)TT * DM * 2;
constexpr size_t OFF_PLO = OFF_YT;
constexpr size_t OFF_Q = OFF_YT + (size_t)8 * 256 * NKEY * 2;
constexpr size_t OFF_K = OFF_Q + (size_t)8 * 4 * NKEY * 96 * 2;
constexpr size_t OFF_VT = OFF_K + (size_t)8 * 4 * NKEY * 96 * 2;
constexpr size_t OFF_HS = OFF_VT + (size_t)8 * 4 * 64 * NKEY * 2;
constexpr size_t OFF_HSC = OFF_HS + (size_t)2 * 256 * 8192 * 8;
constexpr size_t OFF_HLOC = OFF_HSC + (size_t)2 * 256 * 512 * 8;
constexpr size_t OFF_CUMA = OFF_HLOC + (size_t)2 * TT * 256 * 2;
constexpr size_t WS_END = OFF_CUMA + (size_t)2 * TT * 256 * 2;
constexpr size_t OFF_WG8 = OFF_WIN + (size_t)WIN_G0 * 1024 * 2;
constexpr size_t OFF_H8 = OFF_CUMA;
static_assert(OFF_PLO + (size_t)TT * 4096 <= OFF_CUMA, "P_lo must not reach h8");
constexpr size_t OFF_RS = OFF_SEGA;
constexpr float WG8_SCALE = 512.f;
static_assert(OFF_Y + Y_BYTES <= WS_END, "Y must fit inside the workspace map");
static_assert(OFF_PLO + (size_t)TT * 4096 <= WS_END && OFF_PHI + (size_t)TT * 4096 <= OFF_ZBIG + ZBIG_BYTES, "P halves must fit the dead regions");
static_assert(OFF_Y >= OFF_HID + HID_BYTES, "Y vs hid");
static_assert(WS_END < (size_t)670 * 1000 * 1000, "workspace too large");

constexpr int LDS_BYTES = 147456;
#ifndef PH_HI
#define PH_HI 1000
#define DIAGT_A 1
#define DIAGT_B 2
#define DIAG_FIRST 0
#define DIAG_MODE 0
#define DIAG_ARG 10
#define DIAG_DIV 1408
#define DIAG_MOD 50
#define DIAG_DIV2 (1408 * 400)
#define DIAG_MOD2 100
#endif

struct Params {
    const float* in[41];
    float* out;
    char* ws;
    int ph_lo, ph_hi;
};

enum { I_X = 0, I_C, I_CTX, I_CCTX, I_WMOD, I_BMOD, I_GN1, I_GN2, I_WIN, I_GQ, I_WUQ, I_GKV, I_WUKV, I_RPB, I_HSW, I_HSB, I_HW1, I_HB1, I_HW2,
       I_HB2, I_HW3, I_HDEC, I_HBIAS, I_LCW, I_LCB, I_LWA, I_LBA, I_LWX, I_LBX, I_LLAM, I_WBR, I_WOUT, I_RW, I_RB, I_EG, I_EU, I_ED, I_SG, I_SU,
       I_SD, I_GF };

#define XB_TMO      128
#define XB_XCNT(j)  (256  + 64 * (j))
#define XB_XSUB(j)  (1280 + 64 * (j))
#define XB_XGEN(j)  (2304 + 64 * (j))
#define XB_TOP      3328
#define XB_TOPGEN   3392
#define XCD_BAR_WORDS 3456
#define XB_SPIN_CAP (1u << 18)
#define LAS __attribute__((address_space(3)))

__device__ __forceinline__ unsigned xb_ld(unsigned* p)              { return __hip_atomic_load(p, __ATOMIC_RELAXED, __HIP_MEMORY_SCOPE_AGENT); }
__device__ __forceinline__ unsigned xb_add(unsigned* p, unsigned v) { return __hip_atomic_fetch_add(p, v, __ATOMIC_RELAXED, __HIP_MEMORY_SCOPE_AGENT); }
__device__ __forceinline__ unsigned xb_xcc_id() { return (unsigned)__builtin_amdgcn_s_getreg((3 << 11) | 20) & 0xFu; }
#define XB_SPIN(cond, bar) do { unsigned _sp = 0; while (cond) { __builtin_amdgcn_s_sleep(1); \
    if ((++_sp & 255u) == 0u) { if (xb_ld(&(bar)[XB_TMO])) break; if (_sp > XB_SPIN_CAP) { atomicAdd(&(bar)[XB_TMO], 1u); break; } } } } while (0)

struct XcdBarrier { unsigned* bar; unsigned x; volatile LAS unsigned* st; };

__device__ __forceinline__ XcdBarrier xcd_barrier_post(unsigned* bar, volatile LAS unsigned* st) {
    XcdBarrier b; b.bar = bar; b.x = xb_xcc_id(); b.st = st;
    if (threadIdx.x == 0) (void)xb_add(&bar[XB_XCNT(b.x)], 1u);
    return b;
}
__device__ __forceinline__ void xcd_barrier_complete(unsigned* bar, unsigned x, unsigned& nloc, unsigned& nx) {
    const unsigned G = gridDim.x * gridDim.y * gridDim.z;
    unsigned sum, cnt, mine, sp = 0u;
    for (;;) {
        sum = 0u; cnt = 0u; mine = 0u;
#pragma unroll
        for (unsigned j = 0; j < 16; ++j) { const unsigned c = xb_ld(&bar[XB_XCNT(j)]); sum += c; cnt += (c > 0u) ? 1u : 0u; mine = (j == x) ? c : mine; }
        if (sum == G) break;
        __builtin_amdgcn_s_sleep(1);
        if ((++sp & 255u) == 0u) { if (xb_ld(&bar[XB_TMO])) break; if (sp > XB_SPIN_CAP) { atomicAdd(&bar[XB_TMO], 1u); break; } }
    }
    nloc = mine > 0u ? mine : 1u; nx = cnt > 0u ? cnt : 1u;
}
__device__ __forceinline__ void xcd_barrier(const XcdBarrier& b) {
    asm volatile("s_waitcnt vmcnt(0)" ::: "memory");
    __syncthreads();
    if (threadIdx.x == 0) {
        unsigned* bar = b.bar;
        __builtin_amdgcn_s_waitcnt(0);
        unsigned nloc = b.st[0], nx = b.st[1];
        if (nloc == 0u) { xcd_barrier_complete(bar, b.x, nloc, nx); b.st[0] = nloc; b.st[1] = nx; }
        const unsigned old = xb_add(&bar[XB_XSUB(b.x)], 1u);
        const unsigned gen = old / nloc;
        if (old + 1u == (gen + 1u) * nloc) {
            __builtin_amdgcn_fence(__ATOMIC_RELEASE, "agent");
            asm volatile("s_waitcnt vmcnt(0)" ::: "memory");
            const unsigned og = xb_add(&bar[XB_TOP], 1u);
            const unsigned tg = og / nx;
            if (og + 1u == (tg + 1u) * nx) xb_add(&bar[XB_TOPGEN], 1u);
            else XB_SPIN(xb_ld(&bar[XB_TOPGEN]) == tg, bar);
            __builtin_amdgcn_fence(__ATOMIC_ACQUIRE, "agent");
            xb_add(&bar[XB_XGEN(b.x)], 1u);
            asm volatile("s_waitcnt vmcnt(0)" ::: "memory");
        } else {
            XB_SPIN(xb_ld(&bar[XB_XGEN(b.x)]) == gen, bar);
            __builtin_amdgcn_fence(__ATOMIC_ACQUIRE, "agent");
            asm volatile("s_waitcnt vmcnt(0)" ::: "memory");
        }
    }
    __syncthreads();
}

extern __shared__ __attribute__((aligned(16))) char smem[];
typedef __attribute__((address_space(4))) const Params CParams;
__device__ __forceinline__ const Params& kparams() { CParams* q = (CParams*)__builtin_amdgcn_kernarg_segment_ptr(); asm volatile("" : "+s"(q)); return *(const Params*)q; }
__device__ __forceinline__ char* lds_at(unsigned off) { return (char*)(LAS char*)(uintptr_t)off; }
#define NOINL __device__ __forceinline__
#define UNIT_LOOP(u, n, off) for (int u = (int)((blockIdx.x + gridDim.x - ((off) % gridDim.x)) % gridDim.x); u < (n); u += gridDim.x)
DEVI int tidx() { int t = threadIdx.x; asm volatile("" : "+v"(t)); return t; }
DEVI float bf2f(bf16_t v) { return __uint_as_float((unsigned)v << 16); }
typedef __bf16 bf16v2 __attribute__((ext_vector_type(2)));
DEVI unsigned pk2(float lo, float hi) { bf16v2 v; v[0] = (__bf16)lo; v[1] = (__bf16)hi; return __builtin_bit_cast(unsigned, v); }
DEVI bf16_t f2bf(float v) { return (bf16_t)(pk2(v, 0.f) & 0xffffu); }
DEVI float lo_bf(unsigned u) { return __uint_as_float(u << 16); }
DEVI float hi_bf(unsigned u) { return __uint_as_float(u & 0xffff0000u); }
DEVI float sigmoidf_(float x) { return __builtin_amdgcn_rcpf(1.f + __expf(-x)); }
DEVI float wave_sum(float v) {
#pragma unroll
    for (int m = 32; m >= 1; m >>= 1) v += __shfl_xor(v, m);
    return v;
}
DEVI float wave_max(float v) {
#pragma unroll
    for (int m = 32; m >= 1; m >>= 1) v = fmaxf(v, __shfl_xor(v, m));
    return v;
}
DEVI unsigned f2e4m3(float x) {
    const unsigned s = (__float_as_uint(x) >> 24) & 0x80u;
    const float a = fminf(fabsf(x), 448.f);
    const unsigned au = __float_as_uint(a);
    const unsigned nrm = ((au + 0x7FFFFu + ((au >> 20) & 1u)) >> 20) - (120u << 3);
    const unsigned sub = (unsigned)__float2int_rn(a * 512.f);
    const unsigned mag = a < 0.015625f ? sub : nrm;
    return mag ? (s | mag) : 0u;
}
DEVI unsigned pk4_fp8(float a, float b, float c, float d) { return f2e4m3(a) | (f2e4m3(b) << 8) | (f2e4m3(c) << 16) | (f2e4m3(d) << 24); }
DEVI int row_b(int r) { return r < TL ? (r >> 12) : ((r - TL) >> 8); }
DEVI int row_key(int r) { return r < TL ? (r & 4095) : (4096 + ((r - TL) & 255)); }
DEVI int row_mod(int r) { return r < TL ? (r >> 12) : 8; }
DEVI const float* xsrc(const Params& p, int l, int r) {
    if (l == 0) return r < TL ? p.in[I_X] + (size_t)r * DM : p.in[I_CTX] + (size_t)(r - TL) * DM;
    return r < TL ? p.out + (size_t)r * DM : (const float*)(p.ws + OFF_XC) + (size_t)(r - TL) * DM;
}
DEVI float* xdst(const Params& p, int r) { return r < TL ? p.out + (size_t)r * DM : (float*)(p.ws + OFF_XC) + (size_t)(r - TL) * DM; }
DEVI int mt_row0(int mt) { return mt < 128 ? mt * 256 : TL + (mt - 128) * 256; }

#define MFMA(a, b, c) __builtin_amdgcn_mfma_f32_32x32x16_bf16((a), (b), (c), 0, 0, 0)

constexpr int G_LD = 72;
constexpr int G_ASZ = 256 * G_LD * 2;
constexpr int G_BSZ = 128 * G_LD * 2;
constexpr int G_STAGE = G_ASZ + G_BSZ;
constexpr int G_LDS = 2 * G_STAGE;

struct RowLoader {
    const bf16_t* p0; const bf16_t* p1; const bf16_t* p2; const bf16_t* p3; int soff;
    u32x4 r0, r1, r2, r3;
    DEVI void issue(int k0) { r0 = *(const u32x4*)(p0 + k0); r1 = *(const u32x4*)(p1 + k0); r2 = *(const u32x4*)(p2 + k0); r3 = *(const u32x4*)(p3 + k0); }
    DEVI void commit(bf16_t* As) const {
        *(u32x4*)(As + soff) = r0; *(u32x4*)(As + soff + 64 * G_LD) = r1; *(u32x4*)(As + soff + 128 * G_LD) = r2; *(u32x4*)(As + soff + 192 * G_LD) = r3;
    }
};

template <bool SW, int NI, class AL_>
DEVI void gemm_mainloop(f32x16 (&acc)[2][NI], AL_ al0, const bf16_t* __restrict__ Bt, int ldb, int K, char* lds) {
    const int tid = tidx(), lane = tid & 63, w = tid >> 6, wm = w >> 1, wn = w & 1, l31 = lane & 31, hh = lane >> 5;
    const int lr = tid >> 3, kc = (tid & 7) * 8;
    const bf16_t* bp0 = Bt + (size_t)lr * ldb + kc;
    const bf16_t* bp1 = Bt + (size_t)(lr + 64) * ldb + kc;
    AL_ al1 = al0;
    u32x4 b00, b01, b10, b11;
#pragma unroll
    for (int mi = 0; mi < 2; ++mi)
#pragma unroll
        for (int ni = 0; ni < NI; ++ni)
#pragma unroll
            for (int e = 0; e < 16; ++e) acc[mi][ni][e] = 0.f;
    const int nk = K >> 6;
    const int aoff = (wm * 64 + l31) * G_LD + 8 * hh, boff = (wn * 32 * NI + l31) * G_LD + 8 * hh, bst = lr * G_LD + kc;
    auto compute = [&](const char* st) __attribute__((always_inline)) {
        const bf16_t* As = (const bf16_t*)st; const bf16_t* Bs = (const bf16_t*)(st + G_ASZ);
#pragma unroll
        for (int ks = 0; ks < 4; ++ks) {
            bf16x8 af[2], bfr[NI];
#pragma unroll
            for (int mi = 0; mi < 2; ++mi) af[mi] = *(const bf16x8*)(As + aoff + mi * 32 * G_LD + ks * 16);
#pragma unroll
            for (int ni = 0; ni < NI; ++ni) bfr[ni] = *(const bf16x8*)(Bs + boff + ni * 32 * G_LD + ks * 16);
#pragma unroll
            for (int mi = 0; mi < 2; ++mi)
#pragma unroll
                for (int ni = 0; ni < NI; ++ni) {
                    if (SW) acc[mi][ni] = MFMA(bfr[ni], af[mi], acc[mi][ni]);
                    else    acc[mi][ni] = MFMA(af[mi], bfr[ni], acc[mi][ni]);
                }
            if (ks == 1) __builtin_amdgcn_sched_barrier(0);
        }
    };
    __syncthreads();
    al0.issue(0); b00 = *(const u32x4*)bp0; if (NI == 2) b01 = *(const u32x4*)bp1;
    if (nk > 1) { al1.issue(64); b10 = *(const u32x4*)(bp0 + 64); if (NI == 2) b11 = *(const u32x4*)(bp1 + 64); }
    {
        bf16_t* As = (bf16_t*)lds; bf16_t* Bs = (bf16_t*)(lds + G_ASZ);
        al0.commit(As);
        *(u32x4*)(Bs + bst) = b00; if (NI == 2) *(u32x4*)(Bs + bst + 64 * G_LD) = b01;
    }
    __syncthreads();
    for (int kt = 0; kt < nk; kt += 2) {
        if (kt + 2 < nk) { const int k0 = (kt + 2) << 6; al0.issue(k0); b00 = *(const u32x4*)(bp0 + k0); if (NI == 2) b01 = *(const u32x4*)(bp1 + k0); }
        compute(lds);
        if (kt + 1 < nk) {
            bf16_t* As = (bf16_t*)(lds + G_STAGE); bf16_t* Bs = (bf16_t*)(lds + G_STAGE + G_ASZ);
            al1.commit(As);
            *(u32x4*)(Bs + bst) = b10; if (NI == 2) *(u32x4*)(Bs + bst + 64 * G_LD) = b11;
        }
        __syncthreads();
        if (kt + 1 >= nk) break;
        if (kt + 3 < nk) { const int k0 = (kt + 3) << 6; al1.issue(k0); b10 = *(const u32x4*)(bp0 + k0); if (NI == 2) b11 = *(const u32x4*)(bp1 + k0); }
        compute(lds + G_STAGE);
        if (kt + 2 < nk) {
            bf16_t* As = (bf16_t*)lds; bf16_t* Bs = (bf16_t*)(lds + G_ASZ);
            al0.commit(As);
            *(u32x4*)(Bs + bst) = b00; if (NI == 2) *(u32x4*)(Bs + bst + 64 * G_LD) = b01;
        }
        __syncthreads();
    }
}
template <bool SW, int NI, class AL_>
DEVI void gemm_mainloop1(f32x16 (&acc)[2][NI], AL_ al, const bf16_t* __restrict__ Bt, int ldb, int K, char* lds, int bhalf = -1) {
    const int tid = tidx(), lane = tid & 63, w = tid >> 6, wm = w >> 1, wn = w & 1, l31 = lane & 31, hh = lane >> 5;
    const int lr = tid >> 3, kc = (tid & 7) * 8;
    const bf16_t* bp0 = Bt + (size_t)(bhalf < 0 ? lr : ((lr >> 5) * 64 + bhalf * 32 + (lr & 31))) * ldb + kc;
    const bf16_t* bp1 = Bt + (size_t)(lr + 64) * ldb + kc;
    u32x4 rb0, rb1;
#pragma unroll
    for (int mi = 0; mi < 2; ++mi)
#pragma unroll
        for (int ni = 0; ni < NI; ++ni)
#pragma unroll
            for (int e = 0; e < 16; ++e) acc[mi][ni][e] = 0.f;
    __syncthreads();
    al.issue(0); rb0 = *(const u32x4*)bp0; if (NI == 2) rb1 = *(const u32x4*)bp1;
    {
        bf16_t* As = (bf16_t*)lds; bf16_t* Bs = (bf16_t*)(lds + G_ASZ);
        al.commit(As);
        *(u32x4*)(Bs + lr * G_LD + kc) = rb0; if (NI == 2) *(u32x4*)(Bs + (lr + 64) * G_LD + kc) = rb1;
    }
    __syncthreads();
    const int nk = K >> 6;
#pragma unroll 1
    for (int kt = 0; kt < nk; ++kt) {
        const bf16_t* As = (const bf16_t*)(lds + (kt & 1) * G_STAGE);
        const bf16_t* Bs = (const bf16_t*)(lds + (kt & 1) * G_STAGE + G_ASZ);
        const bool more = kt + 1 < nk;
        if (more) { const int k0 = (kt + 1) << 6; al.issue(k0); rb0 = *(const u32x4*)(bp0 + k0); if (NI == 2) rb1 = *(const u32x4*)(bp1 + k0); }
#pragma unroll
        for (int ks = 0; ks < 4; ++ks) {
            bf16x8 af[2], bfr[NI];
#pragma unroll
            for (int mi = 0; mi < 2; ++mi) af[mi] = *(const bf16x8*)(As + (wm * 64 + mi * 32 + l31) * G_LD + ks * 16 + 8 * hh);
#pragma unroll
            for (int ni = 0; ni < NI; ++ni) bfr[ni] = *(const bf16x8*)(Bs + (wn * 32 * NI + ni * 32 + l31) * G_LD + ks * 16 + 8 * hh);
#pragma unroll
            for (int mi = 0; mi < 2; ++mi)
#pragma unroll
                for (int ni = 0; ni < NI; ++ni) {
                    if (SW) acc[mi][ni] = MFMA(bfr[ni], af[mi], acc[mi][ni]);
                    else    acc[mi][ni] = MFMA(af[mi], bfr[ni], acc[mi][ni]);
                }
        }
        if (more) {
            bf16_t* An = (bf16_t*)(lds + ((kt + 1) & 1) * G_STAGE); bf16_t* Bn = (bf16_t*)(lds + ((kt + 1) & 1) * G_STAGE + G_ASZ);
            al.commit(An);
            *(u32x4*)(Bn + lr * G_LD + kc) = rb0; if (NI == 2) *(u32x4*)(Bn + (lr + 64) * G_LD + kc) = rb1;
        }
        __syncthreads();
    }
}
DEVI RowLoader make_rows(const bf16_t* base, size_t ld, int row0) {
    RowLoader r; const int tid = tidx(), lr = tid >> 3, kc = (tid & 7) * 8;
    r.p0 = base + (size_t)(row0 + lr) * ld + kc; r.p1 = r.p0 + 64 * ld; r.p2 = r.p0 + 128 * ld; r.p3 = r.p0 + 192 * ld; r.soff = lr * G_LD + kc;
    return r;
}

constexpr int K2_LD = 264;
constexpr int K2_BUF = 64 * K2_LD * 2;
struct K256A { bf16x8 f[2][16]; };
DEVI void k256_load_a(K256A& a, const bf16_t* A, size_t lda, int row0, char* lds) {
    const int tid = tidx(), lane = tid & 63, w = tid >> 6, wm = w >> 1, l31 = lane & 31, hh = lane >> 5;
    bf16_t* As = (bf16_t*)lds;
#pragma unroll 1
    for (int half = 0; half < 2; ++half) {
        __syncthreads();
        u32x4 r[8];
#pragma unroll
        for (int i = 0; i < 8; ++i) { const int c = tid + 512 * i; r[i] = *(const u32x4*)(A + (size_t)(row0 + half * 128 + (c >> 5)) * lda + (c & 31) * 8); }
#pragma unroll
        for (int i = 0; i < 8; ++i) { const int c = tid + 512 * i; *(u32x4*)(As + (c >> 5) * K2_LD + (c & 31) * 8) = r[i]; }
        __syncthreads();
        if ((wm >> 1) == half) {
#pragma unroll
            for (int mi = 0; mi < 2; ++mi)
#pragma unroll
                for (int ks = 0; ks < 16; ++ks) a.f[mi][ks] = *(const bf16x8*)(As + ((wm & 1) * 64 + mi * 32 + l31) * K2_LD + ks * 16 + 8 * hh);
        }
    }
}
template <class EPI>
DEVI void k256_stream(const K256A& a, const bf16_t* Bt, int n_tiles, char* lds, const EPI& epi) {
    const int tid = tidx(), lane = tid & 63, w = tid >> 6, wn = w & 1, l31 = lane & 31, hh = lane >> 5;
    const int br = tid >> 3, bc = (tid & 7) * 8;
    const bf16_t* bp = Bt + (size_t)br * 256 + bc;
    const int sto = br * K2_LD + bc, fro = (wn * 32 + l31) * K2_LD + 8 * hh;
    u32x4 s0, s1, s2, s3, t0, t1, t2, t3;
#define K2_ISSUE(j_, A_, B_, C_, D_) do { const bf16_t* _q = bp + (size_t)(j_) * 64 * 256; A_ = *(const u32x4*)_q; B_ = *(const u32x4*)(_q + 64); C_ = *(const u32x4*)(_q + 128); D_ = *(const u32x4*)(_q + 192); } while (0)
#define K2_COMMIT(buf_, A_, B_, C_, D_) do { bf16_t* _b = (bf16_t*)(lds + (buf_) * K2_BUF) + sto; *(u32x4*)_b = A_; *(u32x4*)(_b + 64) = B_; *(u32x4*)(_b + 128) = C_; *(u32x4*)(_b + 192) = D_; } while (0)
#define K2_TILE(j_, buf_) do { const bf16_t* Bs = (const bf16_t*)(lds + (buf_) * K2_BUF) + fro; f32x16 acc[2]; \
        _Pragma("unroll") for (int e = 0; e < 16; ++e) { acc[0][e] = 0.f; acc[1][e] = 0.f; } \
        _Pragma("unroll") for (int ks = 0; ks < 16; ++ks) { const bf16x8 bf = *(const bf16x8*)(Bs + ks * 16); acc[0] = MFMA(bf, a.f[0][ks], acc[0]); acc[1] = MFMA(bf, a.f[1][ks], acc[1]); } \
        epi((j_), acc); } while (0)
    __syncthreads();
    K2_ISSUE(0, s0, s1, s2, s3);
    K2_ISSUE(min(1, n_tiles - 1), t0, t1, t2, t3);
    K2_COMMIT(0, s0, s1, s2, s3);
    __syncthreads();
#pragma unroll 1
    for (int j = 0; j < n_tiles; j += 2) {
        K2_ISSUE(min(j + 2, n_tiles - 1), s0, s1, s2, s3);
        K2_TILE(j, 0);
        if (j + 1 < n_tiles) K2_COMMIT(1, t0, t1, t2, t3);
        __syncthreads();
        if (j + 1 >= n_tiles) break;
        K2_ISSUE(min(j + 3, n_tiles - 1), t0, t1, t2, t3);
        K2_TILE(j + 1, 1);
        if (j + 2 < n_tiles) K2_COMMIT(0, s0, s1, s2, s3);
        __syncthreads();
    }
#undef K2_ISSUE
#undef K2_COMMIT
#undef K2_TILE
}

template <int KS> struct KFragA { bf16x8 f[2][KS]; };
template <int KS>
DEVI void kx_load_a(KFragA<KS>& a, const bf16_t* A, size_t lda, int row0, char* lds, float* rs, float eps) {
    constexpr int K = 16 * KS, LD = K + 8, CPR = K / 8, NCH = 256 * CPR / 512;
    const int tid = tidx(), lane = tid & 63, w = tid >> 6, wm = w >> 1, l31 = lane & 31, hh = lane >> 5;
    bf16_t* As = (bf16_t*)lds;
    __syncthreads();
    {
        u32x4 r[NCH];
#pragma unroll
        for (int i = 0; i < NCH; ++i) { const int c = tid + 512 * i; r[i] = *(const u32x4*)(A + (size_t)(row0 + c / CPR) * lda + (c % CPR) * 8); }
#pragma unroll
        for (int i = 0; i < NCH; ++i) { const int c = tid + 512 * i; *(u32x4*)(As + (c / CPR) * LD + (c % CPR) * 8) = r[i]; }
    }
    __syncthreads();
#pragma unroll
    for (int mi = 0; mi < 2; ++mi)
#pragma unroll
        for (int ks = 0; ks < KS; ++ks) a.f[mi][ks] = *(const bf16x8*)(As + (wm * 64 + mi * 32 + l31) * LD + ks * 16 + 8 * hh);
    if (tid < 256) { float ss = 0.f;
#pragma unroll
        for (int i = 0; i < CPR; ++i) { const u32x4 v = *(const u32x4*)(As + tid * LD + 8 * i);
#pragma unroll
            for (int j = 0; j < 4; ++j) { const float x = lo_bf(v[j]), y = hi_bf(v[j]); ss += x * x + y * y; } }
        rs[tid] = rsqrtf(ss * (1.f / (float)K) + eps); }
    __syncthreads();
}
template <int KS, class EPI>
DEVI void kx_stream(const KFragA<KS>& a, const bf16_t* Bt, int n_tiles, char* lds, const EPI& epi) {
    constexpr int K = 16 * KS, LD = K + 8, CPR = K / 8, NCH = 64 * CPR / 512, BUF = 64 * LD * 2;
    const int tid = tidx(), lane = tid & 63, w = tid >> 6, wn = w & 1, l31 = lane & 31, hh = lane >> 5;
    u32x4 s[NCH];
    auto issue = [&](int j) __attribute__((always_inline)) {
#pragma unroll
        for (int i = 0; i < NCH; ++i) { const int c = tid + 512 * i; s[i] = *(const u32x4*)(Bt + (size_t)(j * 64 + c / CPR) * K + (c % CPR) * 8); } };
    auto commit = [&](int buf) __attribute__((always_inline)) {
#pragma unroll
        for (int i = 0; i < NCH; ++i) { const int c = tid + 512 * i; *(u32x4*)((bf16_t*)(lds + buf * BUF) + (c / CPR) * LD + (c % CPR) * 8) = s[i]; } };
    __syncthreads();
    issue(0); commit(0);
    __syncthreads();
#pragma unroll 1
    for (int j = 0; j < n_tiles; ++j) {
        const bool more = j + 1 < n_tiles;
        issue(more ? j + 1 : j);
        const bf16_t* Bs = (const bf16_t*)(lds + (j & 1) * BUF) + (wn * 32 + l31) * LD + 8 * hh;
        f32x16 acc[2];
#pragma unroll
        for (int e = 0; e < 16; ++e) { acc[0][e] = 0.f; acc[1][e] = 0.f; }
#pragma unroll
        for (int ks = 0; ks < KS; ++ks) { const bf16x8 bf = *(const bf16x8*)(Bs + ks * 16); acc[0] = MFMA(bf, a.f[0][ks], acc[0]); acc[1] = MFMA(bf, a.f[1][ks], acc[1]); }
        epi(j, acc);
        if (more) commit((j + 1) & 1);
        __syncthreads();
    }
}
DEVI void mod_unit(const Params& p, int u, char* lds) {
    const int tid = tidx(), l = u / 96, j0 = (u % 96) * 64;
    float* sc = (float*)lds; float* red = sc + 9 * 1024;
    __syncthreads();
    for (int i = tid; i < 9 * 1024; i += 512) { const int row = i >> 10, k = i & 1023; const float v = row < 8 ? p.in[I_C][row * 1024 + k] : p.in[I_CCTX][k]; sc[i] = v / (1.f + expf(-v)); }
    __syncthreads();
    const int col = tid & 63, kg = tid >> 6;
    float a[9];
#pragma unroll
    for (int r = 0; r < 9; ++r) a[r] = 0.f;
    const float* w = p.in[I_WMOD] + (size_t)l * 1024 * 6144 + j0 + col;
    for (int k = kg * 128; k < kg * 128 + 128; ++k) {
        const float wv = w[(size_t)k * 6144];
#pragma unroll
        for (int r = 0; r < 9; ++r) a[r] += sc[r * 1024 + k] * wv;
    }
#pragma unroll
    for (int r = 0; r < 9; ++r) red[(kg * 9 + r) * 64 + col] = a[r];
    __syncthreads();
    float* mod = (float*)(p.ws + OFF_MOD);
    for (int i = tid; i < 9 * 64; i += 512) {
        const int r = i >> 6, cc = i & 63; float s = 0.f;
#pragma unroll
        for (int g = 0; g < 8; ++g) s += red[(g * 9 + r) * 64 + cc];
        mod[(size_t)(l * 9 + r) * 6144 + j0 + cc] = s + p.in[I_BMOD][l * 6144 + j0 + cc];
    }
}
DEVI void rope_unit(const Params& p, int v) {
    const int idx = v * 512 + tidx(), pos = idx >> 4, i = idx & 15, fi = i & 7;
    const float inv = powf(10000.f, -(float)fi / 8.f);
    const float coord = (float)(i < 8 ? (pos >> 6) : (pos & 63));
    const float ang = coord * inv;
    ((float*)(p.ws + OFF_COS))[idx] = cosf(ang);
    ((float*)(p.ws + OFF_SIN))[idx] = sinf(ang);
}
DEVI void norm_rows(const Params& p, int l, int r0, int r1, int which  ) {
    const int lane = tidx() & 63, w = tidx() >> 6;
    const float* mod = (const float*)(p.ws + OFF_MOD);
    bf16_t* h = (bf16_t*)(p.ws + OFF_H);
    const float* gn = p.in[which ? I_GN2 : I_GN1] + l * 1024;
#pragma unroll 1
    for (int r = r0 + w; r < r1; r += 16) {
        float4 xv[2][4], gq[4], shq[2][4], scq[2][4]; float ss[2] = {0.f, 0.f};
#pragma unroll
        for (int u = 0; u < 2; ++u) {
            const int rr = min(r + 8 * u, r1 - 1);
            const float* src = which ? (const float*)xdst(p, rr) : xsrc(p, l, rr);
            const float* mr = mod + (size_t)(l * 9 + row_mod(rr)) * 6144 + (which ? 3072 : 0);
#pragma unroll
            for (int q = 0; q < 4; ++q) { const int k = 4 * lane + 256 * q; xv[u][q] = *(const float4*)(src + k); shq[u][q] = *(const float4*)(mr + k); scq[u][q] = *(const float4*)(mr + 1024 + k); }
        }
#pragma unroll
        for (int q = 0; q < 4; ++q) gq[q] = *(const float4*)(gn + 4 * lane + 256 * q);
        __builtin_amdgcn_sched_barrier(0);
#pragma unroll
        for (int u = 0; u < 2; ++u) {
#pragma unroll
            for (int q = 0; q < 4; ++q) ss[u] += xv[u][q].x * xv[u][q].x + xv[u][q].y * xv[u][q].y + xv[u][q].z * xv[u][q].z + xv[u][q].w * xv[u][q].w;
            ss[u] = wave_sum(ss[u]);
        }
#pragma unroll
        for (int u = 0; u < 2; ++u) {
            const int rr = r + 8 * u;
            if (rr < r1) {
                const float rstd = rsqrtf(ss[u] * (1.f / 1024.f) + 1e-6f);
#pragma unroll
                for (int q = 0; q < 4; ++q) {
                    const int k = 4 * lane + 256 * q;
                    const float4 g = gq[q], sh = shq[u][q], sc = scq[u][q];
                    const float o0 = xv[u][q].x * rstd * g.x * (1.f + sc.x) + sh.x, o1 = xv[u][q].y * rstd * g.y * (1.f + sc.y) + sh.y;
                    const float o2 = xv[u][q].z * rstd * g.z * (1.f + sc.z) + sh.z, o3 = xv[u][q].w * rstd * g.w * (1.f + sc.w) + sh.w;
                    uint2 pk; pk.x = pk2(o0, o1); pk.y = pk2(o2, o3);
                    *(uint2*)(h + (size_t)rr * DM + k) = pk;
                }
            }
        }
    }
}

DEVI void quant_rows(const Params& p, int r0, int r1) {
    const int lane = tidx() & 63, w = tidx() >> 6;
    const bf16_t* h = (const bf16_t*)(p.ws + OFF_H);
    float* rs = (float*)(p.ws + OFF_RS);
#pragma unroll 1
    for (int rb = r0 + w; rb < r1; rb += 32) {
        uint4 a0[4], a1[4];
#pragma unroll
        for (int u = 0; u < 4; ++u) { const int r = min(rb + 8 * u, r1 - 1); a0[u] = *(const uint4*)(h + (size_t)r * DM + 8 * lane); a1[u] = *(const uint4*)(h + (size_t)r * DM + 512 + 8 * lane); }
        __builtin_amdgcn_sched_barrier(0);
#pragma unroll
        for (int u = 0; u < 4; ++u) {
            const int r = rb + 8 * u;
            if (r < r1) {
                const uint4 v0 = a0[u], v1 = a1[u];
                float m = fmaxf(fmaxf(fmaxf(fabsf(lo_bf(v0.x)), fabsf(hi_bf(v0.x))), fmaxf(fabsf(lo_bf(v0.y)), fabsf(hi_bf(v0.y)))), fmaxf(fmaxf(fabsf(lo_bf(v0.z)), fabsf(hi_bf(v0.z))), fmaxf(fabsf(lo_bf(v0.w)), fabsf(hi_bf(v0.w)))));
                m = fmaxf(m, fmaxf(fmaxf(fmaxf(fabsf(lo_bf(v1.x)), fabsf(hi_bf(v1.x))), fmaxf(fabsf(lo_bf(v1.y)), fabsf(hi_bf(v1.y)))), fmaxf(fmaxf(fabsf(lo_bf(v1.z)), fabsf(hi_bf(v1.z))), fmaxf(fabsf(lo_bf(v1.w)), fabsf(hi_bf(v1.w))))));
                m = fmaxf(wave_max(m), 1e-20f);
                const float s = 256.f / m;
                uint2 o0, o1;
                o0.x = pk4_fp8(lo_bf(v0.x) * s, hi_bf(v0.x) * s, lo_bf(v0.y) * s, hi_bf(v0.y) * s); o0.y = pk4_fp8(lo_bf(v0.z) * s, hi_bf(v0.z) * s, lo_bf(v0.w) * s, hi_bf(v0.w) * s);
                o1.x = pk4_fp8(lo_bf(v1.x) * s, hi_bf(v1.x) * s, lo_bf(v1.y) * s, hi_bf(v1.y) * s); o1.y = pk4_fp8(lo_bf(v1.z) * s, hi_bf(v1.z) * s, lo_bf(v1.w) * s, hi_bf(v1.w) * s);
                *(uint2*)(p.ws + OFF_H8 + (size_t)r * 1024 + 8 * lane) = o0;
                *(uint2*)(p.ws + OFF_H8 + (size_t)r * 1024 + 512 + 8 * lane) = o1;
                if (lane == 0) rs[r] = m * (1.f / (256.f * WG8_SCALE));
            }
        }
    }
}

constexpr int CJ_WIN = 0, CJ_WUQ = CJ_WIN + 8 * 102, CJ_WUKV = CJ_WUQ + 3 * 6, CJ_WBR = CJ_WUKV + 1 * 8, CJ_WOUT = CJ_WBR + 4 * 32, CJ_RT = CJ_WOUT + 128,
              CJ_EG = CJ_RT + 8, CJ_EU = CJ_EG + 65 * 32, CJ_ED = CJ_EU + 65 * 32, CJ_LW = CJ_ED + 65 * 32, CJ_END = CJ_LW + 16;
DEVI int win_map(int n) {
    if (n < 352) return n;
    if (n < 1120) { const int j = n - 352; return j < 256 ? ZC_NAQ + j : (j < 512 ? ZC_NAK + (j - 256) : ZLD + ZT_NAV + (j - 512)); }
    if (n < 1888) return ZLD + ZT_HY + (n - 1120);
    if (n < 2144) return ZC_LU + (n - 1888);
    if (n < 2400) return ZC_LG + (n - 2144);
    { const int np = n - 2400, g = np >> 10, col = np & 1023, pn = col >> 6, c64 = col & 63;
      return WIN_G0 + pn * 256 + 128 * (g >> 1) + 32 * (c64 >> 4) + 16 * (g & 1) + 4 * ((c64 >> 2) & 3) + (c64 & 3); }
}
template <int STAGE>
DEVI void conv_unit(const Params& p, int l, int cu, char* lds, float4 (&v)[4]) {
    const int tid = tidx();
    const float* src; int K, N, kt, nt, KH = 128; bf16_t* dst; int mode = 0; const float* ksc = nullptr;
    if (cu < CJ_WUQ) { const int t = cu - CJ_WIN; kt = t / 102; nt = t % 102; src = p.in[I_WIN] + (size_t)l * 1024 * 6496; K = 1024; N = 6496; dst = (bf16_t*)(p.ws + OFF_WIN); mode = 1; }
    else if (cu < CJ_WUKV) { const int t = cu - CJ_WUQ; kt = t / 6; nt = t % 6; src = p.in[I_WUQ] + (size_t)l * 192 * 384; K = 192; N = 384; dst = (bf16_t*)(p.ws + OFF_WUQ); ksc = p.in[I_GQ] + l * 192; KH = 64; }
    else if (cu < CJ_WBR) { const int t = cu - CJ_WUKV; kt = 0; nt = t; src = p.in[I_WUKV] + (size_t)l * 128 * 512; K = 128; N = 512; dst = (bf16_t*)(p.ws + OFF_WUKV); ksc = p.in[I_GKV] + l * 128; }
    else if (cu < CJ_WOUT) { const int t = cu - CJ_WBR, k = t >> 5, tt = t & 31; kt = tt >> 4; nt = tt & 15; src = p.in[I_WBR] + (size_t)(l * 4 + k) * 256 * 1024; K = 256; N = 1024; dst = (bf16_t*)(p.ws + OFF_WBR) + (size_t)k * 1024 * 256; }
    else if (cu < CJ_RT) { const int t = cu - CJ_WOUT; kt = t >> 4; nt = t & 15; src = p.in[I_WOUT] + (size_t)l * 1024 * 1024; K = 1024; N = 1024; dst = (bf16_t*)(p.ws + OFF_WOUT); }
    else if (cu < CJ_EG) { kt = cu - CJ_RT; nt = 0; src = p.in[I_RW] + (size_t)l * 1024 * 64; K = 1024; N = 64; dst = (bf16_t*)(p.ws + OFF_RT); mode = 4; }
    else if (cu < CJ_EU) { const int t = cu - CJ_EG, e = t >> 5, tt = t & 31; kt = tt >> 2; nt = tt & 3; src = e < 64 ? p.in[I_EG] + (size_t)(l * 64 + e) * 1024 * 256 : p.in[I_SG] + (size_t)l * 1024 * 256; K = 1024; N = 256; dst = (bf16_t*)(p.ws + OFF_WGU) + (size_t)e * 512 * 1024; mode = 2; }
    else if (cu < CJ_ED) { const int t = cu - CJ_EU, e = t >> 5, tt = t & 31; kt = tt >> 2; nt = tt & 3; src = e < 64 ? p.in[I_EU] + (size_t)(l * 64 + e) * 1024 * 256 : p.in[I_SU] + (size_t)l * 1024 * 256; K = 1024; N = 256; dst = (bf16_t*)(p.ws + OFF_WGU) + (size_t)e * 512 * 1024; mode = 3; }
    else if (cu >= CJ_LW) { const int t = cu - CJ_LW, d = t >> 3, g = (t >> 2) & 1, n = t & 3; kt = 0; nt = 0; src = p.in[g ? I_LWX : I_LWA] + (size_t)((l * 2 + d) * 4 + n) * 4096; K = 64; N = 64; dst = (bf16_t*)(p.ws + OFF_LWT) + (size_t)((d * 2 + g) * 4 + n) * 4096; KH = 64; }
    else { const int t = cu - CJ_ED, e = t >> 5, tt = t & 31; kt = tt >> 4; nt = tt & 15; src = e < 64 ? p.in[I_ED] + (size_t)(l * 64 + e) * 256 * 1024 : p.in[I_SD] + (size_t)l * 256 * 1024; K = 256; N = 1024; dst = (bf16_t*)(p.ws + OFF_WDT) + (size_t)e * 1024 * 256; }
    float* tl = (float*)lds;
    if constexpr (STAGE == 0) {
        const int kk = tid >> 4, n4 = (tid & 15) * 4, n = nt * 64 + n4, nc = min(n, N - 4);
#pragma unroll
        for (int ps = 0; ps < 4; ++ps) { const int pr = ps * 32 < KH ? ps : 0; v[ps] = *(const float4*)(src + (size_t)(kt * KH + kk + 32 * pr) * N + nc); }
        return;
    }
    __syncthreads();
    {
        const int kk = tid >> 4, n4 = (tid & 15) * 4, n = nt * 64 + n4;
        if (n >= N) {
#pragma unroll
            for (int ps = 0; ps < 4; ++ps) v[ps] = make_float4(0.f, 0.f, 0.f, 0.f);
        }
#pragma unroll
        for (int ps = 0; ps < 4; ++ps) if (ps * 32 < KH) {
            float4 x = v[ps];
            if (ksc) { const float s = ksc[kt * KH + kk + 32 * ps]; x.x *= s; x.y *= s; x.z *= s; x.w *= s; }
            float* t = tl + (kk + 32 * ps) * 65 + n4; t[0] = x.x; t[1] = x.y; t[2] = x.z; t[3] = x.w; }
    }
    __syncthreads();
    {
        const int nn = tid >> 3, n = nt * 64 + nn;
#pragma unroll
        for (int q = 0; q < 2; ++q) if (q * 64 < KH) {
            const int kc = (tid & 7) * 8 + 64 * q;
            if (n < N) {
                int dr = n;
                if (mode == 1) dr = win_map(n);
                else if (mode == 2 || mode == 3) { const int r = n & 127; dr = (n >> 7) * 256 + 128 * (r >> 6) + 32 * ((r >> 4) & 3) + 16 * (mode - 2) + 4 * ((r >> 2) & 3) + (r & 3); }
                if (mode == 1 && n >= 2400) {
                    uint2 o8;
                    o8.x = pk4_fp8(tl[(kc + 0) * 65 + nn] * WG8_SCALE, tl[(kc + 1) * 65 + nn] * WG8_SCALE, tl[(kc + 2) * 65 + nn] * WG8_SCALE, tl[(kc + 3) * 65 + nn] * WG8_SCALE);
                    o8.y = pk4_fp8(tl[(kc + 4) * 65 + nn] * WG8_SCALE, tl[(kc + 5) * 65 + nn] * WG8_SCALE, tl[(kc + 6) * 65 + nn] * WG8_SCALE, tl[(kc + 7) * 65 + nn] * WG8_SCALE);
                    *(uint2*)(p.ws + OFF_WG8 + (size_t)(dr - WIN_G0) * 1024 + kt * KH + kc) = o8;
                } else {
                uint4 o;
                o.x = pk2(tl[(kc + 0) * 65 + nn], tl[(kc + 1) * 65 + nn]); o.y = pk2(tl[(kc + 2) * 65 + nn], tl[(kc + 3) * 65 + nn]);
                o.z = pk2(tl[(kc + 4) * 65 + nn], tl[(kc + 5) * 65 + nn]); o.w = pk2(tl[(kc + 6) * 65 + nn], tl[(kc + 7) * 65 + nn]);
                *(uint4*)(dst + (size_t)dr * K + kt * KH + kc) = o;
                }
                if (mode == 4) *(uint4*)(dst + (size_t)(64 + n) * K + kt * KH + kc) = make_uint4(0u, 0u, 0u, 0u);
            }
            if (mode == 1 && nt == 0 && nn < 32) *(uint4*)(dst + (size_t)(352 + nn) * K + kt * KH + kc) = make_uint4(0u, 0u, 0u, 0u);
            if (mode == 1 && nt >= 1 && nt <= 2) *(uint4*)(dst + (size_t)(NIN + (nt - 1) * 64 + nn) * K + kt * KH + kc) = make_uint4(0u, 0u, 0u, 0u);
        }
    }
}
DEVI void h2tab_unit(const Params& p, int l, int hu, char* lds) {
    const int tid = tidx();
    const int L = hu < 64 ? 4096 : 256, pos0 = hu < 64 ? hu * 64 : (hu - 64) * 64, rbase = hu < 64 ? 0 : 4096;
    float* feats = (float*)lds; float* h1 = feats + 64 * 33;
    const float* w1 = p.in[I_HW1] + l * 33 * 64; const float* b1 = p.in[I_HB1] + l * 64;
    const float* w2 = p.in[I_HW2] + l * 64 * 64; const float* b2 = p.in[I_HB2] + l * 64;
    __syncthreads();
    for (int i = tid; i < 64 * 33; i += 512) {
        const int pl = i / 33, f = i % 33, pos = pos0 + pl; float v;
        if (f == 0) v = (float)pos / (float)(L - 1);
        else { const int j = (f - 1) & 15; const float wv = 6.283185307179586f * (float)pos / (float)L; const float fj = 1e-4f + (float)j * ((15.f - 1e-4f) / 15.f); const float zz = wv * fj; v = f <= 16 ? cosf(zz) : -sinf(zz); }
        feats[i] = v;
    }
    __syncthreads();
    const int pl = tid >> 3, og = tid & 7;
    float o[8];
#pragma unroll
    for (int j = 0; j < 8; ++j) o[j] = b1[og * 8 + j];
#pragma unroll 1
    for (int i = 0; i < 33; ++i) { const float f = feats[pl * 33 + i];
#pragma unroll
        for (int j = 0; j < 8; ++j) o[j] += f * w1[i * 64 + og * 8 + j]; }
#pragma unroll
    for (int j = 0; j < 8; ++j) h1[pl * 64 + og * 8 + j] = sinf(o[j]);
    __syncthreads();
#pragma unroll
    for (int j = 0; j < 8; ++j) o[j] = b2[og * 8 + j];
#pragma unroll 2
    for (int i = 0; i < 64; ++i) { const float f = h1[pl * 64 + i];
#pragma unroll
        for (int j = 0; j < 8; ++j) o[j] += f * w2[i * 64 + og * 8 + j]; }
    float* tab = (float*)(p.ws + OFF_H2T) + (size_t)(rbase + pos0 + pl) * 64 + og * 8;
#pragma unroll
    for (int j = 0; j < 8; ++j) tab[j] = sinf(o[j]);
}
DEVI void fft_twiddles(float2* tw) {
    for (int i = tidx(); i < 4096; i += 512) { float s, c; sincospif((float)i * (1.f / 4096.f), &s, &c); tw[i] = make_float2(c, -s); }
}

DEVI int PI(int i) { return i + (i >> 5); }
DEVI float2 cmul(float2 a, float2 b) { return make_float2(a.x * b.x - a.y * b.y, a.x * b.y + a.y * b.x); }
DEVI float2 cmulc(float2 a, float2 b) { return make_float2(a.x * b.x + a.y * b.y, a.y * b.x - a.x * b.y); }
template <int E> DEVI float2 mulw16(float2 d) {
    constexpr float C[8] = {1.f, 0.9238795325112867f, 0.7071067811865476f, 0.3826834323650898f, 0.f, -0.3826834323650898f, -0.7071067811865476f, -0.9238795325112867f};
    constexpr float S[8] = {0.f, 0.3826834323650898f, 0.7071067811865476f, 0.9238795325112867f, 1.f, 0.9238795325112867f, 0.7071067811865476f, 0.3826834323650898f};
    if (E == 0) return d;
    if (E == 4) return make_float2(d.y, -d.x);
    return make_float2(d.x * C[E] + d.y * S[E], d.y * C[E] - d.x * S[E]);
}
template <int I, int H> DEVI void bfly16(float2 (&v)[16]) { const float2 a = v[I], b = v[I + H]; v[I] = make_float2(a.x + b.x, a.y + b.y); v[I + H] = mulw16<(I & (H - 1)) * (8 / H)>(make_float2(a.x - b.x, a.y - b.y)); }
template <bool ZHI> DEVI void dft16(float2 (&v)[16]) {
    if (ZHI) { v[8] = v[0]; v[9] = mulw16<1>(v[1]); v[10] = mulw16<2>(v[2]); v[11] = mulw16<3>(v[3]); v[12] = mulw16<4>(v[4]); v[13] = mulw16<5>(v[5]); v[14] = mulw16<6>(v[6]); v[15] = mulw16<7>(v[7]); }
    else { bfly16<0, 8>(v); bfly16<1, 8>(v); bfly16<2, 8>(v); bfly16<3, 8>(v); bfly16<4, 8>(v); bfly16<5, 8>(v); bfly16<6, 8>(v); bfly16<7, 8>(v); }
    bfly16<0, 4>(v); bfly16<1, 4>(v); bfly16<2, 4>(v); bfly16<3, 4>(v); bfly16<8, 4>(v); bfly16<9, 4>(v); bfly16<10, 4>(v); bfly16<11, 4>(v);
    bfly16<0, 2>(v); bfly16<1, 2>(v); bfly16<4, 2>(v); bfly16<5, 2>(v); bfly16<8, 2>(v); bfly16<9, 2>(v); bfly16<12, 2>(v); bfly16<13, 2>(v);
    bfly16<0, 1>(v); bfly16<2, 1>(v); bfly16<4, 1>(v); bfly16<6, 1>(v); bfly16<8, 1>(v); bfly16<10, 1>(v); bfly16<12, 1>(v); bfly16<14, 1>(v);
}
#define BR4(k) ((((k) & 1) << 3) | (((k) & 2) << 1) | (((k) & 4) >> 1) | (((k) & 8) >> 3))
DEVI void fwd_store16(float2 (&v)[16], float2 w1, float2* X, int base, int S) {
    float2 w = w1;
    X[PI(base)] = v[0];
#pragma unroll
    for (int k = 1; k < 16; ++k) { X[PI(base + k * S)] = cmul(v[BR4(k)], w); if (k < 15) w = cmul(w, w1); }
}
DEVI void inv_load16(float2 (&v)[16], float2 w1, const float2* X, int base, int S) {
    float2 w = w1;
    { const float2 a = X[PI(base)]; v[0] = make_float2(a.x, -a.y); }
#pragma unroll
    for (int k = 1; k < 16; ++k) { const float2 a = cmulc(X[PI(base + k * S)], w); v[k] = make_float2(a.x, -a.y); if (k < 15) w = cmul(w, w1); }
}
DEVI float2 tw8192(const float2* tw, int idx) { const float2 t = tw[idx & 4095]; return (idx & 4096) ? make_float2(-t.x, -t.y) : t; }
DEVI void fft_fwd_C(float2* X, const float2* tw, int tid) {
    float2 v[16];
    const int n_lo = tid & 1, base = (tid >> 1) * 32 + n_lo;
#pragma unroll
    for (int r = 0; r < 16; ++r) v[r] = X[PI(base + 2 * r)];
    dft16<false>(v); fwd_store16(v, tw[256 * n_lo], X, base, 2);
    __syncthreads();
}
DEVI void fft_fwd_BC(float2* X, const float2* tw, int tid) {
    float2 v[16];
    { const int n_lo = tid & 31, base = (tid >> 5) * 512 + n_lo;
#pragma unroll
      for (int r = 0; r < 16; ++r) v[r] = X[PI(base + 32 * r)];
      dft16<false>(v); fwd_store16(v, tw[16 * n_lo], X, base, 32); }
    __syncthreads();
    fft_fwd_C(X, tw, tid);
}
DEVI void fft_inv_C(float2* X, const float2* tw, int tid) {
    float2 v[16];
    const int n_lo = tid & 1, base = (tid >> 1) * 32 + n_lo;
    inv_load16(v, tw[256 * n_lo], X, base, 2); dft16<false>(v);
#pragma unroll
    for (int n = 0; n < 16; ++n) X[PI(base + 2 * n)] = make_float2(v[BR4(n)].x, -v[BR4(n)].y);
    __syncthreads();
}
DEVI void fft_inv_CB(float2* X, const float2* tw, int tid) {
    fft_inv_C(X, tw, tid);
    float2 v[16];
    { const int n_lo = tid & 31, base = (tid >> 5) * 512 + n_lo;
      inv_load16(v, tw[16 * n_lo], X, base, 32); dft16<false>(v);
#pragma unroll
      for (int n = 0; n < 16; ++n) X[PI(base + 32 * n)] = make_float2(v[BR4(n)].x, -v[BR4(n)].y); }
    __syncthreads();
}
template <class HF>
DEVI void fft512x16_conv(float2 (&io)[8], const HF& Hq, float2* X, const float2* tw, int tid) {
    const int n_lo = tid & 31, baseB = (tid >> 5) * 512 + n_lo;
    {
        float2 v[16];
#pragma unroll
        for (int r = 0; r < 8; ++r) v[r] = io[r];
        dft16<true>(v);
        fwd_store16(v, tw[16 * n_lo], X, baseB, 32);
    }
    __syncthreads();
    fft_fwd_C(X, tw, tid);
#pragma unroll
    for (int i = 0; i < 8; ++i) {
        const int q = tid + 512 * i;
        const float4 hv = *(const float4*)(Hq(q >> 8) + 2 * (q & 255));
        const float2 a = X[PI(2 * q)], b = X[PI(2 * q + 1)];
        const float2 g0 = cmul(make_float2(a.x + b.x, a.y + b.y), make_float2(hv.x, hv.y)), g1 = cmul(make_float2(a.x - b.x, a.y - b.y), make_float2(hv.z, hv.w));
        X[PI(2 * q)] = make_float2(g0.x + g1.x, g0.y + g1.y); X[PI(2 * q + 1)] = make_float2(g0.x - g1.x, g0.y - g1.y);
    }
    __syncthreads();
    fft_inv_C(X, tw, tid);
    {
        float2 v[16];
        inv_load16(v, tw[16 * n_lo], X, baseB, 32); dft16<false>(v);
#pragma unroll
        for (int n = 0; n < 8; ++n) io[n] = make_float2(v[BR4(n)].x, -v[BR4(n)].y);
    }
    __syncthreads();
}
DEVI void fft_conv8192(float2 (&io)[8], const float2* __restrict__ H, float2* X, const float2* tw, int tid) {
    float4 hq[8];
#pragma unroll
    for (int i = 0; i < 8; ++i) hq[i] = *(const float4*)(H + 2 * (tid + 512 * i));
    {
        float2 v[16];
#pragma unroll
        for (int r = 0; r < 8; ++r) v[r] = io[r];
        dft16<true>(v);
        fwd_store16(v, tw[tid], X, tid, 512);
    }
    __syncthreads();
    fft_fwd_BC(X, tw, tid);
#pragma unroll
    for (int i = 0; i < 8; ++i) {
        const int q = tid + 512 * i;
        const float4 hv = hq[i];
        const float2 a = X[PI(2 * q)], b = X[PI(2 * q + 1)];
        const float2 g0 = cmul(make_float2(a.x + b.x, a.y + b.y), make_float2(hv.x, hv.y)), g1 = cmul(make_float2(a.x - b.x, a.y - b.y), make_float2(hv.z, hv.w));
        X[PI(2 * q)] = make_float2(g0.x + g1.x, g0.y + g1.y); X[PI(2 * q + 1)] = make_float2(g0.x - g1.x, g0.y - g1.y);
    }
    __syncthreads();
    fft_inv_CB(X, tw, tid);
    {
        float2 v[16];
        inv_load16(v, tw[tid], X, tid, 512); dft16<false>(v);
#pragma unroll
        for (int n = 0; n < 8; ++n) io[n] = make_float2(v[BR4(n)].x, -v[BR4(n)].y);
    }
    __syncthreads();
}
DEVI void fft_spectrum8192(float2 (&in)[16], float2* __restrict__ Hout, float2* X, const float2* tw, int tid) {
    dft16<false>(in);
    fwd_store16(in, tw[tid], X, tid, 512);
    __syncthreads();
    fft_fwd_BC(X, tw, tid);
#pragma unroll
    for (int i = 0; i < 8; ++i) {
        const int q = tid + 512 * i;
        const float2 a = X[PI(2 * q)], b = X[PI(2 * q + 1)];
        *(float4*)(Hout + 2 * q) = make_float4(a.x + b.x, a.y + b.y, a.x - b.x, a.y - b.y);
    }
    __syncthreads();
}


DEVI void spectrum8192_unit(const Params& p, int l, int n, int c, char* lds) {
    const int tid = tidx();
    float2* X = (float2*)lds; float2* tw = X + 8448; float* w3c = (float*)(tw + 4096);
    const float* h2tab = (const float*)(p.ws + OFF_H2T);
    __syncthreads();
    fft_twiddles(tw);
    if (tid < 128) { const int dir = tid >> 6, k = tid & 63; w3c[tid] = p.in[I_HW3][(size_t)(l * 64 + k) * 1024 + (n * 2 + dir) * 256 + c]; }
    const float dec0 = fabsf(p.in[I_HDEC][((l * 2 + n) * 2 + 0) * 256 + c]), dec1 = fabsf(p.in[I_HDEC][((l * 2 + n) * 2 + 1) * 256 + c]);
    __syncthreads();
    float* F = (float*)X;
    {
        const int part = tid & 7, rsub = tid >> 3;
        float w0[8], w1[8];
#pragma unroll
        for (int i = 0; i < 8; ++i) { w0[i] = w3c[part * 8 + i]; w1[i] = w3c[64 + part * 8 + i]; }
#pragma unroll 8
        for (int ch = 0; ch < 64; ++ch) {
            const int j = ch * 64 + rsub;
            const float4 a = *(const float4*)(h2tab + (size_t)j * 64 + part * 8), b = *(const float4*)(h2tab + (size_t)j * 64 + part * 8 + 4);
            float d0 = a.x * w0[0] + a.y * w0[1] + a.z * w0[2] + a.w * w0[3] + b.x * w0[4] + b.y * w0[5] + b.z * w0[6] + b.w * w0[7];
            float d1 = a.x * w1[0] + a.y * w1[1] + a.z * w1[2] + a.w * w1[3] + b.x * w1[4] + b.y * w1[5] + b.z * w1[6] + b.w * w1[7];
            d0 += __shfl_xor(d0, 1); d1 += __shfl_xor(d1, 1); d0 += __shfl_xor(d0, 2); d1 += __shfl_xor(d1, 2); d0 += __shfl_xor(d0, 4); d1 += __shfl_xor(d1, 4);
            F[j] = d0; F[4096 + j] = d1;
        }
    }
    __syncthreads();
    float2 v[16];
#pragma unroll
    for (int r = 0; r < 16; ++r) {
        const int t = tid + 512 * r;
        const int j = t < 4096 ? t : 8192 - t, dir = t < 4096 ? 0 : 1;
        const float f = F[dir * 4096 + (j & 4095)] * expf(-((float)j / 4095.f) * (dir ? dec1 : dec0));
        v[r] = make_float2(t != 4096 ? f : 0.f, 0.f);
    }
    __syncthreads();
    fft_spectrum8192(v, (float2*)(p.ws + OFF_HS) + (size_t)(n * 256 + c) * 8192, X, tw, tid);
}
DEVI float conv3(const bf16_t* r, int t, int L, float w0, float w1, float w2, float b) {
    const float c = bf2f(r[t]), lf = bf2f(r[max(t - 1, 0)]), rg = bf2f(r[min(t + 1, L - 1)]);
    return b + w1 * c + (t > 0 ? w0 : 0.f) * lf + (t < L - 1 ? w2 : 0.f) * rg;
}

DEVI void hyena8192_unit(const Params& p, int l, int c, int b0, char* lds) {
    const int tid = tidx();
    float2* X = (float2*)lds; float2* tw = X + 8448;
    const bf16_t* zT = (const bf16_t*)(p.ws + OFF_ZT);
    bf16_t* yT = (bf16_t*)(p.ws + OFF_YT);
    const float2* H0 = (const float2*)(p.ws + OFF_HS) + (size_t)c * 8192; const float2* H1 = H0 + (size_t)256 * 8192;
    const float* sw = p.in[I_HSW] + l * 3 * 768; const float* sb = p.in[I_HSB] + l * 768;
    const float bias0 = p.in[I_HBIAS][(l * 2 + 0) * 256 + c], bias1 = p.in[I_HBIAS][(l * 2 + 1) * 256 + c];
    const size_t base0 = (size_t)(b0 * 1024 + ZT_HY + c) * NKEY, base1 = base0 + (size_t)1024 * NKEY;
    const float inv = 1.f / 8192.f;
    float2 io[8], vr[8], x1[8], x2[8];
#pragma unroll
    for (int r = 0; r < 8; ++r) { const int t = tid + 512 * r;
        vr[r] = make_float2(conv3(zT + base0, t, 4096, sw[c], sw[768 + c], sw[1536 + c], sb[c]), conv3(zT + base1, t, 4096, sw[c], sw[768 + c], sw[1536 + c], sb[c]));
        x1[r] = make_float2(conv3(zT + base0 + (size_t)256 * NKEY, t, 4096, sw[256 + c], sw[768 + 256 + c], sw[1536 + 256 + c], sb[256 + c]),
                            conv3(zT + base1 + (size_t)256 * NKEY, t, 4096, sw[256 + c], sw[768 + 256 + c], sw[1536 + 256 + c], sb[256 + c]));
        x2[r] = make_float2(conv3(zT + base0 + (size_t)512 * NKEY, t, 4096, sw[512 + c], sw[768 + 512 + c], sw[1536 + 512 + c], sb[512 + c]),
                            conv3(zT + base1 + (size_t)512 * NKEY, t, 4096, sw[512 + c], sw[768 + 512 + c], sw[1536 + 512 + c], sb[512 + c]));
        io[r] = vr[r]; }
    fft_conv8192(io, H0, X, tw, tid);
#pragma unroll
    for (int r = 0; r < 8; ++r) {
        vr[r] = make_float2(x1[r].x * (io[r].x * inv + vr[r].x * bias0), x1[r].y * (io[r].y * inv + vr[r].y * bias0));
        io[r] = vr[r]; }
    fft_conv8192(io, H1, X, tw, tid);
#pragma unroll
    for (int r = 0; r < 8; ++r) {
        vr[r] = make_float2(x2[r].x * (io[r].x * inv + vr[r].x * bias1), x2[r].y * (io[r].y * inv + vr[r].y * bias1)); }
    __builtin_amdgcn_sched_barrier(0);
#pragma unroll
    for (int r = 0; r < 8; ++r) { const int t = tid + 512 * r;
        yT[(size_t)((b0 + 0) * 256 + c) * NKEY + t] = f2bf(vr[r].x);
        yT[(size_t)((b0 + 1) * 256 + c) * NKEY + t] = f2bf(vr[r].y); }
}

DEVI void spectrum512_unit(const Params& p, int l, int su, char* lds) {
    const int tid = tidx(), n_lo = tid & 31, blk = tid >> 5, f = su * 16 + blk, n = f >> 8, c = f & 255;
    float2* X = (float2*)lds; float2* tw = X + 8448;
    const float* h2tab = (const float*)(p.ws + OFF_H2T) + 4096 * 64;
    __syncthreads();
    fft_twiddles(tw);
    const float dec0 = fabsf(p.in[I_HDEC][((l * 2 + n) * 2 + 0) * 256 + c]), dec1 = fabsf(p.in[I_HDEC][((l * 2 + n) * 2 + 1) * 256 + c]);
    float* w3s = (float*)(tw + 4096);
    for (int i = tid; i < 16 * 128; i += 512) { const int fb = i >> 7, dir = (i >> 6) & 1, k = i & 63, ff = su * 16 + fb;
        w3s[i] = p.in[I_HW3][(size_t)(l * 64 + k) * 1024 + ((ff >> 8) * 2 + dir) * 256 + (ff & 255)]; }
    __syncthreads();
    float* T = (float*)X;
#pragma unroll
    for (int i = 0; i < 8; ++i) { const int idx = tid + 512 * i, row = idx >> 4, c4 = (idx & 15) * 4; const float4 hv = *(const float4*)(h2tab + (size_t)row * 64 + c4);
        float* d = T + row * 65 + c4; d[0] = hv.x; d[1] = hv.y; d[2] = hv.z; d[3] = hv.w; }
    __syncthreads();
    float2 v[16];
#pragma unroll
    for (int dir = 0; dir < 2; ++dir) {
        float fa[8]; int jr[8];
#pragma unroll
        for (int r = 0; r < 8; ++r) { const int t = n_lo + 32 * (r + 8 * dir); jr[r] = (dir ? 512 - t : t) & 255; fa[r] = 0.f; }
        const float* wc = w3s + blk * 128 + dir * 64;
#pragma unroll 4
        for (int k = 0; k < 64; ++k) { const float wk = wc[k];
#pragma unroll
            for (int r = 0; r < 8; ++r) fa[r] += T[jr[r] * 65 + k] * wk; }
#pragma unroll
        for (int r = 0; r < 8; ++r) { const int t = n_lo + 32 * (r + 8 * dir); const int jj = dir ? 512 - t : t;
            const float fv = fa[r] * expf(-((float)jj / 255.f) * (dir ? dec1 : dec0));
            v[r + 8 * dir] = make_float2(t != 256 ? fv : 0.f, 0.f); }
    }
    __syncthreads();
    dft16<false>(v);
    fwd_store16(v, tw[16 * n_lo], X, blk * 512 + n_lo, 32);
    __syncthreads();
    fft_fwd_C(X, tw, tid);
    float2* Hout = (float2*)(p.ws + OFF_HSC) + (size_t)su * 16 * 512;
#pragma unroll
    for (int i = 0; i < 8; ++i) { const int q = tid + 512 * i; const float2 a = X[PI(2 * q)], b = X[PI(2 * q + 1)];
        *(float4*)(Hout + 2 * q) = make_float4(a.x + b.x, a.y + b.y, a.x - b.x, a.y - b.y); }
    __syncthreads();
}
DEVI void hyena512_unit(const Params& p, int l, int hu, char* lds) {
    const int tid = tidx(), n_lo = tid & 31, blk = tid >> 5, c0 = hu * 4, c = c0 + (blk >> 2), b0 = 2 * (blk & 3);
    float2* X = (float2*)lds; float2* tw = X + 8448;
    const bf16_t* zT = (const bf16_t*)(p.ws + OFF_ZT);
    bf16_t* yT = (bf16_t*)(p.ws + OFF_YT);
    const float2* HC = (const float2*)(p.ws + OFF_HSC);
    const float* sw = p.in[I_HSW] + l * 3 * 768; const float* sb = p.in[I_HSB] + l * 768;
    const float bias0 = p.in[I_HBIAS][(l * 2 + 0) * 256 + c], bias1 = p.in[I_HBIAS][(l * 2 + 1) * 256 + c];
    const size_t base0 = (size_t)(b0 * 1024 + ZT_HY + c) * NKEY + 4096, base1 = base0 + (size_t)1024 * NKEY;
    const float inv = 1.f / 512.f;
    auto H0 = [&](int j) __attribute__((always_inline)) -> const float2* { return HC + (size_t)(c0 + (j >> 2)) * 512; };
    auto H1 = [&](int j) __attribute__((always_inline)) -> const float2* { return HC + (size_t)(256 + c0 + (j >> 2)) * 512; };
    float2 io[8], vr[8];
#pragma unroll
    for (int r = 0; r < 8; ++r) { const int t = n_lo + 32 * r;
        vr[r] = make_float2(conv3(zT + base0, t, 256, sw[c], sw[768 + c], sw[1536 + c], sb[c]), conv3(zT + base1, t, 256, sw[c], sw[768 + c], sw[1536 + c], sb[c]));
        io[r] = vr[r]; }
    fft512x16_conv(io, H0, X, tw, tid);
#pragma unroll
    for (int r = 0; r < 8; ++r) { const int t = n_lo + 32 * r;
        const float x10 = conv3(zT + base0 + (size_t)256 * NKEY, t, 256, sw[256 + c], sw[768 + 256 + c], sw[1536 + 256 + c], sb[256 + c]);
        const float x11 = conv3(zT + base1 + (size_t)256 * NKEY, t, 256, sw[256 + c], sw[768 + 256 + c], sw[1536 + 256 + c], sb[256 + c]);
        vr[r] = make_float2(x10 * (io[r].x * inv + vr[r].x * bias0), x11 * (io[r].y * inv + vr[r].y * bias0));
        io[r] = vr[r]; }
    fft512x16_conv(io, H1, X, tw, tid);
#pragma unroll
    for (int r = 0; r < 8; ++r) { const int t = n_lo + 32 * r;
        const float x20 = conv3(zT + base0 + (size_t)512 * NKEY, t, 256, sw[512 + c], sw[768 + 512 + c], sw[1536 + 512 + c], sb[512 + c]);
        const float x21 = conv3(zT + base1 + (size_t)512 * NKEY, t, 256, sw[512 + c], sw[768 + 512 + c], sw[1536 + 512 + c], sb[512 + c]);
        vr[r] = make_float2(x20 * (io[r].x * inv + vr[r].x * bias1), x21 * (io[r].y * inv + vr[r].y * bias1)); }
    __builtin_amdgcn_sched_barrier(0);
#pragma unroll
    for (int r = 0; r < 8; ++r) { const int t = n_lo + 32 * r;
        yT[(size_t)((b0 + 0) * 256 + c) * NKEY + 4096 + t] = f2bf(vr[r].x);
        yT[(size_t)((b0 + 1) * 256 + c) * NKEY + 4096 + t] = f2bf(vr[r].y); }
}
DEVI void hyena_unit(const Params& p, int l, int hu, char* lds) {
    float2* X = (float2*)lds; float2* tw = X + 8448;
    __syncthreads();
    fft_twiddles(tw);
    __syncthreads();
    if (hu < 1024) hyena8192_unit(p, l, hu & 255, 2 * (hu >> 8), lds);
    else hyena512_unit(p, l, hu - 1024, lds);
}

struct KVTile { const bf16_t* k; const bf16_t* vt; };
template <int DQ, bool NA, class TF>
DEVI void attn_core(const bf16x8 (&qf)[DQ / 16], int ntiles, const TF& tilefn, int kstride, int vstride,
                    int r_q, int qc, int kr_lo, int nloc, const float* rpb_s, f32x16 (&o)[2], float& lsum, char* lds) {
    constexpr int KLD = DQ + 8, KCH = DQ / 8, KSZ = 64 * KLD * 2, VSZ = 64 * 72 * 2, ST = KSZ + VSZ;
    constexpr int NKC = (64 * KCH + 511) / 512;
    const int tid = tidx(), lane = tid & 63, l31 = lane & 31, hh = lane >> 5;
    float m = -1e30f; lsum = 0.f;
#pragma unroll
    for (int e = 0; e < 16; ++e) { o[0][e] = 0.f; o[1][e] = 0.f; }
    const int r0 = min(max(r_q - 4, 0), 56), c0 = min(max(qc - 8, 0), 48);
    u32x4 rk0, rk1, rv, sk0, sk1, sv;
    const int c1_ = min(tid + 512, 64 * KCH - 1);
    const unsigned gko0 = (unsigned)((tid / KCH) * kstride + (tid % KCH) * 8), gko1 = (unsigned)((c1_ / KCH) * kstride + (c1_ % KCH) * 8), gvo = (unsigned)((tid >> 3) * vstride + (tid & 7) * 8);
    const unsigned lko0 = (unsigned)((tid / KCH) * KLD + (tid % KCH) * 8), lko1 = (unsigned)(((tid + 512) / KCH) * KLD + ((tid + 512) % KCH) * 8);
    const unsigned lvo = (unsigned)((tid >> 3) * 72 + ((tid & 7) >> 1) * 16 + (tid & 1) * 4);
#define AT_ISSUE(j_, K0, K1, V_) do { const KVTile t = tilefn(j_); \
        K0 = *(const u32x4*)(t.k + gko0); \
        if (NKC == 2) K1 = *(const u32x4*)(t.k + gko1); \
        V_ = *(const u32x4*)(t.vt + gvo); } while (0)
#define AT_COMMIT(buf_, K0, K1, V_) do { bf16_t* Ks_ = (bf16_t*)(lds + (buf_) * ST); bf16_t* Vs_ = (bf16_t*)(lds + (buf_) * ST + KSZ); \
        *(u32x4*)(Ks_ + lko0) = K0; \
        if (NKC == 2) { if (tid + 512 < 64 * KCH) *(u32x4*)(Ks_ + lko1) = K1; } \
        { bf16_t* vr_ = Vs_ + lvo;        \
          uint2 lo_, hi_; lo_.x = V_[0]; lo_.y = V_[1]; hi_.x = V_[2]; hi_.y = V_[3]; *(uint2*)vr_ = lo_; *(uint2*)(vr_ + 8) = hi_; } } while (0)
    auto tile = [&](int j) __attribute__((always_inline)) {
        const int kr = kr_lo + j;
        const bool active = !NA || j >= nloc || (kr >= r0 && kr < r0 + 8);
        if (active) {
            const bf16_t* Ks = (const bf16_t*)(lds + (j & 1) * ST); const bf16_t* Vs = (const bf16_t*)(lds + (j & 1) * ST + KSZ);
            f32x16 s0, s1;
#pragma unroll
            for (int e = 0; e < 16; ++e) { s0[e] = 0.f; s1[e] = 0.f; }
#pragma unroll
            for (int ks = 0; ks < DQ / 16; ++ks) {
                const bf16x8 k0 = *(const bf16x8*)(Ks + l31 * KLD + ks * 16 + 8 * hh);
                const bf16x8 k1 = *(const bf16x8*)(Ks + (32 + l31) * KLD + ks * 16 + 8 * hh);
                s0 = MFMA(k0, qf[ks], s0); s1 = MFMA(k1, qf[ks], s1);
            }
            if (NA && j < nloc) {
                const float* rb = rpb_s + (kr - r_q + 7) * 31 + 15 - qc;
#pragma unroll
                for (int e = 0; e < 16; ++e) {
                    const int kc = (e & 3) + 8 * (e >> 2) + 4 * hh;
                    const bool v0 = kc >= c0 && kc < c0 + 16, v1 = (kc + 32) >= c0 && (kc + 32) < c0 + 16;
                    s0[e] = v0 ? s0[e] + rb[kc] : -1e30f;
                    s1[e] = v1 ? s1[e] + rb[kc + 32] : -1e30f;
                }
            }
            float mx = s0[0];
#pragma unroll
            for (int e = 1; e < 16; ++e) mx = fmaxf(mx, s0[e]);
#pragma unroll
            for (int e = 0; e < 16; ++e) mx = fmaxf(mx, s1[e]);
            mx = fmaxf(mx, __shfl_xor(mx, 32));
            if (__builtin_amdgcn_ballot_w64(mx > m + 8.f) != 0ull) {
                const float mnew = mx > m + 8.f ? fmaxf(m, mx) : m, alpha = __builtin_amdgcn_exp2f(m - mnew);
                lsum *= alpha;
#pragma unroll
                for (int e = 0; e < 16; ++e) { o[0][e] *= alpha; o[1][e] *= alpha; }
                m = mnew;
            }
            const float mn = m;
            float ps = 0.f;
#pragma unroll
            for (int e = 0; e < 16; ++e) { s0[e] = __builtin_amdgcn_exp2f(s0[e] - mn); s1[e] = __builtin_amdgcn_exp2f(s1[e] - mn); ps += s0[e] + s1[e]; }
            lsum += ps;
#pragma unroll
            for (int s4 = 0; s4 < 4; ++s4) {
                const int bs = 8 * (s4 & 1);
                u32x4 pu;
                if (s4 < 2) { pu[0] = pk2(s0[bs], s0[bs + 1]); pu[1] = pk2(s0[bs + 2], s0[bs + 3]); pu[2] = pk2(s0[bs + 4], s0[bs + 5]); pu[3] = pk2(s0[bs + 6], s0[bs + 7]); }
                else        { pu[0] = pk2(s1[bs], s1[bs + 1]); pu[1] = pk2(s1[bs + 2], s1[bs + 3]); pu[2] = pk2(s1[bs + 4], s1[bs + 5]); pu[3] = pk2(s1[bs + 6], s1[bs + 7]); }
                const bf16x8 pfv = __builtin_bit_cast(bf16x8, pu);
#pragma unroll
                for (int dvt = 0; dvt < 2; ++dvt) {
                    const u32x4 vu = *(const u32x4*)(Vs + (dvt * 32 + l31) * 72 + s4 * 16 + 8 * hh);
                    o[dvt] = MFMA(__builtin_bit_cast(bf16x8, vu), pfv, o[dvt]);
                }
            }
        }
    };
    __syncthreads();
    AT_ISSUE(0, rk0, rk1, rv); AT_COMMIT(0, rk0, rk1, rv);
    AT_ISSUE(min(1, ntiles - 1), sk0, sk1, sv);
    __syncthreads();
#pragma unroll 1
    for (int j = 0; j < ntiles; j += 2) {
        AT_ISSUE(min(j + 2, ntiles - 1), rk0, rk1, rv);
        tile(j);
        AT_COMMIT(1, sk0, sk1, sv);
        __syncthreads();
        if (j + 1 >= ntiles) break;
        AT_ISSUE(min(j + 3, ntiles - 1), sk0, sk1, sv);
        tile(j + 1);
        AT_COMMIT(0, rk0, rk1, rv);
        __syncthreads();
    }
#undef AT_ISSUE
#undef AT_COMMIT
    lsum += __shfl_xor(lsum, 32);
}
DEVI void attn_store(const f32x16 (&o)[2], float lsum, bf16_t* dst  ) {
    const int lane = tidx() & 63, hh = lane >> 5;
    const float il = 1.f / lsum;
#pragma unroll
    for (int dvt = 0; dvt < 2; ++dvt)
#pragma unroll
        for (int g = 0; g < 4; ++g) { uint2 v; v.x = pk2(o[dvt][4 * g] * il, o[dvt][4 * g + 1] * il); v.y = pk2(o[dvt][4 * g + 2] * il, o[dvt][4 * g + 3] * il);
            *(uint2*)(dst + dvt * 32 + 8 * g + 4 * hh) = v; }
}
DEVI void na_unit(const Params& p, int l, int au, char* lds) {
    const int tid = tidx(), lane = tid & 63, w = tid >> 6, l31 = lane & 31, hh = lane >> 5;
    const bf16_t* z = (const bf16_t*)(p.ws + OFF_Z); const bf16_t* zT = (const bf16_t*)(p.ws + OFF_ZT);
    bf16_t* br = (bf16_t*)(p.ws + OFF_BR);
    const bool isctx = au >= 512;
    int b, h, R;
    if (!isctx) { b = au >> 6; h = (au >> 4) & 3; R = au & 15; } else { b = (au - 512) >> 2; h = (au - 512) & 3; R = 0; }
    float* rpb_s = (float*)(lds + 2 * (64 * 72 * 2 + 64 * 72 * 2));
    __syncthreads();
    for (int i = tid; i < 465; i += 512) rpb_s[i] = p.in[I_RPB][(size_t)(l * 4 + h) * 465 + i] * 1.4426950408889634f;
    const int r_q = 4 * R + (w >> 1), qc = (w & 1) * 32 + l31;
    const int qrow = isctx ? TL + b * 256 + w * 32 + l31 : b * 4096 + r_q * 64 + qc;
    bf16x8 qf[4];
    {
        const bf16_t* qs = z + (size_t)qrow * ZLD + ZC_NAQ + h * 64 + 8 * hh;
        const float sc = 0.125f * 1.4426950408889634f;
#pragma unroll
        for (int ks = 0; ks < 4; ++ks) { const uint4 v = *(const uint4*)(qs + ks * 16); u32x4 t;
            t[0] = pk2(lo_bf(v.x) * sc, hi_bf(v.x) * sc); t[1] = pk2(lo_bf(v.y) * sc, hi_bf(v.y) * sc); t[2] = pk2(lo_bf(v.z) * sc, hi_bf(v.z) * sc); t[3] = pk2(lo_bf(v.w) * sc, hi_bf(v.w) * sc);
            qf[ks] = __builtin_bit_cast(bf16x8, t); }
    }
    int kr_lo = 0, nloc = 0;
    if (!isctx) { kr_lo = min(max(4 * R - 4, 0), 56); const int kr_hi = min(max(4 * R - 1, 0), 56) + 7; nloc = kr_hi - kr_lo + 1; }
    const bf16_t* kb = z + ZC_NAK + h * 64; const bf16_t* vb = zT + (size_t)(b * 1024 + ZT_NAV + h * 64) * NKEY;
    auto tf = [&](int j) { KVTile t;
        if (j < nloc) { const int kr = kr_lo + j; t.k = kb + (size_t)(b * 4096 + kr * 64) * ZLD; t.vt = vb + kr * 64; }
        else { const int i = j - nloc; t.k = kb + (size_t)(TL + b * 256 + 64 * i) * ZLD; t.vt = vb + 4096 + 64 * i; }
        return t; };
    f32x16 o[2]; float ls;
    attn_core<64, true>(qf, nloc + 4, tf, ZLD, NKEY, r_q, qc, kr_lo, nloc, rpb_s, o, ls, lds);
    attn_store(o, ls, br + (size_t)qrow * DM + 256 + h * 64);
}
DEVI void lru1_unit(const Params& p, int l, int lu, char* lds) {
    const int tid = tidx(), c = tid & 255, half = tid >> 8, lane = tid & 63, w = tid >> 6, l31 = lane & 31, hh = lane >> 5;
    const int tt = lu >> 1, d = lu & 1;
    const int row0 = tt * 64;
    const int s0 = row0 < TL ? (row0 & 4095) : ((row0 - TL) & 255);
    const int L = row0 < TL ? 4096 : 256;
    const bf16_t* z = (const bf16_t*)(p.ws + OFF_Z);
    constexpr int XLD = 264;
    bf16_t* xs = (bf16_t*)lds;
    float* As = (float*)(lds + 34816);
    bf16_t* Bs = (bf16_t*)(lds + 34816 + 65536);
    const int n = w & 3, th = w >> 2;
    bf16x8 wf[2][2][4];
    {
        const bf16_t* wt = (const bf16_t*)(p.ws + OFF_LWT);
#pragma unroll
        for (int g = 0; g < 2; ++g)
#pragma unroll
            for (int ct = 0; ct < 2; ++ct)
#pragma unroll
                for (int ks = 0; ks < 4; ++ks) wf[g][ct][ks] = *(const bf16x8*)(wt + (size_t)((d * 2 + g) * 4 + n) * 4096 + (ct * 32 + l31) * 64 + ks * 16 + 8 * hh);
    }
    float cba[2], cbx[2], csp[2];
#pragma unroll
    for (int ct = 0; ct < 2; ++ct) { const int ch = 64 * n + ct * 32 + l31; cba[ct] = p.in[I_LBA][(l * 2 + d) * 256 + ch]; cbx[ct] = p.in[I_LBX][(l * 2 + d) * 256 + ch]; csp[ct] = p.in[I_LLAM][(l * 2 + d) * 256 + ch]; }
    __syncthreads();
    {
        const float* cw = p.in[I_LCW] + (size_t)(l * 2 + d) * 4 * 256; const float cb = p.in[I_LCB][(l * 2 + d) * 256 + c];
        const float w0 = cw[c], w1 = cw[256 + c], w2 = cw[512 + c], w3 = cw[768 + c];
        const bf16_t* zu = z + (size_t)(row0 - s0) * ZLD + ZC_LU + c;
        auto U = [&](int s) -> float { const float v = bf2f(zu[(size_t)min(max(s, 0), L - 1) * ZLD]); return (s >= 0 && s < L) ? v : 0.f; };
        const int sb = s0 + 32 * half - (d == 0 ? 3 : 0);
        float uv[35];
#pragma unroll
        for (int i = 0; i < 35; ++i) uv[i] = U(sb + i);
#pragma unroll
        for (int i = 0; i < 32; ++i) xs[(32 * half + i) * XLD + c] = f2bf(cb + w0 * uv[i] + w1 * uv[i + 1] + w2 * uv[i + 2] + w3 * uv[i + 3]);
    }
    __syncthreads();
    {
        f32x16 acc[2][2];
#pragma unroll
        for (int g = 0; g < 2; ++g)
#pragma unroll
            for (int ct = 0; ct < 2; ++ct)
#pragma unroll
                for (int e = 0; e < 16; ++e) acc[g][ct][e] = 0.f;
#pragma unroll
        for (int ks = 0; ks < 4; ++ks) {
            const bf16x8 af = *(const bf16x8*)(xs + (th * 32 + l31) * XLD + 64 * n + ks * 16 + 8 * hh);
#pragma unroll
            for (int g = 0; g < 2; ++g)
#pragma unroll
                for (int ct = 0; ct < 2; ++ct) acc[g][ct] = MFMA(af, wf[g][ct][ks], acc[g][ct]);
        }
#pragma unroll
        for (int ct = 0; ct < 2; ++ct) {
            const int ch = 64 * n + ct * 32 + l31;
            const float ba = cba[ct], bx = cbx[ct];
            const float sp = log1pf(expf(-csp[ct]));
#pragma unroll
            for (int e = 0; e < 16; ++e) {
                const int tl = th * 32 + (e & 3) + 8 * (e >> 2) + 4 * hh;
                const float r = sigmoidf_(acc[0][ct][e] + ba), ig = sigmoidf_(acc[1][ct][e] + bx);
                const float la = -8.f * r * sp, a = __expf(la), mult = __builtin_amdgcn_sqrtf(fmaxf(1.f - a * a, 0.f));
                As[tl * 256 + ch] = a;
                Bs[tl * 256 + ch] = f2bf(mult * ig * bf2f(xs[tl * XLD + ch]));
            }
        }
    }
    __syncthreads();
    bf16_t* hloc = (bf16_t*)(p.ws + OFF_HLOC) + (size_t)d * TT * 256; bf16_t* cuma = (bf16_t*)(p.ws + OFF_CUMA) + (size_t)d * TT * 256;
    float hst = 0.f, cum = 1.f;
    for (int i = 0; i < 32; ++i) {
        const int tl = 32 * half + (d == 0 ? i : 31 - i);
        const float a = As[tl * 256 + c], bt = bf2f(Bs[tl * 256 + c]);
        hst = a * hst + bt; cum *= a;
        hloc[(size_t)(row0 + tl) * 256 + c] = f2bf(hst); cuma[(size_t)(row0 + tl) * 256 + c] = f2bf(cum);
    }
    const int seg = tt * 2 + half;
    ((float*)(p.ws + OFF_SEGA))[(size_t)(d * 1088 + seg) * 256 + c] = cum;
    ((float*)(p.ws + OFF_SEGB))[(size_t)(d * 1088 + seg) * 256 + c] = hst;
}
DEVI void qproj_unit(const Params& p, int qu, char* lds) {
    const int mt = qu >> 1, nh = qu & 1;
    const int tid = tidx(), lane = tid & 63, w = tid >> 6, wm = w >> 1, wn = w & 1, l31 = lane & 31, hh = lane >> 5;
    const bf16_t* z = (const bf16_t*)(p.ws + OFF_Z);
    const int row0 = mt_row0(mt);
    float* rs = (float*)(lds + 120 * 1024);
    KFragA<12> a;
    kx_load_a<12>(a, z + ZC_QL, ZLD, row0, lds, rs, 1e-6f);
    bf16_t* Q = (bf16_t*)(p.ws + OFF_Q);
    const float* cosT = (const float*)(p.ws + OFF_COS); const float* sinT = (const float*)(p.ws + OFF_SIN);
    const float QS = 0.10206207261596575f * 1.4426950408889634f;
    const bool lat = mt < 128;
    kx_stream<12>(a, (const bf16_t*)(p.ws + OFF_WUQ) + (size_t)nh * 192 * 192, 3, lds, [&](int j, const f32x16 (&acc)[2]) __attribute__((always_inline)) {
        const int ct = nh * 6 + j * 2 + wn, hd = ct / 3, part = ct % 3;
#pragma unroll
        for (int mi = 0; mi < 2; ++mi) {
            const int rl = wm * 64 + mi * 32 + l31, row = row0 + rl, b = row_b(row), key = row_key(row);
            const float rstd = rs[rl] * QS;
            float v[16];
#pragma unroll
            for (int e = 0; e < 16; ++e) v[e] = acc[mi][e] * rstd;
            if (part == 2 && lat) {
#pragma unroll
                for (int g = 0; g < 2; ++g)
#pragma unroll
                    for (int jj = 0; jj < 4; ++jj) { const int i = 8 * g + 4 * hh + jj; const float cs = cosT[key * 16 + i], sn = sinT[key * 16 + i];
                        const float x1 = v[4 * g + jj], x2 = v[4 * (g + 2) + jj]; v[4 * g + jj] = x1 * cs - x2 * sn; v[4 * (g + 2) + jj] = x1 * sn + x2 * cs; }
            }
            bf16_t* dst = Q + ((size_t)((b * 4 + hd) * NKEY + key)) * 96 + part * 32 + 4 * hh;
#pragma unroll
            for (int g = 0; g < 4; ++g) { uint2 o; o.x = pk2(v[4 * g], v[4 * g + 1]); o.y = pk2(v[4 * g + 2], v[4 * g + 3]); *(uint2*)(dst + 8 * g) = o; }
        }
    });
}
DEVI void kvproj_unit(const Params& p, int ku, char* lds) {
    const int mt = ku >> 1, nh = ku & 1;
    const int tid = tidx(), lane = tid & 63, w = tid >> 6, wm = w >> 1, wn = w & 1, l31 = lane & 31, hh = lane >> 5;
    const bf16_t* z = (const bf16_t*)(p.ws + OFF_Z);
    const int row0 = mt_row0(mt);
    float* rs = (float*)(lds + 120 * 1024);
    bf16_t* Kb = (bf16_t*)(p.ws + OFF_K); bf16_t* Vt = (bf16_t*)(p.ws + OFF_VT);
    const float* cosT = (const float*)(p.ws + OFF_COS); const float* sinT = (const float*)(p.ws + OFF_SIN);
    const bool lat = mt < 128;
    if (nh == 0) {
        const int rl = tid >> 1, part = tid & 1, row = row0 + rl, b = row_b(row), key = row_key(row);
        const bf16_t* zr = z + (size_t)row * ZLD + ZC_KR;
        const u32x4 q1 = *(const u32x4*)(zr + 8 * part), q2 = *(const u32x4*)(zr + 16 + 8 * part);
        const int kk = lat ? key : 0;
        const float4 ca = *(const float4*)(cosT + kk * 16 + 8 * part), cb = *(const float4*)(cosT + kk * 16 + 8 * part + 4);
        const float4 sa = *(const float4*)(sinT + kk * 16 + 8 * part), sb2 = *(const float4*)(sinT + kk * 16 + 8 * part + 4);
        const float csv[8] = {ca.x, ca.y, ca.z, ca.w, cb.x, cb.y, cb.z, cb.w}, snv[8] = {sa.x, sa.y, sa.z, sa.w, sb2.x, sb2.y, sb2.z, sb2.w};
        float y1[8], y2[8];
#pragma unroll
        for (int ii = 0; ii < 8; ++ii) { const float x1 = (ii & 1) ? hi_bf(q1[ii >> 1]) : lo_bf(q1[ii >> 1]), x2 = (ii & 1) ? hi_bf(q2[ii >> 1]) : lo_bf(q2[ii >> 1]);
            const float cs = lat ? csv[ii] : 1.f, sn = lat ? snv[ii] : 0.f; y1[ii] = x1 * cs - x2 * sn; y2[ii] = x1 * sn + x2 * cs; }
        u32x4 o1, o2;
#pragma unroll
        for (int j = 0; j < 4; ++j) { o1[j] = pk2(y1[2 * j], y1[2 * j + 1]); o2[j] = pk2(y2[2 * j], y2[2 * j + 1]); }
#pragma unroll
        for (int hd = 0; hd < 4; ++hd) { bf16_t* kd = Kb + ((size_t)((b * 4 + hd) * NKEY + key)) * 96 + 64 + 8 * part; *(u32x4*)kd = o1; *(u32x4*)(kd + 16) = o2; }
    }
    KFragA<8> a;
    kx_load_a<8>(a, z + ZC_KVL, ZLD, row0, lds, rs, 1e-6f);
    kx_stream<8>(a, (const bf16_t*)(p.ws + OFF_WUKV) + (size_t)nh * 256 * 128, 4, lds, [&](int j, const f32x16 (&acc)[2]) __attribute__((always_inline)) {
        const int hd = nh * 2 + (j >> 1), isv = j & 1;
#pragma unroll
        for (int mi = 0; mi < 2; ++mi) {
            const int rl = wm * 64 + mi * 32 + l31, row = row0 + rl, b = row_b(row), key = row_key(row);
            const float rstd = rs[rl];
            if (!isv) {
                bf16_t* dst = Kb + ((size_t)((b * 4 + hd) * NKEY + key)) * 96 + wn * 32 + 4 * hh;
#pragma unroll
                for (int g = 0; g < 4; ++g) { uint2 o; o.x = pk2(acc[mi][4 * g] * rstd, acc[mi][4 * g + 1] * rstd); o.y = pk2(acc[mi][4 * g + 2] * rstd, acc[mi][4 * g + 3] * rstd); *(uint2*)(dst + 8 * g) = o; }
            } else {
#pragma unroll
                for (int e = 0; e < 16; ++e) { const int dv = wn * 32 + (e & 3) + 8 * (e >> 2) + 4 * hh;
                    Vt[((size_t)((b * 4 + hd) * 64 + dv)) * NKEY + key] = f2bf(acc[mi][e] * rstd); }
            }
        }
    });
}
DEVI void mla_unit(const Params& p, int au, char* lds) {
    const int tid = tidx(), lane = tid & 63, w = tid >> 6, l31 = lane & 31, hh = lane >> 5;
    const bool isctx = au >= 512;
    int b, h, qb;
    if (!isctx) { b = au >> 6; h = (au >> 4) & 3; qb = au & 15; } else { b = (au - 512) >> 2; h = (au - 512) & 3; qb = 16; }
    const int q0 = qb * 256 + w * 32 + l31;
    const bf16_t* Qp = (const bf16_t*)(p.ws + OFF_Q) + ((size_t)((b * 4 + h) * NKEY + q0)) * 96 + 8 * hh;
    bf16x8 qf[6];
#pragma unroll
    for (int ks = 0; ks < 6; ++ks) qf[ks] = *(const bf16x8*)(Qp + ks * 16);
    const bf16_t* kb = (const bf16_t*)(p.ws + OFF_K) + (size_t)((b * 4 + h) * NKEY) * 96;
    const bf16_t* vb = (const bf16_t*)(p.ws + OFF_VT) + (size_t)((b * 4 + h) * 64) * NKEY;
    const int jt0 = isctx ? 64 : 0, ntl = isctx ? 4 : 68;
    auto tf = [&](int j) { KVTile t; t.k = kb + (size_t)(jt0 + j) * 64 * 96; t.vt = vb + (jt0 + j) * 64; return t; };
    f32x16 o[2]; float ls;
    attn_core<96, false>(qf, ntl, tf, 96, NKEY, 0, 0, 0, 0, nullptr, o, ls, lds);
    const int row = isctx ? TL + b * 256 + w * 32 + l31 : b * 4096 + q0;
    attn_store(o, ls, (bf16_t*)(p.ws + OFF_BR) + (size_t)row * DM + h * 64);
}

DEVI void ytrans_unit(const Params& p, int tu, char* lds) {
    const int tid = tidx();
    const int b = tu / 68, kt = tu % 68, key0 = kt * 64;
    const int row0 = kt < 64 ? b * 4096 + key0 : TL + b * 256 + (key0 - 4096);
    const bf16_t* yT = (const bf16_t*)(p.ws + OFF_YT) + (size_t)(b * 256) * NKEY + key0;
    bf16_t* br = (bf16_t*)(p.ws + OFF_BR);
    bf16_t* tl = (bf16_t*)lds;
    __syncthreads();
#pragma unroll
    for (int i = 0; i < 4; ++i) { const int cidx = tid + 512 * i, ch = cidx >> 3, kc = (cidx & 7) * 8; *(u32x4*)(tl + ch * 72 + kc) = *(const u32x4*)(yT + (size_t)ch * NKEY + kc); }
    __syncthreads();
#pragma unroll
    for (int i = 0; i < 4; ++i) { const int cidx = tid + 512 * i, t = cidx >> 5, c8 = (cidx & 31) * 8;
        u32x4 o;
#pragma unroll
        for (int j = 0; j < 4; ++j) o[j] = (unsigned)tl[(c8 + 2 * j) * 72 + t] | ((unsigned)tl[(c8 + 2 * j + 1) * 72 + t] << 16);
        *(u32x4*)(br + (size_t)(row0 + t) * DM + 512 + c8) = o; }
}
DEVI float gelu_tanh(float x) { const float u = 0.7978845608028654f * (x + 0.044715f * x * x * x); return x * __builtin_amdgcn_rcpf(1.f + __expf(-2.f * u)); }
DEVI void lru_carry_unit(const Params& p, int l, int b) {
    const int tid = tidx(), c = tid & 255, d = tid >> 8;
    const float* SA = (const float*)(p.ws + OFF_SEGA) + (size_t)d * 1088 * 256; const float* SB = (const float*)(p.ws + OFF_SEGB) + (size_t)d * 1088 * 256;
    float* HIN = (float*)(p.ws + OFF_HIN) + (size_t)d * 1088 * 256;
    const int cbase = 1024 + 8 * b, lbase = 128 * b;
    float h = 0.f;
#pragma unroll 1
    for (int k0 = 0; k0 < 136; k0 += 17) {
        float sa[17], sbv[17];
#pragma unroll
        for (int i = 0; i < 17; ++i) { const int k = k0 + i; const int seg = d == 0 ? (k < 8 ? cbase + k : lbase + (k - 8)) : (k < 8 ? cbase + 7 - k : lbase + 135 - k);
            const size_t o = (size_t)seg * 256 + c; sa[i] = SA[o]; sbv[i] = SB[o]; }
        __builtin_amdgcn_sched_barrier(0);
#pragma unroll
        for (int i = 0; i < 17; ++i) { const int k = k0 + i; const int seg = d == 0 ? (k < 8 ? cbase + k : lbase + (k - 8)) : (k < 8 ? cbase + 7 - k : lbase + 135 - k);
            const size_t o = (size_t)seg * 256 + c;
            __hip_atomic_store(HIN + o, h, __ATOMIC_RELAXED, __HIP_MEMORY_SCOPE_AGENT);
            h = sa[i] * h + sbv[i]; }
        __builtin_amdgcn_sched_barrier(0);
    }
    asm volatile("s_waitcnt vmcnt(0)" ::: "memory");
    __syncthreads();
    if (tid == 0) __hip_atomic_store((unsigned*)(p.ws + OFF_GCNT) + 768 + l * 8 + b, 1u, __ATOMIC_RELAXED, __HIP_MEMORY_SCOPE_AGENT);
}
DEVI void lru2_unit(const Params& p, int l, int tt) {
    const int tid = tidx(), c = tid & 255, half = tid >> 8;
    const int s0 = tt * 4 + half * 2;
    const bool lat = s0 < 1024;
    const int b = lat ? (s0 >> 7) : ((s0 - 1024) >> 3);
    if (tid == 0) {
        unsigned* flag = (unsigned*)(p.ws + OFF_GCNT) + 768 + l * 8 + b; unsigned sp = 0;
        while (__hip_atomic_load(flag, __ATOMIC_RELAXED, __HIP_MEMORY_SCOPE_AGENT) == 0u && ++sp < (1u << 22)) __builtin_amdgcn_s_sleep(2);
    }
    __syncthreads();
    const float* HIN = (const float*)(p.ws + OFF_HIN);
    float hin[2][2];
#pragma unroll
    for (int d = 0; d < 2; ++d)
#pragma unroll
        for (int sgi = 0; sgi < 2; ++sgi) hin[d][sgi] = __hip_atomic_load(HIN + ((size_t)d * 1088 + s0 + sgi) * 256 + c, __ATOMIC_RELAXED, __HIP_MEMORY_SCOPE_AGENT);
    const bf16_t* hl = (const bf16_t*)(p.ws + OFF_HLOC); const bf16_t* ca = (const bf16_t*)(p.ws + OFF_CUMA);
    const bf16_t* z = (const bf16_t*)(p.ws + OFF_Z); bf16_t* br = (bf16_t*)(p.ws + OFF_BR);
#pragma unroll 1
    for (int t8 = 0; t8 < 8; ++t8) {
        const int sgi = t8 >> 2; const size_t row0 = (size_t)(s0 + sgi) * 32 + (t8 & 3) * 8;
        bf16_t a0[8], a1[8], a2[8], a3[8], a4[8];
#pragma unroll
        for (int i = 0; i < 8; ++i) { const size_t row = row0 + i;
            a0[i] = hl[row * 256 + c]; a1[i] = ca[row * 256 + c]; a2[i] = hl[((size_t)TT + row) * 256 + c]; a3[i] = ca[((size_t)TT + row) * 256 + c]; a4[i] = z[row * ZLD + ZC_LG + c]; }
        __builtin_amdgcn_sched_barrier(0);
        const float h0 = sgi ? hin[0][1] : hin[0][0], h1 = sgi ? hin[1][1] : hin[1][0];
#pragma unroll
        for (int i = 0; i < 8; ++i) { const size_t row = row0 + i;
            const float hf = bf2f(a0[i]) + bf2f(a1[i]) * h0, hr = bf2f(a2[i]) + bf2f(a3[i]) * h1;
            br[row * DM + 768 + c] = f2bf((hf + hr) * gelu_tanh(bf2f(a4[i]))); }
        __builtin_amdgcn_sched_barrier(0);
    }
}
DEVI void pbranch_unit(const Params& p, int u, char* lds) {
    const int mt = u >> 3, g = (u >> 1) & 3, nh = u & 1;
    const int tid = tidx(), lane = tid & 63, w = tid >> 6, wm = w >> 1, wn = w & 1, l31 = lane & 31, hh = lane >> 5;
    const int row0 = mt_row0(mt);
    K256A a;
    k256_load_a(a, (const bf16_t*)(p.ws + OFF_BR) + g * 256, DM, row0, lds);
    bf16_t* P = (bf16_t*)(p.ws + (g < 2 ? OFF_PLO : OFF_PHI)) + (size_t)(g & 1) * 1024 + nh * 512;
    bf16_t* slab = (bf16_t*)(lds + 2 * K2_BUF) + w * (64 * 40);
    k256_stream(a, (const bf16_t*)(p.ws + OFF_WBR) + (size_t)(g * 1024 + nh * 512) * 256, 8, lds, [&](int j, const f32x16 (&acc)[2]) __attribute__((always_inline)) {
#pragma unroll
        for (int mi = 0; mi < 2; ++mi)
#pragma unroll
            for (int q = 0; q < 4; ++q) { uint2 o; o.x = pk2(acc[mi][4 * q], acc[mi][4 * q + 1]); o.y = pk2(acc[mi][4 * q + 2], acc[mi][4 * q + 3]);
                *(uint2*)(slab + (mi * 32 + l31) * 40 + 8 * q + 4 * hh) = o; }
        asm volatile("s_waitcnt lgkmcnt(0)" ::: "memory");
#pragma unroll
        for (int it = 0; it < 4; ++it) {
            const int r64 = it * 16 + (lane >> 2);
            const u32x4 v = *(const u32x4*)(slab + r64 * 40 + (lane & 3) * 8);
            *(u32x4*)(P + (size_t)(row0 + wm * 64 + r64) * 2048 + j * 64 + wn * 32 + (lane & 3) * 8) = v;
        }
        asm volatile("s_waitcnt lgkmcnt(0)" ::: "memory");
    });
}
DEVI void router_unit(const Params& p, int l, int r0, int r1, char* lds) {
    const int tid = tidx(), lane = tid & 63, w = tid >> 6, wm = w >> 1, wn = w & 1, l31 = lane & 31, hh = lane >> 5;
    const int nrows = r1 - r0;
    norm_rows(p, l, r0, r1, 1);
    asm volatile("s_waitcnt vmcnt(0)" ::: "memory");
    __syncthreads();
    const RowLoader al = make_rows((const bf16_t*)(p.ws + OFF_H), DM, r0);
    f32x16 acc[2][1];
    gemm_mainloop<true, 1>(acc, al, (const bf16_t*)(p.ws + OFF_RT), 1024, 1024, lds);
    float* lg = (float*)lds;
    int* cnt_l = (int*)(lds + 256 * 65 * 4);
    int* base_g = cnt_l + 64;
#pragma unroll
    for (int mi = 0; mi < 2; ++mi)
#pragma unroll
        for (int e = 0; e < 16; ++e) lg[(wm * 64 + mi * 32 + l31) * 65 + wn * 32 + (e & 3) + 8 * (e >> 2) + 4 * hh] = sigmoidf_(acc[mi][0][e]);
    float* rbs = (float*)(base_g + 64);
    if (tid < 64) { cnt_l[tid] = 0; rbs[tid] = p.in[I_RB][l * 64 + tid]; }
    __syncthreads();
    int se[6], spos[6]; float swt[6];
    if (tid < nrows) {
        const float* rb = rbs;
        float* my = lg + tid * 65;
        float ssum = 0.f;
#pragma unroll
        for (int k = 0; k < 6; ++k) {
            float best = -1e30f; int bi = 0;
#pragma unroll 8
            for (int e = 0; e < 64; ++e) { const float s = my[e] + rb[e]; if (s > best) { best = s; bi = e; } }
            const float sc = my[bi];
            se[k] = bi; swt[k] = sc; ssum += sc; my[bi] = -1e30f;
        }
        const float nrm = 2.5f / ssum;
#pragma unroll
        for (int k = 0; k < 6; ++k) { swt[k] *= nrm; spos[k] = atomicAdd(&cnt_l[se[k]], 1); }
    }
    __syncthreads();
    if (tid < 64) base_g[tid] = (int)__hip_atomic_fetch_add((unsigned*)(p.ws + OFF_GCNT) + l * 64 + tid, (unsigned)cnt_l[tid], __ATOMIC_RELAXED, __HIP_MEMORY_SCOPE_AGENT);
    __syncthreads();
    if (tid < nrows) {
        const int r = r0 + tid;
        int* list = (int*)(p.ws + OFF_LIST); unsigned* toks = (unsigned*)(p.ws + OFF_TOKS); float* wts = (float*)(p.ws + OFF_WTS);
#pragma unroll
        for (int k = 0; k < 6; ++k) { const int pos = base_g[se[k]] + spos[k]; list[(size_t)se[k] * TT + pos] = r; toks[(size_t)r * 6 + k] = ((unsigned)se[k] << 16) | (unsigned)pos; wts[(size_t)r * 6 + k] = swt[k]; }
    }
}
struct MoeTab { int* cnt; int* blkbase; int* cbase; };
DEVI MoeTab moe_tables(const Params& p, int l, int nact, char* lds) {
    MoeTab t; t.cnt = (int*)(lds + LDS_BYTES - 4096); t.blkbase = t.cnt + 80; t.cbase = t.blkbase + 80;
    __syncthreads();
    if (tidx() < 64) t.cnt[tidx()] = (int)__hip_atomic_load((unsigned*)(p.ws + OFF_GCNT) + l * 64 + tidx(), __ATOMIC_RELAXED, __HIP_MEMORY_SCOPE_AGENT);
    __syncthreads();
    if (tidx() == 0) {
        int bb = 0, cb = 0;
        for (int e = 0; e < 64; ++e) { const int c = t.cnt[e]; t.blkbase[e] = bb; t.cbase[e] = cb; bb += (c + 255) >> 8; cb += c; }
        t.cnt[64] = nact; t.blkbase[64] = bb; t.cbase[64] = cb; t.blkbase[65] = bb + (nact >> 8);
    }
    __syncthreads();
    {
        unsigned char* eb = (unsigned char*)(t.cbase + 80);
        const int nrb = t.blkbase[65];
        for (int rb = tidx(); rb < nrb; rb += 512) { int e = 0; while (e < 64 && rb >= t.blkbase[e + 1]) ++e; eb[rb] = (unsigned char)e; }
    }
    __syncthreads();
    return t;
}
DEVI int find_expert(const MoeTab& t, int rb) { return (int)((const unsigned char*)(t.cbase + 80))[rb]; }
DEVI void moe2_unit(const Params& p, int l, const MoeTab& t, int rb, char* lds) {
    const int tid = tidx(), lane = tid & 63, w = tid >> 6, wm = w >> 1, wn = w & 1, l31 = lane & 31, hh = lane >> 5;
    const int e = find_expert(t, rb), i0 = (rb - t.blkbase[e]) * 256, cnt = t.cnt[e], cbe = t.cbase[e];
    K256A a;
    k256_load_a(a, (const bf16_t*)(p.ws + OFF_HID), 256, rb * 256, lds);
    const bf16_t* Bt = (const bf16_t*)(p.ws + OFF_WDT) + (size_t)e * 1024 * 256;
    if (e < 64) {
        bf16_t* Y = (bf16_t*)(p.ws + OFF_Y);
        bf16_t* slab = (bf16_t*)(lds + 2 * K2_BUF) + w * (64 * 40);
        bf16_t* trash = (bf16_t*)(p.ws + OFF_SEGA + (size_t)blockIdx.x * 8192 + (size_t)tid * 16);
        k256_stream(a, Bt, 16, lds, [&](int j, const f32x16 (&acc)[2]) __attribute__((always_inline)) {
#pragma unroll
            for (int mi = 0; mi < 2; ++mi)
#pragma unroll
                for (int g = 0; g < 4; ++g) { uint2 o; o.x = pk2(acc[mi][4 * g], acc[mi][4 * g + 1]); o.y = pk2(acc[mi][4 * g + 2], acc[mi][4 * g + 3]);
                    *(uint2*)(slab + (mi * 32 + l31) * 40 + 8 * g + 4 * hh) = o; }
            asm volatile("s_waitcnt lgkmcnt(0)" ::: "memory");
#pragma unroll
            for (int it = 0; it < 4; ++it) {
                const int r64 = it * 16 + (lane >> 2), ii = i0 + wm * 64 + r64;
                const u32x4 v = *(const u32x4*)(slab + r64 * 40 + (lane & 3) * 8);
                *(u32x4*)(ii < cnt ? Y + (size_t)(cbe + ii) * DM + j * 64 + wn * 32 + (lane & 3) * 8 : trash) = v;
            }
            asm volatile("s_waitcnt lgkmcnt(0)" ::: "memory");
        });
    } else {
        const float* g2b = (const float*)(p.ws + OFF_MOD) + (size_t)l * 9 * 6144 + 5120 + (size_t)row_mod(i0) * 6144;
        bf16_t* slab = (bf16_t*)(lds + 2 * K2_BUF) + w * (64 * 40);
        k256_stream(a, Bt, 16, lds, [&](int j, const f32x16 (&acc)[2]) __attribute__((always_inline)) {
#pragma unroll
            for (int mi = 0; mi < 2; ++mi)
#pragma unroll
                for (int g = 0; g < 4; ++g) { uint2 o; o.x = pk2(acc[mi][4 * g], acc[mi][4 * g + 1]); o.y = pk2(acc[mi][4 * g + 2], acc[mi][4 * g + 3]);
                    *(uint2*)(slab + (mi * 32 + l31) * 40 + 8 * g + 4 * hh) = o; }
            const int c0 = j * 64 + wn * 32 + (lane & 3) * 8;
            const float4 ga = *(const float4*)(g2b + c0), gb = *(const float4*)(g2b + c0 + 4);
            asm volatile("s_waitcnt lgkmcnt(0)" ::: "memory");
#pragma unroll
            for (int h2 = 0; h2 < 2; ++h2) {
                float4 xa[2], xb[2];
#pragma unroll
                for (int i2 = 0; i2 < 2; ++i2) { const int r64 = (h2 * 2 + i2) * 16 + (lane >> 2); const float* xr = xdst(p, i0 + wm * 64 + r64) + c0; xa[i2] = *(const float4*)xr; xb[i2] = *(const float4*)(xr + 4); }
                __builtin_amdgcn_sched_barrier(0);
#pragma unroll
                for (int i2 = 0; i2 < 2; ++i2) { const int r64 = (h2 * 2 + i2) * 16 + (lane >> 2); float* xr = xdst(p, i0 + wm * 64 + r64) + c0;
                    const u32x4 v = *(const u32x4*)(slab + r64 * 40 + (lane & 3) * 8);
                    float4 oa = xa[i2], ob = xb[i2];
                    oa.x += ga.x * lo_bf(v[0]); oa.y += ga.y * hi_bf(v[0]); oa.z += ga.z * lo_bf(v[1]); oa.w += ga.w * hi_bf(v[1]);
                    ob.x += gb.x * lo_bf(v[2]); ob.y += gb.y * hi_bf(v[2]); ob.z += gb.z * lo_bf(v[3]); ob.w += gb.w * hi_bf(v[3]);
                    *(float4*)xr = oa; *(float4*)(xr + 4) = ob; }
                __builtin_amdgcn_sched_barrier(0);
            }
            asm volatile("s_waitcnt lgkmcnt(0)" ::: "memory");
        });
    }
}
DEVI void combine_unit(const Params& p, int l, const MoeTab& t, int r0, int r1) {
    const int lane = tidx() & 63, w = tidx() >> 6;
    const float* mod = (const float*)(p.ws + OFF_MOD);
    const bf16_t* Y = (const bf16_t*)(p.ws + OFF_Y);
    const unsigned* toks = (const unsigned*)(p.ws + OFF_TOKS); const float* wts = (const float*)(p.ws + OFF_WTS);
#pragma unroll 2
    for (int r = r0 + w; r < r1; r += 8) {
        float* xd = xdst(p, r);
        const float* g2 = mod + (size_t)(l * 9 + row_mod(r)) * 6144 + 5120;
        const bf16_t* yr[6]; float wk[6];
#pragma unroll
        for (int k = 0; k < 6; ++k) { const unsigned v = toks[(size_t)r * 6 + k]; yr[k] = Y + (size_t)(t.cbase[v >> 16] + (int)(v & 0xffffu)) * DM; wk[k] = wts[(size_t)r * 6 + k]; }
        float4 xo[4]; float ss = 0.f;
#pragma unroll
        for (int q = 0; q < 4; ++q) {
            const int k0 = 4 * lane + 256 * q;
            float f0 = 0.f, f1 = 0.f, f2 = 0.f, f3 = 0.f;
#pragma unroll
            for (int k = 0; k < 6; ++k) { const uint2 yv = *(const uint2*)(yr[k] + k0); f0 += wk[k] * lo_bf(yv.x); f1 += wk[k] * hi_bf(yv.x); f2 += wk[k] * lo_bf(yv.y); f3 += wk[k] * hi_bf(yv.y); }
            float4 xv = *(const float4*)(xd + k0); const float4 gv = *(const float4*)(g2 + k0);
            xv.x += gv.x * f0; xv.y += gv.y * f1; xv.z += gv.z * f2; xv.w += gv.w * f3;
            xo[q] = xv; ss += xv.x * xv.x + xv.y * xv.y + xv.z * xv.z + xv.w * xv.w;
        }
        if (l == 1) {
            ss = wave_sum(ss);
            const float rstd = rsqrtf(ss * (1.f / 1024.f) + 1e-6f);
#pragma unroll
            for (int q = 0; q < 4; ++q) { const int k0 = 4 * lane + 256 * q; const float4 gf = *(const float4*)(p.in[I_GF] + k0);
                float4 o; o.x = xo[q].x * rstd * gf.x; o.y = xo[q].y * rstd * gf.y; o.z = xo[q].z * rstd * gf.z; o.w = xo[q].w * rstd * gf.w; *(float4*)(xd + k0) = o; }
        } else {
#pragma unroll
            for (int q = 0; q < 4; ++q) *(float4*)(xd + 4 * lane + 256 * q) = xo[q];
        }
    }
}


namespace pg8 {
#define PG8_LAS __attribute__((address_space(3)))
typedef unsigned short bf16_t;
typedef short bf16x8 __attribute__((ext_vector_type(8)));
typedef float f32x4 __attribute__((ext_vector_type(4)));
typedef unsigned u32x4 __attribute__((ext_vector_type(4)));
typedef int i32x4 __attribute__((ext_vector_type(4)));
typedef int i32x8 __attribute__((ext_vector_type(8)));
constexpr int BM = 256, BK = 64, HALF = 128, HTB = HALF * BK * 2  , STAGE_BYTES = 8 * HTB, NXCD = 8, WGM = 8;

__host__ __device__ __forceinline__ int lds_byte(int r, int c) { const int st = (r >> 4) * 2 + (c >> 5), rr = r & 15, cc = c & 31, ob = rr * 64 + cc * 2; return st * 1024 + (ob ^ (((ob >> 9) & 1) << 5)); }
__host__ __device__ __forceinline__ void stage_rc(int b, int& R, int& C) { const int st = b / 1024, sb = b % 1024, swz = sb ^ (((sb >> 9) & 1) << 5); R = (st >> 1) * 16 + swz / 64; C = (st & 1) * 32 + (swz % 64) / 2; }
__host__ __device__ __forceinline__ int perm32(int rho) { const int n = rho >> 4, i = rho & 15; return 8 * (i >> 2) + 4 * n + (i & 3); }

struct Unit { int pm, pn; };
struct Gemm { const bf16_t* A; const bf16_t* Bt; int M, N, K; };

struct StaticOrder {
    int nM, nN, nwg, G, c;
    __host__ __device__ void init(int M, int N, int G_, int c_) { nM = M / BM; nN = N / BM; nwg = nM * nN; G = G_; c = c_; }
    __host__ __device__ bool next(int i, Unit& u) const {
        const long L = (long)i * G + c; if (L >= nwg) return false;
        int wgid = (int)L; { const int q = nwg / NXCD, r = nwg % NXCD, xcd = wgid % NXCD, off = wgid / NXCD; wgid = (xcd < r ? xcd * (q + 1) : r * (q + 1) + (xcd - r) * q) + off; }
        const int nig = WGM * nN, gid = wgid / nig, fm = gid * WGM, gsz = (nM - fm) < WGM ? (nM - fm) : WGM;
        u.pm = fm + ((wgid % nig) % gsz); u.pn = (wgid % nig) / gsz; return true;
    }
    __device__ __forceinline__ void a_ready(const Unit&) const {}
    __device__ __forceinline__ void done(const Unit&) const {}
};
template <class Epi, class Sched, bool STAMP = false, bool F8 = false>
__device__ __forceinline__ void gemm_phase(PG8_LAS unsigned char* lds, const Gemm g, const Sched& S, const Epi& E, unsigned long long* stamps) {
    const int tid = threadIdx.x, wid = __builtin_amdgcn_readfirstlane(tid >> 6), lane = tid & 63, wr = wid >> 2, wc = wid & 3, fr = lane & 15, fq = lane >> 4;
    int K = g.K; if constexpr (F8) asm volatile("" : "+s"(K));
    const int nt = K / BK;
    int ts_lo = 0, ts_hi = 0, nts = 0; const unsigned long long rt_entry = STAMP ? (unsigned long long)wall_clock64() : 0ull;
#define PG8_STAMP() do { if (STAMP && wid == 0 && nts < 64) { const unsigned long long _c = (unsigned long long)clock64(); \
        ts_lo = (lane == nts) ? (int)(unsigned)_c : ts_lo; ts_hi = (lane == nts) ? (int)(unsigned)(_c >> 32) : ts_hi; ++nts; } } while (0)
    PG8_STAMP();
    unsigned voffA[2], voffB[2];
#pragma unroll
    for (int i = 0; i < 2; ++i) { int R, C; stage_rc(tid * 16 + i * 8192, R, C); const int Rb = Epi::PERM ? ((R & ~31) + perm32(R & 31)) : R;
        voffA[i] = (unsigned)(R * K + C) * 2u; voffB[i] = (unsigned)(Rb * K + C) * 2u; }
    const size_t kstep = (size_t)(BK * 2);
    const size_t hstep = (size_t)HALF * K * 2;
    const size_t tstep = 2 * hstep;
    const unsigned ldsw = (unsigned)wid * 1024u;
    const int aoff = lds_byte(wr * 64 + fr, fq * 8), boff = lds_byte(wc * 32 + fr, fq * 8);
#define PG8_SA(b, h) (((b) * 2 + (h)) * HTB)
#define PG8_SB(b, h) ((4 + (b) * 2 + (h)) * HTB)
#define PG8_STAGE(bufoff, gbase, voff) do { _Pragma("unroll") for (int _i = 0; _i < 2; ++_i) \
        __builtin_amdgcn_global_load_lds((const unsigned*)((const char*)(gbase) + (voff)[_i]), (PG8_LAS unsigned*)(lds + (bufoff) + ldsw + _i * 8192), 16, 0, 0); } while (0)
#define PG8_CAT(x, y) __builtin_shufflevector(x, y, 0, 1, 2, 3, 4, 5, 6, 7)
#define PG8_LDA(dst, b, h) do { _Pragma("unroll") for (int m = 0; m < 4; ++m) { \
        if constexpr (F8) dst##8[m] = PG8_CAT(*(const PG8_LAS i32x4*)(lds + PG8_SA(b, h) + aoff + m * 2048), *(const PG8_LAS i32x4*)(lds + PG8_SA(b, h) + aoff + m * 2048 + 1024)); \
        else { _Pragma("unroll") for (int k = 0; k < 2; ++k) dst[m][k] = *(const PG8_LAS bf16x8*)(lds + PG8_SA(b, h) + aoff + m * 2048 + k * 1024); } } } while (0)
#define PG8_LDB(dst, b, h) do { _Pragma("unroll") for (int n = 0; n < 2; ++n) { \
        if constexpr (F8) dst##8[n] = PG8_CAT(*(const PG8_LAS i32x4*)(lds + PG8_SB(b, h) + boff + n * 2048), *(const PG8_LAS i32x4*)(lds + PG8_SB(b, h) + boff + n * 2048 + 1024)); \
        else { _Pragma("unroll") for (int k = 0; k < 2; ++k) dst[n][k] = *(const PG8_LAS bf16x8*)(lds + PG8_SB(b, h) + boff + n * 2048 + k * 1024); } } } while (0)
#define PG8_MMA(ai, bj, At, Bt) do { __builtin_amdgcn_s_setprio(1); _Pragma("unroll") for (int m = 0; m < 4; ++m) _Pragma("unroll") for (int n = 0; n < 2; ++n) { \
        if constexpr (F8) asm volatile("v_mfma_scale_f32_16x16x128_f8f6f4 %0, %1, %2, %0, %3, %3 op_sel_hi:[0,0,0]" : "+v"(acc[ai][bj][m][n]) : "v"(Bt##8[n]), "v"(At##8[m]), "v"(sc8)); \
        else { _Pragma("unroll") for (int k = 0; k < 2; ++k) acc[ai][bj][m][n] = __builtin_amdgcn_mfma_f32_16x16x32_bf16(Bt[n][k], At[m][k], acc[ai][bj][m][n], 0, 0, 0); } } __builtin_amdgcn_s_setprio(0); } while (0)
#define PG8_WAIT_V(n) asm volatile("s_waitcnt vmcnt(" #n ")" ::: "memory")
#define PG8_WAIT_L(n) asm volatile("s_waitcnt lgkmcnt(" #n ")" ::: "memory")
#define PG8_BAR __builtin_amdgcn_s_barrier()
#define PG8_SCHED __builtin_amdgcn_sched_barrier(0)
    Unit cur, nxt; int ui = 0;
    if (!S.next(0, cur)) return;
    f32x4 acc[2][2][4][2];
#pragma unroll
    for (int a = 0; a < 2; ++a)
#pragma unroll
        for (int b = 0; b < 2; ++b)
#pragma unroll
            for (int m = 0; m < 4; ++m)
#pragma unroll
                for (int n = 0; n < 2; ++n) acc[a][b][m][n] = (f32x4){0.f, 0.f, 0.f, 0.f};
    bf16x8 At[4][2], B0[2][2], B1[2][2];
    i32x8 At8[4], B08[2], B18[2];
    int sc8 = 0x7F7F7F7F; asm volatile("" : "+v"(sc8));
    const char* cA = (const char*)g.A + (size_t)cur.pm * tstep; const char* cB = (const char*)g.Bt + (size_t)cur.pn * tstep;
    S.a_ready(cur);
    PG8_STAGE(PG8_SB(0, 0), cB, voffB); PG8_STAGE(PG8_SA(0, 0), cA, voffA); PG8_STAGE(PG8_SB(0, 1), cB + hstep, voffB); PG8_STAGE(PG8_SA(0, 1), cA + hstep, voffA);
    if (wr == 1) PG8_BAR;
    PG8_WAIT_V(4); PG8_BAR;
    PG8_STAGE(PG8_SB(1, 0), cB + kstep, voffB); PG8_STAGE(PG8_SA(1, 0), cA + kstep, voffA); PG8_STAGE(PG8_SB(1, 1), cB + hstep + kstep, voffB);
    PG8_WAIT_V(6); PG8_BAR;
    PG8_STAMP();
    for (;;) {
        const bool has_next = S.next(ui + 1, nxt);
        const char* nA = has_next ? (const char*)g.A + (size_t)nxt.pm * tstep : cA; const char* nB = has_next ? (const char*)g.Bt + (size_t)nxt.pn * tstep : cB;
        for (int t = 0; t < nt; t += 2) {
            const bool last = (t == nt - 2);
            const char* a1 = cA + (size_t)(t + 1) * kstep;
            const char* a2 = last ? nA : cA + (size_t)(t + 2) * kstep; const char* b2 = last ? nB : cB + (size_t)(t + 2) * kstep;
            const char* a3 = a2 + kstep; const char* b3 = b2 + kstep;
            if (last && has_next) S.a_ready(nxt);
            PG8_LDB(B0, 0, 0); PG8_SCHED; PG8_LDA(At, 0, 0); PG8_STAGE(PG8_SA(1, 1), a1 + hstep, voffA);
            PG8_WAIT_L(8); PG8_BAR; PG8_WAIT_L(0); PG8_MMA(0, 0, At, B0); PG8_BAR; PG8_SCHED;
            PG8_LDB(B1, 0, 1); PG8_STAGE(PG8_SB(0, 0), b2, voffB);
            PG8_BAR; PG8_WAIT_L(0); PG8_MMA(0, 1, At, B1); PG8_BAR;
            PG8_LDA(At, 0, 1); PG8_STAGE(PG8_SA(0, 0), a2, voffA);
            PG8_BAR; PG8_WAIT_L(0); PG8_MMA(1, 0, At, B0); PG8_BAR; PG8_SCHED;
            PG8_STAGE(PG8_SB(0, 1), b2 + hstep, voffB);
            PG8_WAIT_V(6); PG8_BAR; PG8_MMA(1, 1, At, B1); PG8_BAR;
            PG8_LDB(B0, 1, 0); PG8_SCHED; PG8_LDA(At, 1, 0); PG8_STAGE(PG8_SA(0, 1), a2 + hstep, voffA);
            PG8_WAIT_L(8); PG8_BAR; PG8_WAIT_L(0); PG8_MMA(0, 0, At, B0); PG8_BAR; PG8_SCHED;
            PG8_LDB(B1, 1, 1); PG8_STAGE(PG8_SB(1, 0), b3, voffB);
            PG8_BAR; PG8_WAIT_L(0); PG8_MMA(0, 1, At, B1); PG8_BAR;
            PG8_LDA(At, 1, 1); PG8_STAGE(PG8_SA(1, 0), a3, voffA);
            PG8_BAR; PG8_WAIT_L(0); PG8_MMA(1, 0, At, B0); PG8_BAR; PG8_SCHED;
            PG8_STAGE(PG8_SB(1, 1), b3 + hstep, voffB);
            PG8_WAIT_V(6); PG8_BAR; PG8_MMA(1, 1, At, B1); PG8_BAR;
        }
        if constexpr (F8) asm volatile("s_nop 15\n\ts_nop 15" ::: "memory");
        PG8_STAMP();
        if constexpr (!Epi::AFTER_DRAIN) { E(acc, cur, wr, wc, fr, fq); S.done(cur); }
        PG8_STAMP();
        if (!has_next) break;
#pragma unroll
        for (int a = 0; a < 2; ++a)
#pragma unroll
            for (int b = 0; b < 2; ++b)
#pragma unroll
                for (int m = 0; m < 4; ++m)
#pragma unroll
                    for (int n = 0; n < 2; ++n) acc[a][b][m][n] = (f32x4){0.f, 0.f, 0.f, 0.f};
        cur = nxt; cA = nA; cB = nB; ++ui;
    }
    PG8_WAIT_V(0);
    if (wr == 0) PG8_BAR;
    PG8_BAR;
    if constexpr (Epi::AFTER_DRAIN) { E.fused(acc, cur, wr, wc, fr, fq, lds, wid, lane); S.done(cur); }
    PG8_STAMP();
    if (STAMP && wid == 0) { stamps[lane] = lane < nts ? (((unsigned long long)(unsigned)ts_hi << 32) | (unsigned)ts_lo) : 0ull;
        if (lane == 62) stamps[62] = rt_entry; if (lane == 63) stamps[63] = (unsigned long long)wall_clock64(); }
#undef PG8_STAMP
#undef PG8_SA
#undef PG8_SB
#undef PG8_STAGE
#undef PG8_LDA
#undef PG8_LDB
#undef PG8_MMA
#undef PG8_CAT
#undef PG8_WAIT_V
#undef PG8_WAIT_L
#undef PG8_BAR
#undef PG8_SCHED
}
template <class Epi, class Sched, bool STAMP = false>
__device__ __forceinline__ void gemm_phase_gather(PG8_LAS unsigned char* lds, const Gemm g, const Sched& S, const Epi& E, unsigned long long* stamps) {
    const int tid = threadIdx.x, wid = __builtin_amdgcn_readfirstlane(tid >> 6), lane = tid & 63, wr = wid >> 2, wc = wid & 3, fr = lane & 15, fq = lane >> 4;
    const int K = g.K, nt = K / BK;
    int ts_lo = 0, ts_hi = 0, nts = 0; const unsigned long long rt_entry = STAMP ? (unsigned long long)wall_clock64() : 0ull;
#define PG8_STAMP() do { if (STAMP && wid == 0 && nts < 64) { const unsigned long long _c = (unsigned long long)clock64(); \
        ts_lo = (lane == nts) ? (int)(unsigned)_c : ts_lo; ts_hi = (lane == nts) ? (int)(unsigned)(_c >> 32) : ts_hi; ++nts; } } while (0)
    PG8_STAMP();
    unsigned voffA[2], voffB[2];
#pragma unroll
    for (int i = 0; i < 2; ++i) { int R, C; stage_rc(tid * 16 + i * 8192, R, C); const int Rb = Epi::PERM ? ((R & ~31) + perm32(R & 31)) : R;
        voffA[i] = (unsigned)(R * K + C) * 2u; voffB[i] = (unsigned)(Rb * K + C) * 2u; }
    unsigned vc[2][2], vn[2][2];
    const char* gA = (const char*)g.A;
    const size_t kstep = (size_t)(BK * 2);
    const size_t hstep = (size_t)HALF * K * 2;
    const size_t tstep = 2 * hstep;
    const unsigned ldsw = (unsigned)wid * 1024u;
    const int aoff = lds_byte(wr * 64 + fr, fq * 8), boff = lds_byte(wc * 32 + fr, fq * 8);
#define PG8_SA(b, h) (((b) * 2 + (h)) * HTB)
#define PG8_SB(b, h) ((4 + (b) * 2 + (h)) * HTB)
#define PG8_STAGE(bufoff, gbase, voff) do { _Pragma("unroll") for (int _i = 0; _i < 2; ++_i) \
        __builtin_amdgcn_global_load_lds((const unsigned*)((const char*)(gbase) + (voff)[_i]), (PG8_LAS unsigned*)(lds + (bufoff) + ldsw + _i * 8192), 16, 0, 0); } while (0)
#define PG8_LDA(dst, b, h) do { _Pragma("unroll") for (int m = 0; m < 4; ++m) _Pragma("unroll") for (int k = 0; k < 2; ++k) dst[m][k] = *(const PG8_LAS bf16x8*)(lds + PG8_SA(b, h) + aoff + m * 2048 + k * 1024); } while (0)
#define PG8_LDB(dst, b, h) do { _Pragma("unroll") for (int n = 0; n < 2; ++n) _Pragma("unroll") for (int k = 0; k < 2; ++k) dst[n][k] = *(const PG8_LAS bf16x8*)(lds + PG8_SB(b, h) + boff + n * 2048 + k * 1024); } while (0)
#define PG8_MMA(ai, bj, At, Bt) do { __builtin_amdgcn_s_setprio(1); _Pragma("unroll") for (int m = 0; m < 4; ++m) _Pragma("unroll") for (int n = 0; n < 2; ++n) _Pragma("unroll") for (int k = 0; k < 2; ++k) \
        acc[ai][bj][m][n] = __builtin_amdgcn_mfma_f32_16x16x32_bf16(Bt[n][k], At[m][k], acc[ai][bj][m][n], 0, 0, 0); __builtin_amdgcn_s_setprio(0); } while (0)
#define PG8_WAIT_V(n) asm volatile("s_waitcnt vmcnt(" #n ")" ::: "memory")
#define PG8_WAIT_L(n) asm volatile("s_waitcnt lgkmcnt(" #n ")" ::: "memory")
#define PG8_BAR __builtin_amdgcn_s_barrier()
#define PG8_SCHED __builtin_amdgcn_sched_barrier(0)
    Unit cur, nxt; int ui = 0;
    if (!S.next(0, cur)) return;
    f32x4 acc[2][2][4][2];
#pragma unroll
    for (int a = 0; a < 2; ++a)
#pragma unroll
        for (int b = 0; b < 2; ++b)
#pragma unroll
            for (int m = 0; m < 4; ++m)
#pragma unroll
                for (int n = 0; n < 2; ++n) acc[a][b][m][n] = (f32x4){0.f, 0.f, 0.f, 0.f};
    bf16x8 At[4][2], B0[2][2], B1[2][2];
    const char* cA = (const char*)g.A + (size_t)cur.pm * tstep; const char* cB = S.bbase(g, cur, tstep);
    S.arows(cur, K, vc);
#pragma unroll
    for (int h_ = 0; h_ < 2; ++h_) { vn[h_][0] = vc[h_][0]; vn[h_][1] = vc[h_][1]; }
    PG8_STAGE(PG8_SB(0, 0), cB, voffB); PG8_STAGE(PG8_SA(0, 0), gA, vc[0]); PG8_STAGE(PG8_SB(0, 1), cB + hstep, voffB); PG8_STAGE(PG8_SA(0, 1), gA, vc[1]);
    if (wr == 1) PG8_BAR;
    PG8_WAIT_V(4); PG8_BAR;
    PG8_STAGE(PG8_SB(1, 0), cB + kstep, voffB); PG8_STAGE(PG8_SA(1, 0), gA + kstep, vc[0]); PG8_STAGE(PG8_SB(1, 1), cB + hstep + kstep, voffB);
    PG8_WAIT_V(6); PG8_BAR;
    PG8_STAMP();
    for (;;) {
        const bool has_next = S.next(ui + 1, nxt);
        const char* nA = has_next ? (const char*)g.A + (size_t)nxt.pm * tstep : cA; const char* nB = has_next ? S.bbase(g, nxt, tstep) : cB;
        for (int t = 0; t < nt; t += 2) {
            const bool last = (t == nt - 2);
            const char* a1 = gA + (size_t)(t + 1) * kstep;
            const char* a2 = last ? gA : gA + (size_t)(t + 2) * kstep; const char* b2 = last ? nB : cB + (size_t)(t + 2) * kstep;
            const char* a3 = a2 + kstep; const char* b3 = b2 + kstep;
            if (last && has_next) S.arows(nxt, K, vn);
            unsigned sel[2][2];
#pragma unroll
            for (int h_ = 0; h_ < 2; ++h_) { sel[h_][0] = last ? vn[h_][0] : vc[h_][0]; sel[h_][1] = last ? vn[h_][1] : vc[h_][1]; }
            PG8_LDB(B0, 0, 0); PG8_SCHED; PG8_LDA(At, 0, 0); PG8_STAGE(PG8_SA(1, 1), a1, vc[1]);
            PG8_WAIT_L(8); PG8_BAR; PG8_WAIT_L(0); PG8_MMA(0, 0, At, B0); PG8_BAR; PG8_SCHED;
            PG8_LDB(B1, 0, 1); PG8_STAGE(PG8_SB(0, 0), b2, voffB);
            PG8_BAR; PG8_WAIT_L(0); PG8_MMA(0, 1, At, B1); PG8_BAR;
            PG8_LDA(At, 0, 1); PG8_STAGE(PG8_SA(0, 0), a2, sel[0]);
            PG8_BAR; PG8_WAIT_L(0); PG8_MMA(1, 0, At, B0); PG8_BAR; PG8_SCHED;
            PG8_STAGE(PG8_SB(0, 1), b2 + hstep, voffB);
            PG8_WAIT_V(6); PG8_BAR; PG8_MMA(1, 1, At, B1); PG8_BAR;
            PG8_LDB(B0, 1, 0); PG8_SCHED; PG8_LDA(At, 1, 0); PG8_STAGE(PG8_SA(0, 1), a2, sel[1]);
            PG8_WAIT_L(8); PG8_BAR; PG8_WAIT_L(0); PG8_MMA(0, 0, At, B0); PG8_BAR; PG8_SCHED;
            PG8_LDB(B1, 1, 1); PG8_STAGE(PG8_SB(1, 0), b3, voffB);
            PG8_BAR; PG8_WAIT_L(0); PG8_MMA(0, 1, At, B1); PG8_BAR;
            PG8_LDA(At, 1, 1); PG8_STAGE(PG8_SA(1, 0), a3, sel[0]);
            PG8_BAR; PG8_WAIT_L(0); PG8_MMA(1, 0, At, B0); PG8_BAR; PG8_SCHED;
            PG8_STAGE(PG8_SB(1, 1), b3 + hstep, voffB);
            PG8_WAIT_V(6); PG8_BAR; PG8_MMA(1, 1, At, B1); PG8_BAR;
        }
        PG8_STAMP();
        if constexpr (!Epi::AFTER_DRAIN) { E(acc, cur, wr, wc, fr, fq); S.done(cur); }
        PG8_STAMP();
        if (!has_next) break;
#pragma unroll
        for (int a = 0; a < 2; ++a)
#pragma unroll
            for (int b = 0; b < 2; ++b)
#pragma unroll
                for (int m = 0; m < 4; ++m)
#pragma unroll
                    for (int n = 0; n < 2; ++n) acc[a][b][m][n] = (f32x4){0.f, 0.f, 0.f, 0.f};
        cur = nxt; cA = nA; cB = nB; ++ui;
#pragma unroll
        for (int h_ = 0; h_ < 2; ++h_) { vc[h_][0] = vn[h_][0]; vc[h_][1] = vn[h_][1]; }
    }
    PG8_WAIT_V(0);
    if (wr == 0) PG8_BAR;
    PG8_BAR;
    if constexpr (Epi::AFTER_DRAIN) { E.fused(acc, cur, wr, wc, fr, fq, lds, wid, lane); S.done(cur); }
    PG8_STAMP();
    if (STAMP && wid == 0) { stamps[lane] = lane < nts ? (((unsigned long long)(unsigned)ts_hi << 32) | (unsigned)ts_lo) : 0ull;
        if (lane == 62) stamps[62] = rt_entry; if (lane == 63) stamps[63] = (unsigned long long)wall_clock64(); }
#undef PG8_STAMP
#undef PG8_SA
#undef PG8_SB
#undef PG8_STAGE
#undef PG8_LDA
#undef PG8_LDB
#undef PG8_MMA
#undef PG8_WAIT_V
#undef PG8_WAIT_L
#undef PG8_BAR
#undef PG8_SCHED
}
}

struct EpiInproj {
    static constexpr bool PERM = false, AFTER_DRAIN = false;
    bf16_t* z; bf16_t* zT;
    __device__ __forceinline__ void operator()(const pg8::f32x4 (&acc)[2][2][4][2], const pg8::Unit& u, int wr, int wc, int fr, int fq) const {
        const int pm = u.pm, b = pm < 128 ? (pm >> 4) : (pm - 128), key0 = pm < 128 ? (pm & 15) * 256 : 4096, row0 = mt_row0(pm);
#pragma unroll
        for (int bj = 0; bj < 2; ++bj) {
            const int cb = u.pn * 256 + bj * 128;
            if (cb < ZLD) {
#pragma unroll
                for (int ai = 0; ai < 2; ++ai)
#pragma unroll
                    for (int m = 0; m < 4; ++m) { const int rl = ai * 128 + wr * 64 + m * 16 + fr;
#pragma unroll
                        for (int n = 0; n < 2; ++n) { const pg8::f32x4 v = acc[ai][bj][m][n]; uint2 o; o.x = pk2(v[0], v[1]); o.y = pk2(v[2], v[3]);
                            *(uint2*)(z + (size_t)(row0 + rl) * ZLD + cb + wc * 32 + n * 16 + fq * 4) = o; } }
            } else if (cb < NIN) {
#pragma unroll
                for (int ai = 0; ai < 2; ++ai)
#pragma unroll
                    for (int m = 0; m < 4; ++m) { const int rl = ai * 128 + wr * 64 + m * 16 + fr;
#pragma unroll
                        for (int n = 0; n < 2; ++n) { const pg8::f32x4 v = acc[ai][bj][m][n]; const int ch = cb - ZLD + wc * 32 + n * 16 + fq * 4;
                            bf16_t* d = zT + (size_t)(b * 1024 + ch) * NKEY + key0 + rl;
                            d[0] = f2bf(v[0]); d[NKEY] = f2bf(v[1]); d[2 * NKEY] = f2bf(v[2]); d[3 * NKEY] = f2bf(v[3]); } }
            }
        }
    }
};
struct EpiWout {
    static constexpr bool PERM = false, AFTER_DRAIN = false;
    const float* xs_lat; const float* xs_ctx; float* xd_lat; float* xd_ctx; const float* g1base;
    __device__ __forceinline__ void operator()(const pg8::f32x4 (&acc)[2][2][4][2], const pg8::Unit& u, int wr, int wc, int fr, int fq) const {
        const int row0 = mt_row0(u.pm);
        const float* xs = (row0 < TL ? xs_lat + (size_t)row0 * DM : xs_ctx + (size_t)(row0 - TL) * DM) + (size_t)(wr * 64 + fr) * DM + u.pn * 256 + wc * 32 + fq * 4;
        float* xd = (row0 < TL ? xd_lat + (size_t)row0 * DM : xd_ctx + (size_t)(row0 - TL) * DM) + (size_t)(wr * 64 + fr) * DM + u.pn * 256 + wc * 32 + fq * 4;
        const float* g1 = g1base + (size_t)row_mod(row0) * 6144 + u.pn * 256 + wc * 32 + fq * 4;
        float4 gv[2][2];
#pragma unroll
        for (int bj = 0; bj < 2; ++bj)
#pragma unroll
            for (int n = 0; n < 2; ++n) gv[bj][n] = *(const float4*)(g1 + bj * 128 + n * 16);
#pragma unroll
        for (int ai = 0; ai < 2; ++ai) {
            float4 xv[4][2][2];
#pragma unroll
            for (int m = 0; m < 4; ++m)
#pragma unroll
                for (int bj = 0; bj < 2; ++bj)
#pragma unroll
                    for (int n = 0; n < 2; ++n) xv[m][bj][n] = *(const float4*)(xs + (size_t)(ai * 128 + m * 16) * DM + bj * 128 + n * 16);
            __builtin_amdgcn_sched_barrier(0);
#pragma unroll
            for (int m = 0; m < 4; ++m)
#pragma unroll
                for (int bj = 0; bj < 2; ++bj)
#pragma unroll
                    for (int n = 0; n < 2; ++n) {
                        const pg8::f32x4 v = acc[ai][bj][m][n]; const float4 x4 = xv[m][bj][n], g4 = gv[bj][n];
                        float4 o; o.x = x4.x + g4.x * v[0]; o.y = x4.y + g4.y * v[1]; o.z = x4.z + g4.z * v[2]; o.w = x4.w + g4.w * v[3];
                        *(float4*)(xd + (size_t)(ai * 128 + m * 16) * DM + bj * 128 + n * 16) = o;
                    }
            __builtin_amdgcn_sched_barrier(0);
        }
    }
};

struct Moe1Order : pg8::StaticOrder {
    const unsigned char* eb; const int* blkbase; const int* cnt; const int* list;
    __device__ __forceinline__ const char* bbase(const pg8::Gemm& g, const pg8::Unit& u, size_t tstep) const { return (const char*)g.Bt + ((size_t)eb[u.pm] * 2 + u.pn) * tstep; }
    __device__ __forceinline__ void arows(const pg8::Unit& u, int K, unsigned (&vo)[2][2]) const {
        const int e = eb[u.pm], i0 = (u.pm - blkbase[e]) * 256, n_e = cnt[e];
        int lt[2][2];
#pragma unroll
        for (int h = 0; h < 2; ++h)
#pragma unroll
            for (int i = 0; i < 2; ++i) { int R, C; pg8::stage_rc((int)threadIdx.x * 16 + i * 8192, R, C);
                const int ii = i0 + h * 128 + R; lt[h][i] = list[(size_t)min(e, 63) * TT + min(ii, max(n_e - 1, 0))]; }
#pragma unroll
        for (int h = 0; h < 2; ++h)
#pragma unroll
            for (int i = 0; i < 2; ++i) { int R, C; pg8::stage_rc((int)threadIdx.x * 16 + i * 8192, R, C);
                const int ii = i0 + h * 128 + R; const int tok = e == 64 ? ii : (ii < n_e ? lt[h][i] : 0);
                vo[h][i] = (unsigned)(tok * K + C) * 2u; }
    }
};
struct EpiMoe1 {
    static constexpr bool PERM = false, AFTER_DRAIN = false;
    bf16_t* hid;
    __device__ __forceinline__ void operator()(const pg8::f32x4 (&acc)[2][2][4][2], const pg8::Unit& u, int wr, int wc, int fr, int fq) const {
#pragma unroll
        for (int ai = 0; ai < 2; ++ai)
#pragma unroll
            for (int m = 0; m < 4; ++m) { bf16_t* d = hid + ((size_t)u.pm * 256 + ai * 128 + wr * 64 + m * 16 + fr) * 256 + u.pn * 128 + 16 * wc + 4 * fq;
#pragma unroll
                for (int bj = 0; bj < 2; ++bj) { const pg8::f32x4 gt = acc[ai][bj][m][0], up = acc[ai][bj][m][1];
                    uint2 o; o.x = pk2(gt[0] * sigmoidf_(gt[0]) * up[0], gt[1] * sigmoidf_(gt[1]) * up[1]); o.y = pk2(gt[2] * sigmoidf_(gt[2]) * up[2], gt[3] * sigmoidf_(gt[3]) * up[3]);
                    *(uint2*)(d + 64 * bj) = o; } }
    }
};

struct EpiMerge {
    static constexpr bool PERM = false, AFTER_DRAIN = false;
    const bf16_t* plo; const bf16_t* phi; bf16_t* out; const float* rs;
    __device__ __forceinline__ void operator()(const pg8::f32x4 (&acc)[2][2][4][2], const pg8::Unit& u, int wr, int wc, int fr, int fq) const {
        const int row0 = mt_row0(u.pm) + wr * 64 + fr;
        const int col = u.pn * 64 + wc * 16 + fq * 4;
        uint2 pp[8][4]; float scv[8];
#pragma unroll
        for (int q = 0; q < 8; ++q) {
            const int row = row0 + (q >> 2) * 128 + (q & 3) * 16;
            pp[q][0] = *(const uint2*)(plo + (size_t)row * 2048 + col); pp[q][1] = *(const uint2*)(plo + (size_t)row * 2048 + 1024 + col);
            pp[q][2] = *(const uint2*)(phi + (size_t)row * 2048 + col); pp[q][3] = *(const uint2*)(phi + (size_t)row * 2048 + 1024 + col);
            scv[q] = rs[row];
        }
        __builtin_amdgcn_sched_barrier(0);
#pragma unroll
        for (int q = 0; q < 8; ++q) {
            const int ai = q >> 2, m = q & 3, row = row0 + ai * 128 + m * 16;
            const float sc = scv[q];
            float o0, o1, o2, o3;
            { const pg8::f32x4 v = acc[ai][0][m][0]; const uint2 pv = pp[q][0]; o0 = sigmoidf_(v[0] * sc) * lo_bf(pv.x); o1 = sigmoidf_(v[1] * sc) * hi_bf(pv.x); o2 = sigmoidf_(v[2] * sc) * lo_bf(pv.y); o3 = sigmoidf_(v[3] * sc) * hi_bf(pv.y); }
            { const pg8::f32x4 v = acc[ai][0][m][1]; const uint2 pv = pp[q][1]; o0 += sigmoidf_(v[0] * sc) * lo_bf(pv.x); o1 += sigmoidf_(v[1] * sc) * hi_bf(pv.x); o2 += sigmoidf_(v[2] * sc) * lo_bf(pv.y); o3 += sigmoidf_(v[3] * sc) * hi_bf(pv.y); }
            { const pg8::f32x4 v = acc[ai][1][m][0]; const uint2 pv = pp[q][2]; o0 += sigmoidf_(v[0] * sc) * lo_bf(pv.x); o1 += sigmoidf_(v[1] * sc) * hi_bf(pv.x); o2 += sigmoidf_(v[2] * sc) * lo_bf(pv.y); o3 += sigmoidf_(v[3] * sc) * hi_bf(pv.y); }
            { const pg8::f32x4 v = acc[ai][1][m][1]; const uint2 pv = pp[q][3]; o0 += sigmoidf_(v[0] * sc) * lo_bf(pv.x); o1 += sigmoidf_(v[1] * sc) * hi_bf(pv.x); o2 += sigmoidf_(v[2] * sc) * lo_bf(pv.y); o3 += sigmoidf_(v[3] * sc) * hi_bf(pv.y); }
            uint2 wv; wv.x = pk2(o0, o1); wv.y = pk2(o2, o3);
            *(uint2*)(out + (size_t)row * DM + col) = wv;
        }
    }
};
#define GEMM_TILE_LOOP(NM_, NN_, mt, nt, BODY) do { \
    const int _SN = ((NN_) + 3) >> 2, _SM = ((NM_) + 7) >> 3, _nx = (int)gridDim.x >> 3, _xcd = (int)blockIdx.x & 7; \
    if (((int)gridDim.x & 7) == 0) { \
        for (int _s = _xcd; _s < _SM * _SN; _s += 8) \
            for (int _jj = (int)blockIdx.x >> 3; _jj < 32; _jj += _nx) { \
                const int mt = (_s / _SN) * 8 + (_jj & 7), nt = (_s % _SN) * 4 + (_jj >> 3); \
                if (mt < (NM_) && nt < (NN_)) { BODY; } } \
    } else { for (int _u = (int)blockIdx.x; _u < (NM_) * (NN_); _u += (int)gridDim.x) { const int mt = _u / (NN_), nt = _u % (NN_); BODY; } } \
} while (0)
NOINL void f_p0() { const Params& p = kparams(); char* lds = lds_at(256); UNIT_LOOP(u, 320, 0) { if (u < 192) mod_unit(p, u, lds); else rope_unit(p, u - 192); } }
NOINL void f_norm1(int l) { const Params& p = kparams(); const int rpb = (TT + (int)gridDim.x - 1) / (int)gridDim.x, r0 = (int)blockIdx.x * rpb; norm_rows(p, l, r0, min(TT, r0 + rpb), 0); }
NOINL void f_conv(int l) {
    const Params& p = kparams(); char* lds = lds_at(256);
    const int G = (int)gridDim.x; int u = (int)((blockIdx.x + G - (544 % G)) % G);
    float4 va[4], vb[4];
    if (u < CJ_END) conv_unit<0>(p, l, u, lds, va);
    for (;;) {
        if (u >= CJ_END) break;
        { const int un = u + G; conv_unit<0>(p, l, un < CJ_END ? un : u, lds, vb); conv_unit<1>(p, l, u, lds, va); u = un; }
        if (u >= CJ_END) break;
        { const int un = u + G; conv_unit<0>(p, l, un < CJ_END ? un : u, lds, va); conv_unit<1>(p, l, u, lds, vb); u = un; }
    }
}
NOINL void f_h2tab(int l) { const Params& p = kparams(); char* lds = lds_at(256); UNIT_LOOP(u, 68, 544 + CJ_END) h2tab_unit(p, l, u, lds); }
NOINL void f_spectrum(int l) {
    const Params& p = kparams(); char* lds = lds_at(256);
    UNIT_LOOP(u, 512, 0) spectrum8192_unit(p, l, u >> 8, u & 255, lds);
}
NOINL void f_spectrum_ctx(int l) {
    const Params& p = kparams(); char* lds = lds_at(256);
    const int b0 = (int)gridDim.x >= 232 ? 200 : 0;
    for (int u = (int)blockIdx.x - b0; u >= 0 && u < 32; u += (int)gridDim.x) spectrum512_unit(p, l, u, lds);
}
NOINL void f_inproj(int off) {
    const Params& p = kparams();
    pg8::Gemm g{(const bf16_t*)(p.ws + OFF_H), (const bf16_t*)(p.ws + OFF_WIN), TT, WIN_G0, 1024};
    pg8::StaticOrder S; S.init(TT, WIN_G0, (int)gridDim.x, (int)blockIdx.x);
    EpiInproj E{(bf16_t*)(p.ws + OFF_Z), (bf16_t*)(p.ws + OFF_ZT)};
    __syncthreads();
    pg8::gemm_phase<EpiInproj, pg8::StaticOrder, false>((PG8_LAS unsigned char*)(uintptr_t)256, g, S, E, nullptr);
    __syncthreads();
}
NOINL void f_hyena(int l) { const Params& p = kparams(); char* lds = lds_at(256); const int n = l == 0 ? 1088 : 1024; UNIT_LOOP(u, n, 0) hyena_unit(p, l, u, lds); }
NOINL void f_na(int l, int off) { const Params& p = kparams(); char* lds = lds_at(256); const int n = l == 0 ? 544 : 512; UNIT_LOOP(u, n, off) na_unit(p, l, u, lds); }
NOINL void f_lru1(int l, int off) { const Params& p = kparams(); char* lds = lds_at(256); UNIT_LOOP(u, 1088, off) lru1_unit(p, l, u, lds); }
NOINL void f_qproj(int off) { const Params& p = kparams(); char* lds = lds_at(256); UNIT_LOOP(u, NMT * 2, off) qproj_unit(p, u, lds); }
NOINL void f_kvproj(int off) { const Params& p = kparams(); char* lds = lds_at(256); UNIT_LOOP(u, NMT * 2, off) kvproj_unit(p, u, lds); }
NOINL void f_mla(int l) { const Params& p = kparams(); char* lds = lds_at(256); const int n = l == 0 ? 544 : 512; UNIT_LOOP(u, n, 0) mla_unit(p, u, lds); }
NOINL void f_ytrans(int off) { const Params& p = kparams(); char* lds = lds_at(256); UNIT_LOOP(u, 544, off) ytrans_unit(p, u, lds); }
NOINL void f_lrucarry(int l) { const Params& p = kparams(); UNIT_LOOP(u, 8, 0) lru_carry_unit(p, l, u); }
NOINL void f_lru2(int l, int off) { const Params& p = kparams(); UNIT_LOOP(u, 272, off) lru2_unit(p, l, u); }
NOINL void f_quant(int nmt) {
    const Params& p = kparams(); const int rows = nmt * 256;
    int nb = (int)gridDim.x, b = (int)blockIdx.x;
    const int extra = nmt * 8 - (nmt * 8 / nb) * nb;
    if (extra > 0 && extra * 2 <= nb) { if (b < extra) return; b -= extra; nb -= extra; }
    const int rpb = (rows + nb - 1) / nb, r0 = b * rpb;
    quant_rows(p, r0, min(rows, r0 + rpb));
}
NOINL void f_pbranch(int nmt) { const Params& p = kparams(); char* lds = lds_at(256); UNIT_LOOP(u, nmt * 8, 0) pbranch_unit(p, u, lds); }
NOINL void f_merge(int nmt) {
    const Params& p = kparams();
    pg8::Gemm g{(const bf16_t*)(p.ws + OFF_H8), (const bf16_t*)(p.ws + OFF_WG8), nmt * 256, 4096, 512};
    pg8::StaticOrder S; S.init(nmt * 256, 4096, (int)gridDim.x, (int)blockIdx.x);
    EpiMerge E{(const bf16_t*)(p.ws + OFF_PLO), (const bf16_t*)(p.ws + OFF_PHI), (bf16_t*)(p.ws + OFF_ACC), (const float*)(p.ws + OFF_RS)};
    __syncthreads();
    pg8::gemm_phase<EpiMerge, pg8::StaticOrder, false, true>((PG8_LAS unsigned char*)(uintptr_t)256, g, S, E, nullptr);
    __syncthreads();
}
NOINL void f_wout(int l, int nmt) {
    const Params& p = kparams();
    pg8::Gemm g{(const bf16_t*)(p.ws + OFF_ACC), (const bf16_t*)(p.ws + OFF_WOUT), nmt * 256, 1024, 1024};
    pg8::StaticOrder S; S.init(nmt * 256, 1024, (int)gridDim.x, (int)blockIdx.x);
    EpiWout E{l == 0 ? p.in[I_X] : p.out, l == 0 ? p.in[I_CTX] : (const float*)(p.ws + OFF_XC), p.out, (float*)(p.ws + OFF_XC), (const float*)(p.ws + OFF_MOD) + (size_t)l * 9 * 6144 + 2048};
    __syncthreads();
    pg8::gemm_phase<EpiWout, pg8::StaticOrder, false>((PG8_LAS unsigned char*)(uintptr_t)256, g, S, E, nullptr);
    __syncthreads();
}
NOINL void f_router(int l, int nmt) { const Params& p = kparams(); char* lds = lds_at(256); const int tot = nmt * 256, rpb = (tot + (int)gridDim.x - 1) / (int)gridDim.x, r0 = (int)blockIdx.x * rpb; if (r0 < tot) router_unit(p, l, r0, min(tot, r0 + rpb), lds); }
NOINL void f_moe1(int l, int nmt) {
    const Params& p = kparams(); char* lds = lds_at(256);
    const MoeTab t = moe_tables(p, l, nmt * 256, lds);
    const int nrb = t.blkbase[65];
    pg8::Gemm g{(const bf16_t*)(p.ws + OFF_H), (const bf16_t*)(p.ws + OFF_WGU), nrb * 256, 512, 1024};
    Moe1Order S; S.init(nrb * 256, 512, (int)gridDim.x, (int)blockIdx.x);
    S.eb = (const unsigned char*)(t.cbase + 80); S.blkbase = t.blkbase; S.cnt = t.cnt; S.list = (const int*)(p.ws + OFF_LIST);
    EpiMoe1 E{(bf16_t*)(p.ws + OFF_HID)};
    __syncthreads();
    pg8::gemm_phase_gather<EpiMoe1, Moe1Order, false>((PG8_LAS unsigned char*)(uintptr_t)256, g, S, E, nullptr);
    __syncthreads();
}
NOINL void f_moe2(int l, int nmt) { const Params& p = kparams(); char* lds = lds_at(256); const MoeTab t = moe_tables(p, l, nmt * 256, lds); const int nrb = t.blkbase[65], s0 = t.blkbase[64];
    UNIT_LOOP(u, nrb, 0) { int rb = u + s0; if (rb >= nrb) rb -= nrb; moe2_unit(p, l, t, rb, lds); } }
NOINL void f_combine(int l, int nmt) { const Params& p = kparams(); char* lds = lds_at(256); const MoeTab t = moe_tables(p, l, nmt * 256, lds); const int tot = nmt * 256, rpb = (tot + (int)gridDim.x - 1) / (int)gridDim.x, r0 = (int)blockIdx.x * rpb; combine_unit(p, l, t, r0, min(tot, r0 + rpb)); }


#ifdef DIAG
struct DiagBuf { size_t off; size_t n; int kind; };
DEVI void diag_phase(const Params& p, const XcdBarrier& bar) {
    const DiagBuf bufs[] = {
        {OFF_MOD, 2 * 9 * 6144, 1}, {OFF_COS, 2 * 4096 * 16, 1}, {OFF_H2T, 4352 * 64, 1}, {OFF_WIN, (size_t)(WIN_G0 + 4096) * 1024, 0}, {OFF_WGU, (size_t)65 * 512 * 1024, 0},
        {OFF_WDT, (size_t)65 * 1024 * 256, 0}, {OFF_WUQ, (OFF_H - OFF_WUQ) / 2, 0}, {OFF_H, (size_t)TT * DM, 0}, {OFF_HS, (size_t)2 * 256 * 8192 * 2, 1}, {OFF_HSC, (size_t)2 * 256 * 512 * 2, 1},
        {OFF_Z, (size_t)TT * ZLD, 0}, {OFF_ZT, (size_t)8 * 1024 * NKEY, 0}, {OFF_YT, (size_t)8 * 256 * NKEY, 0}, {OFF_Q, (size_t)8 * 4 * NKEY * 96, 0}, {OFF_K, (size_t)8 * 4 * NKEY * 96, 0},
        {OFF_VT, (size_t)8 * 4 * 64 * NKEY, 0}, {OFF_HLOC, (size_t)2 * TT * 256, 0}, {OFF_CUMA, (size_t)2 * TT * 256, 0}, {OFF_SEGA, (size_t)4 * 1088 * 256, 1}, {OFF_BR, (size_t)TT * DM, 0},
        {OFF_XC, (size_t)TCX * DM, 1}, {OFF_WTS, (size_t)TT * 6, 1} };
    constexpr int NB = sizeof(bufs) / sizeof(bufs[0]);
    unsigned* flags = (unsigned*)(p.ws + OFF_GCNT) + 1024;
    xcd_barrier(bar);
    const size_t gtid = (size_t)blockIdx.x * 512 + threadIdx.x, gn = (size_t)gridDim.x * 512;
    for (int b = DIAG_FIRST; b < NB; ++b) {
        unsigned bad = 0, poi = 0;
        if (bufs[b].kind == 0) { const bf16_t* q = (const bf16_t*)(p.ws + bufs[b].off);
            for (size_t i = gtid; i < bufs[b].n; i += gn) { const unsigned v = q[i]; if ((v & 0x7F80u) == 0x7F80u || fabsf(bf2f((bf16_t)v)) > 1e5f) ++bad; if (v == 0xAAAAu) ++poi; } }
        else { const unsigned* q = (const unsigned*)(p.ws + bufs[b].off);
            for (size_t i = gtid; i < bufs[b].n; i += gn) { const unsigned v = q[i]; if ((v & 0x7F800000u) == 0x7F800000u || fabsf(__uint_as_float(v)) > 1e5f) ++bad; if (v == 0xAAAAAAAAu) ++poi; } }
        bad = (unsigned)wave_sum((float)bad); poi = (unsigned)wave_sum((float)poi);
        if ((threadIdx.x & 63) == 0) { if (bad) atomicAdd(&flags[2 * b], bad); if (poi) atomicAdd(&flags[2 * b + 1], poi); }
    }
    xcd_barrier(bar);
    float K = 1000.f, K2 = 0.f;
    for (int b = NB - 1; b >= DIAG_FIRST; --b) {
        const unsigned bad = __hip_atomic_load(&flags[2 * b], __ATOMIC_RELAXED, __HIP_MEMORY_SCOPE_AGENT), poi = __hip_atomic_load(&flags[2 * b + 1], __ATOMIC_RELAXED, __HIP_MEMORY_SCOPE_AGENT);
        if (bad) K = 1000.f * (float)(10 + b);
        else if ((size_t)poi * 2 > bufs[b].n) K = 1000.f * (float)(50 + b);
    }
#if DIAG_MODE == 1
    {
        float* acc = (float*)((unsigned*)(p.ws + OFF_GCNT) + 2048);
        float s = 0.f; const int b = DIAG_ARG;
        if (bufs[b].kind == 0) { const bf16_t* q = (const bf16_t*)(p.ws + bufs[b].off); for (size_t i = gtid; i < bufs[b].n; i += gn) { const float v = bf2f(q[i]); s += v * v; } }
        else { const float* q = (const float*)(p.ws + bufs[b].off); for (size_t i = gtid; i < bufs[b].n; i += gn) { const float v = q[i]; s += v * v; } }
        s = wave_sum(s); if ((threadIdx.x & 63) == 0) atomicAdd(acc, s);
        xcd_barrier(bar);
        K = 1000.f * sqrtf(__hip_atomic_load(acc, __ATOMIC_RELAXED, __HIP_MEMORY_SCOPE_AGENT) / (float)bufs[b].n);
    }
#elif DIAG_MODE == 5
    {
        unsigned* cn = (unsigned*)(p.ws + OFF_GCNT) + 2048;
        unsigned nn = 0, nz = 0;
        const unsigned char* q = (const unsigned char*)(p.ws + OFF_H8);
        for (size_t i = gtid; i < (size_t)TT * 1024; i += gn) { const unsigned v = q[i]; if ((v & 0x7Fu) == 0x7Fu) ++nz; }
        q = (const unsigned char*)(p.ws + OFF_WG8);
        for (size_t i = gtid; i < (size_t)4096 * 1024; i += gn) { const unsigned v = q[i]; if ((v & 0x7Fu) == 0x7Fu) ++nn; }
        nn = (unsigned)wave_sum((float)nn); nz = (unsigned)wave_sum((float)nz);
        if ((threadIdx.x & 63) == 0) { if (nn) atomicAdd(&cn[0], nn); if (nz) atomicAdd(&cn[1], nz); }
        xcd_barrier(bar);
        K = (float)__hip_atomic_load(&cn[0], __ATOMIC_RELAXED, __HIP_MEMORY_SCOPE_AGENT);
        K2 = (float)__hip_atomic_load(&cn[1], __ATOMIC_RELAXED, __HIP_MEMORY_SCOPE_AGENT);
    }
#elif DIAG_MODE == 2
    K = (float)__hip_atomic_load(&flags[2 * DIAG_ARG], __ATOMIC_RELAXED, __HIP_MEMORY_SCOPE_AGENT);
#elif DIAG_MODE == 3
    {
        unsigned* mn = (unsigned*)(p.ws + OFF_GCNT) + 2048;
        if (blockIdx.x == 0 && threadIdx.x == 0) __hip_atomic_store(mn, 0xFFFFFFFFu, __ATOMIC_RELAXED, __HIP_MEMORY_SCOPE_AGENT);
        xcd_barrier(bar);
        const int b = DIAG_ARG; unsigned best = 0xFFFFFFFFu;
        if (bufs[b].kind == 0) { const bf16_t* q = (const bf16_t*)(p.ws + bufs[b].off);
            for (size_t i = gtid; i < bufs[b].n; i += gn) { const unsigned v = q[i]; if (((v & 0x7F80u) == 0x7F80u || fabsf(bf2f((bf16_t)v)) > 1e5f) && (unsigned)i < best) best = (unsigned)i; } }
        if (best != 0xFFFFFFFFu) atomicMin(mn, best);
        xcd_barrier(bar);
        const unsigned r = __hip_atomic_load(mn, __ATOMIC_RELAXED, __HIP_MEMORY_SCOPE_AGENT);
        K = (float)((r / DIAG_DIV) % DIAG_MOD);
        K2 = 1000.f * (float)((r / DIAG_DIV2) % DIAG_MOD2);
#ifdef DIAG_ROW0
        { const bf16_t* q = (const bf16_t*)(p.ws + bufs[b].off); int cnt = 0, cnt2 = 0;
          for (int c2 = 0; c2 < ZLD; ++c2) { const unsigned v = q[(size_t)DIAG_ROW0 * ZLD + c2]; if ((v & 0x7F80u) == 0x7F80u) ++cnt; }
          for (int r2 = 0; r2 < 99; ++r2) { const unsigned v = q[(size_t)r2 * ZLD + DIAG_COL0]; if ((v & 0x7F80u) == 0x7F80u) ++cnt2; }
          K = (float)cnt; K2 = 1000.f * (float)cnt2; }
#endif
#ifdef DIAG_VAL
        { const unsigned v = ((const bf16_t*)(p.ws + bufs[b].off))[r]; const float f = fabsf(bf2f((bf16_t)v)); K = ((v & 0x7F80u) == 0x7F80u) ? ((v & 0x7Fu) ? 49.f : 48.f) : fminf(47.f, log2f(f) * 0.25f); }
#endif
    }
#endif
    for (size_t i = gtid; i < (size_t)TL * DM; i += gn) p.out[i] = (i == 12345 && K2 != 0.f) ? K2 : K;
}
#endif

__global__ void __launch_bounds__(512, 2) mega_fwd(Params p) {
    if (threadIdx.x == 0) *(uint4*)smem = make_uint4(0u, 0u, 0u, 0u);
    __syncthreads();
    XcdBarrier bar = xcd_barrier_post((unsigned*)(p.ws + OFF_BAR), (volatile LAS unsigned*)smem);
    int ph = 0;
#ifdef DIAGT
#define STAMP(i) do { if (blockIdx.x == 0 && threadIdx.x == 0) ((unsigned long long*)(p.ws + OFF_GCNT + 8192))[i] = wall_clock64(); } while (0)
#else
#define STAMP(i) do {} while (0)
#endif
#ifndef REP_PHASE
#define REP_PHASE -1
#endif
#define PHASE(...) do { if (ph >= p.ph_lo && ph < p.ph_hi) { STAMP(ph); __VA_ARGS__; if (ph == REP_PHASE) { xcd_barrier(bar); __VA_ARGS__; } if (ph + 1 < p.ph_hi) xcd_barrier(bar); } ++ph; } while (0)
    PHASE({ f_p0(); f_conv(0); f_h2tab(0); });
#define LAYER(l) do { \
        const int nmt = l == 0 ? NMT : 128; \
        PHASE({ f_norm1(l); if (l > 0) { f_conv(l); f_h2tab(l); } }); \
        PHASE({ f_spectrum(l); f_inproj(0); if (l == 0) f_spectrum_ctx(l); }); \
        PHASE({ const int nh = l == 0 ? 1088 : 1024, nn = l == 0 ? 544 : 512; f_hyena(l); f_na(l, nh); f_lru1(l, nh + nn); f_qproj(nh + nn + 1088); f_kvproj(nh + nn + 1088 + NMT * 2); }); \
        PHASE({ f_lrucarry(l); f_mla(l); f_lru2(l, l == 0 ? 544 : 512); f_ytrans((l == 0 ? 544 : 512) + 272); }); \
        PHASE({ f_quant(nmt); f_pbranch(nmt); }); \
        PHASE(f_merge(nmt)); \
        PHASE(f_wout(l, nmt)); \
        PHASE(f_router(l, nmt)); \
        PHASE(f_moe1(l, nmt)); \
        PHASE(f_moe2(l, nmt)); \
        PHASE(f_combine(l, nmt)); \
    } while (0)
    LAYER(0);
    LAYER(1);
#ifdef DIAG
    diag_phase(p, bar);
#endif
#ifdef DIAGT
    {
        xcd_barrier(bar); STAMP(ph); xcd_barrier(bar);
        const unsigned long long* ts = (const unsigned long long*)(p.ws + OFF_GCNT + 8192);
        const float K = (float)(__hip_atomic_load(ts + DIAGT_A + 1, __ATOMIC_RELAXED, __HIP_MEMORY_SCOPE_AGENT) - __hip_atomic_load(ts + DIAGT_A, __ATOMIC_RELAXED, __HIP_MEMORY_SCOPE_AGENT)) * 0.01f;
        const float K2 = (float)(__hip_atomic_load(ts + DIAGT_B + 1, __ATOMIC_RELAXED, __HIP_MEMORY_SCOPE_AGENT) - __hip_atomic_load(ts + DIAGT_B, __ATOMIC_RELAXED, __HIP_MEMORY_SCOPE_AGENT)) * 1.0f;
        const size_t gtid = (size_t)blockIdx.x * 512 + threadIdx.x, gn = (size_t)gridDim.x * 512;
        for (size_t i = gtid; i < (size_t)TL * DM; i += gn) p.out[i] = (i == 12345) ? K2 : K;
    }
#endif
}

extern "C" void kernel_launch(void* const* d_in, const int* in_sizes, int n_in, void* d_out, int out_size, void* d_ws, size_t ws_size, hipStream_t stream) {
    static int grid = 0;
    if (!grid) {
        int dev = 0, cus = 0, per_cu = 0;
        hipGetDevice(&dev);
        hipDeviceGetAttribute(&cus, hipDeviceAttributeMultiprocessorCount, dev);
        if (hipFuncSetAttribute((const void*)mega_fwd, hipFuncAttributeMaxDynamicSharedMemorySize, LDS_BYTES + 256) != hipSuccess) fprintf(stderr, "hipFuncSetAttribute failed\n");
        if (hipOccupancyMaxActiveBlocksPerMultiprocessor(&per_cu, (const void*)mega_fwd, 512, LDS_BYTES + 256) != hipSuccess || per_cu < 1) { fprintf(stderr, "occupancy query failed\n"); per_cu = 1; }
        grid = cus * 1;
        if (ws_size < WS_END) fprintf(stderr, "workspace too small: %zu < %zu\n", ws_size, (size_t)WS_END);
    }
    hipMemsetAsync(d_ws, 0, ZERO_BYTES, stream);
    Params p{};
    for (int i = 0; i < 41; ++i) p.in[i] = (const float*)d_in[i];
    p.out = (float*)d_out; p.ws = (char*)d_ws; p.ph_lo = 0; p.ph_hi = PH_HI;
    hipLaunchKernelGGL(mega_fwd, dim3(grid), dim3(512), LDS_BYTES + 256, stream, p);
}
```
